# Optimizing an MI355X kernel written in HIP

```python
import math
import jax, jax.numpy as jnp
from jax import lax
import numpy as np

D_MODEL = 1024
BATCH = 8
SEQ = 8192
DEPTH = 2

PLE_DIM = 256
D_FF = 2816
DA_QK_DIM = 64
DA_V_DIM = 2 * DA_QK_DIM
DA_HEADS = (D_MODEL // 2) // DA_V_DIM
DA_WIDTH = DA_HEADS * DA_V_DIM
SSM_GROUP = 16
SSM_WIDTH = D_MODEL // 4
SSM_GROUPS = SSM_WIDTH // SSM_GROUP
SSM_STATE = 64
SA_HEAD_DIM = 64
SA_WIDTH = D_MODEL // 4
SA_HEADS = SA_WIDTH // SA_HEAD_DIM
IDX_HEADS = 8
IDX_DIM = 32
TOPK_MAX = 256
REL_BUCKETS = 32
REL_MAX_DIST = 128
N_ATT_HEADS = DA_HEADS + SA_HEADS
Q_BLOCK = 128
D_MIX = DA_WIDTH + SSM_WIDTH + SA_WIDTH
ALPHA = (2 * DEPTH) ** 0.25
BETA = (8 * DEPTH) ** -0.25
LN_EPS = 1e-5
IN_SIZES = (DA_HEADS * 2 * DA_QK_DIM, DA_HEADS * 2 * DA_QK_DIM, DA_HEADS * DA_V_DIM,
            SSM_WIDTH,
            SA_HEADS * SA_HEAD_DIM, SA_HEAD_DIM, SA_HEAD_DIM,
            IDX_HEADS * IDX_DIM, IDX_DIM, IDX_HEADS)
IN_COLS = sum(IN_SIZES)

kernel_name = "hybrid_diffattn_s5_dsa_macaron_deepnorm"


def layer_norm(x, g, b):
    xf = x.astype(jnp.float32)
    mu = xf.mean(-1, keepdims=True)
    var = jnp.square(xf - mu).mean(-1, keepdims=True)
    return ((xf - mu) * lax.rsqrt(var + LN_EPS) * g + b).astype(x.dtype)


def rms_norm(x, g):
    xf = x.astype(jnp.float32)
    return (xf * lax.rsqrt(jnp.mean(xf * xf, -1, keepdims=True) + LN_EPS) * g).astype(x.dtype)


def swiglu(x, w_gate, w_up, w_down):
    return (jax.nn.silu(x @ w_gate) * (x @ w_up)) @ w_down


def t5_bucket(rel):
    n = jnp.maximum(rel, 0)
    max_exact = REL_BUCKETS // 2
    nf = jnp.maximum(n, 1).astype(jnp.float32)
    large = max_exact + (jnp.log(nf / max_exact) / math.log(REL_MAX_DIST / max_exact)
                         * (REL_BUCKETS - max_exact)).astype(jnp.int32)
    large = jnp.minimum(large, REL_BUCKETS - 1)
    return jnp.where(n < max_exact, n, large)


def diff_attention(q, k, v, lam, bias_table):
    bsz, L, H = q.shape[0], q.shape[1], q.shape[2]
    nb = L // Q_BLOCK
    scale = DA_QK_DIM ** -0.5
    key_pos = jnp.arange(L)
    q_blocks = q.reshape(bsz, nb, Q_BLOCK, H, 2, DA_QK_DIM).swapaxes(0, 1)

    def block(args):
        qb, start = args
        qpos = start + jnp.arange(Q_BLOCK)
        rel = qpos[:, None] - key_pos[None, :]
        bias = bias_table[t5_bucket(rel)].transpose(2, 0, 1).astype(jnp.float32)
        s = jnp.einsum('bqhcd,bshcd->bhcqs', qb, k).astype(jnp.float32) * scale + bias[None, :, None]
        s = jnp.where(rel >= 0, s, -jnp.inf)
        pr = jax.nn.softmax(s, axis=-1)
        a = (pr[:, :, 0] - lam * pr[:, :, 1]).astype(v.dtype)
        return jnp.einsum('bhqs,bshe->bqhe', a, v)

    o = lax.map(block, (q_blocks, jnp.arange(nb) * Q_BLOCK))
    return o.swapaxes(0, 1).reshape(bsz, L, H, DA_V_DIM)


def _ssm_combine(e1, e2):
    a1r, a1i, b1r, b1i = e1
    a2r, a2i, b2r, b2i = e2
    return (a2r * a1r - a2i * a1i, a2r * a1i + a2i * a1r,
            a2r * b1r - a2i * b1i + b2r, a2r * b1i + a2i * b1r + b2i)


def s5_ssm(u, lam_re, lam_im, log_dt, b_re, b_im, c_re, c_im, d_skip, w_glu):
    f32 = jnp.float32
    bsz, L, _ = u.shape
    ug = u.reshape(bsz, L, SSM_GROUPS, SSM_GROUP).astype(f32)
    dt = jnp.exp(log_dt.astype(f32))[:, None]
    lr, li = lam_re.astype(f32), lam_im.astype(f32)
    mag = jnp.exp(lr * dt)
    ab_re, ab_im = mag * jnp.cos(li * dt), mag * jnp.sin(li * dt)
    den = lr * lr + li * li
    nr, ni = ab_re - 1.0, ab_im
    f_re, f_im = (nr * lr + ni * li) / den, (ni * lr - nr * li) / den
    br, bi = b_re.astype(f32), b_im.astype(f32)
    bb_re = f_re[..., None] * br - f_im[..., None] * bi
    bb_im = f_re[..., None] * bi + f_im[..., None] * br
    bu_re = jnp.einsum('gpc,blgc->blgp', bb_re, ug)
    bu_im = jnp.einsum('gpc,blgc->blgp', bb_im, ug)
    a_re = jnp.broadcast_to(ab_re, bu_re.shape)
    a_im = jnp.broadcast_to(ab_im, bu_re.shape)
    _, _, x_re, x_im = lax.associative_scan(_ssm_combine, (a_re, a_im, bu_re, bu_im), axis=1)
    y = (jnp.einsum('gcp,blgp->blgc', c_re.astype(f32), x_re)
         - jnp.einsum('gcp,blgp->blgc', c_im.astype(f32), x_im))
    y = y + d_skip.astype(f32).reshape(SSM_GROUPS, SSM_GROUP) * ug
    y = jax.nn.gelu(y.reshape(bsz, L, SSM_WIDTH))
    y = y * jax.nn.sigmoid(y @ w_glu.astype(f32))
    return y.astype(u.dtype)


def dsa_attention(q, k, v, qi, ki, wi, bias_table):
    bsz, L = q.shape[0], q.shape[1]
    topk = min(TOPK_MAX, L // 4)
    nb = L // Q_BLOCK
    key_pos = jnp.arange(L)
    scale = SA_HEAD_DIM ** -0.5
    w_scale = IDX_HEADS ** -0.5 * IDX_DIM ** -0.5

    def to_blocks(a):
        return a.reshape(bsz, nb, Q_BLOCK, *a.shape[2:]).swapaxes(0, 1)

    def block(args):
        qb, qib, wib, start = args
        qpos = start + jnp.arange(Q_BLOCK)
        iscore = jax.nn.relu(jnp.einsum('bqhd,bsd->bqhs', qib, ki).astype(jnp.float32))
        iscore = jnp.einsum('bqhs,bqh->bqs', iscore, wib.astype(jnp.float32) * w_scale)
        iscore = jnp.where(key_pos[None, :] <= qpos[:, None], iscore, -jnp.inf)
        _, idx = lax.top_k(iscore, topk)
        k_sel = jax.vmap(lambda kk, ii: kk[ii])(k, idx)
        v_sel = jax.vmap(lambda vv, ii: vv[ii])(v, idx)
        rel = qpos[None, :, None] - idx
        bias = bias_table[t5_bucket(rel)].transpose(0, 3, 1, 2).astype(jnp.float32)
        s = jnp.einsum('bqhd,bqkd->bhqk', qb, k_sel).astype(jnp.float32) * scale + bias
        s = jnp.where((rel >= 0)[:, None], s, -jnp.inf)
        pr = jax.nn.softmax(s, axis=-1).astype(v.dtype)
        return jnp.einsum('bhqk,bqkd->bqhd', pr, v_sel)

    o = lax.map(block, (to_blocks(q), to_blocks(qi), to_blocks(wi), jnp.arange(nb) * Q_BLOCK))
    return o.swapaxes(0, 1).reshape(bsz, L, SA_WIDTH)


def hybrid_mixer(x, w_in, w_o, lam_q1, lam_k1, lam_q2, lam_k2, lam_init, subln_g,
                 ssm_lam_re, ssm_lam_im, ssm_log_dt, ssm_b_re, ssm_b_im, ssm_c_re, ssm_c_im,
                 ssm_d, ssm_w_glu, rel_bias):
    bsz, L, _ = x.shape
    h = x @ w_in
    offsets = [int(o) for o in np.cumsum(IN_SIZES)[:-1]]
    da_q, da_k, da_v, ssm_u, sa_q, sa_k, sa_v, ix_q, ix_k, ix_w = jnp.split(h, offsets, axis=-1)
    lam = (jnp.exp(jnp.sum(lam_q1.astype(jnp.float32) * lam_k1))
           - jnp.exp(jnp.sum(lam_q2.astype(jnp.float32) * lam_k2)) + lam_init)
    o_da = diff_attention(da_q.reshape(bsz, L, DA_HEADS, 2, DA_QK_DIM),
                          da_k.reshape(bsz, L, DA_HEADS, 2, DA_QK_DIM),
                          da_v.reshape(bsz, L, DA_HEADS, DA_V_DIM),
                          lam, rel_bias[:, :DA_HEADS])
    o_da = (rms_norm(o_da, subln_g) * (1.0 - lam_init)).reshape(bsz, L, DA_WIDTH)
    o_ssm = s5_ssm(ssm_u, ssm_lam_re, ssm_lam_im, ssm_log_dt, ssm_b_re, ssm_b_im,
                   ssm_c_re, ssm_c_im, ssm_d, ssm_w_glu)
    o_sa = dsa_attention(sa_q.reshape(bsz, L, SA_HEADS, SA_HEAD_DIM), sa_k, sa_v,
                         ix_q.reshape(bsz, L, IDX_HEADS, IDX_DIM), ix_k, ix_w,
                         rel_bias[:, DA_HEADS:])
    return jnp.concatenate([o_da, o_ssm, o_sa], axis=-1) @ w_o


def setup_inputs(seed: int = 0) -> dict:
    key = jax.random.key(seed)
    ks = iter(jax.random.split(key, 40))
    f32 = jnp.float32

    def nrm(shape, scale):
        return jax.random.normal(next(ks), shape, f32) * scale

    def gain(shape):
        return 1.0 + nrm(shape, 0.02)

    N = DEPTH
    n_idx = jnp.arange(SSM_STATE, dtype=f32)
    log_dt = jax.random.uniform(next(ks), (N, SSM_GROUPS), f32, math.log(1e-3), math.log(1e-1))
    return {
        'x': nrm((BATCH, SEQ, D_MODEL), 1.0),
        'p': nrm((DEPTH, BATCH, SEQ, PLE_DIM), 1.0),
        'rel_bias': nrm((REL_BUCKETS, N_ATT_HEADS), 0.5),
        'ffn1_w_gate': nrm((N, D_MODEL, D_FF), D_MODEL ** -0.5),
        'ffn1_w_up': nrm((N, D_MODEL, D_FF), D_MODEL ** -0.5),
        'ffn1_w_down': nrm((N, D_FF, D_MODEL), D_FF ** -0.5 * BETA),
        'ln1_g': gain((N, D_MODEL)),
        'ln1_b': nrm((N, D_MODEL), 0.02),
        'w_in': nrm((N, D_MODEL, IN_COLS), D_MODEL ** -0.5),
        'w_o': nrm((N, D_MIX, D_MODEL), D_MIX ** -0.5 * BETA),
        'da_lam_q1': nrm((N, DA_QK_DIM), 0.1),
        'da_lam_k1': nrm((N, DA_QK_DIM), 0.1),
        'da_lam_q2': nrm((N, DA_QK_DIM), 0.1),
        'da_lam_k2': nrm((N, DA_QK_DIM), 0.1),
        'da_subln_g': gain((N, DA_V_DIM)),
        'ssm_lam_re': -0.5 + nrm((N, SSM_GROUPS, SSM_STATE), 0.01),
        'ssm_lam_im': jnp.pi * n_idx + nrm((N, SSM_GROUPS, SSM_STATE), 0.01),
        'ssm_log_dt': log_dt,
        'ssm_b_re': nrm((N, SSM_GROUPS, SSM_STATE, SSM_GROUP), (2.0 * SSM_GROUP) ** -0.5),
        'ssm_b_im': nrm((N, SSM_GROUPS, SSM_STATE, SSM_GROUP), (2.0 * SSM_GROUP) ** -0.5),
        'ssm_c_re': nrm((N, SSM_GROUPS, SSM_GROUP, SSM_STATE), SSM_STATE ** -0.5),
        'ssm_c_im': nrm((N, SSM_GROUPS, SSM_GROUP, SSM_STATE), SSM_STATE ** -0.5),
        'ssm_d': nrm((N, SSM_WIDTH), 1.0),
        'ssm_w_glu': nrm((N, SSM_WIDTH, SSM_WIDTH), SSM_WIDTH ** -0.5),
        'ln2_g': gain((N, D_MODEL)),
        'ln2_b': nrm((N, D_MODEL), 0.02),
        'ffn2_w_gate': nrm((N, D_MODEL, D_FF), D_MODEL ** -0.5),
        'ffn2_w_up': nrm((N, D_MODEL, D_FF), D_MODEL ** -0.5),
        'ffn2_w_down': nrm((N, D_FF, D_MODEL), D_FF ** -0.5 * BETA),
        'ple_w_proj': nrm((N, PLE_DIM, D_MODEL), PLE_DIM ** -0.5 * BETA),
        'ple_w_gate': nrm((N, D_MODEL, D_MODEL), D_MODEL ** -0.5),
        'ln3_g': gain((N, D_MODEL)),
        'ln3_b': nrm((N, D_MODEL), 0.02),
    }


def reference(x, p, rel_bias, ffn1_w_gate, ffn1_w_up, ffn1_w_down, ln1_g, ln1_b,
              w_in, w_o, da_lam_q1, da_lam_k1, da_lam_q2, da_lam_k2, da_subln_g,
              ssm_lam_re, ssm_lam_im, ssm_log_dt, ssm_b_re, ssm_b_im, ssm_c_re, ssm_c_im,
              ssm_d, ssm_w_glu, ln2_g, ln2_b, ffn2_w_gate, ffn2_w_up, ffn2_w_down,
              ple_w_proj, ple_w_gate, ln3_g, ln3_b):
    for i in range(DEPTH):
        lam_init = 0.8 - 0.6 * math.exp(-0.3 * i)
        x = layer_norm(ALPHA * x + 0.5 * swiglu(x, ffn1_w_gate[i], ffn1_w_up[i], ffn1_w_down[i]),
                       ln1_g[i], ln1_b[i])
        mix = hybrid_mixer(x, w_in[i], w_o[i], da_lam_q1[i], da_lam_k1[i], da_lam_q2[i], da_lam_k2[i],
                           lam_init, da_subln_g[i], ssm_lam_re[i], ssm_lam_im[i], ssm_log_dt[i],
                           ssm_b_re[i], ssm_b_im[i], ssm_c_re[i], ssm_c_im[i], ssm_d[i], ssm_w_glu[i],
                           rel_bias)
        x = layer_norm(ALPHA * x + mix, ln2_g[i], ln2_b[i])
        ple = (p[i] @ ple_w_proj[i]) * jax.nn.sigmoid(x @ ple_w_gate[i])
        x = layer_norm(ALPHA * x + 0.5 * swiglu(x, ffn2_w_gate[i], ffn2_w_up[i], ffn2_w_down[i]) + ple,
                       ln3_g[i], ln3_b[i])
    return x
```

```cpp
#include <hip/hip_runtime.h>
#include <hip/hip_cooperative_groups.h>
#include <stdint.h>
#include <math.h>
#include <stdio.h>
#include <string.h>
namespace cg = cooperative_groups;

#ifndef MULTI_LAUNCH
#define MULTI_LAUNCH 0
#endif

typedef unsigned short u16;
typedef __attribute__((ext_vector_type(8))) short bf16x8;
typedef __attribute__((ext_vector_type(4))) short s16x4;
typedef __attribute__((ext_vector_type(16))) float f32x16;
typedef __attribute__((ext_vector_type(4))) unsigned u32x4;
typedef __attribute__((ext_vector_type(2))) unsigned u32x2;

#define DI __device__ __forceinline__
#define MFMA32(a, b, c) __builtin_amdgcn_mfma_f32_32x32x16_bf16((a), (b), (c), 0, 0, 0)

constexpr int T_ = 65536;
constexpr int L_ = 8192;
constexpr int D_ = 1024;
constexpr int FF_ = 2816;
constexpr float ALPHA_ = 1.41421356237309515f;
constexpr float LN_EPS_ = 1e-5f;
constexpr float LOG2E_ = 1.44269504088896341f;
constexpr int LDS_BYTES = 73728;

constexpr size_t SZ_WGU = (size_t)5632 * 1024 * 2;
constexpr size_t SZ_WD = (size_t)1024 * 2816 * 2;
constexpr size_t SZ_WIN = (size_t)2560 * 1024 * 2;
constexpr size_t SZ_WO = (size_t)1024 * 1024 * 2;
constexpr size_t SZ_WGLU = (size_t)256 * 256 * 2;
constexpr size_t SZ_WPG = (size_t)1024 * 1024 * 2;
constexpr size_t SZ_WPP = (size_t)1024 * 256 * 2;
constexpr size_t OFF_WGU1 = 0;
constexpr size_t OFF_WD1 = OFF_WGU1 + 2 * SZ_WGU;
constexpr size_t OFF_WGU2 = OFF_WD1 + 2 * SZ_WD;
constexpr size_t OFF_WD2 = OFF_WGU2 + 2 * SZ_WGU;
constexpr size_t OFF_WIN = OFF_WD2 + 2 * SZ_WD;
constexpr size_t OFF_WO = OFF_WIN + 2 * SZ_WIN;
constexpr size_t OFF_WGLU = OFF_WO + 2 * SZ_WO;
constexpr size_t OFF_WPG = OFF_WGLU + 2 * SZ_WGLU;
constexpr size_t OFF_WPP = OFF_WPG + 2 * SZ_WPG;
constexpr size_t OFF_COEFA = OFF_WPP + 2 * SZ_WPP;
constexpr size_t OFF_COEFB = OFF_COEFA + 2 * 16 * 64 * 16;
constexpr size_t OFF_LAM = OFF_COEFB + 2 * 16 * 64 * 16 * 8;
constexpr size_t OFF_BIAS = OFF_LAM + 256;
constexpr size_t OFF_XB = OFF_BIAS + 8 * 129 * 4 + 32;
constexpr size_t OFF_PB = OFF_XB + (size_t)T_ * 1024 * 2;
constexpr size_t OFF_H = OFF_PB + (size_t)2 * T_ * 256 * 2;
constexpr size_t SZ_H = (size_t)384 << 20;
constexpr size_t OFF_CC = OFF_H + SZ_H;
constexpr size_t WS_END = OFF_CC + (size_t)T_ * 1024 * 2;
constexpr size_t MB_ = (size_t)1 << 20;
constexpr size_t M_QD = 0, M_KD = 64 * MB_, M_VT = 128 * MB_, M_U = 192 * MB_, M_QS = 256 * MB_, M_QI = 288 * MB_, M_YG = 320 * MB_,
                 M_KS = 352 * MB_, M_VS = 360 * MB_, M_KI = 368 * MB_, M_WI = 372 * MB_, M_SEND = 374 * MB_;

struct Params {
  const float* in[33];
  float* out;
  char* ws;
};

DI int tidx() { int t = threadIdx.x; asm volatile("" : "+v"(t)); return t; }
DI char* WS(const Params& P) { char* w = P.ws; asm volatile("" : "+s"(w)); return w; }
DI float* OUTP(const Params& P) { float* w = P.out; asm volatile("" : "+s"(w)); return w; }
DI u16 f2bf(float x) { unsigned u = __float_as_uint(x); u += 0x7fffu + ((u >> 16) & 1u); return (u16)(u >> 16); }
DI float bf2f(u16 v) { return __uint_as_float(((unsigned)v) << 16); }
DI unsigned pack2(float a, float b) { return (unsigned)f2bf(a) | ((unsigned)f2bf(b) << 16); }
DI int crow(int i, int hh) { return (i & 3) + 8 * (i >> 2) + 4 * hh; }
DI float sigmoidf_(float x) { return 1.f / (1.f + __expf(-x)); }
DI float wave_sum(float v) { for (int o = 32; o > 0; o >>= 1) v += __shfl_xor(v, o); return v; }
DI float wave_max(float v) { for (int o = 32; o > 0; o >>= 1) v = fmaxf(v, __shfl_xor(v, o)); return v; }
DI f32x16 zero16() { f32x16 z; for (int i = 0; i < 16; i++) z[i] = 0.f; return z; }
DI bf16x8 pack8(const f32x16& x, int s) {
  union { unsigned u[4]; bf16x8 v; } t;
  t.u[0] = pack2(x[8 * s + 0], x[8 * s + 1]); t.u[1] = pack2(x[8 * s + 2], x[8 * s + 3]);
  t.u[2] = pack2(x[8 * s + 4], x[8 * s + 5]); t.u[3] = pack2(x[8 * s + 6], x[8 * s + 7]);
  return t.v;
}

constexpr int GS_ = 72;
constexpr int GT_ = 128 * GS_;

DI void gemm_mainloop(f32x16 (&acc)[2][2], const u16* __restrict__ A, int lda, const u16* __restrict__ B, int ldb, int K, u16* sm) {
  const int tid = tidx(), lane = tid & 63, wave = tid >> 6;
  const int wm = wave >> 1, wn = wave & 1, r = lane & 31, hh = lane >> 5;
  const int srow = tid >> 3, sk = (tid & 7) * 8;
  const u16* Ap = A + (size_t)srow * lda + sk;
  const u16* Bp = B + (size_t)srow * ldb + sk;
  u32x4 ra[4], rb[4];
#pragma unroll
  for (int i = 0; i < 4; i++) { ra[i] = *(const u32x4*)(Ap + (size_t)i * 32 * lda); rb[i] = *(const u32x4*)(Bp + (size_t)i * 32 * ldb); }
  __syncthreads();
#pragma unroll
  for (int i = 0; i < 4; i++) { *(u32x4*)(sm + (srow + i * 32) * GS_ + sk) = ra[i]; *(u32x4*)(sm + GT_ + (srow + i * 32) * GS_ + sk) = rb[i]; }
  __syncthreads();
  const int nk = K >> 6;
  for (int kt = 0; kt < nk; kt++) {
    u16* sA = sm + (kt & 1) * 2 * GT_;
    u16* sB = sA + GT_;
    if (kt + 1 < nk) {
      const int ko = (kt + 1) * 64;
#pragma unroll
      for (int i = 0; i < 4; i++) { ra[i] = *(const u32x4*)(Ap + (size_t)i * 32 * lda + ko); rb[i] = *(const u32x4*)(Bp + (size_t)i * 32 * ldb + ko); }
    }
#pragma unroll
    for (int ks = 0; ks < 4; ks++) {
      bf16x8 a0 = *(const bf16x8*)(sA + (wm * 64 + r) * GS_ + ks * 16 + hh * 8);
      bf16x8 a1 = *(const bf16x8*)(sA + (wm * 64 + 32 + r) * GS_ + ks * 16 + hh * 8);
      bf16x8 b0 = *(const bf16x8*)(sB + (wn * 64 + r) * GS_ + ks * 16 + hh * 8);
      bf16x8 b1 = *(const bf16x8*)(sB + (wn * 64 + 32 + r) * GS_ + ks * 16 + hh * 8);
      acc[0][0] = MFMA32(a0, b0, acc[0][0]);
      acc[0][1] = MFMA32(a0, b1, acc[0][1]);
      acc[1][0] = MFMA32(a1, b0, acc[1][0]);
      acc[1][1] = MFMA32(a1, b1, acc[1][1]);
    }
    if (kt + 1 < nk) {
      u16* dA = sm + ((kt + 1) & 1) * 2 * GT_;
#pragma unroll
      for (int i = 0; i < 4; i++) { *(u32x4*)(dA + (srow + i * 32) * GS_ + sk) = ra[i]; *(u32x4*)(dA + GT_ + (srow + i * 32) * GS_ + sk) = rb[i]; }
    }
    __syncthreads();
  }
}

DI bool tile_at(int it, int bid, int nb, int TM, int TN, int& tm, int& tn) {
  if ((nb & 7) == 0 && (TM & 63) == 0) {
    const int xcd = bid & 7, lw = bid >> 3, nlw = nb >> 3;
    const int lt = lw + it * nlw, per = (TM >> 3) * TN;
    if (lt >= per) return false;
    const int g = lt / (8 * TN), rem = lt - g * 8 * TN;
    tn = rem >> 3; tm = xcd * (TM >> 3) + g * 8 + (rem & 7);
    return true;
  } else {
    const int t = bid + it * nb;
    if (t >= TM * TN) return false;
    tn = t / TM; tm = t - tn * TM;
    return true;
  }
}

DI void transpose_job(const float* __restrict__ src, int K, int N, u16* __restrict__ dst, int mode, int bid, int nb, float* tile) {
  const int tid = tidx();
  const int tk = K >> 6, tn = (N + 63) >> 6;
  for (int t = bid; t < tk * tn; t += nb) {
    const int k0 = (t % tk) * 64, n0 = (t / tk) * 64;
    __syncthreads();
#pragma unroll 4
    for (int i = 0; i < 16; i++) {
      const int k = i * 4 + (tid >> 6), n = tid & 63;
      tile[k * 65 + n] = (n0 + n < N) ? src[(size_t)(k0 + k) * N + n0 + n] : 0.f;
    }
    __syncthreads();
#pragma unroll 4
    for (int i = 0; i < 16; i++) {
      const int n = i * 4 + (tid >> 6), k = tid & 63;
      const int ng = n0 + n;
      if (ng < N) {
        int row = ng;
        if (mode == 1) row = (ng >> 5) * 64 + (ng & 31);
        else if (mode == 2) row = (ng >> 5) * 64 + 32 + (ng & 31);
        dst[(size_t)row * K + k0 + k] = f2bf(tile[k * 65 + n]);
      }
    }
  }
}

DI void phase_prep(const Params& P, int bid, int nb, char* smem) {
  float* tile = (float*)smem;
  char* ws = WS(P);
  for (int l = 0; l < 2; l++) {
    transpose_job(P.in[3] + (size_t)l * 1024 * FF_, 1024, FF_, (u16*)(ws + OFF_WGU1 + l * SZ_WGU), 1, bid, nb, tile);
    transpose_job(P.in[4] + (size_t)l * 1024 * FF_, 1024, FF_, (u16*)(ws + OFF_WGU1 + l * SZ_WGU), 2, bid, nb, tile);
    transpose_job(P.in[5] + (size_t)l * FF_ * 1024, FF_, 1024, (u16*)(ws + OFF_WD1 + l * SZ_WD), 0, bid, nb, tile);
    transpose_job(P.in[26] + (size_t)l * 1024 * FF_, 1024, FF_, (u16*)(ws + OFF_WGU2 + l * SZ_WGU), 1, bid, nb, tile);
    transpose_job(P.in[27] + (size_t)l * 1024 * FF_, 1024, FF_, (u16*)(ws + OFF_WGU2 + l * SZ_WGU), 2, bid, nb, tile);
    transpose_job(P.in[28] + (size_t)l * FF_ * 1024, FF_, 1024, (u16*)(ws + OFF_WD2 + l * SZ_WD), 0, bid, nb, tile);
    transpose_job(P.in[8] + (size_t)l * 1024 * 2472, 1024, 2472, (u16*)(ws + OFF_WIN + l * SZ_WIN), 0, bid, nb, tile);
    transpose_job(P.in[9] + (size_t)l * 1024 * 1024, 1024, 1024, (u16*)(ws + OFF_WO + l * SZ_WO), 0, bid, nb, tile);
    transpose_job(P.in[23] + (size_t)l * 256 * 256, 256, 256, (u16*)(ws + OFF_WGLU + l * SZ_WGLU), 0, bid, nb, tile);
    transpose_job(P.in[30] + (size_t)l * 1024 * 1024, 1024, 1024, (u16*)(ws + OFF_WPG + l * SZ_WPG), 0, bid, nb, tile);
    transpose_job(P.in[29] + (size_t)l * 256 * 1024, 256, 1024, (u16*)(ws + OFF_WPP + l * SZ_WPP), 0, bid, nb, tile);
    u16* win = (u16*)(ws + OFF_WIN + l * SZ_WIN);
    for (int i = bid * 256 + tidx(); i < 88 * 1024; i += nb * 256) win[(size_t)2472 * 1024 + i] = 0;
  }
  const size_t gt = (size_t)bid * 256 + tidx(), gs = (size_t)nb * 256;
  {
    const float4* x4 = (const float4*)P.in[0];
    uint2* xb = (uint2*)(ws + OFF_XB);
    for (size_t i = gt; i < (size_t)T_ * 1024 / 4; i += gs) { float4 v = x4[i]; xb[i] = make_uint2(pack2(v.x, v.y), pack2(v.z, v.w)); }
    const float4* p4 = (const float4*)P.in[1];
    uint2* pb = (uint2*)(ws + OFF_PB);
    for (size_t i = gt; i < (size_t)2 * T_ * 256 / 4; i += gs) { float4 v = p4[i]; pb[i] = make_uint2(pack2(v.x, v.y), pack2(v.z, v.w)); }
  }
  if (gt < 2 * 16 * 64) {
    const int l = (int)gt >> 10, g = ((int)gt >> 6) & 15, p = (int)gt & 63;
    const int gi = (l * 16 + g) * 64 + p;
    const double lr = P.in[15][gi], li = P.in[16][gi];
    const double dt = exp((double)P.in[17][l * 16 + g]);
    const double mag = exp(lr * dt);
    const double ar = mag * cos(li * dt), ai = mag * sin(li * dt);
    const double mag5 = exp(512.0 * lr * dt);
    const double a5r = mag5 * cos(512.0 * li * dt), a5i = mag5 * sin(512.0 * li * dt);
    ((float4*)(ws + OFF_COEFA))[gi] = make_float4((float)ar, (float)ai, (float)a5r, (float)a5i);
    const double den = lr * lr + li * li, nr = ar - 1.0, ni = ai;
    const double fr = (nr * lr + ni * li) / den, fi = (ni * lr - nr * li) / den;
    float2* cb = (float2*)(ws + OFF_COEFB) + (size_t)gi * 16;
    for (int c = 0; c < 16; c++) {
      const double br = P.in[18][(size_t)gi * 16 + c], bi = P.in[19][(size_t)gi * 16 + c];
      cb[c] = make_float2((float)(fr * br - fi * bi), (float)(fr * bi + fi * br));
    }
  }
  if (gt < 8 * 129) {
    const int hd = (int)gt / 129, n = (int)gt - hd * 129;
    int bk = n;
    if (n >= 16) { bk = 16 + (int)(log((double)n / 16.0) / log(8.0) * 16.0); bk = bk < 31 ? bk : 31; }
    ((float*)(ws + OFF_BIAS))[gt] = P.in[2][bk * 8 + hd];
  }
  if (gt < 2) {
    const int l = (int)gt;
    float s1 = 0.f, s2 = 0.f;
    for (int i = 0; i < 64; i++) { s1 += P.in[10][l * 64 + i] * P.in[11][l * 64 + i]; s2 += P.in[12][l * 64 + i] * P.in[13][l * 64 + i]; }
    const float lam_init = 0.8f - 0.6f * expf(-0.3f * (float)l);
    ((float*)(ws + OFF_LAM))[l] = expf(s1) - expf(s2) + lam_init;
  }
}

DI void phase_ffn_up(const u16* __restrict__ Xb, const u16* __restrict__ Wgu, u16* __restrict__ H, int bid, int nb, u16* sm) {
  const int lane = tidx() & 63, wave = tidx() >> 6, wm = wave >> 1, wn = wave & 1, r = lane & 31, hh = lane >> 5;
  int tm, tn;
  for (int it = 0; tile_at(it, bid, nb, 512, 44, tm, tn); it++) {
    f32x16 acc[2][2] = {{zero16(), zero16()}, {zero16(), zero16()}};
    gemm_mainloop(acc, Xb + (size_t)tm * 128 * 1024, 1024, Wgu + (size_t)tn * 128 * 1024, 1024, 1024, sm);
    const int j = tn * 64 + wn * 32 + r;
#pragma unroll
    for (int mi = 0; mi < 2; mi++)
#pragma unroll
      for (int i = 0; i < 16; i++) {
        const int row = tm * 128 + wm * 64 + mi * 32 + crow(i, hh);
        const float g = acc[mi][0][i], u = acc[mi][1][i];
        H[(size_t)row * FF_ + j] = f2bf(g * sigmoidf_(g) * u);
      }
  }
}

DI void phase_ffn_down(const u16* __restrict__ H, const u16* __restrict__ Wd, const float* xin, float* xout, const u16* __restrict__ ple, int bid, int nb, u16* sm) {
  const int lane = tidx() & 63, wave = tidx() >> 6, wm = wave >> 1, wn = wave & 1, r = lane & 31, hh = lane >> 5;
  int tm, tn;
  for (int it = 0; tile_at(it, bid, nb, 512, 8, tm, tn); it++) {
    f32x16 acc[2][2] = {{zero16(), zero16()}, {zero16(), zero16()}};
    gemm_mainloop(acc, H + (size_t)tm * 128 * FF_, FF_, Wd + (size_t)tn * 128 * FF_, FF_, FF_, sm);
#pragma unroll
    for (int mi = 0; mi < 2; mi++)
#pragma unroll
      for (int ni = 0; ni < 2; ni++)
#pragma unroll
        for (int i = 0; i < 16; i++) {
          const size_t o = (size_t)(tm * 128 + wm * 64 + mi * 32 + crow(i, hh)) * 1024 + tn * 128 + wn * 64 + ni * 32 + r;
          float v = ALPHA_ * xin[o] + 0.5f * acc[mi][ni][i];
          if (ple) v += bf2f(ple[o]);
          xout[o] = v;
        }
  }
}

DI void phase_w_o(const u16* __restrict__ CC, const u16* __restrict__ Wo, float* x, int bid, int nb, u16* sm) {
  const int lane = tidx() & 63, wave = tidx() >> 6, wm = wave >> 1, wn = wave & 1, r = lane & 31, hh = lane >> 5;
  int tm, tn;
  for (int it = 0; tile_at(it, bid, nb, 512, 8, tm, tn); it++) {
    f32x16 acc[2][2] = {{zero16(), zero16()}, {zero16(), zero16()}};
    gemm_mainloop(acc, CC + (size_t)tm * 128 * 1024, 1024, Wo + (size_t)tn * 128 * 1024, 1024, 1024, sm);
#pragma unroll
    for (int mi = 0; mi < 2; mi++)
#pragma unroll
      for (int ni = 0; ni < 2; ni++)
#pragma unroll
        for (int i = 0; i < 16; i++) {
          const size_t o = (size_t)(tm * 128 + wm * 64 + mi * 32 + crow(i, hh)) * 1024 + tn * 128 + wn * 64 + ni * 32 + r;
          x[o] = ALPHA_ * x[o] + acc[mi][ni][i];
        }
  }
}

DI void phase_glu(const u16* __restrict__ Yg, const u16* __restrict__ Wglu, u16* __restrict__ CC, int bid, int nb, u16* sm) {
  const int lane = tidx() & 63, wave = tidx() >> 6, wm = wave >> 1, wn = wave & 1, r = lane & 31, hh = lane >> 5;
  int tm, tn;
  for (int it = 0; tile_at(it, bid, nb, 512, 2, tm, tn); it++) {
    f32x16 acc[2][2] = {{zero16(), zero16()}, {zero16(), zero16()}};
    gemm_mainloop(acc, Yg + (size_t)tm * 128 * 256, 256, Wglu + (size_t)tn * 128 * 256, 256, 256, sm);
#pragma unroll
    for (int mi = 0; mi < 2; mi++)
#pragma unroll
      for (int ni = 0; ni < 2; ni++)
#pragma unroll
        for (int i = 0; i < 16; i++) {
          const int row = tm * 128 + wm * 64 + mi * 32 + crow(i, hh), col = tn * 128 + wn * 64 + ni * 32 + r;
          const float y = bf2f(Yg[(size_t)row * 256 + col]);
          CC[(size_t)row * 1024 + 512 + col] = f2bf(y * sigmoidf_(acc[mi][ni][i]));
        }
  }
}

DI void phase_ple(const u16* __restrict__ Xb, const u16* __restrict__ Wpg, const u16* __restrict__ Pb, const u16* __restrict__ Wpp, u16* ple, int bid, int nb, u16* sm) {
  const int lane = tidx() & 63, wave = tidx() >> 6, wm = wave >> 1, wn = wave & 1, r = lane & 31, hh = lane >> 5;
  int tm, tn;
  for (int it = 0; tile_at(it, bid, nb, 512, 8, tm, tn); it++) {
    f32x16 acc[2][2] = {{zero16(), zero16()}, {zero16(), zero16()}};
    gemm_mainloop(acc, Xb + (size_t)tm * 128 * 1024, 1024, Wpg + (size_t)tn * 128 * 1024, 1024, 1024, sm);
#pragma unroll
    for (int mi = 0; mi < 2; mi++)
#pragma unroll
      for (int ni = 0; ni < 2; ni++)
#pragma unroll
        for (int i = 0; i < 16; i++) {
          const size_t o = (size_t)(tm * 128 + wm * 64 + mi * 32 + crow(i, hh)) * 1024 + tn * 128 + wn * 64 + ni * 32 + r;
          ple[o] = f2bf(sigmoidf_(acc[mi][ni][i]));
        }
#pragma unroll
    for (int mi = 0; mi < 2; mi++)
#pragma unroll
      for (int ni = 0; ni < 2; ni++) acc[mi][ni] = zero16();
    gemm_mainloop(acc, Pb + (size_t)tm * 128 * 256, 256, Wpp + (size_t)tn * 128 * 256, 256, 256, sm);
#pragma unroll
    for (int mi = 0; mi < 2; mi++)
#pragma unroll
      for (int ni = 0; ni < 2; ni++)
#pragma unroll
        for (int i = 0; i < 16; i++) {
          const size_t o = (size_t)(tm * 128 + wm * 64 + mi * 32 + crow(i, hh)) * 1024 + tn * 128 + wn * 64 + ni * 32 + r;
          ple[o] = f2bf(acc[mi][ni][i] * bf2f(ple[o]));
        }
  }
}

DI void phase_w_in(const u16* __restrict__ Xb, const u16* __restrict__ Win, char* mb, int bid, int nb, u16* sm) {
  const int lane = tidx() & 63, wave = tidx() >> 6, wm = wave >> 1, wn = wave & 1, r = lane & 31, hh = lane >> 5;
  u16* Qd = (u16*)(mb + M_QD); u16* Kd = (u16*)(mb + M_KD); u16* Vt = (u16*)(mb + M_VT); float* U = (float*)(mb + M_U);
  u16* Qs = (u16*)(mb + M_QS); u16* Qi = (u16*)(mb + M_QI); u16* Ks = (u16*)(mb + M_KS); u16* Vs = (u16*)(mb + M_VS);
  u16* Ki = (u16*)(mb + M_KI); float* Wi = (float*)(mb + M_WI);
  int tm, tn;
  for (int it = 0; tile_at(it, bid, nb, 512, 20, tm, tn); it++) {
    f32x16 acc[2][2] = {{zero16(), zero16()}, {zero16(), zero16()}};
    gemm_mainloop(acc, Xb + (size_t)tm * 128 * 1024, 1024, Win + (size_t)tn * 128 * 1024, 1024, 1024, sm);
#pragma unroll
    for (int ni = 0; ni < 2; ni++) {
      const int c0 = tn * 128 + wn * 64 + ni * 32;
      const int c = c0 + r;
#pragma unroll
      for (int mi = 0; mi < 2; mi++) {
        const int rowb = tm * 128 + wm * 64 + mi * 32;
        if (c0 >= 1024 && c0 < 1536) {
          const int cc = c - 1024, head = cc >> 7, dv = cc & 127;
          const int b = rowb >> 13, t0 = rowb & 8191;
#pragma unroll
          for (int g4 = 0; g4 < 4; g4++) {
            uint2 v = make_uint2(pack2(acc[mi][ni][4 * g4], acc[mi][ni][4 * g4 + 1]), pack2(acc[mi][ni][4 * g4 + 2], acc[mi][ni][4 * g4 + 3]));
            *(uint2*)(Vt + ((size_t)((b * 4 + head) * 128 + dv)) * L_ + t0 + 8 * g4 + 4 * hh) = v;
          }
        } else {
#pragma unroll
          for (int i = 0; i < 16; i++) {
            const size_t row = rowb + crow(i, hh);
            const float v = acc[mi][ni][i];
            if (c0 < 512) Qd[row * 512 + c] = f2bf(v);
            else if (c0 < 1024) Kd[row * 512 + (c - 512)] = f2bf(v);
            else if (c0 < 1792) U[row * 256 + (c - 1536)] = v;
            else if (c0 < 2048) Qs[row * 256 + (c - 1792)] = f2bf(v);
            else if (c0 < 2112) Ks[row * 64 + (c - 2048)] = f2bf(v);
            else if (c0 < 2176) Vs[row * 64 + (c - 2112)] = f2bf(v);
            else if (c0 < 2432) Qi[row * 256 + (c - 2176)] = f2bf(v);
            else if (c0 < 2464) Ki[row * 32 + (c - 2432)] = f2bf(v);
            else if (c0 == 2464) { if (r < 8) Wi[row * 8 + r] = v * 0.0625f; }
          }
        }
      }
    }
  }
}

DI void phase_ln(float* x, u16* __restrict__ xb, const float* __restrict__ g, const float* __restrict__ bta, int bid, int nb) {
  const int lane = tidx() & 63, wave = tidx() >> 6;
  float4 gg[4], bb[4];
#pragma unroll
  for (int i = 0; i < 4; i++) { gg[i] = *(const float4*)(g + i * 256 + lane * 4); bb[i] = *(const float4*)(bta + i * 256 + lane * 4); }
  for (int row = bid * 4 + wave; row < T_; row += nb * 4) {
    float4 v[4];
#pragma unroll
    for (int i = 0; i < 4; i++) v[i] = *(const float4*)(x + (size_t)row * 1024 + i * 256 + lane * 4);
    float s = 0.f;
#pragma unroll
    for (int i = 0; i < 4; i++) s += v[i].x + v[i].y + v[i].z + v[i].w;
    const float mu = wave_sum(s) * (1.f / 1024.f);
    float q = 0.f;
#pragma unroll
    for (int i = 0; i < 4; i++) { v[i].x -= mu; v[i].y -= mu; v[i].z -= mu; v[i].w -= mu; q += v[i].x * v[i].x + v[i].y * v[i].y + v[i].z * v[i].z + v[i].w * v[i].w; }
    const float rs = rsqrtf(wave_sum(q) * (1.f / 1024.f) + LN_EPS_);
#pragma unroll
    for (int i = 0; i < 4; i++) {
      float4 o;
      o.x = v[i].x * rs * gg[i].x + bb[i].x; o.y = v[i].y * rs * gg[i].y + bb[i].y;
      o.z = v[i].z * rs * gg[i].z + bb[i].z; o.w = v[i].w * rs * gg[i].w + bb[i].w;
      *(float4*)(x + (size_t)row * 1024 + i * 256 + lane * 4) = o;
      *(uint2*)(xb + (size_t)row * 1024 + i * 256 + lane * 4) = make_uint2(pack2(o.x, o.y), pack2(o.z, o.w));
    }
  }
}

DI float gelu_tanh(float x) { const float u = 0.7978845608028654f * (x + 0.044715f * x * x * x); return 0.5f * x * (1.f + tanhf(u)); }

template <bool OUT>
DI void ssm_scan(const Params& P, int layer, int widx, char* mb) {
  const int lane = tidx() & 63;
  const int b = widx >> 8, g = (widx >> 4) & 15, ch = widx & 15;
  const int gi = (layer * 16 + g) * 64 + lane;
  const float4 ca = ((const float4*)(WS(P) + OFF_COEFA))[gi];
  const float2* cbp = (const float2*)(WS(P) + OFF_COEFB) + (size_t)gi * 16;
  float bre[16], bim[16];
#pragma unroll
  for (int c = 0; c < 16; c++) { float2 t = cbp[c]; bre[c] = t.x; bim[c] = t.y; }
  const float* U = (const float*)(mb + M_U);
  float2* Send = (float2*)(mb + M_SEND);
  const size_t sbase = (size_t)((b * 16 + g) * 16) * 64 + lane;
  float xr = 0.f, xi = 0.f;
  float cre[16], cim[16];
  float dsk = 0.f;
  int mych = 0;
  if (OUT) {
    for (int j = 0; j < ch; j++) {
      const float2 e = Send[sbase + (size_t)j * 64];
      const float nr = ca.z * xr - ca.w * xi + e.x, ni = ca.z * xi + ca.w * xr + e.y;
      xr = nr; xi = ni;
    }
#pragma unroll
    for (int c = 0; c < 16; c++) {
      cre[c] = P.in[20][((size_t)(layer * 16 + g) * 16 + c) * 64 + lane];
      cim[c] = P.in[21][((size_t)(layer * 16 + g) * 16 + c) * 64 + lane];
    }
    mych = ((lane >> 5) & 1) * 8 + ((lane >> 4) & 1) * 4 + ((lane >> 3) & 1) * 2 + ((lane >> 2) & 1);
    dsk = P.in[22][layer * 256 + g * 16 + mych];
  }
  u16* Yg = (u16*)(mb + M_YG);
  const size_t tok0 = (size_t)b * L_ + ch * 512;
  const float* up = U + tok0 * 256 + g * 16;
#pragma unroll 2
  for (int t = 0; t < 512; t++) {
    const float4 u0 = *(const float4*)(up + (size_t)t * 256), u1 = *(const float4*)(up + (size_t)t * 256 + 4);
    const float4 u2 = *(const float4*)(up + (size_t)t * 256 + 8), u3 = *(const float4*)(up + (size_t)t * 256 + 12);
    const float uu[16] = {u0.x, u0.y, u0.z, u0.w, u1.x, u1.y, u1.z, u1.w, u2.x, u2.y, u2.z, u2.w, u3.x, u3.y, u3.z, u3.w};
    float br = 0.f, bi = 0.f;
#pragma unroll
    for (int c = 0; c < 16; c++) { br += bre[c] * uu[c]; bi += bim[c] * uu[c]; }
    const float nr = ca.x * xr - ca.y * xi + br, ni = ca.x * xi + ca.y * xr + bi;
    xr = nr; xi = ni;
    if (OUT) {
      float v[16];
#pragma unroll
      for (int c = 0; c < 16; c++) v[c] = cre[c] * xr - cim[c] * xi;
      const bool b5 = lane & 32, b4 = lane & 16, b3 = lane & 8, b2 = lane & 4;
      float v8[8], v4[4], v2[2], v1;
#pragma unroll
      for (int i = 0; i < 8; i++) { const float snd = b5 ? v[i] : v[i + 8]; const float rcv = __shfl_xor(snd, 32); v8[i] = (b5 ? v[i + 8] : v[i]) + rcv; }
#pragma unroll
      for (int i = 0; i < 4; i++) { const float snd = b4 ? v8[i] : v8[i + 4]; const float rcv = __shfl_xor(snd, 16); v4[i] = (b4 ? v8[i + 4] : v8[i]) + rcv; }
#pragma unroll
      for (int i = 0; i < 2; i++) { const float snd = b3 ? v4[i] : v4[i + 2]; const float rcv = __shfl_xor(snd, 8); v2[i] = (b3 ? v4[i + 2] : v4[i]) + rcv; }
      { const float snd = b2 ? v2[0] : v2[1]; const float rcv = __shfl_xor(snd, 4); v1 = (b2 ? v2[1] : v2[0]) + rcv; }
      v1 += __shfl_xor(v1, 2);
      v1 += __shfl_xor(v1, 1);
      float um = uu[0];
#pragma unroll
      for (int c = 1; c < 16; c++) um = (mych == c) ? uu[c] : um;
      const float y = gelu_tanh(v1 + dsk * um);
      if ((lane & 3) == 0) Yg[(tok0 + t) * 256 + g * 16 + mych] = f2bf(y);
    }
  }
  if (!OUT) Send[sbase + (size_t)ch * 64] = make_float2(xr, xi);
}

constexpr int KS_ = 72, VS_ = 68;
DI void da_item(const Params& P, int layer, int b, int h, int qt, char* mb, char* smem) {
  const int tid = tidx(), lane = tid & 63, wave = tid >> 6, r = lane & 31, hh = lane >> 5;
  u16* sK = (u16*)smem;
  u16* sV = sK + 64 * KS_;
  float* sbias = (float*)(sV + 128 * VS_);
  u16* sQw = (u16*)(smem + 28672) + (tidx() >> 6) * 32 * KS_;
  const u16* Qd = (const u16*)(mb + M_QD); const u16* Kd = (const u16*)(mb + M_KD); const u16* Vt = (const u16*)(mb + M_VT);
  u16* CC = (u16*)(WS(P) + OFF_CC);
  const int q0 = qt * 128, qw = q0 + wave * 32, qp = qw + r;
  const size_t tokq = (size_t)b * L_ + qp;
  __syncthreads();
  if (tid < 129) sbias[tid] = ((const float*)(WS(P) + OFF_BIAS))[h * 129 + tid] * LOG2E_;
  __syncthreads();
  const float bfar = sbias[128];
  const float SC = 0.125f * LOG2E_;
  const int nkt = (q0 + 128) >> 6;
  const float lam = ((const float*)(WS(P) + OFF_LAM))[layer];
  const int krow_l = tid >> 3, kch = (tid & 7) * 8;
#pragma unroll 1
  for (int c = 0; c < 2; c++) {
#pragma unroll
    for (int ks = 0; ks < 4; ks++) *(bf16x8*)(sQw + r * KS_ + ks * 16 + hh * 8) = *(const bf16x8*)(Qd + tokq * 512 + h * 128 + c * 64 + ks * 16 + hh * 8);
    f32x16 o[4] = {zero16(), zero16(), zero16(), zero16()};
    float m = -INFINITY, l = 0.f;
    const u16* Kbase = Kd + ((size_t)b * L_ + krow_l) * 512 + h * 128 + c * 64 + kch;
    const u16* Vbase = Vt + ((size_t)((b * 4 + h) * 128 + krow_l)) * L_ + kch;
#pragma unroll 1
    for (int kt = 0; kt < nkt; kt++) {
      __syncthreads();
      {
        u32x4 rk[2], rv[4];
#pragma unroll
        for (int i = 0; i < 2; i++) rk[i] = *(const u32x4*)(Kbase + (size_t)(kt * 64 + i * 32) * 512);
#pragma unroll
        for (int i = 0; i < 4; i++) rv[i] = *(const u32x4*)(Vbase + (size_t)(i * 32) * L_ + kt * 64);
#pragma unroll
        for (int i = 0; i < 2; i++) *(u32x4*)(sK + (krow_l + i * 32) * KS_ + kch) = rk[i];
#pragma unroll
        for (int i = 0; i < 4; i++) {
          u32x2* d = (u32x2*)(sV + (krow_l + i * 32) * VS_ + kch);
          u32x2 lo2, hi2; lo2.x = rv[i].x; lo2.y = rv[i].y; hi2.x = rv[i].z; hi2.y = rv[i].w;
          d[0] = lo2; d[1] = hi2;
        }
      }
      __syncthreads();
      if (kt * 64 <= qw + 31) {
        f32x16 s[2];
#pragma unroll
        for (int kb = 0; kb < 2; kb++) {
          s[kb] = zero16();
#pragma unroll
          for (int ks = 0; ks < 4; ks++) {
            const bf16x8 kf = *(const bf16x8*)(sK + (kb * 32 + r) * KS_ + ks * 16 + hh * 8);
            const bf16x8 qf = *(const bf16x8*)(sQw + r * KS_ + ks * 16 + hh * 8);
            s[kb] = MFMA32(kf, qf, s[kb]);
          }
        }
        const bool nearb = (kt * 64 + 63 + 128 > qw);
        float mx = -INFINITY;
        if (nearb) {
#pragma unroll
          for (int kb = 0; kb < 2; kb++)
#pragma unroll
            for (int i = 0; i < 16; i++) {
              const int dist = qp - (kt * 64 + kb * 32 + crow(i, hh));
              const float bv = sbias[min(max(dist, 0), 128)];
              float t = s[kb][i] * SC + bv;
              t = (dist >= 0) ? t : -INFINITY;
              s[kb][i] = t; mx = fmaxf(mx, t);
              if ((i & 7) == 7) __builtin_amdgcn_sched_barrier(0);
            }
        } else {
#pragma unroll
          for (int kb = 0; kb < 2; kb++)
#pragma unroll
            for (int i = 0; i < 16; i++) { const float t = s[kb][i] * SC + bfar; s[kb][i] = t; mx = fmaxf(mx, t); }
        }
        mx = fmaxf(mx, __shfl_xor(mx, 32));
        const float mn = fmaxf(m, mx);
        const float corr = __builtin_amdgcn_exp2f(m - mn);
        m = mn;
        float ls = 0.f;
#pragma unroll
        for (int kb = 0; kb < 2; kb++)
#pragma unroll
          for (int i = 0; i < 16; i++) { const float p = __builtin_amdgcn_exp2f(s[kb][i] - mn); s[kb][i] = p; ls += p; }
        l = l * corr + ls;
#pragma unroll
        for (int dt = 0; dt < 4; dt++)
#pragma unroll
          for (int i = 0; i < 16; i++) o[dt][i] *= corr;
#pragma unroll
        for (int kb = 0; kb < 2; kb++)
#pragma unroll
          for (int s2 = 0; s2 < 2; s2++) {
            const bf16x8 pf = pack8(s[kb], s2);
#pragma unroll
            for (int dt = 0; dt < 4; dt++) {
              const u16* vp = sV + (dt * 32 + r) * VS_ + kb * 32 + s2 * 16 + 4 * hh;
              const s16x4 lo = *(const s16x4*)vp, hi = *(const s16x4*)(vp + 8);
              const bf16x8 vf = __builtin_shufflevector(lo, hi, 0, 1, 2, 3, 4, 5, 6, 7);
              o[dt] = MFMA32(vf, pf, o[dt]);
            }
            __builtin_amdgcn_sched_barrier(0);
          }
      }
    }
    const float lt = l + __shfl_xor(l, 32);
    const float inv = 1.f / lt;
    size_t tq = tokq;
    asm volatile("" : "+v"(tq));
    u16* obase = CC + tq * 1024 + h * 128 + 4 * hh;
    if (c == 0) {
#pragma unroll
      for (int dt = 0; dt < 4; dt++)
#pragma unroll
        for (int g4 = 0; g4 < 4; g4++) {
          *(uint2*)(obase + dt * 32 + 8 * g4) = make_uint2(pack2(o[dt][4 * g4] * inv, o[dt][4 * g4 + 1] * inv), pack2(o[dt][4 * g4 + 2] * inv, o[dt][4 * g4 + 3] * inv));
        }
    } else {
      float ss = 0.f;
#pragma unroll
      for (int dt = 0; dt < 4; dt++)
#pragma unroll
        for (int g4 = 0; g4 < 4; g4++) {
          const uint2 pv = *(const uint2*)(obase + dt * 32 + 8 * g4);
          const float a4[4] = {bf2f((u16)(pv.x & 0xffff)), bf2f((u16)(pv.x >> 16)), bf2f((u16)(pv.y & 0xffff)), bf2f((u16)(pv.y >> 16))};
#pragma unroll
          for (int e = 0; e < 4; e++) { const float v = a4[e] - lam * o[dt][4 * g4 + e] * inv; o[dt][4 * g4 + e] = v; ss = __builtin_fmaf(v, v, ss); }
        }
      ss += __shfl_xor(ss, 32);
      const float lam_init = 0.8f - 0.6f * __expf(-0.3f * (float)layer);
      const float rn = rsqrtf(ss * (1.f / 128.f) + LN_EPS_) * (1.f - lam_init);
      int hh2 = hh;
      asm volatile("" : "+v"(hh2));
      const float* sg = P.in[14] + layer * 128 + 4 * hh2;
#pragma unroll
      for (int dt = 0; dt < 4; dt++)
#pragma unroll
        for (int g4 = 0; g4 < 4; g4++) {
          const int dv = dt * 32 + 8 * g4 + 4 * hh;
          const float4 gv = *(const float4*)(sg + dt * 32 + 8 * g4);
          uint2 w = make_uint2(pack2(o[dt][4 * g4] * rn * gv.x, o[dt][4 * g4 + 1] * rn * gv.y),
                               pack2(o[dt][4 * g4 + 2] * rn * gv.z, o[dt][4 * g4 + 3] * rn * gv.w));
          *(uint2*)(obase + dv - 4 * hh) = w;
        }
    }
  }
}

DI unsigned sortkey(float f) { const unsigned u = __float_as_uint(f + 0.f); return (u & 0x80000000u) ? ~u : (u | 0x80000000u); }

DI void dsa_item(const Params& P, int layer, int b, int qt, char* mb, char* smem) {
  const int tid = tidx(), lane = tid & 63, wave = tid >> 6, r = lane & 31, hh = lane >> 5;
  unsigned* hist = (unsigned*)smem;
  float* sP = (float*)smem;
  float* sQ = (float*)(smem + 16384);
  u16* sidx = (u16*)(smem + 32896);
  unsigned* meta = (unsigned*)(smem + 32896 + 16384);
  float* sbias = (float*)(smem + 32896 + 16384 + 512);
  const u16* Qi = (const u16*)(mb + M_QI); const u16* Ki = (const u16*)(mb + M_KI); const float* Wi = (const float*)(mb + M_WI);
  const u16* Qs = (const u16*)(mb + M_QS); const u16* Ks = (const u16*)(mb + M_KS); const u16* Vs = (const u16*)(mb + M_VS);
  u16* CC = (u16*)(WS(P) + OFF_CC);
  const int q0 = qt * 32;
  const int qp = q0 + r;
  const size_t tokb = (size_t)b * L_;
  const int nk32 = qt + 1;
  const bool radix = (q0 >= 256);
  __syncthreads();
  for (int i = tid; i < 4 * 129; i += 256) sbias[i] = ((const float*)(WS(P) + OFF_BIAS))[4 * 129 + i];
  if (tid < 128) meta[tid] = (tid >= 32 && tid < 64) ? 256u : 0u;
  char* sQi = smem + 51872;
  float* sWi = (float*)(smem + 68768);
  {
    const int row = tid >> 3, ch = tid & 7;
    const uint4* src = (const uint4*)(Qi + (tokb + q0 + row) * 256 + ch * 32);
    uint4* dst = (uint4*)(sQi + row * 528 + ch * 64);
    dst[0] = src[0]; dst[1] = src[1]; dst[2] = src[2]; dst[3] = src[3];
    sWi[tid] = Wi[(tokb + q0) * 8 + tid];
  }
  const int npass = radix ? 5 : 1;
#pragma unroll 1
  for (int pass = (radix ? 0 : 4); pass < 5; pass++) {
    __syncthreads();
    if (pass < 4) { for (int i = tid; i < 32 * 257; i += 256) hist[i] = 0u; }
    __syncthreads();
    const unsigned pref = meta[r];
    const unsigned krem = meta[32 + r];
#pragma unroll 1
    for (int kt = wave; kt < nk32; kt += 4) {
      bf16x8 kf0 = *(const bf16x8*)(Ki + (tokb + kt * 32 + r) * 32 + hh * 8);
      bf16x8 kf1 = *(const bf16x8*)(Ki + (tokb + kt * 32 + r) * 32 + 16 + hh * 8);
      f32x16 sc = zero16();
#pragma unroll 2
      for (int hd = 0; hd < 8; hd++) {
        const bf16x8 q0f = *(const bf16x8*)(sQi + r * 528 + hd * 64 + hh * 16);
        const bf16x8 q1f = *(const bf16x8*)(sQi + r * 528 + hd * 64 + 32 + hh * 16);
        const float w = sWi[r * 8 + hd];
        f32x16 s = MFMA32(kf0, q0f, zero16());
        s = MFMA32(kf1, q1f, s);
#pragma unroll
        for (int i = 0; i < 16; i++) sc[i] += fmaxf(s[i], 0.f) * w;
      }
#pragma unroll
      for (int i = 0; i < 16; i++) {
        const int kp = kt * 32 + crow(i, hh);
        if (kp <= qp) {
          const unsigned key = sortkey(sc[i]);
          if (pass < 4) {
            const int sh = 24 - 8 * pass;
            const bool match = (pass == 0) || ((key >> (sh + 8)) == pref);
            if (match) atomicAdd(&hist[r * 257 + ((key >> sh) & 255u)], 1u);
          } else {
            bool sel = true;
            if (radix) {
              sel = key > pref;
              if (!sel && key == pref) sel = atomicAdd(&meta[96 + r], 1u) < krem;
            }
            if (sel) { const unsigned pos = atomicAdd(&meta[64 + r], 1u); if (pos < 256u) sidx[r * 256 + pos] = (u16)kp; }
          }
        }
      }
    }
    __syncthreads();
    if (pass < 4) {
      for (int j = 0; j < 8; j++) {
        const int qq = wave * 8 + j;
        const unsigned k = meta[32 + qq];
        unsigned c4[4]; unsigned tot = 0;
#pragma unroll
        for (int e = 0; e < 4; e++) { c4[e] = hist[qq * 257 + 255 - 4 * lane - e]; tot += c4[e]; }
        unsigned incl = tot;
        for (int o = 1; o < 64; o <<= 1) { const unsigned t = __shfl_up(incl, o); if (lane >= o) incl += t; }
        unsigned run = incl - tot;
#pragma unroll
        for (int e = 0; e < 4; e++) {
          if (run < k && run + c4[e] >= k) { meta[qq] = (meta[qq] << 8) | (unsigned)(255 - 4 * lane - e); meta[32 + qq] = k - run; }
          run += c4[e];
        }
      }
    }
  }
  (void)npass;
  __syncthreads();
  float* myP = sP + wave * 1024;
  float* myQ = sQ + wave * 256;
#pragma unroll 1
  for (int j = 0; j < 8; j++) {
    const int qq = wave * 8 + j;
    const int qpos = q0 + qq;
    const size_t tok = tokb + qpos;
    const int n = min((int)meta[64 + qq], 256);
    __syncthreads();
    {
      const uint2 qv = *(const uint2*)(Qs + tok * 256 + lane * 4);
      float4 f; f.x = bf2f((u16)(qv.x & 0xffff)); f.y = bf2f((u16)(qv.x >> 16)); f.z = bf2f((u16)(qv.y & 0xffff)); f.w = bf2f((u16)(qv.y >> 16));
      *(float4*)(myQ + lane * 4) = f;
    }
    __syncthreads();
#pragma unroll 1
    for (int rd = 0; rd < 4; rd++) {
      const int jj = rd * 64 + lane;
      const bool valid = jj < n;
      const int kidx = valid ? (int)sidx[qq * 256 + jj] : 0;
      const u32x4* kp = (const u32x4*)(Ks + (tokb + kidx) * 64);
      float d0 = 0.f, d1 = 0.f, d2 = 0.f, d3 = 0.f;
      u32x4 kv = kp[0];
#pragma unroll 1
      for (int ch = 0; ch < 8; ch++) {
        const u32x4 nxt = kp[min(ch + 1, 7)];
        const float kf[8] = {bf2f((u16)(kv.x & 0xffff)), bf2f((u16)(kv.x >> 16)), bf2f((u16)(kv.y & 0xffff)), bf2f((u16)(kv.y >> 16)),
                             bf2f((u16)(kv.z & 0xffff)), bf2f((u16)(kv.z >> 16)), bf2f((u16)(kv.w & 0xffff)), bf2f((u16)(kv.w >> 16))};
        const float* qq4 = myQ + ch * 8;
#pragma unroll
        for (int e4 = 0; e4 < 2; e4++) {
          const float4 qa = *(const float4*)(qq4 + 0 * 64 + e4 * 4), qb = *(const float4*)(qq4 + 1 * 64 + e4 * 4);
          const float4 qc = *(const float4*)(qq4 + 2 * 64 + e4 * 4), qd = *(const float4*)(qq4 + 3 * 64 + e4 * 4);
          d0 += kf[e4 * 4] * qa.x + kf[e4 * 4 + 1] * qa.y + kf[e4 * 4 + 2] * qa.z + kf[e4 * 4 + 3] * qa.w;
          d1 += kf[e4 * 4] * qb.x + kf[e4 * 4 + 1] * qb.y + kf[e4 * 4 + 2] * qb.z + kf[e4 * 4 + 3] * qb.w;
          d2 += kf[e4 * 4] * qc.x + kf[e4 * 4 + 1] * qc.y + kf[e4 * 4 + 2] * qc.z + kf[e4 * 4 + 3] * qc.w;
          d3 += kf[e4 * 4] * qd.x + kf[e4 * 4 + 1] * qd.y + kf[e4 * 4 + 2] * qd.z + kf[e4 * 4 + 3] * qd.w;
        }
        kv = nxt;
      }
      const int dist = min(max(qpos - kidx, 0), 128);
      float4 sv;
      sv.x = valid ? d0 * 0.125f + sbias[0 * 129 + dist] : -INFINITY;
      sv.y = valid ? d1 * 0.125f + sbias[1 * 129 + dist] : -INFINITY;
      sv.z = valid ? d2 * 0.125f + sbias[2 * 129 + dist] : -INFINITY;
      sv.w = valid ? d3 * 0.125f + sbias[3 * 129 + dist] : -INFINITY;
      *(float4*)(myP + jj * 4) = sv;
    }
    __syncthreads();
    float sc[4][4];
#pragma unroll
    for (int rd = 0; rd < 4; rd++) { const float4 sv = *(const float4*)(myP + (rd * 64 + lane) * 4); sc[rd][0] = sv.x; sc[rd][1] = sv.y; sc[rd][2] = sv.z; sc[rd][3] = sv.w; }
#pragma unroll
    for (int hd = 0; hd < 4; hd++) {
      float mx = fmaxf(fmaxf(sc[0][hd], sc[1][hd]), fmaxf(sc[2][hd], sc[3][hd]));
      mx = wave_max(mx);
      float sm = 0.f;
#pragma unroll
      for (int rd = 0; rd < 4; rd++) { sc[rd][hd] = __expf(sc[rd][hd] - mx); sm += sc[rd][hd]; }
      sm = wave_sum(sm);
      const float inv = 1.f / sm;
#pragma unroll
      for (int rd = 0; rd < 4; rd++) sc[rd][hd] *= inv;
    }
#pragma unroll
    for (int rd = 0; rd < 4; rd++) *(float4*)(myP + (rd * 64 + lane) * 4) = make_float4(sc[rd][0], sc[rd][1], sc[rd][2], sc[rd][3]);
    __syncthreads();
    float a0 = 0.f, a1 = 0.f, a2 = 0.f, a3 = 0.f;
#pragma unroll 8
    for (int jj = 0; jj < n; jj++) {
      const int kidx = sidx[qq * 256 + jj];
      const float4 pj = *(const float4*)(myP + jj * 4);
      const float v = bf2f(Vs[(tokb + kidx) * 64 + lane]);
      a0 += pj.x * v; a1 += pj.y * v; a2 += pj.z * v; a3 += pj.w * v;
    }
    u16* op = CC + tok * 1024 + 768 + lane;
    op[0] = f2bf(a0); op[64] = f2bf(a1); op[128] = f2bf(a2); op[192] = f2bf(a3);
  }
}

DI void phase_mix1(const Params& P, int layer, int bid, int nb, char* smem) {
  char* mb = WS(P) + OFF_H;
  for (int w = bid * 4 + (tidx() >> 6); w < 2048; w += nb * 4) ssm_scan<false>(P, layer, w, mb);
  for (int j = 0;; j++) {
    const int idx = (j & 1) ? (j * nb + (nb - 1 - bid)) : (j * nb + bid);
    if (j * nb >= 2048) break;
    if (idx >= 2048) continue;
    const int qt = 255 - (idx >> 3), b = idx & 7;
    dsa_item(P, layer, b, qt, mb, smem);
  }
}

DI void phase_mix2(const Params& P, int layer, int bid, int nb, char* smem) {
  char* mb = WS(P) + OFF_H;
  for (int w = bid * 4 + (tidx() >> 6); w < 2048; w += nb * 4) ssm_scan<true>(P, layer, w, mb);
  for (int j = 0;; j++) {
    const int idx = (j & 1) ? (j * nb + (nb - 1 - bid)) : (j * nb + bid);
    if (j * nb >= 2048) break;
    if (idx >= 2048) continue;
    const int qt = 63 - (idx >> 5), bh = idx & 31;
    da_item(P, layer, bh >> 2, bh & 3, qt, mb, smem);
  }
}

DI void run_phase(const Params& P, int ph, int bid, int nb, char* smem) {
  char* ws = WS(P);
  u16* sm = (u16*)smem;
  if (ph == 0) { phase_prep(P, bid, nb, smem); return; }
  const int l = (ph - 1) / 12, s = (ph - 1) % 12;
  u16* Xb = (u16*)(ws + OFF_XB);
  u16* H = (u16*)(ws + OFF_H);
  u16* CC = (u16*)(ws + OFF_CC);
  float* X = OUTP(P);
  switch (s) {
    case 0: phase_ffn_up(Xb, (const u16*)(ws + OFF_WGU1 + l * SZ_WGU), H, bid, nb, sm); break;
    case 1: phase_ffn_down(H, (const u16*)(ws + OFF_WD1 + l * SZ_WD), (l == 0) ? P.in[0] : (const float*)X, X, nullptr, bid, nb, sm); break;
    case 2: phase_ln(X, Xb, P.in[6] + l * 1024, P.in[7] + l * 1024, bid, nb); break;
    case 3: phase_w_in(Xb, (const u16*)(ws + OFF_WIN + l * SZ_WIN), ws + OFF_H, bid, nb, sm); break;
    case 4: phase_mix1(P, l, bid, nb, smem); break;
    case 5: phase_mix2(P, l, bid, nb, smem); break;
    case 6: phase_glu((const u16*)(ws + OFF_H + M_YG), (const u16*)(ws + OFF_WGLU + l * SZ_WGLU), CC, bid, nb, sm); break;
    case 7: phase_w_o(CC, (const u16*)(ws + OFF_WO + l * SZ_WO), X, bid, nb, sm); break;
    case 8: phase_ln(X, Xb, P.in[24] + l * 1024, P.in[25] + l * 1024, bid, nb); break;
    case 9:
      phase_ffn_up(Xb, (const u16*)(ws + OFF_WGU2 + l * SZ_WGU), H, bid, nb, sm);
      phase_ple(Xb, (const u16*)(ws + OFF_WPG + l * SZ_WPG), (const u16*)(ws + OFF_PB) + (size_t)l * T_ * 256, (const u16*)(ws + OFF_WPP + l * SZ_WPP), CC, bid, nb, sm);
      break;
    case 10: phase_ffn_down(H, (const u16*)(ws + OFF_WD2 + l * SZ_WD), X, X, CC, bid, nb, sm); break;
    case 11: phase_ln(X, Xb, P.in[31] + l * 1024, P.in[32] + l * 1024, bid, nb); break;
  }
}

constexpr int NPHASES = 25;

__global__ void __launch_bounds__(256, 2) mega(Params P, int ph0, int ph1) {
  extern __shared__ __attribute__((aligned(16))) char smem[];
  cg::grid_group grid = cg::this_grid();
  const int bid = blockIdx.x, nb = gridDim.x;
#define PHASE(k) if (ph0 <= (k) && (k) < ph1) { run_phase(P, (k), bid, nb, smem); if ((k) + 1 < ph1) grid.sync(); }
  PHASE(0) PHASE(1) PHASE(2) PHASE(3) PHASE(4) PHASE(5) PHASE(6) PHASE(7) PHASE(8) PHASE(9) PHASE(10) PHASE(11) PHASE(12)
  PHASE(13) PHASE(14) PHASE(15) PHASE(16) PHASE(17) PHASE(18) PHASE(19) PHASE(20) PHASE(21) PHASE(22) PHASE(23) PHASE(24)
#undef PHASE
}

extern "C" void kernel_launch(void* const* d_in, const int* in_sizes, int n_in, void* d_out, int out_size, void* d_ws, size_t ws_size, hipStream_t stream) {
  static int grid_blocks = 0;
  if (grid_blocks == 0) {
    if (n_in != 33 || ws_size < WS_END) { fprintf(stderr, "kernel_launch: need 33 inputs and %zu bytes of ws (got %d, %zu)\n", (size_t)WS_END, n_in, ws_size); grid_blocks = -1; return; }
    int dev = 0, cus = 0, per_cu = 0;
    (void)hipGetDevice(&dev);
    (void)hipDeviceGetAttribute(&cus, hipDeviceAttributeMultiprocessorCount, dev);
    (void)hipFuncSetAttribute((const void*)mega, hipFuncAttributeMaxDynamicSharedMemorySize, LDS_BYTES);
    (void)hipOccupancyMaxActiveBlocksPerMultiprocessor(&per_cu, (const void*)mega, 256, LDS_BYTES);
    if (per_cu < 1) per_cu = 1;
    if (per_cu > 2) per_cu = 2;
    grid_blocks = cus * per_cu;
    fprintf(stderr, "kernel_launch: cus %d per_cu %d grid %d\n", cus, per_cu, grid_blocks);
  }
  if (grid_blocks < 0) return;
  Params p;
  memset(&p, 0, sizeof(p));
  for (int i = 0; i < 33; i++) p.in[i] = (const float*)d_in[i];
  p.out = (float*)d_out;
  p.ws = (char*)d_ws;
#if MULTI_LAUNCH
  for (int ph = 0; ph < NPHASES; ph++) {
    hipLaunchKernelGGL(mega, dim3(grid_blocks), dim3(256), LDS_BYTES, stream, p, ph, ph + 1);
  }
#else
  int ph0 = 0, ph1 = NPHASES;
  void* args[] = {&p, &ph0, &ph1};
  hipError_t e = hipLaunchCooperativeKernel((const void*)mega, dim3(grid_blocks), dim3(256), args, LDS_BYTES, stream);
  if (e != hipSuccess) fprintf(stderr, "cooperative launch failed: %s (grid %d)\n", hipGetErrorString(e), grid_blocks);
#endif
}
```

```cpp
#include <hip/hip_runtime.h>
#include <hip/hip_cooperative_groups.h>
#include <stdint.h>
#include <math.h>
#include <stdio.h>
#include <string.h>
namespace cg = cooperative_groups;

#ifndef MULTI_LAUNCH
#define MULTI_LAUNCH 0
#endif

typedef unsigned short u16;
typedef __attribute__((ext_vector_type(8))) short bf16x8;
typedef __attribute__((ext_vector_type(4))) short s16x4;
typedef __attribute__((ext_vector_type(16))) float f32x16;
typedef __attribute__((ext_vector_type(4))) unsigned u32x4;
typedef __attribute__((ext_vector_type(2))) unsigned u32x2;

#define DI __device__ __forceinline__
#define MFMA32(a, b, c) __builtin_amdgcn_mfma_f32_32x32x16_bf16((a), (b), (c), 0, 0, 0)

constexpr int T_ = 65536;
constexpr int L_ = 8192;
constexpr int D_ = 1024;
constexpr int FF_ = 2816;
constexpr float ALPHA_ = 1.41421356237309515f;
constexpr float LN_EPS_ = 1e-5f;
constexpr float LOG2E_ = 1.44269504088896341f;
constexpr int LDS_BYTES = 73728;

constexpr size_t SZ_WGU = (size_t)5632 * 1024 * 2;
constexpr size_t SZ_WD = (size_t)1024 * 2816 * 2;
constexpr size_t SZ_WIN = (size_t)2560 * 1024 * 2;
constexpr size_t SZ_WO = (size_t)1024 * 1024 * 2;
constexpr size_t SZ_WGLU = (size_t)256 * 256 * 2;
constexpr size_t SZ_WPG = (size_t)1024 * 1024 * 2;
constexpr size_t SZ_WPP = (size_t)1024 * 256 * 2;
constexpr size_t OFF_WGU1 = 0;
constexpr size_t OFF_WD1 = OFF_WGU1 + 2 * SZ_WGU;
constexpr size_t OFF_WGU2 = OFF_WD1 + 2 * SZ_WD;
constexpr size_t OFF_WD2 = OFF_WGU2 + 2 * SZ_WGU;
constexpr size_t OFF_WIN = OFF_WD2 + 2 * SZ_WD;
constexpr size_t OFF_WO = OFF_WIN + 2 * SZ_WIN;
constexpr size_t OFF_WGLU = OFF_WO + 2 * SZ_WO;
constexpr size_t OFF_WPG = OFF_WGLU + 2 * SZ_WGLU;
constexpr size_t OFF_WPP = OFF_WPG + 2 * SZ_WPG;
constexpr size_t OFF_COEFA = OFF_WPP + 2 * SZ_WPP;
constexpr size_t OFF_COEFB = OFF_COEFA + 2 * 16 * 64 * 16;
constexpr size_t OFF_LAM = OFF_COEFB + 2 * 16 * 64 * 16 * 8;
constexpr size_t OFF_BIAS = OFF_LAM + 256;
constexpr size_t OFF_XB = OFF_BIAS + 8 * 129 * 4 + 32;
constexpr size_t OFF_PB = OFF_XB + (size_t)T_ * 1024 * 2;
constexpr size_t OFF_H = OFF_PB + (size_t)2 * T_ * 256 * 2;
constexpr size_t SZ_H = (size_t)384 << 20;
constexpr size_t OFF_CC = OFF_H + SZ_H;
constexpr size_t WS_END = OFF_CC + (size_t)T_ * 1024 * 2;
constexpr size_t MB_ = (size_t)1 << 20;
constexpr size_t M_QD = 0, M_KD = 64 * MB_, M_VT = 128 * MB_, M_U = 192 * MB_, M_QS = 256 * MB_, M_QI = 288 * MB_, M_YG = 320 * MB_,
                 M_KS = 352 * MB_, M_VS = 360 * MB_, M_KI = 368 * MB_, M_WI = 372 * MB_, M_SEND = 374 * MB_;

struct Params {
  const float* in[33];
  float* out;
  char* ws;
};

DI int tidx() { int t = threadIdx.x; asm volatile("" : "+v"(t)); return t; }
DI char* WS(const Params& P) { char* w = P.ws; asm volatile("" : "+s"(w)); return w; }
DI float* OUTP(const Params& P) { float* w = P.out; asm volatile("" : "+s"(w)); return w; }
DI u16 f2bf(float x) { unsigned u = __float_as_uint(x); u += 0x7fffu + ((u >> 16) & 1u); return (u16)(u >> 16); }
DI float bf2f(u16 v) { return __uint_as_float(((unsigned)v) << 16); }
DI unsigned pack2(float a, float b) { return (unsigned)f2bf(a) | ((unsigned)f2bf(b) << 16); }
DI int crow(int i, int hh) { return (i & 3) + 8 * (i >> 2) + 4 * hh; }
DI float sigmoidf_(float x) { return 1.f / (1.f + __expf(-x)); }
DI float wave_sum(float v) { for (int o = 32; o > 0; o >>= 1) v += __shfl_xor(v, o); return v; }
DI float wave_max(float v) { for (int o = 32; o > 0; o >>= 1) v = fmaxf(v, __shfl_xor(v, o)); return v; }
DI f32x16 zero16() { f32x16 z; for (int i = 0; i < 16; i++) z[i] = 0.f; return z; }
DI bf16x8 pack8(const f32x16& x, int s) {
  union { unsigned u[4]; bf16x8 v; } t;
  t.u[0] = pack2(x[8 * s + 0], x[8 * s + 1]); t.u[1] = pack2(x[8 * s + 2], x[8 * s + 3]);
  t.u[2] = pack2(x[8 * s + 4], x[8 * s + 5]); t.u[3] = pack2(x[8 * s + 6], x[8 * s + 7]);
  return t.v;
}

constexpr int GS_ = 72;
constexpr int GT_ = 128 * GS_;

DI void gemm_mainloop(f32x16 (&acc)[2][2], const u16* __restrict__ A, int lda, const u16* __restrict__ B, int ldb, int K, u16* sm) {
  const int tid = tidx(), lane = tid & 63, wave = tid >> 6;
  const int wm = wave >> 1, wn = wave & 1, r = lane & 31, hh = lane >> 5;
  const int srow = tid >> 3, sk = (tid & 7) * 8;
  const u16* Ap = A + (size_t)srow * lda + sk;
  const u16* Bp = B + (size_t)srow * ldb + sk;
  u32x4 ra[4], rb[4];
#pragma unroll
  for (int i = 0; i < 4; i++) { ra[i] = *(const u32x4*)(Ap + (size_t)i * 32 * lda); rb[i] = *(const u32x4*)(Bp + (size_t)i * 32 * ldb); }
  __syncthreads();
#pragma unroll
  for (int i = 0; i < 4; i++) { *(u32x4*)(sm + (srow + i * 32) * GS_ + sk) = ra[i]; *(u32x4*)(sm + GT_ + (srow + i * 32) * GS_ + sk) = rb[i]; }
  __syncthreads();
  const int nk = K >> 6;
  for (int kt = 0; kt < nk; kt++) {
    u16* sA = sm + (kt & 1) * 2 * GT_;
    u16* sB = sA + GT_;
    if (kt + 1 < nk) {
      const int ko = (kt + 1) * 64;
#pragma unroll
      for (int i = 0; i < 4; i++) { ra[i] = *(const u32x4*)(Ap + (size_t)i * 32 * lda + ko); rb[i] = *(const u32x4*)(Bp + (size_t)i * 32 * ldb + ko); }
    }
#pragma unroll
    for (int ks = 0; ks < 4; ks++) {
      bf16x8 a0 = *(const bf16x8*)(sA + (wm * 64 + r) * GS_ + ks * 16 + hh * 8);
      bf16x8 a1 = *(const bf16x8*)(sA + (wm * 64 + 32 + r) * GS_ + ks * 16 + hh * 8);
      bf16x8 b0 = *(const bf16x8*)(sB + (wn * 64 + r) * GS_ + ks * 16 + hh * 8);
      bf16x8 b1 = *(const bf16x8*)(sB + (wn * 64 + 32 + r) * GS_ + ks * 16 + hh * 8);
      acc[0][0] = MFMA32(a0, b0, acc[0][0]);
      acc[0][1] = MFMA32(a0, b1, acc[0][1]);
      acc[1][0] = MFMA32(a1, b0, acc[1][0]);
      acc[1][1] = MFMA32(a1, b1, acc[1][1]);
    }
    if (kt + 1 < nk) {
      u16* dA = sm + ((kt + 1) & 1) * 2 * GT_;
#pragma unroll
      for (int i = 0; i < 4; i++) { *(u32x4*)(dA + (srow + i * 32) * GS_ + sk) = ra[i]; *(u32x4*)(dA + GT_ + (srow + i * 32) * GS_ + sk) = rb[i]; }
    }
    __syncthreads();
  }
}

DI bool tile_at(int it, int bid, int nb, int TM, int TN, int& tm, int& tn) {
  if ((nb & 7) == 0 && (TM & 63) == 0) {
    const int xcd = bid & 7, lw = bid >> 3, nlw = nb >> 3;
    const int lt = lw + it * nlw, per = (TM >> 3) * TN;
    if (lt >= per) return false;
    const int g = lt / (8 * TN), rem = lt - g * 8 * TN;
    tn = rem >> 3; tm = xcd * (TM >> 3) + g * 8 + (rem & 7);
    return true;
  } else {
    const int t = bid + it * nb;
    if (t >= TM * TN) return false;
    tn = t / TM; tm = t - tn * TM;
    return true;
  }
}

DI void transpose_job(const float* __restrict__ src, int K, int N, u16* __restrict__ dst, int mode, int bid, int nb, float* tile) {
  const int tid = tidx();
  const int tk = K >> 6, tn = (N + 63) >> 6;
  for (int t = bid; t < tk * tn; t += nb) {
    const int k0 = (t % tk) * 64, n0 = (t / tk) * 64;
    __syncthreads();
#pragma unroll 4
    for (int i = 0; i < 16; i++) {
      const int k = i * 4 + (tid >> 6), n = tid & 63;
      tile[k * 65 + n] = (n0 + n < N) ? src[(size_t)(k0 + k) * N + n0 + n] : 0.f;
    }
    __syncthreads();
#pragma unroll 4
    for (int i = 0; i < 16; i++) {
      const int n = i * 4 + (tid >> 6), k = tid & 63;
      const int ng = n0 + n;
      if (ng < N) {
        int row = ng;
        if (mode == 1) row = (ng >> 5) * 64 + (ng & 31);
        else if (mode == 2) row = (ng >> 5) * 64 + 32 + (ng & 31);
        dst[(size_t)row * K + k0 + k] = f2bf(tile[k * 65 + n]);
      }
    }
  }
}

DI void phase_prep(const Params& P, int bid, int nb, char* smem) {
  float* tile = (float*)smem;
  char* ws = WS(P);
  for (int l = 0; l < 2; l++) {
    transpose_job(P.in[3] + (size_t)l * 1024 * FF_, 1024, FF_, (u16*)(ws + OFF_WGU1 + l * SZ_WGU), 1, bid, nb, tile);
    transpose_job(P.in[4] + (size_t)l * 1024 * FF_, 1024, FF_, (u16*)(ws + OFF_WGU1 + l * SZ_WGU), 2, bid, nb, tile);
    transpose_job(P.in[5] + (size_t)l * FF_ * 1024, FF_, 1024, (u16*)(ws + OFF_WD1 + l * SZ_WD), 0, bid, nb, tile);
    transpose_job(P.in[26] + (size_t)l * 1024 * FF_, 1024, FF_, (u16*)(ws + OFF_WGU2 + l * SZ_WGU), 1, bid, nb, tile);
    transpose_job(P.in[27] + (size_t)l * 1024 * FF_, 1024, FF_, (u16*)(ws + OFF_WGU2 + l * SZ_WGU), 2, bid, nb, tile);
    transpose_job(P.in[28] + (size_t)l * FF_ * 1024, FF_, 1024, (u16*)(ws + OFF_WD2 + l * SZ_WD), 0, bid, nb, tile);
    transpose_job(P.in[8] + (size_t)l * 1024 * 2472, 1024, 2472, (u16*)(ws + OFF_WIN + l * SZ_WIN), 0, bid, nb, tile);
    transpose_job(P.in[9] + (size_t)l * 1024 * 1024, 1024, 1024, (u16*)(ws + OFF_WO + l * SZ_WO), 0, bid, nb, tile);
    transpose_job(P.in[23] + (size_t)l * 256 * 256, 256, 256, (u16*)(ws + OFF_WGLU + l * SZ_WGLU), 0, bid, nb, tile);
    transpose_job(P.in[30] + (size_t)l * 1024 * 1024, 1024, 1024, (u16*)(ws + OFF_WPG + l * SZ_WPG), 0, bid, nb, tile);
    transpose_job(P.in[29] + (size_t)l * 256 * 1024, 256, 1024, (u16*)(ws + OFF_WPP + l * SZ_WPP), 0, bid, nb, tile);
    u16* win = (u16*)(ws + OFF_WIN + l * SZ_WIN);
    for (int i = bid * 256 + tidx(); i < 88 * 1024; i += nb * 256) win[(size_t)2472 * 1024 + i] = 0;
  }
  const size_t gt = (size_t)bid * 256 + tidx(), gs = (size_t)nb * 256;
  {
    const float4* x4 = (const float4*)P.in[0];
    uint2* xb = (uint2*)(ws + OFF_XB);
    for (size_t i = gt; i < (size_t)T_ * 1024 / 4; i += gs) { float4 v = x4[i]; xb[i] = make_uint2(pack2(v.x, v.y), pack2(v.z, v.w)); }
    const float4* p4 = (const float4*)P.in[1];
    uint2* pb = (uint2*)(ws + OFF_PB);
    for (size_t i = gt; i < (size_t)2 * T_ * 256 / 4; i += gs) { float4 v = p4[i]; pb[i] = make_uint2(pack2(v.x, v.y), pack2(v.z, v.w)); }
  }
  if (gt < 2 * 16 * 64) {
    const int l = (int)gt >> 10, g = ((int)gt >> 6) & 15, p = (int)gt & 63;
    const int gi = (l * 16 + g) * 64 + p;
    const double lr = P.in[15][gi], li = P.in[16][gi];
    const double dt = exp((double)P.in[17][l * 16 + g]);
    const double mag = exp(lr * dt);
    const double ar = mag * cos(li * dt), ai = mag * sin(li * dt);
    const double mag5 = exp(512.0 * lr * dt);
    const double a5r = mag5 * cos(512.0 * li * dt), a5i = mag5 * sin(512.0 * li * dt);
    ((float4*)(ws + OFF_COEFA))[gi] = make_float4((float)ar, (float)ai, (float)a5r, (float)a5i);
    const double den = lr * lr + li * li, nr = ar - 1.0, ni = ai;
    const double fr = (nr * lr + ni * li) / den, fi = (ni * lr - nr * li) / den;
    float2* cb = (float2*)(ws + OFF_COEFB) + (size_t)gi * 16;
    for (int c = 0; c < 16; c++) {
      const double br = P.in[18][(size_t)gi * 16 + c], bi = P.in[19][(size_t)gi * 16 + c];
      cb[c] = make_float2((float)(fr * br - fi * bi), (float)(fr * bi + fi * br));
    }
  }
  if (gt < 8 * 129) {
    const int hd = (int)gt / 129, n = (int)gt - hd * 129;
    int bk = n;
    if (n >= 16) { bk = 16 + (int)(log((double)n / 16.0) / log(8.0) * 16.0); bk = bk < 31 ? bk : 31; }
    ((float*)(ws + OFF_BIAS))[gt] = P.in[2][bk * 8 + hd];
  }
  if (gt < 2) {
    const int l = (int)gt;
    float s1 = 0.f, s2 = 0.f;
    for (int i = 0; i < 64; i++) { s1 += P.in[10][l * 64 + i] * P.in[11][l * 64 + i]; s2 += P.in[12][l * 64 + i] * P.in[13][l * 64 + i]; }
    const float lam_init = 0.8f - 0.6f * expf(-0.3f * (float)l);
    ((float*)(ws + OFF_LAM))[l] = expf(s1) - expf(s2) + lam_init;
  }
}

DI void phase_ffn_up(const u16* __restrict__ Xb, const u16* __restrict__ Wgu, u16* __restrict__ H, int bid, int nb, u16* sm) {
  const int lane = tidx() & 63, wave = tidx() >> 6, wm = wave >> 1, wn = wave & 1, r = lane & 31, hh = lane >> 5;
  int tm, tn;
  for (int it = 0; tile_at(it, bid, nb, 512, 44, tm, tn); it++) {
    f32x16 acc[2][2] = {{zero16(), zero16()}, {zero16(), zero16()}};
    gemm_mainloop(acc, Xb + (size_t)tm * 128 * 1024, 1024, Wgu + (size_t)tn * 128 * 1024, 1024, 1024, sm);
    const int j = tn * 64 + wn * 32 + r;
#pragma unroll
    for (int mi = 0; mi < 2; mi++)
#pragma unroll
      for (int i = 0; i < 16; i++) {
        const int row = tm * 128 + wm * 64 + mi * 32 + crow(i, hh);
        const float g = acc[mi][0][i], u = acc[mi][1][i];
        H[(size_t)row * FF_ + j] = f2bf(g * sigmoidf_(g) * u);
      }
  }
}

DI void phase_ffn_down(const u16* __restrict__ H, const u16* __restrict__ Wd, const float* xin, float* xout, const u16* __restrict__ ple, int bid, int nb, u16* sm) {
  const int lane = tidx() & 63, wave = tidx() >> 6, wm = wave >> 1, wn = wave & 1, r = lane & 31, hh = lane >> 5;
  int tm, tn;
  for (int it = 0; tile_at(it, bid, nb, 512, 8, tm, tn); it++) {
    f32x16 acc[2][2] = {{zero16(), zero16()}, {zero16(), zero16()}};
    gemm_mainloop(acc, H + (size_t)tm * 128 * FF_, FF_, Wd + (size_t)tn * 128 * FF_, FF_, FF_, sm);
#pragma unroll
    for (int mi = 0; mi < 2; mi++)
#pragma unroll
      for (int ni = 0; ni < 2; ni++)
#pragma unroll
        for (int i = 0; i < 16; i++) {
          const size_t o = (size_t)(tm * 128 + wm * 64 + mi * 32 + crow(i, hh)) * 1024 + tn * 128 + wn * 64 + ni * 32 + r;
          float v = ALPHA_ * xin[o] + 0.5f * acc[mi][ni][i];
          if (ple) v += bf2f(ple[o]);
          xout[o] = v;
        }
  }
}

DI void phase_w_o(const u16* __restrict__ CC, const u16* __restrict__ Wo, float* x, int bid, int nb, u16* sm) {
  const int lane = tidx() & 63, wave = tidx() >> 6, wm = wave >> 1, wn = wave & 1, r = lane & 31, hh = lane >> 5;
  int tm, tn;
  for (int it = 0; tile_at(it, bid, nb, 512, 8, tm, tn); it++) {
    f32x16 acc[2][2] = {{zero16(), zero16()}, {zero16(), zero16()}};
    gemm_mainloop(acc, CC + (size_t)tm * 128 * 1024, 1024, Wo + (size_t)tn * 128 * 1024, 1024, 1024, sm);
#pragma unroll
    for (int mi = 0; mi < 2; mi++)
#pragma unroll
      for (int ni = 0; ni < 2; ni++)
#pragma unroll
        for (int i = 0; i < 16; i++) {
          const size_t o = (size_t)(tm * 128 + wm * 64 + mi * 32 + crow(i, hh)) * 1024 + tn * 128 + wn * 64 + ni * 32 + r;
          x[o] = ALPHA_ * x[o] + acc[mi][ni][i];
        }
  }
}

DI void phase_glu(const u16* __restrict__ Yg, const u16* __restrict__ Wglu, u16* __restrict__ CC, int bid, int nb, u16* sm) {
  const int lane = tidx() & 63, wave = tidx() >> 6, wm = wave >> 1, wn = wave & 1, r = lane & 31, hh = lane >> 5;
  int tm, tn;
  for (int it = 0; tile_at(it, bid, nb, 512, 2, tm, tn); it++) {
    f32x16 acc[2][2] = {{zero16(), zero16()}, {zero16(), zero16()}};
    gemm_mainloop(acc, Yg + (size_t)tm * 128 * 256, 256, Wglu + (size_t)tn * 128 * 256, 256, 256, sm);
#pragma unroll
    for (int mi = 0; mi < 2; mi++)
#pragma unroll
      for (int ni = 0; ni < 2; ni++)
#pragma unroll
        for (int i = 0; i < 16; i++) {
          const int row = tm * 128 + wm * 64 + mi * 32 + crow(i, hh), col = tn * 128 + wn * 64 + ni * 32 + r;
          const float y = bf2f(Yg[(size_t)row * 256 + col]);
          CC[(size_t)row * 1024 + 512 + col] = f2bf(y * sigmoidf_(acc[mi][ni][i]));
        }
  }
}

DI void phase_ple(const u16* __restrict__ Xb, const u16* __restrict__ Wpg, const u16* __restrict__ Pb, const u16* __restrict__ Wpp, u16* ple, int bid, int nb, u16* sm) {
  const int lane = tidx() & 63, wave = tidx() >> 6, wm = wave >> 1, wn = wave & 1, r = lane & 31, hh = lane >> 5;
  int tm, tn;
  for (int it = 0; tile_at(it, bid, nb, 512, 8, tm, tn); it++) {
    f32x16 acc[2][2] = {{zero16(), zero16()}, {zero16(), zero16()}};
    gemm_mainloop(acc, Xb + (size_t)tm * 128 * 1024, 1024, Wpg + (size_t)tn * 128 * 1024, 1024, 1024, sm);
#pragma unroll
    for (int mi = 0; mi < 2; mi++)
#pragma unroll
      for (int ni = 0; ni < 2; ni++)
#pragma unroll
        for (int i = 0; i < 16; i++) {
          const size_t o = (size_t)(tm * 128 + wm * 64 + mi * 32 + crow(i, hh)) * 1024 + tn * 128 + wn * 64 + ni * 32 + r;
          ple[o] = f2bf(sigmoidf_(acc[mi][ni][i]));
        }
#pragma unroll
    for (int mi = 0; mi < 2; mi++)
#pragma unroll
      for (int ni = 0; ni < 2; ni++) acc[mi][ni] = zero16();
    gemm_mainloop(acc, Pb + (size_t)tm * 128 * 256, 256, Wpp + (size_t)tn * 128 * 256, 256, 256, sm);
#pragma unroll
    for (int mi = 0; mi < 2; mi++)
#pragma unroll
      for (int ni = 0; ni < 2; ni++)
#pragma unroll
        for (int i = 0; i < 16; i++) {
          const size_t o = (size_t)(tm * 128 + wm * 64 + mi * 32 + crow(i, hh)) * 1024 + tn * 128 + wn * 64 + ni * 32 + r;
          ple[o] = f2bf(acc[mi][ni][i] * bf2f(ple[o]));
        }
  }
}

DI void phase_w_in(const u16* __restrict__ Xb, const u16* __restrict__ Win, char* mb, int bid, int nb, u16* sm) {
  const int lane = tidx() & 63, wave = tidx() >> 6, wm = wave >> 1, wn = wave & 1, r = lane & 31, hh = lane >> 5;
  u16* Qd = (u16*)(mb + M_QD); u16* Kd = (u16*)(mb + M_KD); u16* Vt = (u16*)(mb + M_VT); float* U = (float*)(mb + M_U);
  u16* Qs = (u16*)(mb + M_QS); u16* Qi = (u16*)(mb + M_QI); u16* Ks = (u16*)(mb + M_KS); u16* Vs = (u16*)(mb + M_VS);
  u16* Ki = (u16*)(mb + M_KI); float* Wi = (float*)(mb + M_WI);
  int tm, tn;
  for (int it = 0; tile_at(it, bid, nb, 512, 20, tm, tn); it++) {
    f32x16 acc[2][2] = {{zero16(), zero16()}, {zero16(), zero16()}};
    gemm_mainloop(acc, Xb + (size_t)tm * 128 * 1024, 1024, Win + (size_t)tn * 128 * 1024, 1024, 1024, sm);
#pragma unroll
    for (int ni = 0; ni < 2; ni++) {
      const int c0 = tn * 128 + wn * 64 + ni * 32;
      const int c = c0 + r;
#pragma unroll
      for (int mi = 0; mi < 2; mi++) {
        const int rowb = tm * 128 + wm * 64 + mi * 32;
        if (c0 >= 1024 && c0 < 1536) {
          const int cc = c - 1024, head = cc >> 7, dv = cc & 127;
          const int b = rowb >> 13, t0 = rowb & 8191;
#pragma unroll
          for (int g4 = 0; g4 < 4; g4++) {
            uint2 v = make_uint2(pack2(acc[mi][ni][4 * g4], acc[mi][ni][4 * g4 + 1]), pack2(acc[mi][ni][4 * g4 + 2], acc[mi][ni][4 * g4 + 3]));
            *(uint2*)(Vt + ((size_t)((b * 4 + head) * 128 + dv)) * L_ + t0 + 8 * g4 + 4 * hh) = v;
          }
        } else {
#pragma unroll
          for (int i = 0; i < 16; i++) {
            const size_t row = rowb + crow(i, hh);
            const float v = acc[mi][ni][i];
            if (c0 < 512) Qd[row * 512 + c] = f2bf(v);
            else if (c0 < 1024) Kd[row * 512 + (c - 512)] = f2bf(v);
            else if (c0 < 1792) U[row * 256 + (c - 1536)] = v;
            else if (c0 < 2048) Qs[row * 256 + (c - 1792)] = f2bf(v);
            else if (c0 < 2112) Ks[row * 64 + (c - 2048)] = f2bf(v);
            else if (c0 < 2176) Vs[row * 64 + (c - 2112)] = f2bf(v);
            else if (c0 < 2432) Qi[row * 256 + (c - 2176)] = f2bf(v);
            else if (c0 < 2464) Ki[row * 32 + (c - 2432)] = f2bf(v);
            else if (c0 == 2464) { if (r < 8) Wi[row * 8 + r] = v * 0.0625f; }
          }
        }
      }
    }
  }
}

DI void phase_ln(float* x, u16* __restrict__ xb, const float* __restrict__ g, const float* __restrict__ bta, int bid, int nb) {
  const int lane = tidx() & 63, wave = tidx() >> 6;
  float4 gg[4], bb[4];
#pragma unroll
  for (int i = 0; i < 4; i++) { gg[i] = *(const float4*)(g + i * 256 + lane * 4); bb[i] = *(const float4*)(bta + i * 256 + lane * 4); }
  for (int row = bid * 4 + wave; row < T_; row += nb * 4) {
    float4 v[4];
#pragma unroll
    for (int i = 0; i < 4; i++) v[i] = *(const float4*)(x + (size_t)row * 1024 + i * 256 + lane * 4);
    float s = 0.f;
#pragma unroll
    for (int i = 0; i < 4; i++) s += v[i].x + v[i].y + v[i].z + v[i].w;
    const float mu = wave_sum(s) * (1.f / 1024.f);
    float q = 0.f;
#pragma unroll
    for (int i = 0; i < 4; i++) { v[i].x -= mu; v[i].y -= mu; v[i].z -= mu; v[i].w -= mu; q += v[i].x * v[i].x + v[i].y * v[i].y + v[i].z * v[i].z + v[i].w * v[i].w; }
    const float rs = rsqrtf(wave_sum(q) * (1.f / 1024.f) + LN_EPS_);
#pragma unroll
    for (int i = 0; i < 4; i++) {
      float4 o;
      o.x = v[i].x * rs * gg[i].x + bb[i].x; o.y = v[i].y * rs * gg[i].y + bb[i].y;
      o.z = v[i].z * rs * gg[i].z + bb[i].z; o.w = v[i].w * rs * gg[i].w + bb[i].w;
      *(float4*)(x + (size_t)row * 1024 + i * 256 + lane * 4) = o;
      *(uint2*)(xb + (size_t)row * 1024 + i * 256 + lane * 4) = make_uint2(pack2(o.x, o.y), pack2(o.z, o.w));
    }
  }
}

DI float gelu_tanh(float x) { const float u = 0.7978845608028654f * (x + 0.044715f * x * x * x); return 0.5f * x * (1.f + tanhf(u)); }

template <bool OUT>
DI void ssm_scan(const Params& P, int layer, int widx, char* mb) {
  const int lane = tidx() & 63;
  const int b = widx >> 8, g = (widx >> 4) & 15, ch = widx & 15;
  const int gi = (layer * 16 + g) * 64 + lane;
  const float4 ca = ((const float4*)(WS(P) + OFF_COEFA))[gi];
  const float2* cbp = (const float2*)(WS(P) + OFF_COEFB) + (size_t)gi * 16;
  float bre[16], bim[16];
#pragma unroll
  for (int c = 0; c < 16; c++) { float2 t = cbp[c]; bre[c] = t.x; bim[c] = t.y; }
  const float* U = (const float*)(mb + M_U);
  float2* Send = (float2*)(mb + M_SEND);
  const size_t sbase = (size_t)((b * 16 + g) * 16) * 64 + lane;
  float xr = 0.f, xi = 0.f;
  float cre[16], cim[16];
  float dsk = 0.f;
  int mych = 0;
  if (OUT) {
    for (int j = 0; j < ch; j++) {
      const float2 e = Send[sbase + (size_t)j * 64];
      const float nr = ca.z * xr - ca.w * xi + e.x, ni = ca.z * xi + ca.w * xr + e.y;
      xr = nr; xi = ni;
    }
#pragma unroll
    for (int c = 0; c < 16; c++) {
      cre[c] = P.in[20][((size_t)(layer * 16 + g) * 16 + c) * 64 + lane];
      cim[c] = P.in[21][((size_t)(layer * 16 + g) * 16 + c) * 64 + lane];
    }
    mych = ((lane >> 5) & 1) * 8 + ((lane >> 4) & 1) * 4 + ((lane >> 3) & 1) * 2 + ((lane >> 2) & 1);
    dsk = P.in[22][layer * 256 + g * 16 + mych];
  }
  u16* Yg = (u16*)(mb + M_YG);
  const size_t tok0 = (size_t)b * L_ + ch * 512;
  const float* up = U + tok0 * 256 + g * 16;
#pragma unroll 2
  for (int t = 0; t < 512; t++) {
    const float4 u0 = *(const float4*)(up + (size_t)t * 256), u1 = *(const float4*)(up + (size_t)t * 256 + 4);
    const float4 u2 = *(const float4*)(up + (size_t)t * 256 + 8), u3 = *(const float4*)(up + (size_t)t * 256 + 12);
    const float uu[16] = {u0.x, u0.y, u0.z, u0.w, u1.x, u1.y, u1.z, u1.w, u2.x, u2.y, u2.z, u2.w, u3.x, u3.y, u3.z, u3.w};
    float br = 0.f, bi = 0.f;
#pragma unroll
    for (int c = 0; c < 16; c++) { br += bre[c] * uu[c]; bi += bim[c] * uu[c]; }
    const float nr = ca.x * xr - ca.y * xi + br, ni = ca.x * xi + ca.y * xr + bi;
    xr = nr; xi = ni;
    if (OUT) {
      float v[16];
#pragma unroll
      for (int c = 0; c < 16; c++) v[c] = cre[c] * xr - cim[c] * xi;
      const bool b5 = lane & 32, b4 = lane & 16, b3 = lane & 8, b2 = lane & 4;
      float v8[8], v4[4], v2[2], v1;
#pragma unroll
      for (int i = 0; i < 8; i++) { const float snd = b5 ? v[i] : v[i + 8]; const float rcv = __shfl_xor(snd, 32); v8[i] = (b5 ? v[i + 8] : v[i]) + rcv; }
#pragma unroll
      for (int i = 0; i < 4; i++) { const float snd = b4 ? v8[i] : v8[i + 4]; const float rcv = __shfl_xor(snd, 16); v4[i] = (b4 ? v8[i + 4] : v8[i]) + rcv; }
#pragma unroll
      for (int i = 0; i < 2; i++) { const float snd = b3 ? v4[i] : v4[i + 2]; const float rcv = __shfl_xor(snd, 8); v2[i] = (b3 ? v4[i + 2] : v4[i]) + rcv; }
      { const float snd = b2 ? v2[0] : v2[1]; const float rcv = __shfl_xor(snd, 4); v1 = (b2 ? v2[1] : v2[0]) + rcv; }
      v1 += __shfl_xor(v1, 2);
      v1 += __shfl_xor(v1, 1);
      float um = uu[0];
#pragma unroll
      for (int c = 1; c < 16; c++) um = (mych == c) ? uu[c] : um;
      const float y = gelu_tanh(v1 + dsk * um);
      if ((lane & 3) == 0) Yg[(tok0 + t) * 256 + g * 16 + mych] = f2bf(y);
    }
  }
  if (!OUT) Send[sbase + (size_t)ch * 64] = make_float2(xr, xi);
}

constexpr int KS_ = 72, VS_ = 68;
DI void da_item(const Params& P, int layer, int b, int h, int qt, char* mb, char* smem) {
  const int tid = tidx(), lane = tid & 63, wave = tid >> 6, r = lane & 31, hh = lane >> 5;
  u16* sK = (u16*)smem;
  u16* sV = sK + 64 * KS_;
  float* sbias = (float*)(sV + 128 * VS_);
  u16* sQw = (u16*)(smem + 28672) + (tidx() >> 6) * 32 * KS_;
  const u16* Qd = (const u16*)(mb + M_QD); const u16* Kd = (const u16*)(mb + M_KD); const u16* Vt = (const u16*)(mb + M_VT);
  u16* CC = (u16*)(WS(P) + OFF_CC);
  const int q0 = qt * 128, qw = q0 + wave * 32, qp = qw + r;
  const size_t tokq = (size_t)b * L_ + qp;
  __syncthreads();
  if (tid < 129) sbias[tid] = ((const float*)(WS(P) + OFF_BIAS))[h * 129 + tid] * LOG2E_;
  __syncthreads();
  const float bfar = sbias[128];
  const float SC = 0.125f * LOG2E_;
  const int nkt = (q0 + 128) >> 6;
  const float lam = ((const float*)(WS(P) + OFF_LAM))[layer];
  const int krow_l = tid >> 3, kch = (tid & 7) * 8;
#pragma unroll 1
  for (int c = 0; c < 2; c++) {
#pragma unroll
    for (int ks = 0; ks < 4; ks++) *(bf16x8*)(sQw + r * KS_ + ks * 16 + hh * 8) = *(const bf16x8*)(Qd + tokq * 512 + h * 128 + c * 64 + ks * 16 + hh * 8);
    f32x16 o[4] = {zero16(), zero16(), zero16(), zero16()};
    float m = -INFINITY, l = 0.f;
    const u16* Kbase = Kd + ((size_t)b * L_ + krow_l) * 512 + h * 128 + c * 64 + kch;
    const u16* Vbase = Vt + ((size_t)((b * 4 + h) * 128 + krow_l)) * L_ + kch;
#pragma unroll 1
    for (int kt = 0; kt < nkt; kt++) {
      __syncthreads();
      {
        u32x4 rk[2], rv[4];
#pragma unroll
        for (int i = 0; i < 2; i++) rk[i] = *(const u32x4*)(Kbase + (size_t)(kt * 64 + i * 32) * 512);
#pragma unroll
        for (int i = 0; i < 4; i++) rv[i] = *(const u32x4*)(Vbase + (size_t)(i * 32) * L_ + kt * 64);
#pragma unroll
        for (int i = 0; i < 2; i++) *(u32x4*)(sK + (krow_l + i * 32) * KS_ + kch) = rk[i];
#pragma unroll
        for (int i = 0; i < 4; i++) {
          u32x2* d = (u32x2*)(sV + (krow_l + i * 32) * VS_ + kch);
          u32x2 lo2, hi2; lo2.x = rv[i].x; lo2.y = rv[i].y; hi2.x = rv[i].z; hi2.y = rv[i].w;
          d[0] = lo2; d[1] = hi2;
        }
      }
      __syncthreads();
      if (kt * 64 <= qw + 31) {
        f32x16 s[2];
#pragma unroll
        for (int kb = 0; kb < 2; kb++) {
          s[kb] = zero16();
#pragma unroll
          for (int ks = 0; ks < 4; ks++) {
            const bf16x8 kf = *(const bf16x8*)(sK + (kb * 32 + r) * KS_ + ks * 16 + hh * 8);
            const bf16x8 qf = *(const bf16x8*)(sQw + r * KS_ + ks * 16 + hh * 8);
            s[kb] = MFMA32(kf, qf, s[kb]);
          }
        }
        const bool nearb = (kt * 64 + 63 + 128 > qw);
        float mx = -INFINITY;
        if (nearb) {
#pragma unroll
          for (int kb = 0; kb < 2; kb++)
#pragma unroll
            for (int i = 0; i < 16; i++) {
              const int dist = qp - (kt * 64 + kb * 32 + crow(i, hh));
              const float bv = sbias[min(max(dist, 0), 128)];
              float t = s[kb][i] * SC + bv;
              t = (dist >= 0) ? t : -INFINITY;
              s[kb][i] = t; mx = fmaxf(mx, t);
              if ((i & 7) == 7) __builtin_amdgcn_sched_barrier(0);
            }
        } else {
#pragma unroll
          for (int kb = 0; kb < 2; kb++)
#pragma unroll
            for (int i = 0; i < 16; i++) { const float t = s[kb][i] * SC + bfar; s[kb][i] = t; mx = fmaxf(mx, t); }
        }
        mx = fmaxf(mx, __shfl_xor(mx, 32));
        const float mn = fmaxf(m, mx);
        const float corr = __builtin_amdgcn_exp2f(m - mn);
        m = mn;
        float ls = 0.f;
#pragma unroll
        for (int kb = 0; kb < 2; kb++)
#pragma unroll
          for (int i = 0; i < 16; i++) { const float p = __builtin_amdgcn_exp2f(s[kb][i] - mn); s[kb][i] = p; ls += p; }
        l = l * corr + ls;
#pragma unroll
        for (int dt = 0; dt < 4; dt++)
#pragma unroll
          for (int i = 0; i < 16; i++) o[dt][i] *= corr;
#pragma unroll
        for (int kb = 0; kb < 2; kb++)
#pragma unroll
          for (int s2 = 0; s2 < 2; s2++) {
            const bf16x8 pf = pack8(s[kb], s2);
#pragma unroll
            for (int dt = 0; dt < 4; dt++) {
              const u16* vp = sV + (dt * 32 + r) * VS_ + kb * 32 + s2 * 16 + 4 * hh;
              const s16x4 lo = *(const s16x4*)vp, hi = *(const s16x4*)(vp + 8);
              const bf16x8 vf = __builtin_shufflevector(lo, hi, 0, 1, 2, 3, 4, 5, 6, 7);
              o[dt] = MFMA32(vf, pf, o[dt]);
            }
            __builtin_amdgcn_sched_barrier(0);
          }
      }
    }
    const float lt = l + __shfl_xor(l, 32);
    const float inv = 1.f / lt;
    size_t tq = tokq;
    asm volatile("" : "+v"(tq));
    u16* obase = CC + tq * 1024 + h * 128 + 4 * hh;
    if (c == 0) {
#pragma unroll
      for (int dt = 0; dt < 4; dt++)
#pragma unroll
        for (int g4 = 0; g4 < 4; g4++) {
          *(uint2*)(obase + dt * 32 + 8 * g4) = make_uint2(pack2(o[dt][4 * g4] * inv, o[dt][4 * g4 + 1] * inv), pack2(o[dt][4 * g4 + 2] * inv, o[dt][4 * g4 + 3] * inv));
        }
    } else {
      float ss = 0.f;
#pragma unroll
      for (int dt = 0; dt < 4; dt++)
#pragma unroll
        for (int g4 = 0; g4 < 4; g4++) {
          const uint2 pv = *(const uint2*)(obase + dt * 32 + 8 * g4);
          const float a4[4] = {bf2f((u16)(pv.x & 0xffff)), bf2f((u16)(pv.x >> 16)), bf2f((u16)(pv.y & 0xffff)), bf2f((u16)(pv.y >> 16))};
#pragma unroll
          for (int e = 0; e < 4; e++) { const float v = a4[e] - lam * o[dt][4 * g4 + e] * inv; o[dt][4 * g4 + e] = v; ss = __builtin_fmaf(v, v, ss); }
        }
      ss += __shfl_xor(ss, 32);
      const float lam_init = 0.8f - 0.6f * __expf(-0.3f * (float)layer);
      const float rn = rsqrtf(ss * (1.f / 128.f) + LN_EPS_) * (1.f - lam_init);
      int hh2 = hh;
      asm volatile("" : "+v"(hh2));
      const float* sg = P.in[14] + layer * 128 + 4 * hh2;
#pragma unroll
      for (int dt = 0; dt < 4; dt++)
#pragma unroll
        for (int g4 = 0; g4 < 4; g4++) {
          const int dv = dt * 32 + 8 * g4 + 4 * hh;
          const float4 gv = *(const float4*)(sg + dt * 32 + 8 * g4);
          uint2 w = make_uint2(pack2(o[dt][4 * g4] * rn * gv.x, o[dt][4 * g4 + 1] * rn * gv.y),
                               pack2(o[dt][4 * g4 + 2] * rn * gv.z, o[dt][4 * g4 + 3] * rn * gv.w));
          *(uint2*)(obase + dv - 4 * hh) = w;
        }
    }
  }
}

DI unsigned sortkey(float f) { const unsigned u = __float_as_uint(f + 0.f); return u ^ (((unsigned)((int)u >> 31)) | 0x80000000u); }

DI void dsa_item(const Params& P, int layer, int b, int qt, char* mb, char* smem) {
  const int tid = tidx(), lane = tid & 63, wave = tid >> 6, r = lane & 31, hh = lane >> 5;
  unsigned* hist = (unsigned*)smem;
  float* sP = (float*)smem;
  float* sQ = (float*)(smem + 16384);
  u16* sidx = (u16*)(smem + 32896);
  unsigned* meta = (unsigned*)(smem + 32896 + 16384);
  float* sbias = (float*)(smem + 32896 + 16384 + 512);
  const u16* Qi = (const u16*)(mb + M_QI); const u16* Ki = (const u16*)(mb + M_KI); const float* Wi = (const float*)(mb + M_WI);
  const u16* Qs = (const u16*)(mb + M_QS); const u16* Ks = (const u16*)(mb + M_KS); const u16* Vs = (const u16*)(mb + M_VS);
  u16* CC = (u16*)(WS(P) + OFF_CC);
  const int q0 = qt * 32;
  const int qp = q0 + r;
  const size_t tokb = (size_t)b * L_;
  const int nk32 = qt + 1;
  const bool radix = (q0 >= 256);
  __syncthreads();
  for (int i = tid; i < 4 * 129; i += 256) sbias[i] = ((const float*)(WS(P) + OFF_BIAS))[4 * 129 + i];
  if (tid < 128) meta[tid] = (tid >= 32 && tid < 64) ? 256u : 0u;
  char* sQi = smem + 51872;
  float* sWi = (float*)(smem + 68768);
  {
    const int row = tid >> 3, ch = tid & 7;
    const uint4* src = (const uint4*)(Qi + (tokb + q0 + row) * 256 + ch * 32);
    uint4* dst = (uint4*)(sQi + row * 528 + ch * 64);
    dst[0] = src[0]; dst[1] = src[1]; dst[2] = src[2]; dst[3] = src[3];
    sWi[tid] = Wi[(tokb + q0) * 8 + tid];
  }
  const int npass = radix ? 5 : 1;
#pragma unroll 1
  for (int pass = (radix ? 0 : 4); pass < 5; pass++) {
    __syncthreads();
    if (pass < 4) { for (int i = tid; i < 32 * 257; i += 256) hist[i] = 0u; }
    __syncthreads();
    const unsigned pref = meta[r];
    const unsigned krem = meta[32 + r];
    bf16x8 nf0 = {0, 0, 0, 0, 0, 0, 0, 0}, nf1 = {0, 0, 0, 0, 0, 0, 0, 0};
    if (wave < nk32) {
      nf0 = *(const bf16x8*)(Ki + (tokb + wave * 32 + r) * 32 + hh * 8);
      nf1 = *(const bf16x8*)(Ki + (tokb + wave * 32 + r) * 32 + 16 + hh * 8);
    }
#pragma unroll 1
    for (int kt = wave; kt < nk32; kt += 4) {
      const bf16x8 kf0 = nf0, kf1 = nf1;
      if (kt + 4 < nk32) {
        nf0 = *(const bf16x8*)(Ki + (tokb + (kt + 4) * 32 + r) * 32 + hh * 8);
        nf1 = *(const bf16x8*)(Ki + (tokb + (kt + 4) * 32 + r) * 32 + 16 + hh * 8);
      }
      f32x16 sc = zero16();
#pragma unroll 4
      for (int hd = 0; hd < 8; hd++) {
        const bf16x8 q0f = *(const bf16x8*)(sQi + r * 528 + hd * 64 + hh * 16);
        const bf16x8 q1f = *(const bf16x8*)(sQi + r * 528 + hd * 64 + 32 + hh * 16);
        const float w = sWi[r * 8 + hd];
        f32x16 s = MFMA32(kf0, q0f, zero16());
        s = MFMA32(kf1, q1f, s);
#pragma unroll
        for (int i = 0; i < 16; i++) sc[i] += __int_as_float(max(__float_as_int(s[i]), 0)) * w;
      }
      const int lim = (kt == qt) ? qp : 0x7fffffff;
      if (pass == 0) {
#pragma unroll
        for (int i = 0; i < 16; i++) {
          const int kp = kt * 32 + crow(i, hh);
          const unsigned key = sortkey(sc[i]);
          const unsigned bin = (kp <= lim) ? (key >> 24) : 256u;
          atomicAdd(&hist[r * 257 + bin], 1u);
        }
      } else if (pass < 4) {
        const int sh = 24 - 8 * pass;
#pragma unroll
        for (int i = 0; i < 16; i++) {
          const int kp = kt * 32 + crow(i, hh);
          const unsigned key = sortkey(sc[i]);
          if ((key >> (sh + 8)) == pref && kp <= lim) atomicAdd(&hist[r * 257 + ((key >> sh) & 255u)], 1u);
        }
      } else {
#pragma unroll
        for (int i = 0; i < 16; i++) {
          const int kp = kt * 32 + crow(i, hh);
          const unsigned key = sortkey(sc[i]);
          bool sel = (kp <= lim);
          if (radix) {
            sel = sel && (key >= pref);
            if (sel && key == pref) sel = atomicAdd(&meta[96 + r], 1u) < krem;
          }
          if (sel) { const unsigned pos = atomicAdd(&meta[64 + r], 1u); if (pos < 256u) sidx[r * 256 + pos] = (u16)kp; }
        }
      }
    }
    __syncthreads();
    if (pass < 4) {
      for (int j = 0; j < 8; j++) {
        const int qq = wave * 8 + j;
        const unsigned k = meta[32 + qq];
        unsigned c4[4]; unsigned tot = 0;
#pragma unroll
        for (int e = 0; e < 4; e++) { c4[e] = hist[qq * 257 + 255 - 4 * lane - e]; tot += c4[e]; }
        unsigned incl = tot;
        for (int o = 1; o < 64; o <<= 1) { const unsigned t = __shfl_up(incl, o); if (lane >= o) incl += t; }
        unsigned run = incl - tot;
#pragma unroll
        for (int e = 0; e < 4; e++) {
          if (run < k && run + c4[e] >= k) { meta[qq] = (meta[qq] << 8) | (unsigned)(255 - 4 * lane - e); meta[32 + qq] = k - run; }
          run += c4[e];
        }
      }
    }
  }
  (void)npass;
  __syncthreads();
  float* myP = sP + wave * 1024;
  (void)sQ;
#pragma unroll 1
  for (int j = 0; j < 8; j++) {
    const int qq = wave * 8 + j;
    const int qpos = q0 + qq;
    const size_t tok = tokb + qpos;
    const int n = min((int)meta[64 + qq], 256);
    __syncthreads();
    bf16x8 qf[4];
#pragma unroll
    for (int ks = 0; ks < 4; ks++) {
      bf16x8 z = {0, 0, 0, 0, 0, 0, 0, 0};
      if (r < 4) z = *(const bf16x8*)(Qs + tok * 256 + r * 64 + ks * 16 + hh * 8);
      qf[ks] = z;
    }
#pragma unroll 2
    for (int kb = 0; kb < 8; kb++) {
      const int jj = kb * 32 + r;
      const int kidx = (jj < n) ? (int)sidx[qq * 256 + jj] : 0;
      const u16* kp = Ks + (tokb + kidx) * 64 + hh * 8;
      bf16x8 kf[4];
#pragma unroll
      for (int ks = 0; ks < 4; ks++) kf[ks] = *(const bf16x8*)(kp + ks * 16);
      f32x16 sacc = zero16();
#pragma unroll
      for (int ks = 0; ks < 4; ks++) sacc = MFMA32(kf[ks], qf[ks], sacc);
      if (r < 4) {
#pragma unroll
        for (int i = 0; i < 16; i++) myP[(kb * 32 + crow(i, hh)) * 4 + r] = sacc[i];
      }
    }
    __syncthreads();
    float sc[4][4];
#pragma unroll
    for (int rd = 0; rd < 4; rd++) {
      const int jj = rd * 64 + lane;
      const bool valid = jj < n;
      const int kidx = valid ? (int)sidx[qq * 256 + jj] : 0;
      const int dist = min(max(qpos - kidx, 0), 128);
      const float4 d = *(const float4*)(myP + jj * 4);
      sc[rd][0] = valid ? d.x * 0.125f + sbias[0 * 129 + dist] : -INFINITY;
      sc[rd][1] = valid ? d.y * 0.125f + sbias[1 * 129 + dist] : -INFINITY;
      sc[rd][2] = valid ? d.z * 0.125f + sbias[2 * 129 + dist] : -INFINITY;
      sc[rd][3] = valid ? d.w * 0.125f + sbias[3 * 129 + dist] : -INFINITY;
    }
#pragma unroll
    for (int hd = 0; hd < 4; hd++) {
      float mx = fmaxf(fmaxf(sc[0][hd], sc[1][hd]), fmaxf(sc[2][hd], sc[3][hd]));
      mx = wave_max(mx);
      float sm = 0.f;
#pragma unroll
      for (int rd = 0; rd < 4; rd++) { sc[rd][hd] = __expf(sc[rd][hd] - mx); sm += sc[rd][hd]; }
      sm = wave_sum(sm);
      const float inv = 1.f / sm;
#pragma unroll
      for (int rd = 0; rd < 4; rd++) sc[rd][hd] *= inv;
    }
#pragma unroll
    for (int rd = 0; rd < 4; rd++) *(float4*)(myP + (rd * 64 + lane) * 4) = make_float4(sc[rd][0], sc[rd][1], sc[rd][2], sc[rd][3]);
    __syncthreads();
    const int g = lane >> 3, c8 = lane & 7;
    float acc[32];
#pragma unroll
    for (int i = 0; i < 32; i++) acc[i] = 0.f;
#pragma unroll 4
    for (int it = 0; it < 32; it++) {
      const int jj = it * 8 + g;
      const int kidx = (jj < n) ? (int)sidx[qq * 256 + jj] : 0;
      const float4 pj = *(const float4*)(myP + jj * 4);
      const u32x4 vv = *(const u32x4*)(Vs + (tokb + kidx) * 64 + c8 * 8);
      const float vf[8] = {bf2f((u16)(vv.x & 0xffff)), bf2f((u16)(vv.x >> 16)), bf2f((u16)(vv.y & 0xffff)), bf2f((u16)(vv.y >> 16)),
                           bf2f((u16)(vv.z & 0xffff)), bf2f((u16)(vv.z >> 16)), bf2f((u16)(vv.w & 0xffff)), bf2f((u16)(vv.w >> 16))};
#pragma unroll
      for (int e = 0; e < 8; e++) {
        acc[0 * 8 + e] += pj.x * vf[e]; acc[1 * 8 + e] += pj.y * vf[e];
        acc[2 * 8 + e] += pj.z * vf[e]; acc[3 * 8 + e] += pj.w * vf[e];
      }
    }
    const bool b5 = lane & 32, b4 = lane & 16, b3 = lane & 8;
    float w16[16], w8[8], w4[4];
#pragma unroll
    for (int i = 0; i < 16; i++) { const float snd = b5 ? acc[i] : acc[i + 16]; const float rcv = __shfl_xor(snd, 32); w16[i] = (b5 ? acc[i + 16] : acc[i]) + rcv; }
#pragma unroll
    for (int i = 0; i < 8; i++) { const float snd = b4 ? w16[i] : w16[i + 8]; const float rcv = __shfl_xor(snd, 16); w8[i] = (b4 ? w16[i + 8] : w16[i]) + rcv; }
#pragma unroll
    for (int i = 0; i < 4; i++) { const float snd = b3 ? w8[i] : w8[i + 4]; const float rcv = __shfl_xor(snd, 8); w4[i] = (b3 ? w8[i + 4] : w8[i]) + rcv; }
    const int hd = (b5 ? 2 : 0) + (b4 ? 1 : 0);
    *(uint2*)(CC + tok * 1024 + 768 + hd * 64 + c8 * 8 + (b3 ? 4 : 0)) = make_uint2(pack2(w4[0], w4[1]), pack2(w4[2], w4[3]));
  }
}

DI void phase_mix1(const Params& P, int layer, int bid, int nb, char* smem) {
  char* mb = WS(P) + OFF_H;
  for (int w = bid * 4 + (tidx() >> 6); w < 2048; w += nb * 4) ssm_scan<false>(P, layer, w, mb);
  for (int j = 0;; j++) {
    const int idx = (j & 1) ? (j * nb + (nb - 1 - bid)) : (j * nb + bid);
    if (j * nb >= 2048) break;
    if (idx >= 2048) continue;
    const int qt = 255 - (idx >> 3), b = idx & 7;
    dsa_item(P, layer, b, qt, mb, smem);
  }
}

DI void phase_mix2(const Params& P, int layer, int bid, int nb, char* smem) {
  char* mb = WS(P) + OFF_H;
  for (int w = bid * 4 + (tidx() >> 6); w < 2048; w += nb * 4) ssm_scan<true>(P, layer, w, mb);
  for (int j = 0;; j++) {
    const int idx = (j & 1) ? (j * nb + (nb - 1 - bid)) : (j * nb + bid);
    if (j * nb >= 2048) break;
    if (idx >= 2048) continue;
    const int qt = 63 - (idx >> 5), bh = idx & 31;
    da_item(P, layer, bh >> 2, bh & 3, qt, mb, smem);
  }
}

DI void run_phase(const Params& P, int ph, int bid, int nb, char* smem) {
  char* ws = WS(P);
  u16* sm = (u16*)smem;
  if (ph == 0) { phase_prep(P, bid, nb, smem); return; }
  const int l = (ph - 1) / 12, s = (ph - 1) % 12;
  u16* Xb = (u16*)(ws + OFF_XB);
  u16* H = (u16*)(ws + OFF_H);
  u16* CC = (u16*)(ws + OFF_CC);
  float* X = OUTP(P);
  switch (s) {
    case 0: phase_ffn_up(Xb, (const u16*)(ws + OFF_WGU1 + l * SZ_WGU), H, bid, nb, sm); break;
    case 1: phase_ffn_down(H, (const u16*)(ws + OFF_WD1 + l * SZ_WD), (l == 0) ? P.in[0] : (const float*)X, X, nullptr, bid, nb, sm); break;
    case 2: phase_ln(X, Xb, P.in[6] + l * 1024, P.in[7] + l * 1024, bid, nb); break;
    case 3: phase_w_in(Xb, (const u16*)(ws + OFF_WIN + l * SZ_WIN), ws + OFF_H, bid, nb, sm); break;
    case 4: phase_mix1(P, l, bid, nb, smem); break;
    case 5: phase_mix2(P, l, bid, nb, smem); break;
    case 6: phase_glu((const u16*)(ws + OFF_H + M_YG), (const u16*)(ws + OFF_WGLU + l * SZ_WGLU), CC, bid, nb, sm); break;
    case 7: phase_w_o(CC, (const u16*)(ws + OFF_WO + l * SZ_WO), X, bid, nb, sm); break;
    case 8: phase_ln(X, Xb, P.in[24] + l * 1024, P.in[25] + l * 1024, bid, nb); break;
    case 9:
      phase_ffn_up(Xb, (const u16*)(ws + OFF_WGU2 + l * SZ_WGU), H, bid, nb, sm);
      phase_ple(Xb, (const u16*)(ws + OFF_WPG + l * SZ_WPG), (const u16*)(ws + OFF_PB) + (size_t)l * T_ * 256, (const u16*)(ws + OFF_WPP + l * SZ_WPP), CC, bid, nb, sm);
      break;
    case 10: phase_ffn_down(H, (const u16*)(ws + OFF_WD2 + l * SZ_WD), X, X, CC, bid, nb, sm); break;
    case 11: phase_ln(X, Xb, P.in[31] + l * 1024, P.in[32] + l * 1024, bid, nb); break;
  }
}

constexpr int NPHASES = 25;

__global__ void __launch_bounds__(256, 2) mega(Params P, int ph0, int ph1) {
  extern __shared__ __attribute__((aligned(16))) char smem[];
  cg::grid_group grid = cg::this_grid();
  const int bid = blockIdx.x, nb = gridDim.x;
#ifndef DUP_MASK
#define DUP_MASK 0
#endif
#define PHASE(k) if (ph0 <= (k) && (k) < ph1) { \
    if ((k) > 0 && ((DUP_MASK >> (((k) - 1) % 12)) & 1)) { run_phase(P, (k), bid, nb, smem); grid.sync(); } \
    run_phase(P, (k), bid, nb, smem); if ((k) + 1 < ph1) grid.sync(); }
  PHASE(0) PHASE(1) PHASE(2) PHASE(3) PHASE(4) PHASE(5) PHASE(6) PHASE(7) PHASE(8) PHASE(9) PHASE(10) PHASE(11) PHASE(12)
  PHASE(13) PHASE(14) PHASE(15) PHASE(16) PHASE(17) PHASE(18) PHASE(19) PHASE(20) PHASE(21) PHASE(22) PHASE(23) PHASE(24)
#undef PHASE
}

extern "C" void kernel_launch(void* const* d_in, const int* in_sizes, int n_in, void* d_out, int out_size, void* d_ws, size_t ws_size, hipStream_t stream) {
  static int grid_blocks = 0;
  if (grid_blocks == 0) {
    if (n_in != 33 || ws_size < WS_END) { fprintf(stderr, "kernel_launch: need 33 inputs and %zu bytes of ws (got %d, %zu)\n", (size_t)WS_END, n_in, ws_size); grid_blocks = -1; return; }
    int dev = 0, cus = 0, per_cu = 0;
    (void)hipGetDevice(&dev);
    (void)hipDeviceGetAttribute(&cus, hipDeviceAttributeMultiprocessorCount, dev);
    (void)hipFuncSetAttribute((const void*)mega, hipFuncAttributeMaxDynamicSharedMemorySize, LDS_BYTES);
    (void)hipOccupancyMaxActiveBlocksPerMultiprocessor(&per_cu, (const void*)mega, 256, LDS_BYTES);
    if (per_cu < 1) per_cu = 1;
    if (per_cu > 2) per_cu = 2;
    grid_blocks = cus * per_cu;
    fprintf(stderr, "kernel_launch: cus %d per_cu %d grid %d\n", cus, per_cu, grid_blocks);
  }
  if (grid_blocks < 0) return;
  Params p;
  memset(&p, 0, sizeof(p));
  for (int i = 0; i < 33; i++) p.in[i] = (const float*)d_in[i];
  p.out = (float*)d_out;
  p.ws = (char*)d_ws;
#if MULTI_LAUNCH
  for (int ph = 0; ph < NPHASES; ph++) {
    hipLaunchKernelGGL(mega, dim3(grid_blocks), dim3(256), LDS_BYTES, stream, p, ph, ph + 1);
  }
#else
  int ph0 = 0, ph1 = NPHASES;
  void* args[] = {&p, &ph0, &ph1};
  hipError_t e = hipLaunchCooperativeKernel((const void*)mega, dim3(grid_blocks), dim3(256), args, LDS_BYTES, stream);
  if (e != hipSuccess) fprintf(stderr, "cooperative launch failed: %s (grid %d)\n", hipGetErrorString(e), grid_blocks);
#endif
}
```

```cpp
#include <hip/hip_runtime.h>
#include <hip/hip_cooperative_groups.h>
#include <stdint.h>
#include <math.h>
#include <stdio.h>
#include <string.h>
namespace cg = cooperative_groups;

#ifndef MULTI_LAUNCH
#define MULTI_LAUNCH 0
#endif

typedef unsigned short u16;
typedef __attribute__((ext_vector_type(8))) short bf16x8;
typedef __attribute__((ext_vector_type(4))) short s16x4;
typedef __attribute__((ext_vector_type(16))) float f32x16;
typedef __attribute__((ext_vector_type(4))) unsigned u32x4;
typedef __attribute__((ext_vector_type(2))) unsigned u32x2;

#define DI __device__ __forceinline__
#define MFMA32(a, b, c) __builtin_amdgcn_mfma_f32_32x32x16_bf16((a), (b), (c), 0, 0, 0)

constexpr int T_ = 65536;
constexpr int L_ = 8192;
constexpr int D_ = 1024;
constexpr int FF_ = 2816;
constexpr float ALPHA_ = 1.41421356237309515f;
constexpr float LN_EPS_ = 1e-5f;
constexpr float LOG2E_ = 1.44269504088896341f;
constexpr int LDS_BYTES = 73728;

constexpr size_t SZ_WGU = (size_t)5632 * 1024 * 2;
constexpr size_t SZ_WD = (size_t)1024 * 2816 * 2;
constexpr size_t SZ_WIN = (size_t)2560 * 1024 * 2;
constexpr size_t SZ_WO = (size_t)1024 * 1024 * 2;
constexpr size_t SZ_WGLU = (size_t)256 * 256 * 2;
constexpr size_t SZ_WPG = (size_t)1024 * 1024 * 2;
constexpr size_t SZ_WPP = (size_t)1024 * 256 * 2;
constexpr size_t OFF_WGU1 = 0;
constexpr size_t OFF_WD1 = OFF_WGU1 + 2 * SZ_WGU;
constexpr size_t OFF_WGU2 = OFF_WD1 + 2 * SZ_WD;
constexpr size_t OFF_WD2 = OFF_WGU2 + 2 * SZ_WGU;
constexpr size_t OFF_WIN = OFF_WD2 + 2 * SZ_WD;
constexpr size_t OFF_WO = OFF_WIN + 2 * SZ_WIN;
constexpr size_t OFF_WGLU = OFF_WO + 2 * SZ_WO;
constexpr size_t OFF_WPG = OFF_WGLU + 2 * SZ_WGLU;
constexpr size_t OFF_WPP = OFF_WPG + 2 * SZ_WPG;
constexpr size_t OFF_COEFA = OFF_WPP + 2 * SZ_WPP;
constexpr size_t OFF_COEFB = OFF_COEFA + 2 * 16 * 64 * 16;
constexpr size_t OFF_LAM = OFF_COEFB + 2 * 16 * 64 * 16 * 8;
constexpr size_t OFF_BIAS = OFF_LAM + 256;
constexpr size_t OFF_XB = OFF_BIAS + 8 * 129 * 4 + 32;
constexpr size_t OFF_PB = OFF_XB + (size_t)T_ * 1024 * 2;
constexpr size_t OFF_H = OFF_PB + (size_t)2 * T_ * 256 * 2;
constexpr size_t SZ_H = (size_t)384 << 20;
constexpr size_t OFF_CC = OFF_H + SZ_H;
constexpr size_t OFF_CANDK = OFF_CC + (size_t)T_ * 1024 * 2;
constexpr int CAP_ = 2048;
constexpr size_t OFF_CANDI = OFF_CANDK + (size_t)512 * 32 * CAP_ * 4;
constexpr size_t WS_END = OFF_CANDI + (size_t)512 * 32 * CAP_ * 2;
constexpr size_t MB_ = (size_t)1 << 20;
constexpr size_t M_QD = 0, M_KD = 64 * MB_, M_VT = 128 * MB_, M_U = 192 * MB_, M_QS = 256 * MB_, M_QI = 288 * MB_, M_YG = 320 * MB_,
                 M_KS = 352 * MB_, M_VS = 360 * MB_, M_KI = 368 * MB_, M_WI = 372 * MB_, M_SEND = 374 * MB_;

struct Params {
  const float* in[33];
  float* out;
  char* ws;
};

DI int tidx() { int t = threadIdx.x; asm volatile("" : "+v"(t)); return t; }
#define GAS __attribute__((address_space(1)))
DI size_t opaque0() { size_t z = 0; asm volatile("" : "+s"(z)); return z; }
DI char* WS(const Params& P) { return P.ws + opaque0(); }
DI float* OUTP(const Params& P) { return P.out + opaque0(); }
DI const float* INP(const Params& P, int i) { return P.in[i]; }
DI u16 f2bf(float x) { unsigned u = __float_as_uint(x); u += 0x7fffu + ((u >> 16) & 1u); return (u16)(u >> 16); }
DI float bf2f(u16 v) { return __uint_as_float(((unsigned)v) << 16); }
DI unsigned pack2(float a, float b) { return (unsigned)f2bf(a) | ((unsigned)f2bf(b) << 16); }
DI int crow(int i, int hh) { return (i & 3) + 8 * (i >> 2) + 4 * hh; }
DI float sigmoidf_(float x) { return 1.f / (1.f + __expf(-x)); }
DI float wave_sum(float v) { for (int o = 32; o > 0; o >>= 1) v += __shfl_xor(v, o); return v; }
DI float wave_max(float v) { for (int o = 32; o > 0; o >>= 1) v = fmaxf(v, __shfl_xor(v, o)); return v; }
DI f32x16 zero16() { f32x16 z; for (int i = 0; i < 16; i++) z[i] = 0.f; return z; }
DI bf16x8 pack8(const f32x16& x, int s) {
  union { unsigned u[4]; bf16x8 v; } t;
  t.u[0] = pack2(x[8 * s + 0], x[8 * s + 1]); t.u[1] = pack2(x[8 * s + 2], x[8 * s + 3]);
  t.u[2] = pack2(x[8 * s + 4], x[8 * s + 5]); t.u[3] = pack2(x[8 * s + 6], x[8 * s + 7]);
  return t.v;
}

constexpr int GS_ = 72;
constexpr int GT_ = 128 * GS_;

struct GemmPre { u32x4 a0[4], b0[4], a1[4], b1[4]; };
#define G_LOAD(RA, RB, T) _Pragma("unroll") for (int i = 0; i < 4; i++) { RA[i] = *(const u32x4*)(Ap + (size_t)i * 32 * lda + (T) * 64); RB[i] = *(const u32x4*)(Bp + (size_t)i * 32 * ldb + (T) * 64); }
DI void gemm_prefetch(GemmPre& R, const u16* __restrict__ A, int lda, const u16* __restrict__ B, int ldb) {
  const int tid = tidx();
  const int srow = tid >> 3, sk = (tid & 7) * 8;
  const u16* Ap = A + (size_t)srow * lda + sk;
  const u16* Bp = B + (size_t)srow * ldb + sk;
  G_LOAD(R.a0, R.b0, 0)
  G_LOAD(R.a1, R.b1, 1)
}
DI void gemm_main(f32x16 (&acc)[2][2], GemmPre& R, const u16* __restrict__ A, int lda, const u16* __restrict__ B, int ldb, int K, u16* sm) {
  const int tid = tidx(), lane = tid & 63, wave = tid >> 6;
  const int wm = wave >> 1, wn = wave & 1, r = lane & 31, hh = lane >> 5;
  const int srow = tid >> 3, sk = (tid & 7) * 8;
  const u16* Ap = A + (size_t)srow * lda + sk;
  const u16* Bp = B + (size_t)srow * ldb + sk;
#define G_STORE(RA, RB, BUF) { u16* d_ = sm + (BUF) * 2 * GT_; _Pragma("unroll") for (int i = 0; i < 4; i++) { *(u32x4*)(d_ + (srow + i * 32) * GS_ + sk) = RA[i]; *(u32x4*)(d_ + GT_ + (srow + i * 32) * GS_ + sk) = RB[i]; } }
#define G_COMPUTE(BUF) { const u16* sA = sm + (BUF) * 2 * GT_; const u16* sB = sA + GT_; \
    _Pragma("unroll") for (int ks = 0; ks < 4; ks++) { \
      const bf16x8 fa0 = *(const bf16x8*)(sA + (wm * 64 + r) * GS_ + ks * 16 + hh * 8); \
      const bf16x8 fa1 = *(const bf16x8*)(sA + (wm * 64 + 32 + r) * GS_ + ks * 16 + hh * 8); \
      const bf16x8 fb0 = *(const bf16x8*)(sB + (wn * 64 + r) * GS_ + ks * 16 + hh * 8); \
      const bf16x8 fb1 = *(const bf16x8*)(sB + (wn * 64 + 32 + r) * GS_ + ks * 16 + hh * 8); \
      acc[0][0] = MFMA32(fa0, fb0, acc[0][0]); acc[0][1] = MFMA32(fa0, fb1, acc[0][1]); \
      acc[1][0] = MFMA32(fa1, fb0, acc[1][0]); acc[1][1] = MFMA32(fa1, fb1, acc[1][1]); } }
  const int nk = K >> 6;
  __syncthreads();
  G_STORE(R.a0, R.b0, 0)
  G_LOAD(R.a0, R.b0, 2)
  __syncthreads();
  int kt = 0;
#pragma unroll 1
  for (; kt + 4 < nk; kt += 2) {
    G_COMPUTE(0)
    G_STORE(R.a1, R.b1, 1)
    __syncthreads();
    G_LOAD(R.a1, R.b1, kt + 3)
    G_COMPUTE(1)
    G_STORE(R.a0, R.b0, 0)
    __syncthreads();
    G_LOAD(R.a0, R.b0, kt + 4)
  }
  G_COMPUTE(0)
  G_STORE(R.a1, R.b1, 1)
  __syncthreads();
  G_LOAD(R.a1, R.b1, kt + 3)
  G_COMPUTE(1)
  G_STORE(R.a0, R.b0, 0)
  __syncthreads();
  G_COMPUTE(0)
  G_STORE(R.a1, R.b1, 1)
  __syncthreads();
  G_COMPUTE(1)
#undef G_STORE
#undef G_COMPUTE
}
#undef G_LOAD

DI bool tile_at(int it, int bid, int nb, int TM, int TN, int& tm, int& tn) {
  if ((nb & 7) == 0 && (TM & 63) == 0) {
    const int xcd = bid & 7, lw = bid >> 3, nlw = nb >> 3;
    const int lt = lw + it * nlw, per = (TM >> 3) * TN;
    if (lt >= per) return false;
    const int g = lt / (8 * TN), rem = lt - g * 8 * TN;
    tn = rem >> 3; tm = xcd * (TM >> 3) + g * 8 + (rem & 7);
    return true;
  } else {
    const int t = bid + it * nb;
    if (t >= TM * TN) return false;
    tn = t / TM; tm = t - tn * TM;
    return true;
  }
}

template <class AF, class BF, class EPI>
DI void gemm_phase(int TM, int TN, int K, int lda, int ldb, AF a_of, BF b_of, EPI epi, int bid, int nb, u16* sm) {
  GemmPre R;
  int tm, tn;
  bool have = tile_at(0, bid, nb, TM, TN, tm, tn);
  if (have) gemm_prefetch(R, a_of(tm), lda, b_of(tn), ldb);
  for (int it = 0; have; it++) {
    f32x16 acc[2][2] = {{zero16(), zero16()}, {zero16(), zero16()}};
    gemm_main(acc, R, a_of(tm), lda, b_of(tn), ldb, K, sm);
    int tm2 = 0, tn2 = 0;
    const bool have2 = tile_at(it + 1, bid, nb, TM, TN, tm2, tn2);
    if (have2) gemm_prefetch(R, a_of(tm2), lda, b_of(tn2), ldb);
    epi(acc, tm, tn);
    have = have2; tm = tm2; tn = tn2;
  }
}

DI void transpose_job(const float* __restrict__ src, int K, int N, u16* __restrict__ dst, int mode, int bid, int nb, float* tile) {
  const int tid = tidx();
  const int tk = K >> 6, tn = (N + 63) >> 6;
  for (int t = bid; t < tk * tn; t += nb) {
    const int k0 = (t % tk) * 64, n0 = (t / tk) * 64;
    __syncthreads();
#pragma unroll 4
    for (int i = 0; i < 16; i++) {
      const int k = i * 4 + (tid >> 6), n = tid & 63;
      tile[k * 65 + n] = (n0 + n < N) ? src[(size_t)(k0 + k) * N + n0 + n] : 0.f;
    }
    __syncthreads();
#pragma unroll 4
    for (int i = 0; i < 16; i++) {
      const int n = i * 4 + (tid >> 6), k = tid & 63;
      const int ng = n0 + n;
      if (ng < N) {
        int row = ng;
        if (mode == 1) row = (ng >> 5) * 64 + (ng & 31);
        else if (mode == 2) row = (ng >> 5) * 64 + 32 + (ng & 31);
        dst[(size_t)row * K + k0 + k] = f2bf(tile[k * 65 + n]);
      }
    }
  }
}

DI void phase_prep(const Params& P, int bid, int nb, char* smem) {
  float* tile = (float*)smem;
  char* ws = WS(P);
  for (int l = 0; l < 2; l++) {
    transpose_job(INP(P, 3) + (size_t)l * 1024 * FF_, 1024, FF_, (u16*)(ws + OFF_WGU1 + l * SZ_WGU), 1, bid, nb, tile);
    transpose_job(INP(P, 4) + (size_t)l * 1024 * FF_, 1024, FF_, (u16*)(ws + OFF_WGU1 + l * SZ_WGU), 2, bid, nb, tile);
    transpose_job(INP(P, 5) + (size_t)l * FF_ * 1024, FF_, 1024, (u16*)(ws + OFF_WD1 + l * SZ_WD), 0, bid, nb, tile);
    transpose_job(INP(P, 26) + (size_t)l * 1024 * FF_, 1024, FF_, (u16*)(ws + OFF_WGU2 + l * SZ_WGU), 1, bid, nb, tile);
    transpose_job(INP(P, 27) + (size_t)l * 1024 * FF_, 1024, FF_, (u16*)(ws + OFF_WGU2 + l * SZ_WGU), 2, bid, nb, tile);
    transpose_job(INP(P, 28) + (size_t)l * FF_ * 1024, FF_, 1024, (u16*)(ws + OFF_WD2 + l * SZ_WD), 0, bid, nb, tile);
    transpose_job(INP(P, 8) + (size_t)l * 1024 * 2472, 1024, 2472, (u16*)(ws + OFF_WIN + l * SZ_WIN), 0, bid, nb, tile);
    transpose_job(INP(P, 9) + (size_t)l * 1024 * 1024, 1024, 1024, (u16*)(ws + OFF_WO + l * SZ_WO), 0, bid, nb, tile);
    transpose_job(INP(P, 23) + (size_t)l * 256 * 256, 256, 256, (u16*)(ws + OFF_WGLU + l * SZ_WGLU), 0, bid, nb, tile);
    transpose_job(INP(P, 30) + (size_t)l * 1024 * 1024, 1024, 1024, (u16*)(ws + OFF_WPG + l * SZ_WPG), 0, bid, nb, tile);
    transpose_job(INP(P, 29) + (size_t)l * 256 * 1024, 256, 1024, (u16*)(ws + OFF_WPP + l * SZ_WPP), 0, bid, nb, tile);
    u16* win = (u16*)(ws + OFF_WIN + l * SZ_WIN);
    for (int i = bid * 256 + tidx(); i < 88 * 1024; i += nb * 256) win[(size_t)2472 * 1024 + i] = 0;
  }
  const size_t gt = (size_t)bid * 256 + tidx(), gs = (size_t)nb * 256;
  {
    const float4* x4 = (const float4*)INP(P, 0);
    uint2* xb = (uint2*)(ws + OFF_XB);
    for (size_t i = gt; i < (size_t)T_ * 1024 / 4; i += gs) { float4 v = x4[i]; xb[i] = make_uint2(pack2(v.x, v.y), pack2(v.z, v.w)); }
    const float4* p4 = (const float4*)INP(P, 1);
    uint2* pb = (uint2*)(ws + OFF_PB);
    for (size_t i = gt; i < (size_t)2 * T_ * 256 / 4; i += gs) { float4 v = p4[i]; pb[i] = make_uint2(pack2(v.x, v.y), pack2(v.z, v.w)); }
  }
  if (gt < 2 * 16 * 64) {
    const int l = (int)gt >> 10, g = ((int)gt >> 6) & 15, p = (int)gt & 63;
    const int gi = (l * 16 + g) * 64 + p;
    const double lr = INP(P, 15)[gi], li = INP(P, 16)[gi];
    const double dt = exp((double)INP(P, 17)[l * 16 + g]);
    const double mag = exp(lr * dt);
    const double ar = mag * cos(li * dt), ai = mag * sin(li * dt);
    const double mag5 = exp(512.0 * lr * dt);
    const double a5r = mag5 * cos(512.0 * li * dt), a5i = mag5 * sin(512.0 * li * dt);
    ((float4*)(ws + OFF_COEFA))[gi] = make_float4((float)ar, (float)ai, (float)a5r, (float)a5i);
    const double den = lr * lr + li * li, nr = ar - 1.0, ni = ai;
    const double fr = (nr * lr + ni * li) / den, fi = (ni * lr - nr * li) / den;
    float2* cb = (float2*)(ws + OFF_COEFB) + (size_t)gi * 16;
    for (int c = 0; c < 16; c++) {
      const double br = INP(P, 18)[(size_t)gi * 16 + c], bi = INP(P, 19)[(size_t)gi * 16 + c];
      cb[c] = make_float2((float)(fr * br - fi * bi), (float)(fr * bi + fi * br));
    }
  }
  if (gt < 8 * 129) {
    const int hd = (int)gt / 129, n = (int)gt - hd * 129;
    int bk = n;
    if (n >= 16) { bk = 16 + (int)(log((double)n / 16.0) / log(8.0) * 16.0); bk = bk < 31 ? bk : 31; }
    ((float*)(ws + OFF_BIAS))[gt] = INP(P, 2)[bk * 8 + hd];
  }
  if (gt < 2) {
    const int l = (int)gt;
    float s1 = 0.f, s2 = 0.f;
    for (int i = 0; i < 64; i++) { s1 += INP(P, 10)[l * 64 + i] * INP(P, 11)[l * 64 + i]; s2 += INP(P, 12)[l * 64 + i] * INP(P, 13)[l * 64 + i]; }
    const float lam_init = 0.8f - 0.6f * expf(-0.3f * (float)l);
    ((float*)(ws + OFF_LAM))[l] = expf(s1) - expf(s2) + lam_init;
  }
}

DI void phase_ffn_up(const u16* __restrict__ Xb, const u16* __restrict__ Wgu, u16* __restrict__ H, int bid, int nb, u16* sm) {
  const int lane = tidx() & 63, wave = tidx() >> 6, wm = wave >> 1, wn = wave & 1, r = lane & 31, hh = lane >> 5;
  gemm_phase(512, 44, 1024, 1024, 1024,
    [&](int tm) { return Xb + (size_t)tm * 128 * 1024; }, [&](int tn) { return Wgu + (size_t)tn * 128 * 1024; },
    [&](f32x16 (&acc)[2][2], int tm, int tn) {
      const int j = tn * 64 + wn * 32 + r;
#pragma unroll
      for (int mi = 0; mi < 2; mi++)
#pragma unroll
        for (int i = 0; i < 16; i++) {
          const int row = tm * 128 + wm * 64 + mi * 32 + crow(i, hh);
          const float g = acc[mi][0][i], u = acc[mi][1][i];
          H[(size_t)row * FF_ + j] = f2bf(g * sigmoidf_(g) * u);
        }
    }, bid, nb, sm);
}

DI void phase_ffn_down(const u16* __restrict__ H, const u16* __restrict__ Wd, const float* xin, float* xout, const u16* __restrict__ ple, int bid, int nb, u16* sm) {
  const int lane = tidx() & 63, wave = tidx() >> 6, wm = wave >> 1, wn = wave & 1, r = lane & 31, hh = lane >> 5;
  gemm_phase(512, 8, FF_, FF_, FF_,
    [&](int tm) { return H + (size_t)tm * 128 * FF_; }, [&](int tn) { return Wd + (size_t)tn * 128 * FF_; },
    [&](f32x16 (&acc)[2][2], int tm, int tn) {
#pragma unroll
      for (int mi = 0; mi < 2; mi++)
#pragma unroll
        for (int ni = 0; ni < 2; ni++)
#pragma unroll
          for (int i = 0; i < 16; i++) {
            const size_t o = (size_t)(tm * 128 + wm * 64 + mi * 32 + crow(i, hh)) * 1024 + tn * 128 + wn * 64 + ni * 32 + r;
            float v = ALPHA_ * xin[o] + 0.5f * acc[mi][ni][i];
            if (ple) v += bf2f(ple[o]);
            xout[o] = v;
          }
    }, bid, nb, sm);
}

DI void phase_w_o(const u16* __restrict__ CC, const u16* __restrict__ Wo, float* x, int bid, int nb, u16* sm) {
  const int lane = tidx() & 63, wave = tidx() >> 6, wm = wave >> 1, wn = wave & 1, r = lane & 31, hh = lane >> 5;
  gemm_phase(512, 8, 1024, 1024, 1024,
    [&](int tm) { return CC + (size_t)tm * 128 * 1024; }, [&](int tn) { return Wo + (size_t)tn * 128 * 1024; },
    [&](f32x16 (&acc)[2][2], int tm, int tn) {
#pragma unroll
      for (int mi = 0; mi < 2; mi++)
#pragma unroll
        for (int ni = 0; ni < 2; ni++)
#pragma unroll
          for (int i = 0; i < 16; i++) {
            const size_t o = (size_t)(tm * 128 + wm * 64 + mi * 32 + crow(i, hh)) * 1024 + tn * 128 + wn * 64 + ni * 32 + r;
            x[o] = ALPHA_ * x[o] + acc[mi][ni][i];
          }
    }, bid, nb, sm);
}

DI void phase_glu(const u16* __restrict__ Yg, const u16* __restrict__ Wglu, u16* __restrict__ CC, int bid, int nb, u16* sm) {
  const int lane = tidx() & 63, wave = tidx() >> 6, wm = wave >> 1, wn = wave & 1, r = lane & 31, hh = lane >> 5;
  gemm_phase(512, 2, 256, 256, 256,
    [&](int tm) { return Yg + (size_t)tm * 128 * 256; }, [&](int tn) { return Wglu + (size_t)tn * 128 * 256; },
    [&](f32x16 (&acc)[2][2], int tm, int tn) {
#pragma unroll
      for (int mi = 0; mi < 2; mi++)
#pragma unroll
        for (int ni = 0; ni < 2; ni++)
#pragma unroll
          for (int i = 0; i < 16; i++) {
            const int row = tm * 128 + wm * 64 + mi * 32 + crow(i, hh), col = tn * 128 + wn * 64 + ni * 32 + r;
            const float y = bf2f(Yg[(size_t)row * 256 + col]);
            CC[(size_t)row * 1024 + 512 + col] = f2bf(y * sigmoidf_(acc[mi][ni][i]));
          }
    }, bid, nb, sm);
}

DI void phase_ple(const u16* __restrict__ Xb, const u16* __restrict__ Wpg, const u16* __restrict__ Pb, const u16* __restrict__ Wpp, u16* ple, int bid, int nb, u16* sm) {
  const int lane = tidx() & 63, wave = tidx() >> 6, wm = wave >> 1, wn = wave & 1, r = lane & 31, hh = lane >> 5;
  gemm_phase(512, 8, 1024, 1024, 1024,
    [&](int tm) { return Xb + (size_t)tm * 128 * 1024; }, [&](int tn) { return Wpg + (size_t)tn * 128 * 1024; },
    [&](f32x16 (&acc)[2][2], int tm, int tn) {
#pragma unroll
      for (int mi = 0; mi < 2; mi++)
#pragma unroll
        for (int ni = 0; ni < 2; ni++)
#pragma unroll
          for (int i = 0; i < 16; i++) {
            const size_t o = (size_t)(tm * 128 + wm * 64 + mi * 32 + crow(i, hh)) * 1024 + tn * 128 + wn * 64 + ni * 32 + r;
            ple[o] = f2bf(sigmoidf_(acc[mi][ni][i]));
          }
    }, bid, nb, sm);
  gemm_phase(512, 8, 256, 256, 256,
    [&](int tm) { return Pb + (size_t)tm * 128 * 256; }, [&](int tn) { return Wpp + (size_t)tn * 128 * 256; },
    [&](f32x16 (&acc)[2][2], int tm, int tn) {
#pragma unroll
      for (int mi = 0; mi < 2; mi++)
#pragma unroll
        for (int ni = 0; ni < 2; ni++)
#pragma unroll
          for (int i = 0; i < 16; i++) {
            const size_t o = (size_t)(tm * 128 + wm * 64 + mi * 32 + crow(i, hh)) * 1024 + tn * 128 + wn * 64 + ni * 32 + r;
            ple[o] = f2bf(acc[mi][ni][i] * bf2f(ple[o]));
          }
    }, bid, nb, sm);
}

DI void phase_w_in(const u16* __restrict__ Xb, const u16* __restrict__ Win, char* mb, int bid, int nb, u16* sm) {
  const int lane = tidx() & 63, wave = tidx() >> 6, wm = wave >> 1, wn = wave & 1, r = lane & 31, hh = lane >> 5;
  u16* Qd = (u16*)(mb + M_QD); u16* Kd = (u16*)(mb + M_KD); u16* Vt = (u16*)(mb + M_VT); float* U = (float*)(mb + M_U);
  u16* Qs = (u16*)(mb + M_QS); u16* Qi = (u16*)(mb + M_QI); u16* Ks = (u16*)(mb + M_KS); u16* Vs = (u16*)(mb + M_VS);
  u16* Ki = (u16*)(mb + M_KI); float* Wi = (float*)(mb + M_WI);
  gemm_phase(512, 20, 1024, 1024, 1024,
    [&](int tm) { return Xb + (size_t)tm * 128 * 1024; }, [&](int tn) { return Win + (size_t)tn * 128 * 1024; },
    [&](f32x16 (&acc)[2][2], int tm, int tn) {
#pragma unroll
    for (int ni = 0; ni < 2; ni++) {
      const int c0 = tn * 128 + wn * 64 + ni * 32;
      const int c = c0 + r;
#pragma unroll
      for (int mi = 0; mi < 2; mi++) {
        const int rowb = tm * 128 + wm * 64 + mi * 32;
        if (c0 >= 1024 && c0 < 1536) {
          const int cc = c - 1024, head = cc >> 7, dv = cc & 127;
          const int b = rowb >> 13, t0 = rowb & 8191;
#pragma unroll
          for (int g4 = 0; g4 < 4; g4++) {
            uint2 v = make_uint2(pack2(acc[mi][ni][4 * g4], acc[mi][ni][4 * g4 + 1]), pack2(acc[mi][ni][4 * g4 + 2], acc[mi][ni][4 * g4 + 3]));
            *(uint2*)(Vt + ((size_t)((b * 4 + head) * 128 + dv)) * L_ + t0 + 8 * g4 + 4 * hh) = v;
          }
        } else {
#pragma unroll
          for (int i = 0; i < 16; i++) {
            const size_t row = rowb + crow(i, hh);
            const float v = acc[mi][ni][i];
            if (c0 < 512) Qd[row * 512 + c] = f2bf(v);
            else if (c0 < 1024) Kd[row * 512 + (c - 512)] = f2bf(v);
            else if (c0 < 1792) U[row * 256 + (c - 1536)] = v;
            else if (c0 < 2048) Qs[row * 256 + (c - 1792)] = f2bf(v);
            else if (c0 < 2112) Ks[row * 64 + (c - 2048)] = f2bf(v);
            else if (c0 < 2176) Vs[row * 64 + (c - 2112)] = f2bf(v);
            else if (c0 < 2432) Qi[row * 256 + (c - 2176)] = f2bf(v);
            else if (c0 < 2464) Ki[row * 32 + (c - 2432)] = f2bf(v);
            else if (c0 == 2464) { if (r < 8) Wi[row * 8 + r] = v * 0.0625f; }
          }
        }
      }
    }
  }, bid, nb, sm);
}

DI void phase_ln(float* x, u16* __restrict__ xb, const float* __restrict__ g, const float* __restrict__ bta, int bid, int nb) {
  const int lane = tidx() & 63, wave = tidx() >> 6;
  float4 gg[4], bb[4];
#pragma unroll
  for (int i = 0; i < 4; i++) { gg[i] = *(const float4*)(g + i * 256 + lane * 4); bb[i] = *(const float4*)(bta + i * 256 + lane * 4); }
  for (int row = bid * 4 + wave; row < T_; row += nb * 4) {
    float4 v[4];
#pragma unroll
    for (int i = 0; i < 4; i++) v[i] = *(const float4*)(x + (size_t)row * 1024 + i * 256 + lane * 4);
    float s = 0.f;
#pragma unroll
    for (int i = 0; i < 4; i++) s += v[i].x + v[i].y + v[i].z + v[i].w;
    const float mu = wave_sum(s) * (1.f / 1024.f);
    float q = 0.f;
#pragma unroll
    for (int i = 0; i < 4; i++) { v[i].x -= mu; v[i].y -= mu; v[i].z -= mu; v[i].w -= mu; q += v[i].x * v[i].x + v[i].y * v[i].y + v[i].z * v[i].z + v[i].w * v[i].w; }
    const float rs = rsqrtf(wave_sum(q) * (1.f / 1024.f) + LN_EPS_);
#pragma unroll
    for (int i = 0; i < 4; i++) {
      float4 o;
      o.x = v[i].x * rs * gg[i].x + bb[i].x; o.y = v[i].y * rs * gg[i].y + bb[i].y;
      o.z = v[i].z * rs * gg[i].z + bb[i].z; o.w = v[i].w * rs * gg[i].w + bb[i].w;
      *(float4*)(x + (size_t)row * 1024 + i * 256 + lane * 4) = o;
      *(uint2*)(xb + (size_t)row * 1024 + i * 256 + lane * 4) = make_uint2(pack2(o.x, o.y), pack2(o.z, o.w));
    }
  }
}

DI float gelu_tanh(float x) { const float u = 0.7978845608028654f * (x + 0.044715f * x * x * x); return 0.5f * x * (1.f + tanhf(u)); }

template <bool OUT>
DI void ssm_scan(const Params& P, int layer, int widx, char* mb) {
  const int lane = tidx() & 63;
  const int b = widx >> 8, g = (widx >> 4) & 15, ch = widx & 15;
  const int gi = (layer * 16 + g) * 64 + lane;
  const float4 ca = ((const float4*)(WS(P) + OFF_COEFA))[gi];
  const float2* cbp = (const float2*)(WS(P) + OFF_COEFB) + (size_t)gi * 16;
  float bre[16], bim[16];
#pragma unroll
  for (int c = 0; c < 16; c++) { float2 t = cbp[c]; bre[c] = t.x; bim[c] = t.y; }
  const float* U = (const float*)(mb + M_U);
  float2* Send = (float2*)(mb + M_SEND);
  const size_t sbase = (size_t)((b * 16 + g) * 16) * 64 + lane;
  float xr = 0.f, xi = 0.f;
  float cre[16], cim[16];
  float dsk = 0.f;
  int mych = 0;
  if (OUT) {
    for (int j = 0; j < ch; j++) {
      const float2 e = Send[sbase + (size_t)j * 64];
      const float nr = ca.z * xr - ca.w * xi + e.x, ni = ca.z * xi + ca.w * xr + e.y;
      xr = nr; xi = ni;
    }
#pragma unroll
    for (int c = 0; c < 16; c++) {
      cre[c] = INP(P, 20)[((size_t)(layer * 16 + g) * 16 + c) * 64 + lane];
      cim[c] = INP(P, 21)[((size_t)(layer * 16 + g) * 16 + c) * 64 + lane];
    }
    mych = ((lane >> 5) & 1) * 8 + ((lane >> 4) & 1) * 4 + ((lane >> 3) & 1) * 2 + ((lane >> 2) & 1);
    dsk = INP(P, 22)[layer * 256 + g * 16 + mych];
  }
  u16* Yg = (u16*)(mb + M_YG);
  const size_t tok0 = (size_t)b * L_ + ch * 512;
  const float* ub = U + (tok0 + (lane >> 2)) * 256 + g * 16 + (lane & 3) * 4;
  float4 cur = *(const float4*)ub;
#pragma unroll 1
  for (int blk = 0; blk < 32; blk++) {
    const float4 nxt = *(const float4*)(ub + (size_t)min(blk + 1, 31) * 16 * 256);
#pragma unroll
  for (int s16 = 0; s16 < 16; s16++) {
    const int t = blk * 16 + s16;
    float uu[16];
#pragma unroll
    for (int c = 0; c < 16; c++) {
      const float comp = ((c & 3) == 0) ? cur.x : ((c & 3) == 1) ? cur.y : ((c & 3) == 2) ? cur.z : cur.w;
      uu[c] = __int_as_float(__builtin_amdgcn_readlane(__float_as_int(comp), 4 * s16 + (c >> 2)));
    }
    float br = 0.f, bi = 0.f;
#pragma unroll
    for (int c = 0; c < 16; c++) { br += bre[c] * uu[c]; bi += bim[c] * uu[c]; }
    const float nr = ca.x * xr - ca.y * xi + br, ni = ca.x * xi + ca.y * xr + bi;
    xr = nr; xi = ni;
    if (OUT) {
      float v[16];
#pragma unroll
      for (int c = 0; c < 16; c++) v[c] = cre[c] * xr - cim[c] * xi;
      const bool b5 = lane & 32, b4 = lane & 16, b3 = lane & 8, b2 = lane & 4;
      float v8[8], v4[4], v2[2], v1;
#pragma unroll
      for (int i = 0; i < 8; i++) { const float snd = b5 ? v[i] : v[i + 8]; const float rcv = __shfl_xor(snd, 32); v8[i] = (b5 ? v[i + 8] : v[i]) + rcv; }
#pragma unroll
      for (int i = 0; i < 4; i++) { const float snd = b4 ? v8[i] : v8[i + 4]; const float rcv = __shfl_xor(snd, 16); v4[i] = (b4 ? v8[i + 4] : v8[i]) + rcv; }
#pragma unroll
      for (int i = 0; i < 2; i++) { const float snd = b3 ? v4[i] : v4[i + 2]; const float rcv = __shfl_xor(snd, 8); v2[i] = (b3 ? v4[i + 2] : v4[i]) + rcv; }
      { const float snd = b2 ? v2[0] : v2[1]; const float rcv = __shfl_xor(snd, 4); v1 = (b2 ? v2[1] : v2[0]) + rcv; }
      v1 += __shfl_xor(v1, 2);
      v1 += __shfl_xor(v1, 1);
      float um = uu[0];
#pragma unroll
      for (int c = 1; c < 16; c++) um = (mych == c) ? uu[c] : um;
      const float y = gelu_tanh(v1 + dsk * um);
      if ((lane & 3) == 0) Yg[(tok0 + t) * 256 + g * 16 + mych] = f2bf(y);
    }
  }
    cur = nxt;
  }
  if (!OUT) Send[sbase + (size_t)ch * 64] = make_float2(xr, xi);
}

constexpr int KS_ = 72, VS_ = 68;
DI void da_item(const Params& P, int layer, int b, int h, int qt, char* mb, char* smem) {
  const int tid = tidx(), lane = tid & 63, wave = tid >> 6, r = lane & 31, hh = lane >> 5;
  u16* sK = (u16*)smem;
  u16* sV = sK + 64 * KS_;
  float* sbias = (float*)(sV + 128 * VS_);
  u16* sQw = (u16*)(smem + 28672) + (tidx() >> 6) * 32 * KS_;
  const u16* Qd = (const u16*)(mb + M_QD); const u16* Kd = (const u16*)(mb + M_KD); const u16* Vt = (const u16*)(mb + M_VT);
  u16* CC = (u16*)(WS(P) + OFF_CC);
  const int q0 = qt * 128, qw = q0 + wave * 32, qp = qw + r;
  const size_t tokq = (size_t)b * L_ + qp;
  __syncthreads();
  if (tid < 129) sbias[tid] = ((const float*)(WS(P) + OFF_BIAS))[h * 129 + tid] * LOG2E_;
  __syncthreads();
  const float bfar = sbias[128];
  const float SC = 0.125f * LOG2E_;
  const int nkt = (q0 + 128) >> 6;
  const float lam = ((const float*)(WS(P) + OFF_LAM))[layer];
  const int krow_l = tid >> 3, kch = (tid & 7) * 8;
#pragma unroll 1
  for (int c = 0; c < 2; c++) {
#pragma unroll
    for (int ks = 0; ks < 4; ks++) *(bf16x8*)(sQw + r * KS_ + ks * 16 + hh * 8) = *(const bf16x8*)(Qd + tokq * 512 + h * 128 + c * 64 + ks * 16 + hh * 8);
    f32x16 o[4] = {zero16(), zero16(), zero16(), zero16()};
    float m = -INFINITY, l = 0.f;
    const u16* Kbase = Kd + ((size_t)b * L_ + krow_l) * 512 + h * 128 + c * 64 + kch;
    const u16* Vbase = Vt + ((size_t)((b * 4 + h) * 128 + krow_l)) * L_ + kch;
    u32x4 rk[2], rv[4];
#pragma unroll
    for (int i = 0; i < 2; i++) rk[i] = *(const u32x4*)(Kbase + (size_t)(i * 32) * 512);
#pragma unroll
    for (int i = 0; i < 4; i++) rv[i] = *(const u32x4*)(Vbase + (size_t)(i * 32) * L_);
#pragma unroll 1
    for (int kt = 0; kt < nkt; kt++) {
      __syncthreads();
#pragma unroll
      for (int i = 0; i < 2; i++) *(u32x4*)(sK + (krow_l + i * 32) * KS_ + kch) = rk[i];
#pragma unroll
      for (int i = 0; i < 4; i++) {
        u32x2* d = (u32x2*)(sV + (krow_l + i * 32) * VS_ + kch);
        u32x2 lo2, hi2; lo2.x = rv[i].x; lo2.y = rv[i].y; hi2.x = rv[i].z; hi2.y = rv[i].w;
        d[0] = lo2; d[1] = hi2;
      }
      __syncthreads();
      {
        const int ktn = min(kt + 1, nkt - 1);
#pragma unroll
        for (int i = 0; i < 2; i++) rk[i] = *(const u32x4*)(Kbase + (size_t)(ktn * 64 + i * 32) * 512);
#pragma unroll
        for (int i = 0; i < 4; i++) rv[i] = *(const u32x4*)(Vbase + (size_t)(i * 32) * L_ + ktn * 64);
      }
      if (kt * 64 <= qw + 31) {
        f32x16 s[2];
#pragma unroll
        for (int kb = 0; kb < 2; kb++) {
          s[kb] = zero16();
#pragma unroll
          for (int ks = 0; ks < 4; ks++) {
            const bf16x8 kf = *(const bf16x8*)(sK + (kb * 32 + r) * KS_ + ks * 16 + hh * 8);
            const bf16x8 qf = *(const bf16x8*)(sQw + r * KS_ + ks * 16 + hh * 8);
            s[kb] = MFMA32(kf, qf, s[kb]);
          }
        }
        const bool nearb = (kt * 64 + 63 + 128 > qw);
        float mx = -INFINITY;
        if (nearb) {
#pragma unroll
          for (int kb = 0; kb < 2; kb++)
#pragma unroll
            for (int i = 0; i < 16; i++) {
              const int dist = qp - (kt * 64 + kb * 32 + crow(i, hh));
              const float bv = sbias[min(max(dist, 0), 128)];
              float t = s[kb][i] * SC + bv;
              t = (dist >= 0) ? t : -INFINITY;
              s[kb][i] = t; mx = fmaxf(mx, t);
              if ((i & 7) == 7) __builtin_amdgcn_sched_barrier(0);
            }
        } else {
#pragma unroll
          for (int kb = 0; kb < 2; kb++)
#pragma unroll
            for (int i = 0; i < 16; i++) { const float t = s[kb][i] * SC + bfar; s[kb][i] = t; mx = fmaxf(mx, t); }
        }
        mx = fmaxf(mx, __shfl_xor(mx, 32));
        const float mn = fmaxf(m, mx);
        const float corr = __builtin_amdgcn_exp2f(m - mn);
        m = mn;
        float ls = 0.f;
#pragma unroll
        for (int kb = 0; kb < 2; kb++)
#pragma unroll
          for (int i = 0; i < 16; i++) { const float p = __builtin_amdgcn_exp2f(s[kb][i] - mn); s[kb][i] = p; ls += p; }
        l = l * corr + ls;
#pragma unroll
        for (int dt = 0; dt < 4; dt++)
#pragma unroll
          for (int i = 0; i < 16; i++) o[dt][i] *= corr;
#pragma unroll
        for (int kb = 0; kb < 2; kb++)
#pragma unroll
          for (int s2 = 0; s2 < 2; s2++) {
            const bf16x8 pf = pack8(s[kb], s2);
#pragma unroll
            for (int dt = 0; dt < 4; dt++) {
              const u16* vp = sV + (dt * 32 + r) * VS_ + kb * 32 + s2 * 16 + 4 * hh;
              const s16x4 lo = *(const s16x4*)vp, hi = *(const s16x4*)(vp + 8);
              const bf16x8 vf = __builtin_shufflevector(lo, hi, 0, 1, 2, 3, 4, 5, 6, 7);
              o[dt] = MFMA32(vf, pf, o[dt]);
            }
            __builtin_amdgcn_sched_barrier(0);
          }
      }
    }
    const float lt = l + __shfl_xor(l, 32);
    const float inv = 1.f / lt;
    size_t tq = tokq;
    asm volatile("" : "+v"(tq));
    u16* obase = CC + tq * 1024 + h * 128 + 4 * hh;
    if (c == 0) {
#pragma unroll
      for (int dt = 0; dt < 4; dt++)
#pragma unroll
        for (int g4 = 0; g4 < 4; g4++) {
          *(uint2*)(obase + dt * 32 + 8 * g4) = make_uint2(pack2(o[dt][4 * g4] * inv, o[dt][4 * g4 + 1] * inv), pack2(o[dt][4 * g4 + 2] * inv, o[dt][4 * g4 + 3] * inv));
        }
    } else {
      float ss = 0.f;
#pragma unroll
      for (int dt = 0; dt < 4; dt++)
#pragma unroll
        for (int g4 = 0; g4 < 4; g4++) {
          const uint2 pv = *(const uint2*)(obase + dt * 32 + 8 * g4);
          const float a4[4] = {bf2f((u16)(pv.x & 0xffff)), bf2f((u16)(pv.x >> 16)), bf2f((u16)(pv.y & 0xffff)), bf2f((u16)(pv.y >> 16))};
#pragma unroll
          for (int e = 0; e < 4; e++) { const float v = a4[e] - lam * o[dt][4 * g4 + e] * inv; o[dt][4 * g4 + e] = v; ss = __builtin_fmaf(v, v, ss); }
        }
      ss += __shfl_xor(ss, 32);
      const float lam_init = 0.8f - 0.6f * __expf(-0.3f * (float)layer);
      const float rn = rsqrtf(ss * (1.f / 128.f) + LN_EPS_) * (1.f - lam_init);
      int hh2 = hh;
      asm volatile("" : "+v"(hh2));
      const float* sg = INP(P, 14) + layer * 128 + 4 * hh2;
#pragma unroll
      for (int dt = 0; dt < 4; dt++)
#pragma unroll
        for (int g4 = 0; g4 < 4; g4++) {
          const int dv = dt * 32 + 8 * g4 + 4 * hh;
          const float4 gv = *(const float4*)(sg + dt * 32 + 8 * g4);
          uint2 w = make_uint2(pack2(o[dt][4 * g4] * rn * gv.x, o[dt][4 * g4 + 1] * rn * gv.y),
                               pack2(o[dt][4 * g4 + 2] * rn * gv.z, o[dt][4 * g4 + 3] * rn * gv.w));
          *(uint2*)(obase + dv - 4 * hh) = w;
        }
    }
  }
}

DI unsigned sortkey(float f) { const unsigned u = __float_as_uint(f + 0.f); return u ^ (((unsigned)((int)u >> 31)) | 0x80000000u); }

DI void dsa_item(const Params& P, int layer, int b, int qt, char* mb, char* smem) {
  const int tid = tidx(), lane = tid & 63, wave = tid >> 6, r = lane & 31, hh = lane >> 5;
  unsigned* hist = (unsigned*)smem;
  float* sP = (float*)smem;
  float* sQ = (float*)(smem + 16384);
  u16* sidx = (u16*)(smem + 32896);
  unsigned* meta = (unsigned*)(smem + 49280);
  float* sbias = (float*)(smem + 50304);
  const u16* Qi = (const u16*)(mb + M_QI); const u16* Ki = (const u16*)(mb + M_KI); const float* Wi = (const float*)(mb + M_WI);
  const u16* Qs = (const u16*)(mb + M_QS); const u16* Ks = (const u16*)(mb + M_KS); const u16* Vs = (const u16*)(mb + M_VS);
  u16* CC = (u16*)(WS(P) + OFF_CC);
  const int q0 = qt * 32;
  const int qp = q0 + r;
  const size_t tokb = (size_t)b * L_;
  const int nk32 = qt + 1;
  const bool radix = (q0 >= 256);
  __syncthreads();
  for (int i = tid; i < 4 * 129; i += 256) sbias[i] = ((const float*)(WS(P) + OFF_BIAS))[4 * 129 + i];
  meta[tid] = (tid >= 32 && tid < 64) ? 256u : 0u;
  char* sQi = smem + 52384;
  float* sWi = (float*)(smem + 69280);
  unsigned* candK = (unsigned*)(WS(P) + OFF_CANDK) + (size_t)blockIdx.x * 32 * CAP_;
  u16* candI = (u16*)(WS(P) + OFF_CANDI) + (size_t)blockIdx.x * 32 * CAP_;
  {
    const int row = tid >> 3, ch = tid & 7;
    const uint4* src = (const uint4*)(Qi + (tokb + q0 + row) * 256 + ch * 32);
    uint4* dst = (uint4*)(sQi + row * 528 + ch * 64);
    dst[0] = src[0]; dst[1] = src[1]; dst[2] = src[2]; dst[3] = src[3];
    sWi[tid] = Wi[(tokb + q0) * 8 + tid];
  }
  int pass = radix ? 0 : 4;
  bool fast = false;
#pragma unroll 1
  while (true) {
    __syncthreads();
    if (pass < 4) { for (int i = tid; i < 32 * 257; i += 256) hist[i] = 0u; }
    __syncthreads();
    const unsigned pref = meta[r];
    const unsigned krem = meta[32 + r];
    bf16x8 nf0 = {0, 0, 0, 0, 0, 0, 0, 0}, nf1 = {0, 0, 0, 0, 0, 0, 0, 0};
    if (wave < nk32) {
      nf0 = *(const bf16x8*)(Ki + (tokb + wave * 32 + r) * 32 + hh * 8);
      nf1 = *(const bf16x8*)(Ki + (tokb + wave * 32 + r) * 32 + 16 + hh * 8);
    }
#pragma unroll 1
    for (int kt = wave; kt < nk32; kt += 4) {
      const bf16x8 kf0 = nf0, kf1 = nf1;
      if (kt + 4 < nk32) {
        nf0 = *(const bf16x8*)(Ki + (tokb + (kt + 4) * 32 + r) * 32 + hh * 8);
        nf1 = *(const bf16x8*)(Ki + (tokb + (kt + 4) * 32 + r) * 32 + 16 + hh * 8);
      }
      f32x16 sc = zero16();
#pragma unroll 4
      for (int hd = 0; hd < 8; hd++) {
        const bf16x8 q0f = *(const bf16x8*)(sQi + r * 528 + hd * 64 + hh * 16);
        const bf16x8 q1f = *(const bf16x8*)(sQi + r * 528 + hd * 64 + 32 + hh * 16);
        const float w = sWi[r * 8 + hd];
        f32x16 s = MFMA32(kf0, q0f, zero16());
        s = MFMA32(kf1, q1f, s);
#pragma unroll
        for (int i = 0; i < 16; i++) sc[i] += __int_as_float(max(__float_as_int(s[i]), 0)) * w;
      }
      const int lim = (kt == qt) ? qp : 0x7fffffff;
      if (pass == 0) {
#pragma unroll
        for (int i = 0; i < 16; i++) {
          const int kp = kt * 32 + crow(i, hh);
          const unsigned key = sortkey(sc[i]);
          const unsigned bin = (kp <= lim) ? (key >> 24) : 256u;
          atomicAdd(&hist[r * 257 + bin], 1u);
        }
      } else if (pass < 4) {
        const int sh = 24 - 8 * pass;
#pragma unroll
        for (int i = 0; i < 16; i++) {
          const int kp = kt * 32 + crow(i, hh);
          const unsigned key = sortkey(sc[i]);
          if ((key >> (sh + 8)) == pref && kp <= lim) atomicAdd(&hist[r * 257 + ((key >> sh) & 255u)], 1u);
        }
      } else if (pass == 5) {
#pragma unroll
        for (int i = 0; i < 16; i++) {
          const int kp = kt * 32 + crow(i, hh);
          const unsigned key = sortkey(sc[i]);
          if (kp <= lim) {
            const unsigned bt = key >> 24;
            if (bt > pref) { const unsigned pos = atomicAdd(&meta[64 + r], 1u); if (pos < 256u) sidx[r * 256 + pos] = (u16)kp; }
            else if (bt == pref) {
              const unsigned cp = atomicAdd(&meta[128 + r], 1u);
              if (cp < (unsigned)CAP_) { candK[r * CAP_ + cp] = key; candI[r * CAP_ + cp] = (u16)kp; }
            }
          }
        }
      } else {
#pragma unroll
        for (int i = 0; i < 16; i++) {
          const int kp = kt * 32 + crow(i, hh);
          const unsigned key = sortkey(sc[i]);
          bool sel = (kp <= lim);
          if (radix) {
            sel = sel && (key >= pref);
            if (sel && key == pref) sel = atomicAdd(&meta[96 + r], 1u) < krem;
          }
          if (sel) { const unsigned pos = atomicAdd(&meta[64 + r], 1u); if (pos < 256u) sidx[r * 256 + pos] = (u16)kp; }
        }
      }
    }
    __syncthreads();
    if (pass < 4) {
      for (int j = 0; j < 8; j++) {
        const int qq = wave * 8 + j;
        const unsigned k = meta[32 + qq];
        unsigned c4[4]; unsigned tot = 0;
#pragma unroll
        for (int e = 0; e < 4; e++) { c4[e] = hist[qq * 257 + 255 - 4 * lane - e]; tot += c4[e]; }
        unsigned incl = tot;
        for (int o = 1; o < 64; o <<= 1) { const unsigned t = __shfl_up(incl, o); if (lane >= o) incl += t; }
        unsigned run = incl - tot;
#pragma unroll
        for (int e = 0; e < 4; e++) {
          if (run < k && run + c4[e] >= k) {
            meta[qq] = (meta[qq] << 8) | (unsigned)(255 - 4 * lane - e); meta[32 + qq] = k - run;
            if (pass == 0 && c4[e] > (unsigned)CAP_) meta[192] = 1u;
          }
          run += c4[e];
        }
      }
    }
    if (pass >= 4) break;
    if (pass == 0) { __syncthreads(); fast = (meta[192] == 0u); pass = fast ? 5 : 1; } else pass++;
  }
  __syncthreads();
  if (fast) {
    unsigned* wh = hist + wave * 256;
#pragma unroll 1
    for (int j = 0; j < 8; j++) {
      const int qq = wave * 8 + j;
      const int c = min((int)meta[128 + qq], CAP_);
      unsigned ck[32];
#pragma unroll
      for (int e = 0; e < 32; e++) ck[e] = (e * 64 + lane < c) ? candK[qq * CAP_ + e * 64 + lane] : 0u;
      unsigned pref = meta[qq], k = meta[32 + qq];
#pragma unroll 1
      for (int ps = 1; ps < 4; ps++) {
        const int sh = 24 - 8 * ps;
        __syncthreads();
#pragma unroll
        for (int e = 0; e < 4; e++) wh[e * 64 + lane] = 0u;
        __syncthreads();
#pragma unroll
        for (int e = 0; e < 32; e++)
          if (e * 64 + lane < c && (ck[e] >> (sh + 8)) == pref) atomicAdd(&wh[(ck[e] >> sh) & 255u], 1u);
        __syncthreads();
        unsigned c4[4]; unsigned tot = 0;
#pragma unroll
        for (int e = 0; e < 4; e++) { c4[e] = wh[255 - 4 * lane - e]; tot += c4[e]; }
        unsigned incl = tot;
        for (int o = 1; o < 64; o <<= 1) { const unsigned t = __shfl_up(incl, o); if (lane >= o) incl += t; }
        unsigned run = incl - tot;
        unsigned found = 0xffffffffu, kn = 0;
#pragma unroll
        for (int e = 0; e < 4; e++) {
          if (run < k && run + c4[e] >= k) { found = (unsigned)(255 - 4 * lane - e); kn = k - run; }
          run += c4[e];
        }
        const unsigned long long bal = __ballot(found != 0xffffffffu);
        const int src = (bal != 0ull) ? (__ffsll((long long)bal) - 1) : 0;
        const unsigned dg = __shfl(found, src);
        k = __shfl(kn, src);
        pref = (pref << 8) | (dg & 255u);
      }
#pragma unroll
      for (int e = 0; e < 32; e++) {
        if (e * 64 + lane < c) {
          const unsigned key = ck[e];
          bool sel = key > pref;
          if (!sel && key == pref) sel = atomicAdd(&meta[96 + qq], 1u) < k;
          if (sel) { const unsigned pos = atomicAdd(&meta[64 + qq], 1u); if (pos < 256u) sidx[qq * 256 + pos] = candI[qq * CAP_ + e * 64 + lane]; }
        }
      }
    }
    __syncthreads();
  }
  float* myP = sP + wave * 1024;
  (void)sQ;
#pragma unroll 1
  for (int j = 0; j < 8; j++) {
    const int qq = wave * 8 + j;
    const int qpos = q0 + qq;
    const size_t tok = tokb + qpos;
    const int n = min((int)meta[64 + qq], 256);
    __syncthreads();
    bf16x8 qf[4];
#pragma unroll
    for (int ks = 0; ks < 4; ks++) {
      bf16x8 z = {0, 0, 0, 0, 0, 0, 0, 0};
      if (r < 4) z = *(const bf16x8*)(Qs + tok * 256 + r * 64 + ks * 16 + hh * 8);
      qf[ks] = z;
    }
#pragma unroll 2
    for (int kb = 0; kb < 8; kb++) {
      const int jj = kb * 32 + r;
      const int kidx = (jj < n) ? (int)sidx[qq * 256 + jj] : 0;
      const u16* kp = Ks + (tokb + kidx) * 64 + hh * 8;
      bf16x8 kf[4];
#pragma unroll
      for (int ks = 0; ks < 4; ks++) kf[ks] = *(const bf16x8*)(kp + ks * 16);
      f32x16 sacc = zero16();
#pragma unroll
      for (int ks = 0; ks < 4; ks++) sacc = MFMA32(kf[ks], qf[ks], sacc);
      if (r < 4) {
#pragma unroll
        for (int i = 0; i < 16; i++) myP[(kb * 32 + crow(i, hh)) * 4 + r] = sacc[i];
      }
    }
    __syncthreads();
    float sc[4][4];
#pragma unroll
    for (int rd = 0; rd < 4; rd++) {
      const int jj = rd * 64 + lane;
      const bool valid = jj < n;
      const int kidx = valid ? (int)sidx[qq * 256 + jj] : 0;
      const int dist = min(max(qpos - kidx, 0), 128);
      const float4 d = *(const float4*)(myP + jj * 4);
      sc[rd][0] = valid ? d.x * 0.125f + sbias[0 * 129 + dist] : -INFINITY;
      sc[rd][1] = valid ? d.y * 0.125f + sbias[1 * 129 + dist] : -INFINITY;
      sc[rd][2] = valid ? d.z * 0.125f + sbias[2 * 129 + dist] : -INFINITY;
      sc[rd][3] = valid ? d.w * 0.125f + sbias[3 * 129 + dist] : -INFINITY;
    }
#pragma unroll
    for (int hd = 0; hd < 4; hd++) {
      float mx = fmaxf(fmaxf(sc[0][hd], sc[1][hd]), fmaxf(sc[2][hd], sc[3][hd]));
      mx = wave_max(mx);
      float sm = 0.f;
#pragma unroll
      for (int rd = 0; rd < 4; rd++) { sc[rd][hd] = __expf(sc[rd][hd] - mx); sm += sc[rd][hd]; }
      sm = wave_sum(sm);
      const float inv = 1.f / sm;
#pragma unroll
      for (int rd = 0; rd < 4; rd++) sc[rd][hd] *= inv;
    }
#pragma unroll
    for (int rd = 0; rd < 4; rd++) *(float4*)(myP + (rd * 64 + lane) * 4) = make_float4(sc[rd][0], sc[rd][1], sc[rd][2], sc[rd][3]);
    __syncthreads();
    const int g = lane >> 3, c8 = lane & 7;
    float acc[32];
#pragma unroll
    for (int i = 0; i < 32; i++) acc[i] = 0.f;
#pragma unroll 4
    for (int it = 0; it < 32; it++) {
      const int jj = it * 8 + g;
      const int kidx = (jj < n) ? (int)sidx[qq * 256 + jj] : 0;
      const float4 pj = *(const float4*)(myP + jj * 4);
      const u32x4 vv = *(const u32x4*)(Vs + (tokb + kidx) * 64 + c8 * 8);
      const float vf[8] = {bf2f((u16)(vv.x & 0xffff)), bf2f((u16)(vv.x >> 16)), bf2f((u16)(vv.y & 0xffff)), bf2f((u16)(vv.y >> 16)),
                           bf2f((u16)(vv.z & 0xffff)), bf2f((u16)(vv.z >> 16)), bf2f((u16)(vv.w & 0xffff)), bf2f((u16)(vv.w >> 16))};
#pragma unroll
      for (int e = 0; e < 8; e++) {
        acc[0 * 8 + e] += pj.x * vf[e]; acc[1 * 8 + e] += pj.y * vf[e];
        acc[2 * 8 + e] += pj.z * vf[e]; acc[3 * 8 + e] += pj.w * vf[e];
      }
    }
    const bool b5 = lane & 32, b4 = lane & 16, b3 = lane & 8;
    float w16[16], w8[8], w4[4];
#pragma unroll
    for (int i = 0; i < 16; i++) { const float snd = b5 ? acc[i] : acc[i + 16]; const float rcv = __shfl_xor(snd, 32); w16[i] = (b5 ? acc[i + 16] : acc[i]) + rcv; }
#pragma unroll
    for (int i = 0; i < 8; i++) { const float snd = b4 ? w16[i] : w16[i + 8]; const float rcv = __shfl_xor(snd, 16); w8[i] = (b4 ? w16[i + 8] : w16[i]) + rcv; }
#pragma unroll
    for (int i = 0; i < 4; i++) { const float snd = b3 ? w8[i] : w8[i + 4]; const float rcv = __shfl_xor(snd, 8); w4[i] = (b3 ? w8[i + 4] : w8[i]) + rcv; }
    const int hd = (b5 ? 2 : 0) + (b4 ? 1 : 0);
    *(uint2*)(CC + tok * 1024 + 768 + hd * 64 + c8 * 8 + (b3 ? 4 : 0)) = make_uint2(pack2(w4[0], w4[1]), pack2(w4[2], w4[3]));
  }
}

DI void phase_mix1(const Params& P, int layer, int bid, int nb, char* smem) {
  char* mb = WS(P) + OFF_H;
  for (int w = bid * 4 + (tidx() >> 6); w < 2048; w += nb * 4) ssm_scan<false>(P, layer, w, mb);
  for (int j = 0;; j++) {
    const int idx = (j & 1) ? (j * nb + (nb - 1 - bid)) : (j * nb + bid);
    if (j * nb >= 2048) break;
    if (idx >= 2048) continue;
    const int qt = 255 - (idx >> 3), b = idx & 7;
    dsa_item(P, layer, b, qt, mb, smem);
  }
  for (int j = 0;; j++) {
    const int idx = (j & 1) ? (j * nb + (nb - 1 - bid)) : (j * nb + bid);
    if (j * nb >= 2048) break;
    if (idx >= 2048) continue;
    const int qt = 63 - (idx >> 5), bh = idx & 31;
    da_item(P, layer, bh >> 2, bh & 3, qt, mb, smem);
  }
}

DI void phase_mix2(const Params& P, int layer, int bid, int nb, char* smem) {
  char* mb = WS(P) + OFF_H;
  for (int w = bid * 4 + (tidx() >> 6); w < 2048; w += nb * 4) ssm_scan<true>(P, layer, w, mb);
}

DI void run_phase(const Params& P, int ph, int bid, int nb, char* smem) {
  char* ws = WS(P);
  u16* sm = (u16*)smem;
  if (ph == 0) { phase_prep(P, bid, nb, smem); return; }
  const int l = (ph - 1) / 12, s = (ph - 1) % 12;
  u16* Xb = (u16*)(ws + OFF_XB);
  u16* H = (u16*)(ws + OFF_H);
  u16* CC = (u16*)(ws + OFF_CC);
  float* X = OUTP(P);
  switch (s) {
    case 0: phase_ffn_up(Xb, (const u16*)(ws + OFF_WGU1 + l * SZ_WGU), H, bid, nb, sm); break;
    case 1: phase_ffn_down(H, (const u16*)(ws + OFF_WD1 + l * SZ_WD), (l == 0) ? INP(P, 0) : (const float*)X, X, nullptr, bid, nb, sm); break;
    case 2: phase_ln(X, Xb, INP(P, 6) + l * 1024, INP(P, 7) + l * 1024, bid, nb); break;
    case 3: phase_w_in(Xb, (const u16*)(ws + OFF_WIN + l * SZ_WIN), ws + OFF_H, bid, nb, sm); break;
    case 4: phase_mix1(P, l, bid, nb, smem); break;
    case 5: phase_mix2(P, l, bid, nb, smem); break;
    case 6: phase_glu((const u16*)(ws + OFF_H + M_YG), (const u16*)(ws + OFF_WGLU + l * SZ_WGLU), CC, bid, nb, sm); break;
    case 7: phase_w_o(CC, (const u16*)(ws + OFF_WO + l * SZ_WO), X, bid, nb, sm); break;
    case 8: phase_ln(X, Xb, INP(P, 24) + l * 1024, INP(P, 25) + l * 1024, bid, nb); break;
    case 9:
      phase_ffn_up(Xb, (const u16*)(ws + OFF_WGU2 + l * SZ_WGU), H, bid, nb, sm);
      phase_ple(Xb, (const u16*)(ws + OFF_WPG + l * SZ_WPG), (const u16*)(ws + OFF_PB) + (size_t)l * T_ * 256, (const u16*)(ws + OFF_WPP + l * SZ_WPP), CC, bid, nb, sm);
      break;
    case 10: phase_ffn_down(H, (const u16*)(ws + OFF_WD2 + l * SZ_WD), X, X, CC, bid, nb, sm); break;
    case 11: phase_ln(X, Xb, INP(P, 31) + l * 1024, INP(P, 32) + l * 1024, bid, nb); break;
  }
}

constexpr int NPHASES = 25;

__global__ void __launch_bounds__(256, 2) mega(Params P, int ph0, int ph1) {
  extern __shared__ __attribute__((aligned(16))) char smem[];
  cg::grid_group grid = cg::this_grid();
  const int bid = blockIdx.x, nb = gridDim.x;
#ifndef DUP_MASK
#define DUP_MASK 0
#endif
#define PHASE(k) if (ph0 <= (k) && (k) < ph1) { \
    if ((k) > 0 && ((DUP_MASK >> (((k) - 1) % 12)) & 1)) { run_phase(P, (k), bid, nb, smem); grid.sync(); } \
    run_phase(P, (k), bid, nb, smem); if ((k) + 1 < ph1) grid.sync(); }
  PHASE(0) PHASE(1) PHASE(2) PHASE(3) PHASE(4) PHASE(5) PHASE(6) PHASE(7) PHASE(8) PHASE(9) PHASE(10) PHASE(11) PHASE(12)
  PHASE(13) PHASE(14) PHASE(15) PHASE(16) PHASE(17) PHASE(18) PHASE(19) PHASE(20) PHASE(21) PHASE(22) PHASE(23) PHASE(24)
#undef PHASE
}

extern "C" void kernel_launch(void* const* d_in, const int* in_sizes, int n_in, void* d_out, int out_size, void* d_ws, size_t ws_size, hipStream_t stream) {
  static int grid_blocks = 0;
  if (grid_blocks == 0) {
    if (n_in != 33 || ws_size < WS_END) { fprintf(stderr, "kernel_launch: need 33 inputs and %zu bytes of ws (got %d, %zu)\n", (size_t)WS_END, n_in, ws_size); grid_blocks = -1; return; }
    int dev = 0, cus = 0, per_cu = 0;
    (void)hipGetDevice(&dev);
    (void)hipDeviceGetAttribute(&cus, hipDeviceAttributeMultiprocessorCount, dev);
    (void)hipFuncSetAttribute((const void*)mega, hipFuncAttributeMaxDynamicSharedMemorySize, LDS_BYTES);
    (void)hipOccupancyMaxActiveBlocksPerMultiprocessor(&per_cu, (const void*)mega, 256, LDS_BYTES);
    if (per_cu < 1) per_cu = 1;
    if (per_cu > 2) per_cu = 2;
    grid_blocks = cus * per_cu;
    fprintf(stderr, "kernel_launch: cus %d per_cu %d grid %d\n", cus, per_cu, grid_blocks);
  }
  if (grid_blocks < 0) return;
  Params p;
  memset(&p, 0, sizeof(p));
  for (int i = 0; i < 33; i++) p.in[i] = (const float*)d_in[i];
  p.out = (float*)d_out;
  p.ws = (char*)d_ws;
#if MULTI_LAUNCH
  for (int ph = 0; ph < NPHASES; ph++) {
    hipLaunchKernelGGL(mega, dim3(grid_blocks), dim3(256), LDS_BYTES, stream, p, ph, ph + 1);
  }
#else
  int ph0 = 0, ph1 = NPHASES;
  void* args[] = {&p, &ph0, &ph1};
  hipError_t e = hipLaunchCooperativeKernel((const void*)mega, dim3(grid_blocks), dim3(256), args, LDS_BYTES, stream);
  if (e != hipSuccess) fprintf(stderr, "cooperative launch failed: %s (grid %d)\n", hipGetErrorString(e), grid_blocks);
#endif
}
```

```cpp
#include <hip/hip_runtime.h>
#include <hip/hip_cooperative_groups.h>
#include <stdint.h>
#include <math.h>
#include <stdio.h>
#include <string.h>
namespace cg = cooperative_groups;

#ifndef MULTI_LAUNCH
#define MULTI_LAUNCH 0
#endif

typedef unsigned short u16;
typedef __attribute__((ext_vector_type(8))) short bf16x8;
typedef __attribute__((ext_vector_type(4))) short s16x4;
typedef __attribute__((ext_vector_type(16))) float f32x16;
typedef __attribute__((ext_vector_type(4))) unsigned u32x4;
typedef __attribute__((ext_vector_type(2))) unsigned u32x2;

#define DI __device__ __forceinline__
#define MFMA32(a, b, c) __builtin_amdgcn_mfma_f32_32x32x16_bf16((a), (b), (c), 0, 0, 0)

constexpr int T_ = 65536;
constexpr int L_ = 8192;
constexpr int D_ = 1024;
constexpr int FF_ = 2816;
constexpr float ALPHA_ = 1.41421356237309515f;
constexpr float LN_EPS_ = 1e-5f;
constexpr float LOG2E_ = 1.44269504088896341f;
constexpr int LDS_BYTES = 73728;

constexpr size_t SZ_WGU = (size_t)5632 * 1024 * 2;
constexpr size_t SZ_WD = (size_t)1024 * 2816 * 2;
constexpr size_t SZ_WIN = (size_t)2560 * 1024 * 2;
constexpr size_t SZ_WO = (size_t)1024 * 1024 * 2;
constexpr size_t SZ_WGLU = (size_t)256 * 256 * 2;
constexpr size_t SZ_WPG = (size_t)1024 * 1024 * 2;
constexpr size_t SZ_WPP = (size_t)1024 * 256 * 2;
constexpr size_t OFF_WGU1 = 0;
constexpr size_t OFF_WD1 = OFF_WGU1 + 2 * SZ_WGU;
constexpr size_t OFF_WGU2 = OFF_WD1 + 2 * SZ_WD;
constexpr size_t OFF_WD2 = OFF_WGU2 + 2 * SZ_WGU;
constexpr size_t OFF_WIN = OFF_WD2 + 2 * SZ_WD;
constexpr size_t OFF_WO = OFF_WIN + 2 * SZ_WIN;
constexpr size_t OFF_WGLU = OFF_WO + 2 * SZ_WO;
constexpr size_t OFF_WPG = OFF_WGLU + 2 * SZ_WGLU;
constexpr size_t OFF_WPP = OFF_WPG + 2 * SZ_WPG;
constexpr size_t OFF_COEFA = OFF_WPP + 2 * SZ_WPP;
constexpr size_t OFF_COEFB = OFF_COEFA + 2 * 16 * 64 * 16;
constexpr size_t OFF_LAM = OFF_COEFB + 2 * 16 * 64 * 16 * 8;
constexpr size_t OFF_BIAS = OFF_LAM + 256;
constexpr size_t OFF_XB = OFF_BIAS + 8 * 129 * 4 + 32;
constexpr size_t OFF_PB = OFF_XB + (size_t)T_ * 1024 * 2;
constexpr size_t OFF_H = OFF_PB + (size_t)2 * T_ * 256 * 2;
constexpr size_t SZ_H = (size_t)384 << 20;
constexpr size_t OFF_CC = OFF_H + SZ_H;
constexpr size_t OFF_CANDK = OFF_CC + (size_t)T_ * 1024 * 2;
constexpr int CAP_ = 2048;
constexpr size_t OFF_CANDI = OFF_CANDK + (size_t)512 * 32 * CAP_ * 4;
constexpr size_t WS_END = OFF_CANDI + (size_t)512 * 32 * CAP_ * 2;
constexpr size_t MB_ = (size_t)1 << 20;
constexpr size_t M_QD = 0, M_KD = 64 * MB_, M_VT = 128 * MB_, M_U = 192 * MB_, M_QS = 256 * MB_, M_QI = 288 * MB_, M_YG = 320 * MB_,
                 M_KS = 352 * MB_, M_VS = 360 * MB_, M_KI = 368 * MB_, M_WI = 372 * MB_, M_SEND = 374 * MB_;

struct Params {
  const float* in[33];
  float* out;
  char* ws;
};

DI int tidx() { int t = threadIdx.x; asm volatile("" : "+v"(t)); return t; }
#define GAS __attribute__((address_space(1)))
DI size_t opaque0() { size_t z = 0; asm volatile("" : "+s"(z)); return z; }
DI char* WS(const Params& P) { return P.ws + opaque0(); }
DI float* OUTP(const Params& P) { return P.out + opaque0(); }
DI const float* INP(const Params& P, int i) { return P.in[i]; }
typedef __bf16 bf16v2_ __attribute__((ext_vector_type(2)));
typedef float f32v2_ __attribute__((ext_vector_type(2)));
DI u16 f2bf(float x) { const __bf16 h = (__bf16)x; return __builtin_bit_cast(u16, h); }
DI float bf2f(u16 v) { return __uint_as_float(((unsigned)v) << 16); }
DI unsigned pack2(float a, float b) { f32v2_ v; v.x = a; v.y = b; const bf16v2_ h = __builtin_convertvector(v, bf16v2_); return __builtin_bit_cast(unsigned, h); }
DI int crow(int i, int hh) { return (i & 3) + 8 * (i >> 2) + 4 * hh; }
DI float sigmoidf_(float x) { return __builtin_amdgcn_rcpf(1.f + __expf(-x)); }
DI float wave_sum(float v) { for (int o = 32; o > 0; o >>= 1) v += __shfl_xor(v, o); return v; }
DI float wave_max(float v) { for (int o = 32; o > 0; o >>= 1) v = fmaxf(v, __shfl_xor(v, o)); return v; }
DI f32x16 zero16() { f32x16 z; for (int i = 0; i < 16; i++) z[i] = 0.f; return z; }
DI bf16x8 pack8(const f32x16& x, int s) {
  union { unsigned u[4]; bf16x8 v; } t;
  t.u[0] = pack2(x[8 * s + 0], x[8 * s + 1]); t.u[1] = pack2(x[8 * s + 2], x[8 * s + 3]);
  t.u[2] = pack2(x[8 * s + 4], x[8 * s + 5]); t.u[3] = pack2(x[8 * s + 6], x[8 * s + 7]);
  return t.v;
}

constexpr int GS_ = 72;
constexpr int GT_ = 128 * GS_;

struct GemmPre { u32x4 a0[4], b0[4], a1[4], b1[4]; };
#define G_LOAD(RA, RB, T) _Pragma("unroll") for (int i = 0; i < 4; i++) { RA[i] = *(const u32x4*)(Ap + (size_t)i * 32 * lda + (T) * 64); RB[i] = *(const u32x4*)(Bp + (size_t)i * 32 * ldb + (T) * 64); }
DI void gemm_prefetch(GemmPre& R, const u16* __restrict__ A, int lda, const u16* __restrict__ B, int ldb) {
  const int tid = tidx();
  const int srow = tid >> 3, sk = (tid & 7) * 8;
  const u16* Ap = A + (size_t)srow * lda + sk;
  const u16* Bp = B + (size_t)srow * ldb + sk;
  G_LOAD(R.a0, R.b0, 0)
  G_LOAD(R.a1, R.b1, 1)
}
DI void gemm_main(f32x16 (&acc)[2][2], GemmPre& R, const u16* __restrict__ A, int lda, const u16* __restrict__ B, int ldb, int K, u16* sm) {
  const int tid = tidx(), lane = tid & 63, wave = tid >> 6;
  const int wm = wave >> 1, wn = wave & 1, r = lane & 31, hh = lane >> 5;
  const int srow = tid >> 3, sk = (tid & 7) * 8;
  const u16* Ap = A + (size_t)srow * lda + sk;
  const u16* Bp = B + (size_t)srow * ldb + sk;
#define G_STORE(RA, RB, BUF) { u16* d_ = sm + (BUF) * 2 * GT_; _Pragma("unroll") for (int i = 0; i < 4; i++) { *(u32x4*)(d_ + (srow + i * 32) * GS_ + sk) = RA[i]; *(u32x4*)(d_ + GT_ + (srow + i * 32) * GS_ + sk) = RB[i]; } }
#define G_COMPUTE(BUF) { const u16* sA = sm + (BUF) * 2 * GT_; const u16* sB = sA + GT_; \
    _Pragma("unroll") for (int ks = 0; ks < 4; ks++) { \
      const bf16x8 fa0 = *(const bf16x8*)(sA + (wm * 64 + r) * GS_ + ks * 16 + hh * 8); \
      const bf16x8 fa1 = *(const bf16x8*)(sA + (wm * 64 + 32 + r) * GS_ + ks * 16 + hh * 8); \
      const bf16x8 fb0 = *(const bf16x8*)(sB + (wn * 64 + r) * GS_ + ks * 16 + hh * 8); \
      const bf16x8 fb1 = *(const bf16x8*)(sB + (wn * 64 + 32 + r) * GS_ + ks * 16 + hh * 8); \
      acc[0][0] = MFMA32(fa0, fb0, acc[0][0]); acc[0][1] = MFMA32(fa0, fb1, acc[0][1]); \
      acc[1][0] = MFMA32(fa1, fb0, acc[1][0]); acc[1][1] = MFMA32(fa1, fb1, acc[1][1]); } }
  const int nk = K >> 6;
  __syncthreads();
  G_STORE(R.a0, R.b0, 0)
  G_LOAD(R.a0, R.b0, 2)
  __syncthreads();
  int kt = 0;
#pragma unroll 1
  for (; kt + 4 < nk; kt += 2) {
    G_COMPUTE(0)
    G_STORE(R.a1, R.b1, 1)
    __syncthreads();
    G_LOAD(R.a1, R.b1, kt + 3)
    G_COMPUTE(1)
    G_STORE(R.a0, R.b0, 0)
    __syncthreads();
    G_LOAD(R.a0, R.b0, kt + 4)
  }
  G_COMPUTE(0)
  G_STORE(R.a1, R.b1, 1)
  __syncthreads();
  G_LOAD(R.a1, R.b1, kt + 3)
  G_COMPUTE(1)
  G_STORE(R.a0, R.b0, 0)
  __syncthreads();
  G_COMPUTE(0)
  G_STORE(R.a1, R.b1, 1)
  __syncthreads();
  G_COMPUTE(1)
#undef G_STORE
#undef G_COMPUTE
}
#undef G_LOAD

DI bool tile_at(int it, int bid, int nb, int TM, int TN, int& tm, int& tn) {
  if ((nb & 7) == 0 && (TM & 63) == 0) {
    const int xcd = bid & 7, lw = bid >> 3, nlw = nb >> 3;
    const int lt = lw + it * nlw, per = (TM >> 3) * TN;
    if (lt >= per) return false;
    const int g = lt / (8 * TN), rem = lt - g * 8 * TN;
    tn = rem >> 3; tm = xcd * (TM >> 3) + g * 8 + (rem & 7);
    return true;
  } else {
    const int t = bid + it * nb;
    if (t >= TM * TN) return false;
    tn = t / TM; tm = t - tn * TM;
    return true;
  }
}

template <class AF, class BF, class EPI>
DI void gemm_phase(int TM, int TN, int K, int lda, int ldb, AF a_of, BF b_of, EPI epi, int bid, int nb, u16* sm) {
  GemmPre R;
  int tm, tn;
  bool have = tile_at(0, bid, nb, TM, TN, tm, tn);
  if (have) gemm_prefetch(R, a_of(tm), lda, b_of(tn), ldb);
  for (int it = 0; have; it++) {
    f32x16 acc[2][2] = {{zero16(), zero16()}, {zero16(), zero16()}};
    gemm_main(acc, R, a_of(tm), lda, b_of(tn), ldb, K, sm);
    int tm2 = 0, tn2 = 0;
    const bool have2 = tile_at(it + 1, bid, nb, TM, TN, tm2, tn2);
    if (have2) gemm_prefetch(R, a_of(tm2), lda, b_of(tn2), ldb);
    epi(acc, tm, tn);
    have = have2; tm = tm2; tn = tn2;
  }
}

DI void transpose_job(const float* __restrict__ src, int K, int N, u16* __restrict__ dst, int mode, int bid, int nb, float* tile) {
  const int tid = tidx();
  const int tk = K >> 6, tn = (N + 63) >> 6;
  for (int t = bid; t < tk * tn; t += nb) {
    const int k0 = (t % tk) * 64, n0 = (t / tk) * 64;
    __syncthreads();
#pragma unroll 4
    for (int i = 0; i < 16; i++) {
      const int k = i * 4 + (tid >> 6), n = tid & 63;
      tile[k * 65 + n] = (n0 + n < N) ? src[(size_t)(k0 + k) * N + n0 + n] : 0.f;
    }
    __syncthreads();
#pragma unroll 4
    for (int i = 0; i < 16; i++) {
      const int n = i * 4 + (tid >> 6), k = tid & 63;
      const int ng = n0 + n;
      if (ng < N) {
        int row = ng;
        if (mode == 1) row = (ng >> 5) * 64 + (ng & 31);
        else if (mode == 2) row = (ng >> 5) * 64 + 32 + (ng & 31);
        dst[(size_t)row * K + k0 + k] = f2bf(tile[k * 65 + n]);
      }
    }
  }
}

DI void phase_prep(const Params& P, int bid, int nb, char* smem) {
  float* tile = (float*)smem;
  char* ws = WS(P);
  for (int l = 0; l < 2; l++) {
    transpose_job(INP(P, 3) + (size_t)l * 1024 * FF_, 1024, FF_, (u16*)(ws + OFF_WGU1 + l * SZ_WGU), 1, bid, nb, tile);
    transpose_job(INP(P, 4) + (size_t)l * 1024 * FF_, 1024, FF_, (u16*)(ws + OFF_WGU1 + l * SZ_WGU), 2, bid, nb, tile);
    transpose_job(INP(P, 5) + (size_t)l * FF_ * 1024, FF_, 1024, (u16*)(ws + OFF_WD1 + l * SZ_WD), 0, bid, nb, tile);
    transpose_job(INP(P, 26) + (size_t)l * 1024 * FF_, 1024, FF_, (u16*)(ws + OFF_WGU2 + l * SZ_WGU), 1, bid, nb, tile);
    transpose_job(INP(P, 27) + (size_t)l * 1024 * FF_, 1024, FF_, (u16*)(ws + OFF_WGU2 + l * SZ_WGU), 2, bid, nb, tile);
    transpose_job(INP(P, 28) + (size_t)l * FF_ * 1024, FF_, 1024, (u16*)(ws + OFF_WD2 + l * SZ_WD), 0, bid, nb, tile);
    transpose_job(INP(P, 8) + (size_t)l * 1024 * 2472, 1024, 2472, (u16*)(ws + OFF_WIN + l * SZ_WIN), 0, bid, nb, tile);
    transpose_job(INP(P, 9) + (size_t)l * 1024 * 1024, 1024, 1024, (u16*)(ws + OFF_WO + l * SZ_WO), 0, bid, nb, tile);
    transpose_job(INP(P, 23) + (size_t)l * 256 * 256, 256, 256, (u16*)(ws + OFF_WGLU + l * SZ_WGLU), 0, bid, nb, tile);
    transpose_job(INP(P, 30) + (size_t)l * 1024 * 1024, 1024, 1024, (u16*)(ws + OFF_WPG + l * SZ_WPG), 0, bid, nb, tile);
    transpose_job(INP(P, 29) + (size_t)l * 256 * 1024, 256, 1024, (u16*)(ws + OFF_WPP + l * SZ_WPP), 0, bid, nb, tile);
    u16* win = (u16*)(ws + OFF_WIN + l * SZ_WIN);
    for (int i = bid * 256 + tidx(); i < 88 * 1024; i += nb * 256) win[(size_t)2472 * 1024 + i] = 0;
  }
  const size_t gt = (size_t)bid * 256 + tidx(), gs = (size_t)nb * 256;
  {
    const float4* x4 = (const float4*)INP(P, 0);
    uint2* xb = (uint2*)(ws + OFF_XB);
    for (size_t i = gt; i < (size_t)T_ * 1024 / 4; i += gs) { float4 v = x4[i]; xb[i] = make_uint2(pack2(v.x, v.y), pack2(v.z, v.w)); }
    const float4* p4 = (const float4*)INP(P, 1);
    uint2* pb = (uint2*)(ws + OFF_PB);
    for (size_t i = gt; i < (size_t)2 * T_ * 256 / 4; i += gs) { float4 v = p4[i]; pb[i] = make_uint2(pack2(v.x, v.y), pack2(v.z, v.w)); }
  }
  if (gt < 2 * 16 * 64) {
    const int l = (int)gt >> 10, g = ((int)gt >> 6) & 15, p = (int)gt & 63;
    const int gi = (l * 16 + g) * 64 + p;
    const double lr = INP(P, 15)[gi], li = INP(P, 16)[gi];
    const double dt = exp((double)INP(P, 17)[l * 16 + g]);
    const double mag = exp(lr * dt);
    const double ar = mag * cos(li * dt), ai = mag * sin(li * dt);
    const double mag5 = exp(512.0 * lr * dt);
    const double a5r = mag5 * cos(512.0 * li * dt), a5i = mag5 * sin(512.0 * li * dt);
    ((float4*)(ws + OFF_COEFA))[gi] = make_float4((float)ar, (float)ai, (float)a5r, (float)a5i);
    const double den = lr * lr + li * li, nr = ar - 1.0, ni = ai;
    const double fr = (nr * lr + ni * li) / den, fi = (ni * lr - nr * li) / den;
    float2* cb = (float2*)(ws + OFF_COEFB) + (size_t)gi * 16;
    for (int c = 0; c < 16; c++) {
      const double br = INP(P, 18)[(size_t)gi * 16 + c], bi = INP(P, 19)[(size_t)gi * 16 + c];
      cb[c] = make_float2((float)(fr * br - fi * bi), (float)(fr * bi + fi * br));
    }
  }
  if (gt < 8 * 129) {
    const int hd = (int)gt / 129, n = (int)gt - hd * 129;
    int bk = n;
    if (n >= 16) { bk = 16 + (int)(log((double)n / 16.0) / log(8.0) * 16.0); bk = bk < 31 ? bk : 31; }
    ((float*)(ws + OFF_BIAS))[gt] = INP(P, 2)[bk * 8 + hd];
  }
  if (gt < 2) {
    const int l = (int)gt;
    float s1 = 0.f, s2 = 0.f;
    for (int i = 0; i < 64; i++) { s1 += INP(P, 10)[l * 64 + i] * INP(P, 11)[l * 64 + i]; s2 += INP(P, 12)[l * 64 + i] * INP(P, 13)[l * 64 + i]; }
    const float lam_init = 0.8f - 0.6f * expf(-0.3f * (float)l);
    ((float*)(ws + OFF_LAM))[l] = expf(s1) - expf(s2) + lam_init;
  }
}

DI void phase_ffn_up(const u16* __restrict__ Xb, const u16* __restrict__ Wgu, u16* __restrict__ H, int bid, int nb, u16* sm) {
  const int lane = tidx() & 63, wave = tidx() >> 6, wm = wave >> 1, wn = wave & 1, r = lane & 31, hh = lane >> 5;
  gemm_phase(512, 44, 1024, 1024, 1024,
    [&](int tm) { return Xb + (size_t)tm * 128 * 1024; }, [&](int tn) { return Wgu + (size_t)tn * 128 * 1024; },
    [&](f32x16 (&acc)[2][2], int tm, int tn) {
      const int j = tn * 64 + wn * 32 + r;
#pragma unroll
      for (int mi = 0; mi < 2; mi++)
#pragma unroll
        for (int i = 0; i < 16; i++) {
          const int row = tm * 128 + wm * 64 + mi * 32 + crow(i, hh);
          const float g = acc[mi][0][i], u = acc[mi][1][i];
          H[(size_t)row * FF_ + j] = f2bf(g * sigmoidf_(g) * u);
        }
    }, bid, nb, sm);
}

DI void phase_ffn_down(const u16* __restrict__ H, const u16* __restrict__ Wd, const float* xin, float* xout, const u16* __restrict__ ple, int bid, int nb, u16* sm) {
  const int lane = tidx() & 63, wave = tidx() >> 6, wm = wave >> 1, wn = wave & 1, r = lane & 31, hh = lane >> 5;
  gemm_phase(512, 8, FF_, FF_, FF_,
    [&](int tm) { return H + (size_t)tm * 128 * FF_; }, [&](int tn) { return Wd + (size_t)tn * 128 * FF_; },
    [&](f32x16 (&acc)[2][2], int tm, int tn) {
#pragma unroll
      for (int mi = 0; mi < 2; mi++)
#pragma unroll
        for (int ni = 0; ni < 2; ni++)
#pragma unroll
          for (int i = 0; i < 16; i++) {
            const size_t o = (size_t)(tm * 128 + wm * 64 + mi * 32 + crow(i, hh)) * 1024 + tn * 128 + wn * 64 + ni * 32 + r;
            float v = ALPHA_ * xin[o] + 0.5f * acc[mi][ni][i];
            if (ple) v += bf2f(ple[o]);
            xout[o] = v;
          }
    }, bid, nb, sm);
}

DI void phase_w_o(const u16* __restrict__ CC, const u16* __restrict__ Wo, float* x, int bid, int nb, u16* sm) {
  const int lane = tidx() & 63, wave = tidx() >> 6, wm = wave >> 1, wn = wave & 1, r = lane & 31, hh = lane >> 5;
  gemm_phase(512, 8, 1024, 1024, 1024,
    [&](int tm) { return CC + (size_t)tm * 128 * 1024; }, [&](int tn) { return Wo + (size_t)tn * 128 * 1024; },
    [&](f32x16 (&acc)[2][2], int tm, int tn) {
#pragma unroll
      for (int mi = 0; mi < 2; mi++)
#pragma unroll
        for (int ni = 0; ni < 2; ni++)
#pragma unroll
          for (int i = 0; i < 16; i++) {
            const size_t o = (size_t)(tm * 128 + wm * 64 + mi * 32 + crow(i, hh)) * 1024 + tn * 128 + wn * 64 + ni * 32 + r;
            x[o] = ALPHA_ * x[o] + acc[mi][ni][i];
          }
    }, bid, nb, sm);
}

DI void phase_glu(const u16* __restrict__ Yg, const u16* __restrict__ Wglu, u16* __restrict__ CC, int bid, int nb, u16* sm) {
  const int lane = tidx() & 63, wave = tidx() >> 6, wm = wave >> 1, wn = wave & 1, r = lane & 31, hh = lane >> 5;
  gemm_phase(512, 2, 256, 256, 256,
    [&](int tm) { return Yg + (size_t)tm * 128 * 256; }, [&](int tn) { return Wglu + (size_t)tn * 128 * 256; },
    [&](f32x16 (&acc)[2][2], int tm, int tn) {
#pragma unroll
      for (int mi = 0; mi < 2; mi++)
#pragma unroll
        for (int ni = 0; ni < 2; ni++)
#pragma unroll
          for (int i = 0; i < 16; i++) {
            const int row = tm * 128 + wm * 64 + mi * 32 + crow(i, hh), col = tn * 128 + wn * 64 + ni * 32 + r;
            const float y = bf2f(Yg[(size_t)row * 256 + col]);
            CC[(size_t)row * 1024 + 512 + col] = f2bf(y * sigmoidf_(acc[mi][ni][i]));
          }
    }, bid, nb, sm);
}

DI void phase_ple(const u16* __restrict__ Xb, const u16* __restrict__ Wpg, const u16* __restrict__ Pb, const u16* __restrict__ Wpp, u16* ple, int bid, int nb, u16* sm) {
  const int lane = tidx() & 63, wave = tidx() >> 6, wm = wave >> 1, wn = wave & 1, r = lane & 31, hh = lane >> 5;
  gemm_phase(512, 8, 1024, 1024, 1024,
    [&](int tm) { return Xb + (size_t)tm * 128 * 1024; }, [&](int tn) { return Wpg + (size_t)tn * 128 * 1024; },
    [&](f32x16 (&acc)[2][2], int tm, int tn) {
#pragma unroll
      for (int mi = 0; mi < 2; mi++)
#pragma unroll
        for (int ni = 0; ni < 2; ni++)
#pragma unroll
          for (int i = 0; i < 16; i++) {
            const size_t o = (size_t)(tm * 128 + wm * 64 + mi * 32 + crow(i, hh)) * 1024 + tn * 128 + wn * 64 + ni * 32 + r;
            ple[o] = f2bf(sigmoidf_(acc[mi][ni][i]));
          }
    }, bid, nb, sm);
  gemm_phase(512, 8, 256, 256, 256,
    [&](int tm) { return Pb + (size_t)tm * 128 * 256; }, [&](int tn) { return Wpp + (size_t)tn * 128 * 256; },
    [&](f32x16 (&acc)[2][2], int tm, int tn) {
#pragma unroll
      for (int mi = 0; mi < 2; mi++)
#pragma unroll
        for (int ni = 0; ni < 2; ni++)
#pragma unroll
          for (int i = 0; i < 16; i++) {
            const size_t o = (size_t)(tm * 128 + wm * 64 + mi * 32 + crow(i, hh)) * 1024 + tn * 128 + wn * 64 + ni * 32 + r;
            ple[o] = f2bf(acc[mi][ni][i] * bf2f(ple[o]));
          }
    }, bid, nb, sm);
}

DI void phase_w_in(const u16* __restrict__ Xb, const u16* __restrict__ Win, char* mb, int bid, int nb, u16* sm) {
  const int lane = tidx() & 63, wave = tidx() >> 6, wm = wave >> 1, wn = wave & 1, r = lane & 31, hh = lane >> 5;
  u16* Qd = (u16*)(mb + M_QD); u16* Kd = (u16*)(mb + M_KD); u16* Vt = (u16*)(mb + M_VT); float* U = (float*)(mb + M_U);
  u16* Qs = (u16*)(mb + M_QS); u16* Qi = (u16*)(mb + M_QI); u16* Ks = (u16*)(mb + M_KS); u16* Vs = (u16*)(mb + M_VS);
  u16* Ki = (u16*)(mb + M_KI); float* Wi = (float*)(mb + M_WI);
  gemm_phase(512, 20, 1024, 1024, 1024,
    [&](int tm) { return Xb + (size_t)tm * 128 * 1024; }, [&](int tn) { return Win + (size_t)tn * 128 * 1024; },
    [&](f32x16 (&acc)[2][2], int tm, int tn) {
#pragma unroll
    for (int ni = 0; ni < 2; ni++) {
      const int c0 = tn * 128 + wn * 64 + ni * 32;
      const int c = c0 + r;
#pragma unroll
      for (int mi = 0; mi < 2; mi++) {
        const int rowb = tm * 128 + wm * 64 + mi * 32;
        if (c0 >= 1024 && c0 < 1536) {
          const int cc = c - 1024, head = cc >> 7, dv = cc & 127;
          const int b = rowb >> 13, t0 = rowb & 8191;
#pragma unroll
          for (int g4 = 0; g4 < 4; g4++) {
            uint2 v = make_uint2(pack2(acc[mi][ni][4 * g4], acc[mi][ni][4 * g4 + 1]), pack2(acc[mi][ni][4 * g4 + 2], acc[mi][ni][4 * g4 + 3]));
            *(uint2*)(Vt + ((size_t)((b * 4 + head) * 128 + dv)) * L_ + t0 + 8 * g4 + 4 * hh) = v;
          }
        } else {
#pragma unroll
          for (int i = 0; i < 16; i++) {
            const size_t row = rowb + crow(i, hh);
            const float v = acc[mi][ni][i];
            if (c0 < 512) Qd[row * 512 + c] = f2bf(v);
            else if (c0 < 1024) Kd[row * 512 + (c - 512)] = f2bf(v);
            else if (c0 < 1792) U[row * 256 + (c - 1536)] = v;
            else if (c0 < 2048) Qs[row * 256 + (c - 1792)] = f2bf(v);
            else if (c0 < 2112) Ks[row * 64 + (c - 2048)] = f2bf(v);
            else if (c0 < 2176) Vs[row * 64 + (c - 2112)] = f2bf(v);
            else if (c0 < 2432) Qi[row * 256 + (c - 2176)] = f2bf(v);
            else if (c0 < 2464) Ki[row * 32 + (c - 2432)] = f2bf(v);
            else if (c0 == 2464) { if (r < 8) Wi[row * 8 + r] = v * 0.0625f; }
          }
        }
      }
    }
  }, bid, nb, sm);
}

DI void phase_ln(float* x, u16* __restrict__ xb, const float* __restrict__ g, const float* __restrict__ bta, int bid, int nb) {
  const int lane = tidx() & 63, wave = tidx() >> 6;
  float4 gg[4], bb[4];
#pragma unroll
  for (int i = 0; i < 4; i++) { gg[i] = *(const float4*)(g + i * 256 + lane * 4); bb[i] = *(const float4*)(bta + i * 256 + lane * 4); }
  for (int row = bid * 4 + wave; row < T_; row += nb * 4) {
    float4 v[4];
#pragma unroll
    for (int i = 0; i < 4; i++) v[i] = *(const float4*)(x + (size_t)row * 1024 + i * 256 + lane * 4);
    float s = 0.f;
#pragma unroll
    for (int i = 0; i < 4; i++) s += v[i].x + v[i].y + v[i].z + v[i].w;
    const float mu = wave_sum(s) * (1.f / 1024.f);
    float q = 0.f;
#pragma unroll
    for (int i = 0; i < 4; i++) { v[i].x -= mu; v[i].y -= mu; v[i].z -= mu; v[i].w -= mu; q += v[i].x * v[i].x + v[i].y * v[i].y + v[i].z * v[i].z + v[i].w * v[i].w; }
    const float rs = rsqrtf(wave_sum(q) * (1.f / 1024.f) + LN_EPS_);
#pragma unroll
    for (int i = 0; i < 4; i++) {
      float4 o;
      o.x = v[i].x * rs * gg[i].x + bb[i].x; o.y = v[i].y * rs * gg[i].y + bb[i].y;
      o.z = v[i].z * rs * gg[i].z + bb[i].z; o.w = v[i].w * rs * gg[i].w + bb[i].w;
      *(float4*)(x + (size_t)row * 1024 + i * 256 + lane * 4) = o;
      *(uint2*)(xb + (size_t)row * 1024 + i * 256 + lane * 4) = make_uint2(pack2(o.x, o.y), pack2(o.z, o.w));
    }
  }
}

DI float gelu_tanh(float x) { const float u = 0.7978845608028654f * (x + 0.044715f * x * x * x); return 0.5f * x * (1.f + tanhf(u)); }

template <bool OUT>
DI void ssm_scan(const Params& P, int layer, int widx, char* mb) {
  const int lane = tidx() & 63;
  const int b = widx >> 8, g = (widx >> 4) & 15, ch = widx & 15;
  const int gi = (layer * 16 + g) * 64 + lane;
  const float4 ca = ((const float4*)(WS(P) + OFF_COEFA))[gi];
  const float2* cbp = (const float2*)(WS(P) + OFF_COEFB) + (size_t)gi * 16;
  float bre[16], bim[16];
#pragma unroll
  for (int c = 0; c < 16; c++) { float2 t = cbp[c]; bre[c] = t.x; bim[c] = t.y; }
  const float* U = (const float*)(mb + M_U);
  float2* Send = (float2*)(mb + M_SEND);
  const size_t sbase = (size_t)((b * 16 + g) * 16) * 64 + lane;
  float xr = 0.f, xi = 0.f;
  float cre[16], cim[16];
  float dsk = 0.f;
  int mych = 0;
  if (OUT) {
    for (int j = 0; j < ch; j++) {
      const float2 e = Send[sbase + (size_t)j * 64];
      const float nr = ca.z * xr - ca.w * xi + e.x, ni = ca.z * xi + ca.w * xr + e.y;
      xr = nr; xi = ni;
    }
#pragma unroll
    for (int c = 0; c < 16; c++) {
      cre[c] = INP(P, 20)[((size_t)(layer * 16 + g) * 16 + c) * 64 + lane];
      cim[c] = INP(P, 21)[((size_t)(layer * 16 + g) * 16 + c) * 64 + lane];
    }
    mych = ((lane >> 5) & 1) * 8 + ((lane >> 4) & 1) * 4 + ((lane >> 3) & 1) * 2 + ((lane >> 2) & 1);
    dsk = INP(P, 22)[layer * 256 + g * 16 + mych];
  }
  u16* Yg = (u16*)(mb + M_YG);
  const size_t tok0 = (size_t)b * L_ + ch * 512;
  const float* ub = U + (tok0 + (lane >> 2)) * 256 + g * 16 + (lane & 3) * 4;
  float4 cur = *(const float4*)ub;
#pragma unroll 1
  for (int blk = 0; blk < 32; blk++) {
    const float4 nxt = *(const float4*)(ub + (size_t)min(blk + 1, 31) * 16 * 256);
#pragma unroll
  for (int s16 = 0; s16 < 16; s16++) {
    const int t = blk * 16 + s16;
    float uu[16];
#pragma unroll
    for (int c = 0; c < 16; c++) {
      const float comp = ((c & 3) == 0) ? cur.x : ((c & 3) == 1) ? cur.y : ((c & 3) == 2) ? cur.z : cur.w;
      uu[c] = __int_as_float(__builtin_amdgcn_readlane(__float_as_int(comp), 4 * s16 + (c >> 2)));
    }
    float br = 0.f, bi = 0.f;
#pragma unroll
    for (int c = 0; c < 16; c++) { br += bre[c] * uu[c]; bi += bim[c] * uu[c]; }
    const float nr = ca.x * xr - ca.y * xi + br, ni = ca.x * xi + ca.y * xr + bi;
    xr = nr; xi = ni;
    if (OUT) {
      float v[16];
#pragma unroll
      for (int c = 0; c < 16; c++) v[c] = cre[c] * xr - cim[c] * xi;
      const bool b5 = lane & 32, b4 = lane & 16, b3 = lane & 8, b2 = lane & 4;
      float v8[8], v4[4], v2[2], v1;
#pragma unroll
      for (int i = 0; i < 8; i++) { const float snd = b5 ? v[i] : v[i + 8]; const float rcv = __shfl_xor(snd, 32); v8[i] = (b5 ? v[i + 8] : v[i]) + rcv; }
#pragma unroll
      for (int i = 0; i < 4; i++) { const float snd = b4 ? v8[i] : v8[i + 4]; const float rcv = __shfl_xor(snd, 16); v4[i] = (b4 ? v8[i + 4] : v8[i]) + rcv; }
#pragma unroll
      for (int i = 0; i < 2; i++) { const float snd = b3 ? v4[i] : v4[i + 2]; const float rcv = __shfl_xor(snd, 8); v2[i] = (b3 ? v4[i + 2] : v4[i]) + rcv; }
      { const float snd = b2 ? v2[0] : v2[1]; const float rcv = __shfl_xor(snd, 4); v1 = (b2 ? v2[1] : v2[0]) + rcv; }
      v1 += __shfl_xor(v1, 2);
      v1 += __shfl_xor(v1, 1);
      float um = uu[0];
#pragma unroll
      for (int c = 1; c < 16; c++) um = (mych == c) ? uu[c] : um;
      const float y = gelu_tanh(v1 + dsk * um);
      if ((lane & 3) == 0) Yg[(tok0 + t) * 256 + g * 16 + mych] = f2bf(y);
    }
  }
    cur = nxt;
  }
  if (!OUT) Send[sbase + (size_t)ch * 64] = make_float2(xr, xi);
}

constexpr int KS_ = 72, VS_ = 68;
DI void da_item(const Params& P, int layer, int b, int h, int qt, char* mb, char* smem) {
  const int tid = tidx(), lane = tid & 63, wave = tid >> 6, r = lane & 31, hh = lane >> 5;
  u16* sK = (u16*)smem;
  u16* sV = sK + 64 * KS_;
  float* sbias = (float*)(sV + 128 * VS_);
  u16* sQw = (u16*)(smem + 28672) + (tidx() >> 6) * 32 * KS_;
  const u16* Qd = (const u16*)(mb + M_QD); const u16* Kd = (const u16*)(mb + M_KD); const u16* Vt = (const u16*)(mb + M_VT);
  u16* CC = (u16*)(WS(P) + OFF_CC);
  const int q0 = qt * 128, qw = q0 + wave * 32, qp = qw + r;
  const size_t tokq = (size_t)b * L_ + qp;
  __syncthreads();
  if (tid < 129) sbias[tid] = ((const float*)(WS(P) + OFF_BIAS))[h * 129 + tid] * LOG2E_;
  __syncthreads();
  const float bfar = sbias[128];
  const float SC = 0.125f * LOG2E_;
  const int nkt = (q0 + 128) >> 6;
  const float lam = ((const float*)(WS(P) + OFF_LAM))[layer];
  const int krow_l = tid >> 3, kch = (tid & 7) * 8;
#pragma unroll 1
  for (int c = 0; c < 2; c++) {
#pragma unroll
    for (int ks = 0; ks < 4; ks++) *(bf16x8*)(sQw + r * KS_ + ks * 16 + hh * 8) = *(const bf16x8*)(Qd + tokq * 512 + h * 128 + c * 64 + ks * 16 + hh * 8);
    f32x16 o[4] = {zero16(), zero16(), zero16(), zero16()};
    float m = -INFINITY, l = 0.f;
    const u16* Kbase = Kd + ((size_t)b * L_ + krow_l) * 512 + h * 128 + c * 64 + kch;
    const u16* Vbase = Vt + ((size_t)((b * 4 + h) * 128 + krow_l)) * L_ + kch;
    u32x4 rk[2], rv[4];
#pragma unroll
    for (int i = 0; i < 2; i++) rk[i] = *(const u32x4*)(Kbase + (size_t)(i * 32) * 512);
#pragma unroll
    for (int i = 0; i < 4; i++) rv[i] = *(const u32x4*)(Vbase + (size_t)(i * 32) * L_);
#pragma unroll 1
    for (int kt = 0; kt < nkt; kt++) {
      __syncthreads();
#pragma unroll
      for (int i = 0; i < 2; i++) *(u32x4*)(sK + (krow_l + i * 32) * KS_ + kch) = rk[i];
#pragma unroll
      for (int i = 0; i < 4; i++) {
        u32x2* d = (u32x2*)(sV + (krow_l + i * 32) * VS_ + kch);
        u32x2 lo2, hi2; lo2.x = rv[i].x; lo2.y = rv[i].y; hi2.x = rv[i].z; hi2.y = rv[i].w;
        d[0] = lo2; d[1] = hi2;
      }
      __syncthreads();
      {
        const int ktn = min(kt + 1, nkt - 1);
#pragma unroll
        for (int i = 0; i < 2; i++) rk[i] = *(const u32x4*)(Kbase + (size_t)(ktn * 64 + i * 32) * 512);
#pragma unroll
        for (int i = 0; i < 4; i++) rv[i] = *(const u32x4*)(Vbase + (size_t)(i * 32) * L_ + ktn * 64);
      }
      if (kt * 64 <= qw + 31) {
        f32x16 s[2];
#pragma unroll
        for (int kb = 0; kb < 2; kb++) {
          s[kb] = zero16();
#pragma unroll
          for (int ks = 0; ks < 4; ks++) {
            const bf16x8 kf = *(const bf16x8*)(sK + (kb * 32 + r) * KS_ + ks * 16 + hh * 8);
            const bf16x8 qf = *(const bf16x8*)(sQw + r * KS_ + ks * 16 + hh * 8);
            s[kb] = MFMA32(kf, qf, s[kb]);
          }
        }
        const bool nearb = (kt * 64 + 63 + 128 > qw);
        float mx = -INFINITY;
        if (nearb) {
#pragma unroll
          for (int kb = 0; kb < 2; kb++)
#pragma unroll
            for (int i = 0; i < 16; i++) {
              const int dist = qp - (kt * 64 + kb * 32 + crow(i, hh));
              const float bv = sbias[min(max(dist, 0), 128)];
              float t = s[kb][i] * SC + bv;
              t = (dist >= 0) ? t : -INFINITY;
              s[kb][i] = t; mx = fmaxf(mx, t);
              if ((i & 7) == 7) __builtin_amdgcn_sched_barrier(0);
            }
        } else {
#pragma unroll
          for (int kb = 0; kb < 2; kb++)
#pragma unroll
            for (int i = 0; i < 16; i++) { const float t = s[kb][i] * SC + bfar; s[kb][i] = t; mx = fmaxf(mx, t); }
        }
        mx = fmaxf(mx, __shfl_xor(mx, 32));
        const float mn = fmaxf(m, mx);
        const float corr = __builtin_amdgcn_exp2f(m - mn);
        m = mn;
        float ls = 0.f;
#pragma unroll
        for (int kb = 0; kb < 2; kb++)
#pragma unroll
          for (int i = 0; i < 16; i++) { const float p = __builtin_amdgcn_exp2f(s[kb][i] - mn); s[kb][i] = p; ls += p; }
        l = l * corr + ls;
        if (__ballot(corr != 1.f) != 0ull) {
#pragma unroll
          for (int dt = 0; dt < 4; dt++)
#pragma unroll
            for (int i = 0; i < 16; i++) o[dt][i] *= corr;
        }
#pragma unroll
        for (int kb = 0; kb < 2; kb++)
#pragma unroll
          for (int s2 = 0; s2 < 2; s2++) {
            const bf16x8 pf = pack8(s[kb], s2);
#pragma unroll
            for (int dt = 0; dt < 4; dt++) {
              const u16* vp = sV + (dt * 32 + r) * VS_ + kb * 32 + s2 * 16 + 4 * hh;
              const s16x4 lo = *(const s16x4*)vp, hi = *(const s16x4*)(vp + 8);
              const bf16x8 vf = __builtin_shufflevector(lo, hi, 0, 1, 2, 3, 4, 5, 6, 7);
              o[dt] = MFMA32(vf, pf, o[dt]);
            }
            __builtin_amdgcn_sched_barrier(0);
          }
      }
    }
    const float lt = l + __shfl_xor(l, 32);
    const float inv = 1.f / lt;
    size_t tq = tokq;
    asm volatile("" : "+v"(tq));
    u16* obase = CC + tq * 1024 + h * 128 + 4 * hh;
    if (c == 0) {
#pragma unroll
      for (int dt = 0; dt < 4; dt++)
#pragma unroll
        for (int g4 = 0; g4 < 4; g4++) {
          *(uint2*)(obase + dt * 32 + 8 * g4) = make_uint2(pack2(o[dt][4 * g4] * inv, o[dt][4 * g4 + 1] * inv), pack2(o[dt][4 * g4 + 2] * inv, o[dt][4 * g4 + 3] * inv));
        }
    } else {
      float ss = 0.f;
#pragma unroll
      for (int dt = 0; dt < 4; dt++)
#pragma unroll
        for (int g4 = 0; g4 < 4; g4++) {
          const uint2 pv = *(const uint2*)(obase + dt * 32 + 8 * g4);
          const float a4[4] = {bf2f((u16)(pv.x & 0xffff)), bf2f((u16)(pv.x >> 16)), bf2f((u16)(pv.y & 0xffff)), bf2f((u16)(pv.y >> 16))};
#pragma unroll
          for (int e = 0; e < 4; e++) { const float v = a4[e] - lam * o[dt][4 * g4 + e] * inv; o[dt][4 * g4 + e] = v; ss = __builtin_fmaf(v, v, ss); }
        }
      ss += __shfl_xor(ss, 32);
      const float lam_init = 0.8f - 0.6f * __expf(-0.3f * (float)layer);
      const float rn = rsqrtf(ss * (1.f / 128.f) + LN_EPS_) * (1.f - lam_init);
      int hh2 = hh;
      asm volatile("" : "+v"(hh2));
      const float* sg = INP(P, 14) + layer * 128 + 4 * hh2;
#pragma unroll
      for (int dt = 0; dt < 4; dt++)
#pragma unroll
        for (int g4 = 0; g4 < 4; g4++) {
          const int dv = dt * 32 + 8 * g4 + 4 * hh;
          const float4 gv = *(const float4*)(sg + dt * 32 + 8 * g4);
          uint2 w = make_uint2(pack2(o[dt][4 * g4] * rn * gv.x, o[dt][4 * g4 + 1] * rn * gv.y),
                               pack2(o[dt][4 * g4 + 2] * rn * gv.z, o[dt][4 * g4 + 3] * rn * gv.w));
          *(uint2*)(obase + dv - 4 * hh) = w;
        }
    }
  }
}

DI unsigned sortkey(float f) { const unsigned u = __float_as_uint(f + 0.f); return u ^ (((unsigned)((int)u >> 31)) | 0x80000000u); }

DI void dsa_item(const Params& P, int layer, int b, int qt, char* mb, char* smem) {
  const int tid = tidx(), lane = tid & 63, wave = tid >> 6, r = lane & 31, hh = lane >> 5;
  unsigned* hist = (unsigned*)smem;
  float* sP = (float*)smem;
  float* sQ = (float*)(smem + 16384);
  u16* sidx = (u16*)(smem + 32896);
  unsigned* meta = (unsigned*)(smem + 49280);
  float* sbias = (float*)(smem + 50304);
  const u16* Qi = (const u16*)(mb + M_QI); const u16* Ki = (const u16*)(mb + M_KI); const float* Wi = (const float*)(mb + M_WI);
  const u16* Qs = (const u16*)(mb + M_QS); const u16* Ks = (const u16*)(mb + M_KS); const u16* Vs = (const u16*)(mb + M_VS);
  u16* CC = (u16*)(WS(P) + OFF_CC);
  const int q0 = qt * 32;
  const int qp = q0 + r;
  const size_t tokb = (size_t)b * L_;
  const int nk32 = qt + 1;
  const bool radix = (q0 >= 256);
  __syncthreads();
  for (int i = tid; i < 4 * 129; i += 256) sbias[i] = ((const float*)(WS(P) + OFF_BIAS))[4 * 129 + i];
  meta[tid] = (tid >= 32 && tid < 64) ? 256u : 0u;
  char* sQi = smem + 52384;
  float* sWi = (float*)(smem + 69280);
  unsigned* candK = (unsigned*)(WS(P) + OFF_CANDK) + (size_t)blockIdx.x * 32 * CAP_;
  u16* candI = (u16*)(WS(P) + OFF_CANDI) + (size_t)blockIdx.x * 32 * CAP_;
  {
    const int row = tid >> 3, ch = tid & 7;
    const uint4* src = (const uint4*)(Qi + (tokb + q0 + row) * 256 + ch * 32);
    uint4* dst = (uint4*)(sQi + row * 528 + ch * 64);
    dst[0] = src[0]; dst[1] = src[1]; dst[2] = src[2]; dst[3] = src[3];
    sWi[tid] = Wi[(tokb + q0) * 8 + tid];
  }
  int pass = radix ? 0 : 4;
  bool fast = false;
#pragma unroll 1
  while (true) {
    __syncthreads();
    if (pass < 4) { for (int i = tid; i < 32 * 257; i += 256) hist[i] = 0u; }
    __syncthreads();
    const unsigned pref = meta[r];
    const unsigned krem = meta[32 + r];
    bf16x8 nf0 = {0, 0, 0, 0, 0, 0, 0, 0}, nf1 = {0, 0, 0, 0, 0, 0, 0, 0};
    if (wave < nk32) {
      nf0 = *(const bf16x8*)(Ki + (tokb + wave * 32 + r) * 32 + hh * 8);
      nf1 = *(const bf16x8*)(Ki + (tokb + wave * 32 + r) * 32 + 16 + hh * 8);
    }
#pragma unroll 1
    for (int kt = wave; kt < nk32; kt += 4) {
      const bf16x8 kf0 = nf0, kf1 = nf1;
      if (kt + 4 < nk32) {
        nf0 = *(const bf16x8*)(Ki + (tokb + (kt + 4) * 32 + r) * 32 + hh * 8);
        nf1 = *(const bf16x8*)(Ki + (tokb + (kt + 4) * 32 + r) * 32 + 16 + hh * 8);
      }
      f32x16 sc = zero16();
#pragma unroll 4
      for (int hd = 0; hd < 8; hd++) {
        const bf16x8 q0f = *(const bf16x8*)(sQi + r * 528 + hd * 64 + hh * 16);
        const bf16x8 q1f = *(const bf16x8*)(sQi + r * 528 + hd * 64 + 32 + hh * 16);
        const float w = sWi[r * 8 + hd];
        f32x16 s = MFMA32(kf0, q0f, zero16());
        s = MFMA32(kf1, q1f, s);
#pragma unroll
        for (int i = 0; i < 16; i++) sc[i] += __int_as_float(max(__float_as_int(s[i]), 0)) * w;
      }
      const int lim = (kt == qt) ? qp : 0x7fffffff;
      if (pass == 0) {
#pragma unroll
        for (int i = 0; i < 16; i++) {
          const int kp = kt * 32 + crow(i, hh);
          const unsigned key = sortkey(sc[i]);
          const unsigned bin = (kp <= lim) ? (key >> 24) : 256u;
          atomicAdd(&hist[r * 257 + bin], 1u);
        }
      } else if (pass < 4) {
        const int sh = 24 - 8 * pass;
#pragma unroll
        for (int i = 0; i < 16; i++) {
          const int kp = kt * 32 + crow(i, hh);
          const unsigned key = sortkey(sc[i]);
          if ((key >> (sh + 8)) == pref && kp <= lim) atomicAdd(&hist[r * 257 + ((key >> sh) & 255u)], 1u);
        }
      } else if (pass == 5) {
#pragma unroll
        for (int i = 0; i < 16; i++) {
          const int kp = kt * 32 + crow(i, hh);
          const unsigned key = sortkey(sc[i]);
          if (kp <= lim) {
            const unsigned bt = key >> 24;
            if (bt > pref) { const unsigned pos = atomicAdd(&meta[64 + r], 1u); if (pos < 256u) sidx[r * 256 + pos] = (u16)kp; }
            else if (bt == pref) {
              const unsigned cp = atomicAdd(&meta[128 + r], 1u);
              if (cp < (unsigned)CAP_) { candK[r * CAP_ + cp] = key; candI[r * CAP_ + cp] = (u16)kp; }
            }
          }
        }
      } else {
#pragma unroll
        for (int i = 0; i < 16; i++) {
          const int kp = kt * 32 + crow(i, hh);
          const unsigned key = sortkey(sc[i]);
          bool sel = (kp <= lim);
          if (radix) {
            sel = sel && (key >= pref);
            if (sel && key == pref) sel = atomicAdd(&meta[96 + r], 1u) < krem;
          }
          if (sel) { const unsigned pos = atomicAdd(&meta[64 + r], 1u); if (pos < 256u) sidx[r * 256 + pos] = (u16)kp; }
        }
      }
    }
    __syncthreads();
    if (pass < 4) {
      for (int j = 0; j < 8; j++) {
        const int qq = wave * 8 + j;
        const unsigned k = meta[32 + qq];
        unsigned c4[4]; unsigned tot = 0;
#pragma unroll
        for (int e = 0; e < 4; e++) { c4[e] = hist[qq * 257 + 255 - 4 * lane - e]; tot += c4[e]; }
        unsigned incl = tot;
        for (int o = 1; o < 64; o <<= 1) { const unsigned t = __shfl_up(incl, o); if (lane >= o) incl += t; }
        unsigned run = incl - tot;
#pragma unroll
        for (int e = 0; e < 4; e++) {
          if (run < k && run + c4[e] >= k) {
            meta[qq] = (meta[qq] << 8) | (unsigned)(255 - 4 * lane - e); meta[32 + qq] = k - run;
            if (pass == 0 && c4[e] > (unsigned)CAP_) meta[192] = 1u;
          }
          run += c4[e];
        }
      }
    }
    if (pass >= 4) break;
    if (pass == 0) { __syncthreads(); fast = (meta[192] == 0u); pass = fast ? 5 : 1; } else pass++;
  }
  __syncthreads();
  if (fast) {
    unsigned* wh = hist + wave * 256;
#pragma unroll 1
    for (int j = 0; j < 8; j++) {
      const int qq = wave * 8 + j;
      const int c = min((int)meta[128 + qq], CAP_);
      unsigned ck[32];
#pragma unroll
      for (int e = 0; e < 32; e++) ck[e] = (e * 64 + lane < c) ? candK[qq * CAP_ + e * 64 + lane] : 0u;
      unsigned pref = meta[qq], k = meta[32 + qq];
#pragma unroll 1
      for (int ps = 1; ps < 4; ps++) {
        const int sh = 24 - 8 * ps;
        __syncthreads();
#pragma unroll
        for (int e = 0; e < 4; e++) wh[e * 64 + lane] = 0u;
        __syncthreads();
#pragma unroll
        for (int e = 0; e < 32; e++)
          if (e * 64 + lane < c && (ck[e] >> (sh + 8)) == pref) atomicAdd(&wh[(ck[e] >> sh) & 255u], 1u);
        __syncthreads();
        unsigned c4[4]; unsigned tot = 0;
#pragma unroll
        for (int e = 0; e < 4; e++) { c4[e] = wh[255 - 4 * lane - e]; tot += c4[e]; }
        unsigned incl = tot;
        for (int o = 1; o < 64; o <<= 1) { const unsigned t = __shfl_up(incl, o); if (lane >= o) incl += t; }
        unsigned run = incl - tot;
        unsigned found = 0xffffffffu, kn = 0;
#pragma unroll
        for (int e = 0; e < 4; e++) {
          if (run < k && run + c4[e] >= k) { found = (unsigned)(255 - 4 * lane - e); kn = k - run; }
          run += c4[e];
        }
        const unsigned long long bal = __ballot(found != 0xffffffffu);
        const int src = (bal != 0ull) ? (__ffsll((long long)bal) - 1) : 0;
        const unsigned dg = __shfl(found, src);
        k = __shfl(kn, src);
        pref = (pref << 8) | (dg & 255u);
      }
#pragma unroll
      for (int e = 0; e < 32; e++) {
        if (e * 64 + lane < c) {
          const unsigned key = ck[e];
          bool sel = key > pref;
          if (!sel && key == pref) sel = atomicAdd(&meta[96 + qq], 1u) < k;
          if (sel) { const unsigned pos = atomicAdd(&meta[64 + qq], 1u); if (pos < 256u) sidx[qq * 256 + pos] = candI[qq * CAP_ + e * 64 + lane]; }
        }
      }
    }
    __syncthreads();
  }
  float* myP = sP + wave * 1024;
  (void)sQ;
#pragma unroll 1
  for (int j = 0; j < 8; j++) {
    const int qq = wave * 8 + j;
    const int qpos = q0 + qq;
    const size_t tok = tokb + qpos;
    const int n = min((int)meta[64 + qq], 256);
    __syncthreads();
    bf16x8 qf[4];
#pragma unroll
    for (int ks = 0; ks < 4; ks++) {
      bf16x8 z = {0, 0, 0, 0, 0, 0, 0, 0};
      if (r < 4) z = *(const bf16x8*)(Qs + tok * 256 + r * 64 + ks * 16 + hh * 8);
      qf[ks] = z;
    }
#pragma unroll 4
    for (int kb = 0; kb < 8; kb++) {
      const int jj = kb * 32 + r;
      const int kidx = (jj < n) ? (int)sidx[qq * 256 + jj] : 0;
      const u16* kp = Ks + (tokb + kidx) * 64 + hh * 8;
      bf16x8 kf[4];
#pragma unroll
      for (int ks = 0; ks < 4; ks++) kf[ks] = *(const bf16x8*)(kp + ks * 16);
      f32x16 sacc = zero16();
#pragma unroll
      for (int ks = 0; ks < 4; ks++) sacc = MFMA32(kf[ks], qf[ks], sacc);
      if (r < 4) {
#pragma unroll
        for (int i = 0; i < 16; i++) myP[(kb * 32 + crow(i, hh)) * 4 + r] = sacc[i];
      }
    }
    __syncthreads();
    float sc[4][4];
#pragma unroll
    for (int rd = 0; rd < 4; rd++) {
      const int jj = rd * 64 + lane;
      const bool valid = jj < n;
      const int kidx = valid ? (int)sidx[qq * 256 + jj] : 0;
      const int dist = min(max(qpos - kidx, 0), 128);
      const float4 d = *(const float4*)(myP + jj * 4);
      sc[rd][0] = valid ? d.x * 0.125f + sbias[0 * 129 + dist] : -INFINITY;
      sc[rd][1] = valid ? d.y * 0.125f + sbias[1 * 129 + dist] : -INFINITY;
      sc[rd][2] = valid ? d.z * 0.125f + sbias[2 * 129 + dist] : -INFINITY;
      sc[rd][3] = valid ? d.w * 0.125f + sbias[3 * 129 + dist] : -INFINITY;
    }
#pragma unroll
    for (int hd = 0; hd < 4; hd++) {
      float mx = fmaxf(fmaxf(sc[0][hd], sc[1][hd]), fmaxf(sc[2][hd], sc[3][hd]));
      mx = wave_max(mx);
      float sm = 0.f;
#pragma unroll
      for (int rd = 0; rd < 4; rd++) { sc[rd][hd] = __expf(sc[rd][hd] - mx); sm += sc[rd][hd]; }
      sm = wave_sum(sm);
      const float inv = 1.f / sm;
#pragma unroll
      for (int rd = 0; rd < 4; rd++) sc[rd][hd] *= inv;
    }
#pragma unroll
    for (int rd = 0; rd < 4; rd++) *(float4*)(myP + (rd * 64 + lane) * 4) = make_float4(sc[rd][0], sc[rd][1], sc[rd][2], sc[rd][3]);
    __syncthreads();
    const int g = lane >> 3, c8 = lane & 7;
    float acc[32];
#pragma unroll
    for (int i = 0; i < 32; i++) acc[i] = 0.f;
#pragma unroll 16
    for (int it = 0; it < 32; it++) {
      const int jj = it * 8 + g;
      const int kidx = (jj < n) ? (int)sidx[qq * 256 + jj] : 0;
      const float4 pj = *(const float4*)(myP + jj * 4);
      const u32x4 vv = *(const u32x4*)(Vs + (tokb + kidx) * 64 + c8 * 8);
      const float vf[8] = {bf2f((u16)(vv.x & 0xffff)), bf2f((u16)(vv.x >> 16)), bf2f((u16)(vv.y & 0xffff)), bf2f((u16)(vv.y >> 16)),
                           bf2f((u16)(vv.z & 0xffff)), bf2f((u16)(vv.z >> 16)), bf2f((u16)(vv.w & 0xffff)), bf2f((u16)(vv.w >> 16))};
#pragma unroll
      for (int e = 0; e < 8; e++) {
        acc[0 * 8 + e] += pj.x * vf[e]; acc[1 * 8 + e] += pj.y * vf[e];
        acc[2 * 8 + e] += pj.z * vf[e]; acc[3 * 8 + e] += pj.w * vf[e];
      }
    }
    const bool b5 = lane & 32, b4 = lane & 16, b3 = lane & 8;
    float w16[16], w8[8], w4[4];
#pragma unroll
    for (int i = 0; i < 16; i++) { const float snd = b5 ? acc[i] : acc[i + 16]; const float rcv = __shfl_xor(snd, 32); w16[i] = (b5 ? acc[i + 16] : acc[i]) + rcv; }
#pragma unroll
    for (int i = 0; i < 8; i++) { const float snd = b4 ? w16[i] : w16[i + 8]; const float rcv = __shfl_xor(snd, 16); w8[i] = (b4 ? w16[i + 8] : w16[i]) + rcv; }
#pragma unroll
    for (int i = 0; i < 4; i++) { const float snd = b3 ? w8[i] : w8[i + 4]; const float rcv = __shfl_xor(snd, 8); w4[i] = (b3 ? w8[i + 4] : w8[i]) + rcv; }
    const int hd = (b5 ? 2 : 0) + (b4 ? 1 : 0);
    *(uint2*)(CC + tok * 1024 + 768 + hd * 64 + c8 * 8 + (b3 ? 4 : 0)) = make_uint2(pack2(w4[0], w4[1]), pack2(w4[2], w4[3]));
  }
}

DI void phase_mix1(const Params& P, int layer, int bid, int nb, char* smem) {
  char* mb = WS(P) + OFF_H;
  for (int w = bid * 4 + (tidx() >> 6); w < 2048; w += nb * 4) ssm_scan<false>(P, layer, w, mb);
  for (int j = 0;; j++) {
    const int idx = (j & 1) ? (j * nb + (nb - 1 - bid)) : (j * nb + bid);
    if (j * nb >= 2048) break;
    if (idx >= 2048) continue;
    const int qt = 255 - (idx >> 3), b = idx & 7;
    dsa_item(P, layer, b, qt, mb, smem);
  }
  for (int j = 0;; j++) {
    const int idx = (j & 1) ? (j * nb + (nb - 1 - bid)) : (j * nb + bid);
    if (j * nb >= 2048) break;
    if (idx >= 2048) continue;
    const int qt = 63 - (idx >> 5), bh = idx & 31;
    da_item(P, layer, bh >> 2, bh & 3, qt, mb, smem);
  }
}

DI void phase_mix2(const Params& P, int layer, int bid, int nb, char* smem) {
  char* mb = WS(P) + OFF_H;
  for (int w = bid * 4 + (tidx() >> 6); w < 2048; w += nb * 4) ssm_scan<true>(P, layer, w, mb);
}

DI void run_phase(const Params& P, int ph, int bid, int nb, char* smem) {
  char* ws = WS(P);
  u16* sm = (u16*)smem;
  if (ph == 0) { phase_prep(P, bid, nb, smem); return; }
  const int l = (ph - 1) / 12, s = (ph - 1) % 12;
  u16* Xb = (u16*)(ws + OFF_XB);
  u16* H = (u16*)(ws + OFF_H);
  u16* CC = (u16*)(ws + OFF_CC);
  float* X = OUTP(P);
  switch (s) {
    case 0: phase_ffn_up(Xb, (const u16*)(ws + OFF_WGU1 + l * SZ_WGU), H, bid, nb, sm); break;
    case 1: phase_ffn_down(H, (const u16*)(ws + OFF_WD1 + l * SZ_WD), (l == 0) ? INP(P, 0) : (const float*)X, X, nullptr, bid, nb, sm); break;
    case 2: phase_ln(X, Xb, INP(P, 6) + l * 1024, INP(P, 7) + l * 1024, bid, nb); break;
    case 3: phase_w_in(Xb, (const u16*)(ws + OFF_WIN + l * SZ_WIN), ws + OFF_H, bid, nb, sm); break;
    case 4: phase_mix1(P, l, bid, nb, smem); break;
    case 5: phase_mix2(P, l, bid, nb, smem); break;
    case 6: phase_glu((const u16*)(ws + OFF_H + M_YG), (const u16*)(ws + OFF_WGLU + l * SZ_WGLU), CC, bid, nb, sm); break;
    case 7: phase_w_o(CC, (const u16*)(ws + OFF_WO + l * SZ_WO), X, bid, nb, sm); break;
    case 8: phase_ln(X, Xb, INP(P, 24) + l * 1024, INP(P, 25) + l * 1024, bid, nb); break;
    case 9:
      phase_ffn_up(Xb, (const u16*)(ws + OFF_WGU2 + l * SZ_WGU), H, bid, nb, sm);
      phase_ple(Xb, (const u16*)(ws + OFF_WPG + l * SZ_WPG), (const u16*)(ws + OFF_PB) + (size_t)l * T_ * 256, (const u16*)(ws + OFF_WPP + l * SZ_WPP), CC, bid, nb, sm);
      break;
    case 10: phase_ffn_down(H, (const u16*)(ws + OFF_WD2 + l * SZ_WD), X, X, CC, bid, nb, sm); break;
    case 11: phase_ln(X, Xb, INP(P, 31) + l * 1024, INP(P, 32) + l * 1024, bid, nb); break;
  }
}

constexpr int NPHASES = 25;

__global__ void __launch_bounds__(256, 2) mega(Params P, int ph0, int ph1) {
  extern __shared__ __attribute__((aligned(16))) char smem[];
  cg::grid_group grid = cg::this_grid();
  const int bid = blockIdx.x, nb = gridDim.x;
#ifndef DUP_MASK
#define DUP_MASK 0
#endif
#define PHASE(k) if (ph0 <= (k) && (k) < ph1) { \
    if ((k) > 0 && ((DUP_MASK >> (((k) - 1) % 12)) & 1)) { run_phase(P, (k), bid, nb, smem); grid.sync(); } \
    run_phase(P, (k), bid, nb, smem); if ((k) + 1 < ph1) grid.sync(); }
  PHASE(0) PHASE(1) PHASE(2) PHASE(3) PHASE(4) PHASE(5) PHASE(6) PHASE(7) PHASE(8) PHASE(9) PHASE(10) PHASE(11) PHASE(12)
  PHASE(13) PHASE(14) PHASE(15) PHASE(16) PHASE(17) PHASE(18) PHASE(19) PHASE(20) PHASE(21) PHASE(22) PHASE(23) PHASE(24)
#undef PHASE
}

extern "C" void kernel_launch(void* const* d_in, const int* in_sizes, int n_in, void* d_out, int out_size, void* d_ws, size_t ws_size, hipStream_t stream) {
  static int grid_blocks = 0;
  if (grid_blocks == 0) {
    if (n_in != 33 || ws_size < WS_END) { fprintf(stderr, "kernel_launch: need 33 inputs and %zu bytes of ws (got %d, %zu)\n", (size_t)WS_END, n_in, ws_size); grid_blocks = -1; return; }
    int dev = 0, cus = 0, per_cu = 0;
    (void)hipGetDevice(&dev);
    (void)hipDeviceGetAttribute(&cus, hipDeviceAttributeMultiprocessorCount, dev);
    (void)hipFuncSetAttribute((const void*)mega, hipFuncAttributeMaxDynamicSharedMemorySize, LDS_BYTES);
    (void)hipOccupancyMaxActiveBlocksPerMultiprocessor(&per_cu, (const void*)mega, 256, LDS_BYTES);
    if (per_cu < 1) per_cu = 1;
    if (per_cu > 2) per_cu = 2;
    grid_blocks = cus * per_cu;
    fprintf(stderr, "kernel_launch: cus %d per_cu %d grid %d\n", cus, per_cu, grid_blocks);
  }
  if (grid_blocks < 0) return;
  Params p;
  memset(&p, 0, sizeof(p));
  for (int i = 0; i < 33; i++) p.in[i] = (const float*)d_in[i];
  p.out = (float*)d_out;
  p.ws = (char*)d_ws;
#if MULTI_LAUNCH
  for (int ph = 0; ph < NPHASES; ph++) {
    hipLaunchKernelGGL(mega, dim3(grid_blocks), dim3(256), LDS_BYTES, stream, p, ph, ph + 1);
  }
#else
  int ph0 = 0, ph1 = NPHASES;
  void* args[] = {&p, &ph0, &ph1};
  hipError_t e = hipLaunchCooperativeKernel((const void*)mega, dim3(grid_blocks), dim3(256), args, LDS_BYTES, stream);
  if (e != hipSuccess) fprintf(stderr, "cooperative launch failed: %s (grid %d)\n", hipGetErrorString(e), grid_blocks);
#endif
}
```

```cpp
#include <hip/hip_runtime.h>
#include <hip/hip_cooperative_groups.h>
#include <stdint.h>
#include <math.h>
#include <stdio.h>
#include <string.h>
namespace cg = cooperative_groups;

#ifndef MULTI_LAUNCH
#define MULTI_LAUNCH 0
#endif

typedef unsigned short u16;
typedef __attribute__((ext_vector_type(8))) short bf16x8;
typedef __attribute__((ext_vector_type(4))) short s16x4;
typedef __attribute__((ext_vector_type(16))) float f32x16;
typedef __attribute__((ext_vector_type(4))) unsigned u32x4;
typedef __attribute__((ext_vector_type(2))) unsigned u32x2;

#define DI __device__ __forceinline__
#define MFMA32(a, b, c) __builtin_amdgcn_mfma_f32_32x32x16_bf16((a), (b), (c), 0, 0, 0)

constexpr int T_ = 65536;
constexpr int L_ = 8192;
constexpr int D_ = 1024;
constexpr int FF_ = 2816;
constexpr float ALPHA_ = 1.41421356237309515f;
constexpr float LN_EPS_ = 1e-5f;
constexpr float LOG2E_ = 1.44269504088896341f;
constexpr int LDS_BYTES = 73728;

constexpr size_t SZ_WGU = (size_t)5632 * 1024 * 2;
constexpr size_t SZ_WD = (size_t)1024 * 2816 * 2;
constexpr size_t SZ_WIN = (size_t)2560 * 1024 * 2;
constexpr size_t SZ_WO = (size_t)1024 * 1024 * 2;
constexpr size_t SZ_WGLU = (size_t)256 * 256 * 2;
constexpr size_t SZ_WPG = (size_t)1024 * 1024 * 2;
constexpr size_t SZ_WPP = (size_t)1024 * 256 * 2;
constexpr size_t OFF_WGU1 = 0;
constexpr size_t OFF_WD1 = OFF_WGU1 + 2 * SZ_WGU;
constexpr size_t OFF_WGU2 = OFF_WD1 + 2 * SZ_WD;
constexpr size_t OFF_WD2 = OFF_WGU2 + 2 * SZ_WGU;
constexpr size_t OFF_WIN = OFF_WD2 + 2 * SZ_WD;
constexpr size_t OFF_WO = OFF_WIN + 2 * SZ_WIN;
constexpr size_t OFF_WGLU = OFF_WO + 2 * SZ_WO;
constexpr size_t OFF_WPG = OFF_WGLU + 2 * SZ_WGLU;
constexpr size_t OFF_WPP = OFF_WPG + 2 * SZ_WPG;
constexpr size_t OFF_COEFA = OFF_WPP + 2 * SZ_WPP;
constexpr size_t OFF_COEFB = OFF_COEFA + 2 * 16 * 64 * 16;
constexpr size_t OFF_LAM = OFF_COEFB + 2 * 16 * 64 * 16 * 8;
constexpr size_t OFF_BIAS = OFF_LAM + 256;
constexpr size_t OFF_XB = OFF_BIAS + 8 * 129 * 4 + 32;
constexpr size_t OFF_PB = OFF_XB + (size_t)T_ * 1024 * 2;
constexpr size_t OFF_H = OFF_PB + (size_t)2 * T_ * 256 * 2;
constexpr size_t SZ_H = (size_t)384 << 20;
constexpr size_t OFF_CC = OFF_H + SZ_H;
constexpr size_t OFF_CANDK = OFF_CC + (size_t)T_ * 1024 * 2;
constexpr int CAP_ = 2048;
constexpr size_t OFF_CANDI = OFF_CANDK + (size_t)512 * 32 * CAP_ * 4;
constexpr size_t WS_END = OFF_CANDI + (size_t)512 * 32 * CAP_ * 2;
constexpr size_t MB_ = (size_t)1 << 20;
constexpr size_t M_QD = 0, M_KD = 64 * MB_, M_VT = 128 * MB_, M_U = 192 * MB_, M_QS = 256 * MB_, M_QI = 288 * MB_, M_YG = 320 * MB_,
                 M_KS = 352 * MB_, M_VS = 360 * MB_, M_KI = 368 * MB_, M_WI = 372 * MB_, M_SEND = 374 * MB_;

struct Params {
  const float* in[33];
  float* out;
  char* ws;
};

DI int tidx() { int t = threadIdx.x; asm volatile("" : "+v"(t)); return t; }
#define GAS __attribute__((address_space(1)))
DI size_t opaque0() { size_t z = 0; asm volatile("" : "+s"(z)); return z; }
DI char* WS(const Params& P) { return P.ws + opaque0(); }
DI float* OUTP(const Params& P) { return P.out + opaque0(); }
DI const float* INP(const Params& P, int i) { return P.in[i]; }
typedef __bf16 bf16v2_ __attribute__((ext_vector_type(2)));
typedef float f32v2_ __attribute__((ext_vector_type(2)));
DI u16 f2bf(float x) { const __bf16 h = (__bf16)x; return __builtin_bit_cast(u16, h); }
DI float bf2f(u16 v) { return __uint_as_float(((unsigned)v) << 16); }
DI unsigned pack2(float a, float b) { f32v2_ v; v.x = a; v.y = b; const bf16v2_ h = __builtin_convertvector(v, bf16v2_); return __builtin_bit_cast(unsigned, h); }
DI int crow(int i, int hh) { return (i & 3) + 8 * (i >> 2) + 4 * hh; }
DI float sigmoidf_(float x) { return __builtin_amdgcn_rcpf(1.f + __expf(-x)); }
DI float wave_sum(float v) { for (int o = 32; o > 0; o >>= 1) v += __shfl_xor(v, o); return v; }
DI float wave_max(float v) { for (int o = 32; o > 0; o >>= 1) v = fmaxf(v, __shfl_xor(v, o)); return v; }
DI f32x16 zero16() { f32x16 z; for (int i = 0; i < 16; i++) z[i] = 0.f; return z; }
DI bf16x8 pack8(const f32x16& x, int s) {
  union { unsigned u[4]; bf16x8 v; } t;
  t.u[0] = pack2(x[8 * s + 0], x[8 * s + 1]); t.u[1] = pack2(x[8 * s + 2], x[8 * s + 3]);
  t.u[2] = pack2(x[8 * s + 4], x[8 * s + 5]); t.u[3] = pack2(x[8 * s + 6], x[8 * s + 7]);
  return t.v;
}

constexpr int GS_ = 72;
constexpr int GT_ = 128 * GS_;

struct GemmPre { u32x4 a0[4], b0[4], a1[4], b1[4]; };
#define G_LOAD(RA, RB, T) _Pragma("unroll") for (int i = 0; i < 4; i++) { RA[i] = *(const u32x4*)(Ap + (size_t)i * 32 * lda + (T) * 64); RB[i] = *(const u32x4*)(Bp + (size_t)i * 32 * ldb + (T) * 64); }
DI void gemm_prefetch(GemmPre& R, const u16* __restrict__ A, int lda, const u16* __restrict__ B, int ldb) {
  const int tid = tidx();
  const int srow = tid >> 3, sk = (tid & 7) * 8;
  const u16* Ap = A + (size_t)srow * lda + sk;
  const u16* Bp = B + (size_t)srow * ldb + sk;
  G_LOAD(R.a0, R.b0, 0)
  G_LOAD(R.a1, R.b1, 1)
}
DI void gemm_main(f32x16 (&acc)[2][2], GemmPre& R, const u16* __restrict__ A, int lda, const u16* __restrict__ B, int ldb, int K, u16* sm) {
  const int tid = tidx(), lane = tid & 63, wave = tid >> 6;
  const int wm = wave >> 1, wn = wave & 1, r = lane & 31, hh = lane >> 5;
  const int srow = tid >> 3, sk = (tid & 7) * 8;
  const u16* Ap = A + (size_t)srow * lda + sk;
  const u16* Bp = B + (size_t)srow * ldb + sk;
#define G_STORE(RA, RB, BUF) { u16* d_ = sm + (BUF) * 2 * GT_; _Pragma("unroll") for (int i = 0; i < 4; i++) { *(u32x4*)(d_ + (srow + i * 32) * GS_ + sk) = RA[i]; *(u32x4*)(d_ + GT_ + (srow + i * 32) * GS_ + sk) = RB[i]; } }
#define G_COMPUTE(BUF) { const u16* sA = sm + (BUF) * 2 * GT_; const u16* sB = sA + GT_; \
    _Pragma("unroll") for (int ks = 0; ks < 4; ks++) { \
      const bf16x8 fa0 = *(const bf16x8*)(sA + (wm * 64 + r) * GS_ + ks * 16 + hh * 8); \
      const bf16x8 fa1 = *(const bf16x8*)(sA + (wm * 64 + 32 + r) * GS_ + ks * 16 + hh * 8); \
      const bf16x8 fb0 = *(const bf16x8*)(sB + (wn * 64 + r) * GS_ + ks * 16 + hh * 8); \
      const bf16x8 fb1 = *(const bf16x8*)(sB + (wn * 64 + 32 + r) * GS_ + ks * 16 + hh * 8); \
      acc[0][0] = MFMA32(fa0, fb0, acc[0][0]); acc[0][1] = MFMA32(fa0, fb1, acc[0][1]); \
      acc[1][0] = MFMA32(fa1, fb0, acc[1][0]); acc[1][1] = MFMA32(fa1, fb1, acc[1][1]); } }
  const int nk = K >> 6;
  __syncthreads();
  G_STORE(R.a0, R.b0, 0)
  G_LOAD(R.a0, R.b0, 2)
  __syncthreads();
  int kt = 0;
#pragma unroll 1
  for (; kt + 4 < nk; kt += 2) {
    G_COMPUTE(0)
    G_STORE(R.a1, R.b1, 1)
    __syncthreads();
    G_LOAD(R.a1, R.b1, kt + 3)
    G_COMPUTE(1)
    G_STORE(R.a0, R.b0, 0)
    __syncthreads();
    G_LOAD(R.a0, R.b0, kt + 4)
  }
  G_COMPUTE(0)
  G_STORE(R.a1, R.b1, 1)
  __syncthreads();
  G_LOAD(R.a1, R.b1, kt + 3)
  G_COMPUTE(1)
  G_STORE(R.a0, R.b0, 0)
  __syncthreads();
  G_COMPUTE(0)
  G_STORE(R.a1, R.b1, 1)
  __syncthreads();
  G_COMPUTE(1)
#undef G_STORE
#undef G_COMPUTE
}
#undef G_LOAD

DI bool tile_at(int it, int bid, int nb, int TM, int TN, int& tm, int& tn) {
  if ((nb & 7) == 0 && (TM & 63) == 0) {
    const int xcd = bid & 7, lw = bid >> 3, nlw = nb >> 3;
    const int lt = lw + it * nlw, per = (TM >> 3) * TN;
    if (lt >= per) return false;
    const int g = lt / (8 * TN), rem = lt - g * 8 * TN;
    tn = rem >> 3; tm = xcd * (TM >> 3) + g * 8 + (rem & 7);
    return true;
  } else {
    const int t = bid + it * nb;
    if (t >= TM * TN) return false;
    tn = t / TM; tm = t - tn * TM;
    return true;
  }
}

template <class AF, class BF, class EPI>
DI void gemm_phase(int TM, int TN, int K, int lda, int ldb, AF a_of, BF b_of, EPI epi, int bid, int nb, u16* sm) {
  GemmPre R;
  int tm, tn;
  bool have = tile_at(0, bid, nb, TM, TN, tm, tn);
  if (have) gemm_prefetch(R, a_of(tm), lda, b_of(tn), ldb);
  for (int it = 0; have; it++) {
    f32x16 acc[2][2] = {{zero16(), zero16()}, {zero16(), zero16()}};
    gemm_main(acc, R, a_of(tm), lda, b_of(tn), ldb, K, sm);
    int tm2 = 0, tn2 = 0;
    const bool have2 = tile_at(it + 1, bid, nb, TM, TN, tm2, tn2);
    if (have2) gemm_prefetch(R, a_of(tm2), lda, b_of(tn2), ldb);
    epi(acc, tm, tn);
    have = have2; tm = tm2; tn = tn2;
  }
}

DI void transpose_job(const float* __restrict__ src, int K, int N, u16* __restrict__ dst, int mode, int bid, int nb, float* tile) {
  const int tid = tidx();
  const int tk = K >> 6, tn = (N + 63) >> 6;
  for (int t = bid; t < tk * tn; t += nb) {
    const int k0 = (t % tk) * 64, n0 = (t / tk) * 64;
    __syncthreads();
#pragma unroll 4
    for (int i = 0; i < 16; i++) {
      const int k = i * 4 + (tid >> 6), n = tid & 63;
      tile[k * 65 + n] = (n0 + n < N) ? src[(size_t)(k0 + k) * N + n0 + n] : 0.f;
    }
    __syncthreads();
#pragma unroll 4
    for (int i = 0; i < 16; i++) {
      const int n = i * 4 + (tid >> 6), k = tid & 63;
      const int ng = n0 + n;
      if (ng < N) {
        int row = ng;
        if (mode == 1) row = (ng >> 5) * 64 + (ng & 31);
        else if (mode == 2) row = (ng >> 5) * 64 + 32 + (ng & 31);
        dst[(size_t)row * K + k0 + k] = f2bf(tile[k * 65 + n]);
      }
    }
  }
}

DI void phase_prep(const Params& P, int bid, int nb, char* smem) {
  float* tile = (float*)smem;
  char* ws = WS(P);
  for (int l = 0; l < 2; l++) {
    transpose_job(INP(P, 3) + (size_t)l * 1024 * FF_, 1024, FF_, (u16*)(ws + OFF_WGU1 + l * SZ_WGU), 1, bid, nb, tile);
    transpose_job(INP(P, 4) + (size_t)l * 1024 * FF_, 1024, FF_, (u16*)(ws + OFF_WGU1 + l * SZ_WGU), 2, bid, nb, tile);
    transpose_job(INP(P, 5) + (size_t)l * FF_ * 1024, FF_, 1024, (u16*)(ws + OFF_WD1 + l * SZ_WD), 0, bid, nb, tile);
    transpose_job(INP(P, 26) + (size_t)l * 1024 * FF_, 1024, FF_, (u16*)(ws + OFF_WGU2 + l * SZ_WGU), 1, bid, nb, tile);
    transpose_job(INP(P, 27) + (size_t)l * 1024 * FF_, 1024, FF_, (u16*)(ws + OFF_WGU2 + l * SZ_WGU), 2, bid, nb, tile);
    transpose_job(INP(P, 28) + (size_t)l * FF_ * 1024, FF_, 1024, (u16*)(ws + OFF_WD2 + l * SZ_WD), 0, bid, nb, tile);
    transpose_job(INP(P, 8) + (size_t)l * 1024 * 2472, 1024, 2472, (u16*)(ws + OFF_WIN + l * SZ_WIN), 0, bid, nb, tile);
    transpose_job(INP(P, 9) + (size_t)l * 1024 * 1024, 1024, 1024, (u16*)(ws + OFF_WO + l * SZ_WO), 0, bid, nb, tile);
    transpose_job(INP(P, 23) + (size_t)l * 256 * 256, 256, 256, (u16*)(ws + OFF_WGLU + l * SZ_WGLU), 0, bid, nb, tile);
    transpose_job(INP(P, 30) + (size_t)l * 1024 * 1024, 1024, 1024, (u16*)(ws + OFF_WPG + l * SZ_WPG), 0, bid, nb, tile);
    transpose_job(INP(P, 29) + (size_t)l * 256 * 1024, 256, 1024, (u16*)(ws + OFF_WPP + l * SZ_WPP), 0, bid, nb, tile);
    u16* win = (u16*)(ws + OFF_WIN + l * SZ_WIN);
    for (int i = bid * 256 + tidx(); i < 88 * 1024; i += nb * 256) win[(size_t)2472 * 1024 + i] = 0;
  }
  const size_t gt = (size_t)bid * 256 + tidx(), gs = (size_t)nb * 256;
  {
    const float4* x4 = (const float4*)INP(P, 0);
    uint2* xb = (uint2*)(ws + OFF_XB);
    for (size_t i = gt; i < (size_t)T_ * 1024 / 4; i += gs) { float4 v = x4[i]; xb[i] = make_uint2(pack2(v.x, v.y), pack2(v.z, v.w)); }
    const float4* p4 = (const float4*)INP(P, 1);
    uint2* pb = (uint2*)(ws + OFF_PB);
    for (size_t i = gt; i < (size_t)2 * T_ * 256 / 4; i += gs) { float4 v = p4[i]; pb[i] = make_uint2(pack2(v.x, v.y), pack2(v.z, v.w)); }
  }
  if (gt < 2 * 16 * 64) {
    const int l = (int)gt >> 10, g = ((int)gt >> 6) & 15, p = (int)gt & 63;
    const int gi = (l * 16 + g) * 64 + p;
    const double lr = INP(P, 15)[gi], li = INP(P, 16)[gi];
    const double dt = exp((double)INP(P, 17)[l * 16 + g]);
    const double mag = exp(lr * dt);
    const double ar = mag * cos(li * dt), ai = mag * sin(li * dt);
    const double mag5 = exp(512.0 * lr * dt);
    const double a5r = mag5 * cos(512.0 * li * dt), a5i = mag5 * sin(512.0 * li * dt);
    ((float4*)(ws + OFF_COEFA))[gi] = make_float4((float)ar, (float)ai, (float)a5r, (float)a5i);
    const double den = lr * lr + li * li, nr = ar - 1.0, ni = ai;
    const double fr = (nr * lr + ni * li) / den, fi = (ni * lr - nr * li) / den;
    float2* cb = (float2*)(ws + OFF_COEFB) + (size_t)gi * 16;
    for (int c = 0; c < 16; c++) {
      const double br = INP(P, 18)[(size_t)gi * 16 + c], bi = INP(P, 19)[(size_t)gi * 16 + c];
      cb[c] = make_float2((float)(fr * br - fi * bi), (float)(fr * bi + fi * br));
    }
  }
  if (gt < 8 * 129) {
    const int hd = (int)gt / 129, n = (int)gt - hd * 129;
    int bk = n;
    if (n >= 16) { bk = 16 + (int)(log((double)n / 16.0) / log(8.0) * 16.0); bk = bk < 31 ? bk : 31; }
    ((float*)(ws + OFF_BIAS))[gt] = INP(P, 2)[bk * 8 + hd];
  }
  if (gt < 2) {
    const int l = (int)gt;
    float s1 = 0.f, s2 = 0.f;
    for (int i = 0; i < 64; i++) { s1 += INP(P, 10)[l * 64 + i] * INP(P, 11)[l * 64 + i]; s2 += INP(P, 12)[l * 64 + i] * INP(P, 13)[l * 64 + i]; }
    const float lam_init = 0.8f - 0.6f * expf(-0.3f * (float)l);
    ((float*)(ws + OFF_LAM))[l] = expf(s1) - expf(s2) + lam_init;
  }
}

DI void phase_ffn_up(const u16* __restrict__ Xb, const u16* __restrict__ Wgu, u16* __restrict__ H, int bid, int nb, u16* sm) {
  const int lane = tidx() & 63, wave = tidx() >> 6, wm = wave >> 1, wn = wave & 1, r = lane & 31, hh = lane >> 5;
  gemm_phase(512, 44, 1024, 1024, 1024,
    [&](int tm) { return Xb + (size_t)tm * 128 * 1024; }, [&](int tn) { return Wgu + (size_t)tn * 128 * 1024; },
    [&](f32x16 (&acc)[2][2], int tm, int tn) {
      const int j = tn * 64 + wn * 32 + r;
#pragma unroll
      for (int mi = 0; mi < 2; mi++)
#pragma unroll
        for (int i = 0; i < 16; i++) {
          const int row = tm * 128 + wm * 64 + mi * 32 + crow(i, hh);
          const float g = acc[mi][0][i], u = acc[mi][1][i];
          H[(size_t)row * FF_ + j] = f2bf(g * sigmoidf_(g) * u);
        }
    }, bid, nb, sm);
}

DI void phase_ffn_down(const u16* __restrict__ H, const u16* __restrict__ Wd, const float* xin, float* xout, const u16* __restrict__ ple, int bid, int nb, u16* sm) {
  const int lane = tidx() & 63, wave = tidx() >> 6, wm = wave >> 1, wn = wave & 1, r = lane & 31, hh = lane >> 5;
  gemm_phase(512, 8, FF_, FF_, FF_,
    [&](int tm) { return H + (size_t)tm * 128 * FF_; }, [&](int tn) { return Wd + (size_t)tn * 128 * FF_; },
    [&](f32x16 (&acc)[2][2], int tm, int tn) {
#pragma unroll
      for (int mi = 0; mi < 2; mi++)
#pragma unroll
        for (int ni = 0; ni < 2; ni++)
#pragma unroll
          for (int i = 0; i < 16; i++) {
            const size_t o = (size_t)(tm * 128 + wm * 64 + mi * 32 + crow(i, hh)) * 1024 + tn * 128 + wn * 64 + ni * 32 + r;
            float v = ALPHA_ * xin[o] + 0.5f * acc[mi][ni][i];
            if (ple) v += bf2f(ple[o]);
            xout[o] = v;
          }
    }, bid, nb, sm);
}

DI void phase_w_o(const u16* __restrict__ CC, const u16* __restrict__ Wo, float* x, int bid, int nb, u16* sm) {
  const int lane = tidx() & 63, wave = tidx() >> 6, wm = wave >> 1, wn = wave & 1, r = lane & 31, hh = lane >> 5;
  gemm_phase(512, 8, 1024, 1024, 1024,
    [&](int tm) { return CC + (size_t)tm * 128 * 1024; }, [&](int tn) { return Wo + (size_t)tn * 128 * 1024; },
    [&](f32x16 (&acc)[2][2], int tm, int tn) {
#pragma unroll
      for (int mi = 0; mi < 2; mi++)
#pragma unroll
        for (int ni = 0; ni < 2; ni++)
#pragma unroll
          for (int i = 0; i < 16; i++) {
            const size_t o = (size_t)(tm * 128 + wm * 64 + mi * 32 + crow(i, hh)) * 1024 + tn * 128 + wn * 64 + ni * 32 + r;
            x[o] = ALPHA_ * x[o] + acc[mi][ni][i];
          }
    }, bid, nb, sm);
}

DI void phase_glu(const u16* __restrict__ Yg, const u16* __restrict__ Wglu, u16* __restrict__ CC, int bid, int nb, u16* sm) {
  const int lane = tidx() & 63, wave = tidx() >> 6, wm = wave >> 1, wn = wave & 1, r = lane & 31, hh = lane >> 5;
  gemm_phase(512, 2, 256, 256, 256,
    [&](int tm) { return Yg + (size_t)tm * 128 * 256; }, [&](int tn) { return Wglu + (size_t)tn * 128 * 256; },
    [&](f32x16 (&acc)[2][2], int tm, int tn) {
#pragma unroll
      for (int mi = 0; mi < 2; mi++)
#pragma unroll
        for (int ni = 0; ni < 2; ni++)
#pragma unroll
          for (int i = 0; i < 16; i++) {
            const int row = tm * 128 + wm * 64 + mi * 32 + crow(i, hh), col = tn * 128 + wn * 64 + ni * 32 + r;
            const float y = bf2f(Yg[(size_t)row * 256 + col]);
            CC[(size_t)row * 1024 + 512 + col] = f2bf(y * sigmoidf_(acc[mi][ni][i]));
          }
    }, bid, nb, sm);
}

DI void phase_ple(const u16* __restrict__ Xb, const u16* __restrict__ Wpg, const u16* __restrict__ Pb, const u16* __restrict__ Wpp, u16* ple, int bid, int nb, u16* sm) {
  const int lane = tidx() & 63, wave = tidx() >> 6, wm = wave >> 1, wn = wave & 1, r = lane & 31, hh = lane >> 5;
  gemm_phase(512, 8, 1024, 1024, 1024,
    [&](int tm) { return Xb + (size_t)tm * 128 * 1024; }, [&](int tn) { return Wpg + (size_t)tn * 128 * 1024; },
    [&](f32x16 (&acc)[2][2], int tm, int tn) {
#pragma unroll
      for (int mi = 0; mi < 2; mi++)
#pragma unroll
        for (int ni = 0; ni < 2; ni++)
#pragma unroll
          for (int i = 0; i < 16; i++) {
            const size_t o = (size_t)(tm * 128 + wm * 64 + mi * 32 + crow(i, hh)) * 1024 + tn * 128 + wn * 64 + ni * 32 + r;
            ple[o] = f2bf(sigmoidf_(acc[mi][ni][i]));
          }
    }, bid, nb, sm);
  gemm_phase(512, 8, 256, 256, 256,
    [&](int tm) { return Pb + (size_t)tm * 128 * 256; }, [&](int tn) { return Wpp + (size_t)tn * 128 * 256; },
    [&](f32x16 (&acc)[2][2], int tm, int tn) {
#pragma unroll
      for (int mi = 0; mi < 2; mi++)
#pragma unroll
        for (int ni = 0; ni < 2; ni++)
#pragma unroll
          for (int i = 0; i < 16; i++) {
            const size_t o = (size_t)(tm * 128 + wm * 64 + mi * 32 + crow(i, hh)) * 1024 + tn * 128 + wn * 64 + ni * 32 + r;
            ple[o] = f2bf(acc[mi][ni][i] * bf2f(ple[o]));
          }
    }, bid, nb, sm);
}

DI void phase_w_in(const u16* __restrict__ Xb, const u16* __restrict__ Win, char* mb, int bid, int nb, u16* sm) {
  const int lane = tidx() & 63, wave = tidx() >> 6, wm = wave >> 1, wn = wave & 1, r = lane & 31, hh = lane >> 5;
  u16* Qd = (u16*)(mb + M_QD); u16* Kd = (u16*)(mb + M_KD); u16* Vt = (u16*)(mb + M_VT); float* U = (float*)(mb + M_U);
  u16* Qs = (u16*)(mb + M_QS); u16* Qi = (u16*)(mb + M_QI); u16* Ks = (u16*)(mb + M_KS); u16* Vs = (u16*)(mb + M_VS);
  u16* Ki = (u16*)(mb + M_KI); float* Wi = (float*)(mb + M_WI);
  gemm_phase(512, 20, 1024, 1024, 1024,
    [&](int tm) { return Xb + (size_t)tm * 128 * 1024; }, [&](int tn) { return Win + (size_t)tn * 128 * 1024; },
    [&](f32x16 (&acc)[2][2], int tm, int tn) {
#pragma unroll
    for (int ni = 0; ni < 2; ni++) {
      const int c0 = tn * 128 + wn * 64 + ni * 32;
      const int c = c0 + r;
#pragma unroll
      for (int mi = 0; mi < 2; mi++) {
        const int rowb = tm * 128 + wm * 64 + mi * 32;
        if (c0 >= 1024 && c0 < 1536) {
          const int cc = c - 1024, head = cc >> 7, dv = cc & 127;
          const int b = rowb >> 13, t0 = rowb & 8191;
#pragma unroll
          for (int g4 = 0; g4 < 4; g4++) {
            uint2 v = make_uint2(pack2(acc[mi][ni][4 * g4], acc[mi][ni][4 * g4 + 1]), pack2(acc[mi][ni][4 * g4 + 2], acc[mi][ni][4 * g4 + 3]));
            const int tt = t0 + 8 * g4 + 4 * hh;
            *(uint2*)(Vt + ((size_t)(((b * 4 + head) * 128 + (tt >> 6)) * 128 + dv)) * 64 + (tt & 63)) = v;
          }
        } else {
#pragma unroll
          for (int i = 0; i < 16; i++) {
            const size_t row = rowb + crow(i, hh);
            const float v = acc[mi][ni][i];
            if (c0 < 512) Qd[row * 512 + c] = f2bf(v);
            else if (c0 < 1024) {
              const int cc = c - 512;
              Kd[((size_t)((((int)(row >> 13) * 4 + (cc >> 7)) * 2 + ((cc >> 6) & 1))) * L_ + (row & 8191)) * 64 + (cc & 63)] = f2bf(v);
            }
            else if (c0 < 1792) U[row * 256 + (c - 1536)] = v;
            else if (c0 < 2048) Qs[row * 256 + (c - 1792)] = f2bf(v);
            else if (c0 < 2112) Ks[row * 64 + (c - 2048)] = f2bf(v);
            else if (c0 < 2176) Vs[row * 64 + (c - 2112)] = f2bf(v);
            else if (c0 < 2432) Qi[row * 256 + (c - 2176)] = f2bf(v);
            else if (c0 < 2464) Ki[row * 32 + (c - 2432)] = f2bf(v);
            else if (c0 == 2464) { if (r < 8) Wi[row * 8 + r] = v * 0.0625f; }
          }
        }
      }
    }
  }, bid, nb, sm);
}

DI void phase_ln(float* x, u16* __restrict__ xb, const float* __restrict__ g, const float* __restrict__ bta, int bid, int nb) {
  const int lane = tidx() & 63, wave = tidx() >> 6;
  float4 gg[4], bb[4];
#pragma unroll
  for (int i = 0; i < 4; i++) { gg[i] = *(const float4*)(g + i * 256 + lane * 4); bb[i] = *(const float4*)(bta + i * 256 + lane * 4); }
  for (int row = bid * 4 + wave; row < T_; row += nb * 4) {
    float4 v[4];
#pragma unroll
    for (int i = 0; i < 4; i++) v[i] = *(const float4*)(x + (size_t)row * 1024 + i * 256 + lane * 4);
    float s = 0.f;
#pragma unroll
    for (int i = 0; i < 4; i++) s += v[i].x + v[i].y + v[i].z + v[i].w;
    const float mu = wave_sum(s) * (1.f / 1024.f);
    float q = 0.f;
#pragma unroll
    for (int i = 0; i < 4; i++) { v[i].x -= mu; v[i].y -= mu; v[i].z -= mu; v[i].w -= mu; q += v[i].x * v[i].x + v[i].y * v[i].y + v[i].z * v[i].z + v[i].w * v[i].w; }
    const float rs = rsqrtf(wave_sum(q) * (1.f / 1024.f) + LN_EPS_);
#pragma unroll
    for (int i = 0; i < 4; i++) {
      float4 o;
      o.x = v[i].x * rs * gg[i].x + bb[i].x; o.y = v[i].y * rs * gg[i].y + bb[i].y;
      o.z = v[i].z * rs * gg[i].z + bb[i].z; o.w = v[i].w * rs * gg[i].w + bb[i].w;
      *(float4*)(x + (size_t)row * 1024 + i * 256 + lane * 4) = o;
      *(uint2*)(xb + (size_t)row * 1024 + i * 256 + lane * 4) = make_uint2(pack2(o.x, o.y), pack2(o.z, o.w));
    }
  }
}

DI float gelu_tanh(float x) { const float u = 0.7978845608028654f * (x + 0.044715f * x * x * x); return 0.5f * x * (1.f + tanhf(u)); }

template <bool OUT>
DI void ssm_scan(const Params& P, int layer, int widx, char* mb) {
  const int lane = tidx() & 63;
  const int b = widx >> 8, g = (widx >> 4) & 15, ch = widx & 15;
  const int gi = (layer * 16 + g) * 64 + lane;
  const float4 ca = ((const float4*)(WS(P) + OFF_COEFA))[gi];
  const float2* cbp = (const float2*)(WS(P) + OFF_COEFB) + (size_t)gi * 16;
  float bre[16], bim[16];
#pragma unroll
  for (int c = 0; c < 16; c++) { float2 t = cbp[c]; bre[c] = t.x; bim[c] = t.y; }
  const float* U = (const float*)(mb + M_U);
  float2* Send = (float2*)(mb + M_SEND);
  const size_t sbase = (size_t)((b * 16 + g) * 16) * 64 + lane;
  float xr = 0.f, xi = 0.f;
  float cre[16], cim[16];
  float dsk = 0.f;
  int mych = 0;
  if (OUT) {
    for (int j = 0; j < ch; j++) {
      const float2 e = Send[sbase + (size_t)j * 64];
      const float nr = ca.z * xr - ca.w * xi + e.x, ni = ca.z * xi + ca.w * xr + e.y;
      xr = nr; xi = ni;
    }
#pragma unroll
    for (int c = 0; c < 16; c++) {
      cre[c] = INP(P, 20)[((size_t)(layer * 16 + g) * 16 + c) * 64 + lane];
      cim[c] = INP(P, 21)[((size_t)(layer * 16 + g) * 16 + c) * 64 + lane];
    }
    mych = ((lane >> 5) & 1) * 8 + ((lane >> 4) & 1) * 4 + ((lane >> 3) & 1) * 2 + ((lane >> 2) & 1);
    dsk = INP(P, 22)[layer * 256 + g * 16 + mych];
  }
  u16* Yg = (u16*)(mb + M_YG);
  const size_t tok0 = (size_t)b * L_ + ch * 512;
  const float* ub = U + (tok0 + (lane >> 2)) * 256 + g * 16 + (lane & 3) * 4;
  float4 cur = *(const float4*)ub;
#pragma unroll 1
  for (int blk = 0; blk < 32; blk++) {
    const float4 nxt = *(const float4*)(ub + (size_t)min(blk + 1, 31) * 16 * 256);
#pragma unroll
  for (int s16 = 0; s16 < 16; s16++) {
    const int t = blk * 16 + s16;
    float uu[16];
#pragma unroll
    for (int c = 0; c < 16; c++) {
      const float comp = ((c & 3) == 0) ? cur.x : ((c & 3) == 1) ? cur.y : ((c & 3) == 2) ? cur.z : cur.w;
      uu[c] = __int_as_float(__builtin_amdgcn_readlane(__float_as_int(comp), 4 * s16 + (c >> 2)));
    }
    float br = 0.f, bi = 0.f;
#pragma unroll
    for (int c = 0; c < 16; c++) { br += bre[c] * uu[c]; bi += bim[c] * uu[c]; }
    const float nr = ca.x * xr - ca.y * xi + br, ni = ca.x * xi + ca.y * xr + bi;
    xr = nr; xi = ni;
    if (OUT) {
      float v[16];
#pragma unroll
      for (int c = 0; c < 16; c++) v[c] = cre[c] * xr - cim[c] * xi;
      const bool b5 = lane & 32, b4 = lane & 16, b3 = lane & 8, b2 = lane & 4;
      float v8[8], v4[4], v2[2], v1;
#pragma unroll
      for (int i = 0; i < 8; i++) { const float snd = b5 ? v[i] : v[i + 8]; const float rcv = __shfl_xor(snd, 32); v8[i] = (b5 ? v[i + 8] : v[i]) + rcv; }
#pragma unroll
      for (int i = 0; i < 4; i++) { const float snd = b4 ? v8[i] : v8[i + 4]; const float rcv = __shfl_xor(snd, 16); v4[i] = (b4 ? v8[i + 4] : v8[i]) + rcv; }
#pragma unroll
      for (int i = 0; i < 2; i++) { const float snd = b3 ? v4[i] : v4[i + 2]; const float rcv = __shfl_xor(snd, 8); v2[i] = (b3 ? v4[i + 2] : v4[i]) + rcv; }
      { const float snd = b2 ? v2[0] : v2[1]; const float rcv = __shfl_xor(snd, 4); v1 = (b2 ? v2[1] : v2[0]) + rcv; }
      v1 += __shfl_xor(v1, 2);
      v1 += __shfl_xor(v1, 1);
      float um = uu[0];
#pragma unroll
      for (int c = 1; c < 16; c++) um = (mych == c) ? uu[c] : um;
      const float y = gelu_tanh(v1 + dsk * um);
      if ((lane & 3) == 0) Yg[(tok0 + t) * 256 + g * 16 + mych] = f2bf(y);
    }
  }
    cur = nxt;
  }
  if (!OUT) Send[sbase + (size_t)ch * 64] = make_float2(xr, xi);
}

constexpr int KS_ = 72, VS_ = 68;
DI void da_item(const Params& P, int layer, int b, int h, int qt, char* mb, char* smem) {
  const int tid = tidx(), lane = tid & 63, wave = tid >> 6, r = lane & 31, hh = lane >> 5;
  u16* sK = (u16*)smem;
  u16* sV = sK + 64 * KS_;
  float* sbias = (float*)(sV + 128 * VS_);
  u16* sQw = (u16*)(smem + 28672) + (tidx() >> 6) * 32 * KS_;
  const u16* Qd = (const u16*)(mb + M_QD); const u16* Kd = (const u16*)(mb + M_KD); const u16* Vt = (const u16*)(mb + M_VT);
  u16* CC = (u16*)(WS(P) + OFF_CC);
  const int q0 = qt * 128, qw = q0 + wave * 32, qp = qw + r;
  const size_t tokq = (size_t)b * L_ + qp;
  __syncthreads();
  if (tid < 129) sbias[tid] = ((const float*)(WS(P) + OFF_BIAS))[h * 129 + tid] * LOG2E_;
  __syncthreads();
  const float bfar = sbias[128];
  const float SC = 0.125f * LOG2E_;
  const int nkt = (q0 + 128) >> 6;
  const float lam = ((const float*)(WS(P) + OFF_LAM))[layer];
  const int krow_l = tid >> 3, kch = (tid & 7) * 8;
#pragma unroll 1
  for (int c = 0; c < 2; c++) {
#pragma unroll
    for (int ks = 0; ks < 4; ks++) *(bf16x8*)(sQw + r * KS_ + ks * 16 + hh * 8) = *(const bf16x8*)(Qd + tokq * 512 + h * 128 + c * 64 + ks * 16 + hh * 8);
    f32x16 o[4] = {zero16(), zero16(), zero16(), zero16()};
    float m = -INFINITY, l = 0.f;
    const u16* Kbase = Kd + ((size_t)(((b * 4 + h) * 2 + c)) * L_ + krow_l) * 64 + kch;
    const u16* Vbase = Vt + ((size_t)((b * 4 + h) * 128) * 128 + krow_l) * 64 + kch;
    u32x4 rk[2], rv[4];
#pragma unroll
    for (int i = 0; i < 2; i++) rk[i] = *(const u32x4*)(Kbase + (size_t)(i * 32) * 64);
#pragma unroll
    for (int i = 0; i < 4; i++) rv[i] = *(const u32x4*)(Vbase + (size_t)(i * 32) * 64);
#pragma unroll 1
    for (int kt = 0; kt < nkt; kt++) {
      __syncthreads();
#pragma unroll
      for (int i = 0; i < 2; i++) *(u32x4*)(sK + (krow_l + i * 32) * KS_ + kch) = rk[i];
#pragma unroll
      for (int i = 0; i < 4; i++) {
        u32x2* d = (u32x2*)(sV + (krow_l + i * 32) * VS_ + kch);
        u32x2 lo2, hi2; lo2.x = rv[i].x; lo2.y = rv[i].y; hi2.x = rv[i].z; hi2.y = rv[i].w;
        d[0] = lo2; d[1] = hi2;
      }
      __syncthreads();
      {
        const int ktn = min(kt + 1, nkt - 1);
#pragma unroll
        for (int i = 0; i < 2; i++) rk[i] = *(const u32x4*)(Kbase + (size_t)(ktn * 64 + i * 32) * 64);
#pragma unroll
        for (int i = 0; i < 4; i++) rv[i] = *(const u32x4*)(Vbase + (size_t)ktn * 8192 + (size_t)(i * 32) * 64);
      }
      if (kt * 64 <= qw + 31) {
        f32x16 s[2];
#pragma unroll
        for (int kb = 0; kb < 2; kb++) {
          s[kb] = zero16();
#pragma unroll
          for (int ks = 0; ks < 4; ks++) {
            const bf16x8 kf = *(const bf16x8*)(sK + (kb * 32 + r) * KS_ + ks * 16 + hh * 8);
            const bf16x8 qf = *(const bf16x8*)(sQw + r * KS_ + ks * 16 + hh * 8);
            s[kb] = MFMA32(kf, qf, s[kb]);
          }
        }
        const bool nearb = (kt * 64 + 63 + 128 > qw);
        float mx = -INFINITY;
        if (nearb) {
#pragma unroll
          for (int kb = 0; kb < 2; kb++)
#pragma unroll
            for (int i = 0; i < 16; i++) {
              const int dist = qp - (kt * 64 + kb * 32 + crow(i, hh));
              const float bv = sbias[min(max(dist, 0), 128)];
              float t = s[kb][i] * SC + bv;
              t = (dist >= 0) ? t : -INFINITY;
              s[kb][i] = t; mx = fmaxf(mx, t);
              if ((i & 7) == 7) __builtin_amdgcn_sched_barrier(0);
            }
        } else {
#pragma unroll
          for (int kb = 0; kb < 2; kb++)
#pragma unroll
            for (int i = 0; i < 16; i++) { const float t = s[kb][i] * SC + bfar; s[kb][i] = t; mx = fmaxf(mx, t); }
        }
        mx = fmaxf(mx, __shfl_xor(mx, 32));
        const float mn = fmaxf(m, mx);
        const float corr = __builtin_amdgcn_exp2f(m - mn);
        m = mn;
        float ls = 0.f;
#pragma unroll
        for (int kb = 0; kb < 2; kb++)
#pragma unroll
          for (int i = 0; i < 16; i++) { const float p = __builtin_amdgcn_exp2f(s[kb][i] - mn); s[kb][i] = p; ls += p; }
        l = l * corr + ls;
        if (__ballot(corr != 1.f) != 0ull) {
#pragma unroll
          for (int dt = 0; dt < 4; dt++)
#pragma unroll
            for (int i = 0; i < 16; i++) o[dt][i] *= corr;
        }
#pragma unroll
        for (int kb = 0; kb < 2; kb++)
#pragma unroll
          for (int s2 = 0; s2 < 2; s2++) {
            const bf16x8 pf = pack8(s[kb], s2);
#pragma unroll
            for (int dt = 0; dt < 4; dt++) {
              const u16* vp = sV + (dt * 32 + r) * VS_ + kb * 32 + s2 * 16 + 4 * hh;
              const s16x4 lo = *(const s16x4*)vp, hi = *(const s16x4*)(vp + 8);
              const bf16x8 vf = __builtin_shufflevector(lo, hi, 0, 1, 2, 3, 4, 5, 6, 7);
              o[dt] = MFMA32(vf, pf, o[dt]);
            }
            __builtin_amdgcn_sched_barrier(0);
          }
      }
    }
    const float lt = l + __shfl_xor(l, 32);
    const float inv = 1.f / lt;
    size_t tq = tokq;
    asm volatile("" : "+v"(tq));
    u16* obase = CC + tq * 1024 + h * 128 + 4 * hh;
    if (c == 0) {
#pragma unroll
      for (int dt = 0; dt < 4; dt++)
#pragma unroll
        for (int g4 = 0; g4 < 4; g4++) {
          *(uint2*)(obase + dt * 32 + 8 * g4) = make_uint2(pack2(o[dt][4 * g4] * inv, o[dt][4 * g4 + 1] * inv), pack2(o[dt][4 * g4 + 2] * inv, o[dt][4 * g4 + 3] * inv));
        }
    } else {
      float ss = 0.f;
#pragma unroll
      for (int dt = 0; dt < 4; dt++)
#pragma unroll
        for (int g4 = 0; g4 < 4; g4++) {
          const uint2 pv = *(const uint2*)(obase + dt * 32 + 8 * g4);
          const float a4[4] = {bf2f((u16)(pv.x & 0xffff)), bf2f((u16)(pv.x >> 16)), bf2f((u16)(pv.y & 0xffff)), bf2f((u16)(pv.y >> 16))};
#pragma unroll
          for (int e = 0; e < 4; e++) { const float v = a4[e] - lam * o[dt][4 * g4 + e] * inv; o[dt][4 * g4 + e] = v; ss = __builtin_fmaf(v, v, ss); }
        }
      ss += __shfl_xor(ss, 32);
      const float lam_init = 0.8f - 0.6f * __expf(-0.3f * (float)layer);
      const float rn = rsqrtf(ss * (1.f / 128.f) + LN_EPS_) * (1.f - lam_init);
      int hh2 = hh;
      asm volatile("" : "+v"(hh2));
      const float* sg = INP(P, 14) + layer * 128 + 4 * hh2;
#pragma unroll
      for (int dt = 0; dt < 4; dt++)
#pragma unroll
        for (int g4 = 0; g4 < 4; g4++) {
          const int dv = dt * 32 + 8 * g4 + 4 * hh;
          const float4 gv = *(const float4*)(sg + dt * 32 + 8 * g4);
          uint2 w = make_uint2(pack2(o[dt][4 * g4] * rn * gv.x, o[dt][4 * g4 + 1] * rn * gv.y),
                               pack2(o[dt][4 * g4 + 2] * rn * gv.z, o[dt][4 * g4 + 3] * rn * gv.w));
          *(uint2*)(obase + dv - 4 * hh) = w;
        }
    }
  }
}

DI unsigned sortkey(float f) { const unsigned u = __float_as_uint(f + 0.f); return u ^ (((unsigned)((int)u >> 31)) | 0x80000000u); }

DI void dsa_item(const Params& P, int layer, int b, int qt, char* mb, char* smem) {
  const int tid = tidx(), lane = tid & 63, wave = tid >> 6, r = lane & 31, hh = lane >> 5;
  unsigned* hist = (unsigned*)smem;
  float* sP = (float*)smem;
  float* sQ = (float*)(smem + 16384);
  u16* sidx = (u16*)(smem + 32896);
  unsigned* meta = (unsigned*)(smem + 49280);
  float* sbias = (float*)(smem + 50304);
  const u16* Qi = (const u16*)(mb + M_QI); const u16* Ki = (const u16*)(mb + M_KI); const float* Wi = (const float*)(mb + M_WI);
  const u16* Qs = (const u16*)(mb + M_QS); const u16* Ks = (const u16*)(mb + M_KS); const u16* Vs = (const u16*)(mb + M_VS);
  u16* CC = (u16*)(WS(P) + OFF_CC);
  const int q0 = qt * 32;
  const int qp = q0 + r;
  const size_t tokb = (size_t)b * L_;
  const int nk32 = qt + 1;
  const bool radix = (q0 >= 256);
  __syncthreads();
  for (int i = tid; i < 4 * 129; i += 256) sbias[i] = ((const float*)(WS(P) + OFF_BIAS))[4 * 129 + i];
  meta[tid] = (tid >= 32 && tid < 64) ? 256u : 0u;
  char* sQi = smem + 52384;
  float* sWi = (float*)(smem + 69280);
  constexpr int CAPL_ = 64;
  unsigned* lK = (unsigned*)smem;
  u16* lI = (u16*)(smem + 32 * CAPL_ * 4);
  {
    const int row = tid >> 3, ch = tid & 7;
    const uint4* src = (const uint4*)(Qi + (tokb + q0 + row) * 256 + ch * 32);
    uint4* dst = (uint4*)(sQi + row * 528 + ch * 64);
    dst[0] = src[0]; dst[1] = src[1]; dst[2] = src[2]; dst[3] = src[3];
    sWi[tid] = Wi[(tokb + q0) * 8 + tid];
  }
  int pass = radix ? 0 : 4;
  bool fast = false;
#pragma unroll 1
  while (true) {
    __syncthreads();
    if (pass < 4) { for (int i = tid; i < 32 * 257; i += 256) hist[i] = 0u; }
    __syncthreads();
    const unsigned pref = meta[r];
    const unsigned krem = meta[32 + r];
    bf16x8 nf0 = {0, 0, 0, 0, 0, 0, 0, 0}, nf1 = {0, 0, 0, 0, 0, 0, 0, 0};
    if (wave < nk32) {
      nf0 = *(const bf16x8*)(Ki + (tokb + wave * 32 + r) * 32 + hh * 8);
      nf1 = *(const bf16x8*)(Ki + (tokb + wave * 32 + r) * 32 + 16 + hh * 8);
    }
#pragma unroll 1
    for (int kt = wave; kt < nk32; kt += 4) {
      const bf16x8 kf0 = nf0, kf1 = nf1;
      if (kt + 4 < nk32) {
        nf0 = *(const bf16x8*)(Ki + (tokb + (kt + 4) * 32 + r) * 32 + hh * 8);
        nf1 = *(const bf16x8*)(Ki + (tokb + (kt + 4) * 32 + r) * 32 + 16 + hh * 8);
      }
      f32x16 sc = zero16();
#pragma unroll 4
      for (int hd = 0; hd < 8; hd++) {
        const bf16x8 q0f = *(const bf16x8*)(sQi + r * 528 + hd * 64 + hh * 16);
        const bf16x8 q1f = *(const bf16x8*)(sQi + r * 528 + hd * 64 + 32 + hh * 16);
        const float w = sWi[r * 8 + hd];
        f32x16 s = MFMA32(kf0, q0f, zero16());
        s = MFMA32(kf1, q1f, s);
#pragma unroll
        for (int i = 0; i < 16; i++) sc[i] += __int_as_float(max(__float_as_int(s[i]), 0)) * w;
      }
      const int lim = (kt == qt) ? qp : 0x7fffffff;
      if (pass == 0) {
#pragma unroll
        for (int i = 0; i < 16; i++) {
          const int kp = kt * 32 + crow(i, hh);
          const unsigned key = sortkey(sc[i]);
          const unsigned bin = (kp <= lim) ? (key >> 24) : 256u;
          atomicAdd(&hist[r * 257 + bin], 1u);
        }
      } else if (pass < 4) {
        const int sh = 24 - 8 * pass;
#pragma unroll
        for (int i = 0; i < 16; i++) {
          const int kp = kt * 32 + crow(i, hh);
          const unsigned key = sortkey(sc[i]);
          if ((key >> (sh + 8)) == pref && kp <= lim) atomicAdd(&hist[r * 257 + ((key >> sh) & 255u)], 1u);
        }
      } else if (pass == 5) {
        unsigned mc = 0u, ms = 0u;
        unsigned keys[16];
#pragma unroll
        for (int i = 0; i < 16; i++) {
          const int kp = kt * 32 + crow(i, hh);
          keys[i] = sortkey(sc[i]);
          const unsigned bt = keys[i] >> 16;
          const bool valid = (kp <= lim);
          ms |= (valid && bt > pref) ? (1u << i) : 0u;
          mc |= (valid && bt == pref) ? (1u << i) : 0u;
        }
        unsigned base_c = 0u, base_s = 0u;
        if (mc) base_c = atomicAdd(&meta[128 + r], (unsigned)__popc(mc));
        if (ms) base_s = atomicAdd(&meta[64 + r], (unsigned)__popc(ms));
#pragma unroll
        for (int i = 0; i < 16; i++) {
          const int kp = kt * 32 + crow(i, hh);
          if ((mc >> i) & 1u) {
            const unsigned cp = base_c + (unsigned)__popc(mc & ((1u << i) - 1u));
            if (cp < (unsigned)CAPL_) { lK[r * CAPL_ + cp] = keys[i]; lI[r * CAPL_ + cp] = (u16)kp; }
          }
          if ((ms >> i) & 1u) {
            const unsigned pos = base_s + (unsigned)__popc(ms & ((1u << i) - 1u));
            if (pos < 256u) sidx[r * 256 + pos] = (u16)kp;
          }
        }
      } else {
#pragma unroll
        for (int i = 0; i < 16; i++) {
          const int kp = kt * 32 + crow(i, hh);
          const unsigned key = sortkey(sc[i]);
          bool sel = (kp <= lim);
          if (radix) {
            sel = sel && (key >= pref);
            if (sel && key == pref) sel = atomicAdd(&meta[96 + r], 1u) < krem;
          }
          if (sel) { const unsigned pos = atomicAdd(&meta[64 + r], 1u); if (pos < 256u) sidx[r * 256 + pos] = (u16)kp; }
        }
      }
    }
    __syncthreads();
    if (pass < 4) {
      for (int j = 0; j < 8; j++) {
        const int qq = wave * 8 + j;
        const unsigned k = meta[32 + qq];
        unsigned c4[4]; unsigned tot = 0;
#pragma unroll
        for (int e = 0; e < 4; e++) { c4[e] = hist[qq * 257 + 255 - 4 * lane - e]; tot += c4[e]; }
        unsigned incl = tot;
        for (int o = 1; o < 64; o <<= 1) { const unsigned t = __shfl_up(incl, o); if (lane >= o) incl += t; }
        unsigned run = incl - tot;
#pragma unroll
        for (int e = 0; e < 4; e++) {
          if (run < k && run + c4[e] >= k) {
            meta[qq] = (meta[qq] << 8) | (unsigned)(255 - 4 * lane - e); meta[32 + qq] = k - run;
            if (pass == 1 && c4[e] > (unsigned)CAPL_) meta[192] = 1u;
          }
          run += c4[e];
        }
      }
    }
    if (pass >= 4) break;
    if (pass == 1) { __syncthreads(); fast = (meta[192] == 0u); pass = fast ? 5 : 2; } else pass++;
  }
  __syncthreads();
  if (fast) {
#pragma unroll 1
    for (int j = 0; j < 8; j++) {
      const int qq = wave * 8 + j;
      const int c = min((int)meta[128 + qq], CAPL_);
      const unsigned k = meta[32 + qq];
      const bool in = lane < c;
      const unsigned mykey = in ? lK[qq * CAPL_ + lane] : 0u;
      const unsigned myidx = in ? (unsigned)lI[qq * CAPL_ + lane] : 0u;
      unsigned rank = 0u;
      for (int t = 0; t < c; t++) {
        const unsigned ok = __shfl(mykey, t);
        rank += (ok > mykey || (ok == mykey && t < lane)) ? 1u : 0u;
      }
      const bool sel = in && (rank < k);
      const unsigned long long m = __ballot(sel);
      const unsigned base = meta[64 + qq];
      if (sel) {
        const unsigned pos = base + (unsigned)__popcll(m & ((1ull << lane) - 1ull));
        if (pos < 256u) sidx[qq * 256 + pos] = (u16)myidx;
      }
      __builtin_amdgcn_wave_barrier();
      if (lane == 0) meta[64 + qq] = base + (unsigned)__popcll(m);
    }
    __syncthreads();
  }
  float* myP = sP + wave * 1024;
  (void)sQ;
#pragma unroll 1
  for (int j = 0; j < 8; j++) {
    const int qq = wave * 8 + j;
    const int qpos = q0 + qq;
    const size_t tok = tokb + qpos;
    const int n = min((int)meta[64 + qq], 256);
    __syncthreads();
    bf16x8 qf[4];
#pragma unroll
    for (int ks = 0; ks < 4; ks++) {
      bf16x8 z = {0, 0, 0, 0, 0, 0, 0, 0};
      if (r < 4) z = *(const bf16x8*)(Qs + tok * 256 + r * 64 + ks * 16 + hh * 8);
      qf[ks] = z;
    }
#pragma unroll 4
    for (int kb = 0; kb < 8; kb++) {
      const int jj = kb * 32 + r;
      const int kidx = (jj < n) ? (int)sidx[qq * 256 + jj] : 0;
      const u16* kp = Ks + (tokb + kidx) * 64 + hh * 8;
      bf16x8 kf[4];
#pragma unroll
      for (int ks = 0; ks < 4; ks++) kf[ks] = *(const bf16x8*)(kp + ks * 16);
      f32x16 sacc = zero16();
#pragma unroll
      for (int ks = 0; ks < 4; ks++) sacc = MFMA32(kf[ks], qf[ks], sacc);
      if (r < 4) {
#pragma unroll
        for (int i = 0; i < 16; i++) myP[(kb * 32 + crow(i, hh)) * 4 + r] = sacc[i];
      }
    }
    __syncthreads();
    float sc[4][4];
#pragma unroll
    for (int rd = 0; rd < 4; rd++) {
      const int jj = rd * 64 + lane;
      const bool valid = jj < n;
      const int kidx = valid ? (int)sidx[qq * 256 + jj] : 0;
      const int dist = min(max(qpos - kidx, 0), 128);
      const float4 d = *(const float4*)(myP + jj * 4);
      sc[rd][0] = valid ? d.x * 0.125f + sbias[0 * 129 + dist] : -INFINITY;
      sc[rd][1] = valid ? d.y * 0.125f + sbias[1 * 129 + dist] : -INFINITY;
      sc[rd][2] = valid ? d.z * 0.125f + sbias[2 * 129 + dist] : -INFINITY;
      sc[rd][3] = valid ? d.w * 0.125f + sbias[3 * 129 + dist] : -INFINITY;
    }
#pragma unroll
    for (int hd = 0; hd < 4; hd++) {
      float mx = fmaxf(fmaxf(sc[0][hd], sc[1][hd]), fmaxf(sc[2][hd], sc[3][hd]));
      mx = wave_max(mx);
      float sm = 0.f;
#pragma unroll
      for (int rd = 0; rd < 4; rd++) { sc[rd][hd] = __expf(sc[rd][hd] - mx); sm += sc[rd][hd]; }
      sm = wave_sum(sm);
      const float inv = 1.f / sm;
#pragma unroll
      for (int rd = 0; rd < 4; rd++) sc[rd][hd] *= inv;
    }
#pragma unroll
    for (int rd = 0; rd < 4; rd++) *(float4*)(myP + (rd * 64 + lane) * 4) = make_float4(sc[rd][0], sc[rd][1], sc[rd][2], sc[rd][3]);
    __syncthreads();
    const int g = lane >> 3, c8 = lane & 7;
    float acc[32];
#pragma unroll
    for (int i = 0; i < 32; i++) acc[i] = 0.f;
#pragma unroll 16
    for (int it = 0; it < 32; it++) {
      const int jj = it * 8 + g;
      const int kidx = (jj < n) ? (int)sidx[qq * 256 + jj] : 0;
      const float4 pj = *(const float4*)(myP + jj * 4);
      const u32x4 vv = *(const u32x4*)(Vs + (tokb + kidx) * 64 + c8 * 8);
      const float vf[8] = {bf2f((u16)(vv.x & 0xffff)), bf2f((u16)(vv.x >> 16)), bf2f((u16)(vv.y & 0xffff)), bf2f((u16)(vv.y >> 16)),
                           bf2f((u16)(vv.z & 0xffff)), bf2f((u16)(vv.z >> 16)), bf2f((u16)(vv.w & 0xffff)), bf2f((u16)(vv.w >> 16))};
#pragma unroll
      for (int e = 0; e < 8; e++) {
        acc[0 * 8 + e] += pj.x * vf[e]; acc[1 * 8 + e] += pj.y * vf[e];
        acc[2 * 8 + e] += pj.z * vf[e]; acc[3 * 8 + e] += pj.w * vf[e];
      }
    }
    const bool b5 = lane & 32, b4 = lane & 16, b3 = lane & 8;
    float w16[16], w8[8], w4[4];
#pragma unroll
    for (int i = 0; i < 16; i++) { const float snd = b5 ? acc[i] : acc[i + 16]; const float rcv = __shfl_xor(snd, 32); w16[i] = (b5 ? acc[i + 16] : acc[i]) + rcv; }
#pragma unroll
    for (int i = 0; i < 8; i++) { const float snd = b4 ? w16[i] : w16[i + 8]; const float rcv = __shfl_xor(snd, 16); w8[i] = (b4 ? w16[i + 8] : w16[i]) + rcv; }
#pragma unroll
    for (int i = 0; i < 4; i++) { const float snd = b3 ? w8[i] : w8[i + 4]; const float rcv = __shfl_xor(snd, 8); w4[i] = (b3 ? w8[i + 4] : w8[i]) + rcv; }
    const int hd = (b5 ? 2 : 0) + (b4 ? 1 : 0);
    *(uint2*)(CC + tok * 1024 + 768 + hd * 64 + c8 * 8 + (b3 ? 4 : 0)) = make_uint2(pack2(w4[0], w4[1]), pack2(w4[2], w4[3]));
  }
}

DI void phase_mix1(const Params& P, int layer, int bid, int nb, char* smem) {
  char* mb = WS(P) + OFF_H;
  for (int w = bid * 4 + (tidx() >> 6); w < 2048; w += nb * 4) ssm_scan<false>(P, layer, w, mb);
  for (int j = 0;; j++) {
    const int idx = (j & 1) ? (j * nb + (nb - 1 - bid)) : (j * nb + bid);
    if (j * nb >= 2048) break;
    if (idx >= 2048) continue;
    const int qt = 255 - (idx >> 3), b = idx & 7;
    dsa_item(P, layer, b, qt, mb, smem);
  }
  for (int j = 0;; j++) {
    const int idx = (j & 1) ? (j * nb + (nb - 1 - bid)) : (j * nb + bid);
    if (j * nb >= 2048) break;
    if (idx >= 2048) continue;
    const int qt = 63 - (idx >> 5), bh = idx & 31;
    da_item(P, layer, bh >> 2, bh & 3, qt, mb, smem);
  }
}

DI void phase_mix2(const Params& P, int layer, int bid, int nb, char* smem) {
  char* mb = WS(P) + OFF_H;
  for (int w = bid * 4 + (tidx() >> 6); w < 2048; w += nb * 4) ssm_scan<true>(P, layer, w, mb);
}

DI void run_phase(const Params& P, int ph, int bid, int nb, char* smem) {
  char* ws = WS(P);
  u16* sm = (u16*)smem;
  if (ph == 0) { phase_prep(P, bid, nb, smem); return; }
  const int l = (ph - 1) / 12, s = (ph - 1) % 12;
  u16* Xb = (u16*)(ws + OFF_XB);
  u16* H = (u16*)(ws + OFF_H);
  u16* CC = (u16*)(ws + OFF_CC);
  float* X = OUTP(P);
  switch (s) {
    case 0: phase_ffn_up(Xb, (const u16*)(ws + OFF_WGU1 + l * SZ_WGU), H, bid, nb, sm); break;
    case 1: phase_ffn_down(H, (const u16*)(ws + OFF_WD1 + l * SZ_WD), (l == 0) ? INP(P, 0) : (const float*)X, X, nullptr, bid, nb, sm); break;
    case 2: phase_ln(X, Xb, INP(P, 6) + l * 1024, INP(P, 7) + l * 1024, bid, nb); break;
    case 3: phase_w_in(Xb, (const u16*)(ws + OFF_WIN + l * SZ_WIN), ws + OFF_H, bid, nb, sm); break;
    case 4: phase_mix1(P, l, bid, nb, smem); break;
    case 5: phase_mix2(P, l, bid, nb, smem); break;
    case 6: phase_glu((const u16*)(ws + OFF_H + M_YG), (const u16*)(ws + OFF_WGLU + l * SZ_WGLU), CC, bid, nb, sm); break;
    case 7: phase_w_o(CC, (const u16*)(ws + OFF_WO + l * SZ_WO), X, bid, nb, sm); break;
    case 8: phase_ln(X, Xb, INP(P, 24) + l * 1024, INP(P, 25) + l * 1024, bid, nb); break;
    case 9:
      phase_ffn_up(Xb, (const u16*)(ws + OFF_WGU2 + l * SZ_WGU), H, bid, nb, sm);
      phase_ple(Xb, (const u16*)(ws + OFF_WPG + l * SZ_WPG), (const u16*)(ws + OFF_PB) + (size_t)l * T_ * 256, (const u16*)(ws + OFF_WPP + l * SZ_WPP), CC, bid, nb, sm);
      break;
    case 10: phase_ffn_down(H, (const u16*)(ws + OFF_WD2 + l * SZ_WD), X, X, CC, bid, nb, sm); break;
    case 11: phase_ln(X, Xb, INP(P, 31) + l * 1024, INP(P, 32) + l * 1024, bid, nb); break;
  }
}

constexpr int NPHASES = 25;

__global__ void __launch_bounds__(256, 2) mega(Params P, int ph0, int ph1) {
  extern __shared__ __attribute__((aligned(16))) char smem[];
  cg::grid_group grid = cg::this_grid();
  const int bid = blockIdx.x, nb = gridDim.x;
#ifndef DUP_MASK
#define DUP_MASK 0
#endif
#define PHASE(k) if (ph0 <= (k) && (k) < ph1) { \
    if ((k) > 0 && ((DUP_MASK >> (((k) - 1) % 12)) & 1)) { run_phase(P, (k), bid, nb, smem); grid.sync(); } \
    run_phase(P, (k), bid, nb, smem); if ((k) + 1 < ph1) grid.sync(); }
  PHASE(0) PHASE(1) PHASE(2) PHASE(3) PHASE(4) PHASE(5) PHASE(6) PHASE(7) PHASE(8) PHASE(9) PHASE(10) PHASE(11) PHASE(12)
  PHASE(13) PHASE(14) PHASE(15) PHASE(16) PHASE(17) PHASE(18) PHASE(19) PHASE(20) PHASE(21) PHASE(22) PHASE(23) PHASE(24)
#undef PHASE
}

extern "C" void kernel_launch(void* const* d_in, const int* in_sizes, int n_in, void* d_out, int out_size, void* d_ws, size_t ws_size, hipStream_t stream) {
  static int grid_blocks = 0;
  if (grid_blocks == 0) {
    if (n_in != 33 || ws_size < WS_END) { fprintf(stderr, "kernel_launch: need 33 inputs and %zu bytes of ws (got %d, %zu)\n", (size_t)WS_END, n_in, ws_size); grid_blocks = -1; return; }
    int dev = 0, cus = 0, per_cu = 0;
    (void)hipGetDevice(&dev);
    (void)hipDeviceGetAttribute(&cus, hipDeviceAttributeMultiprocessorCount, dev);
    (void)hipFuncSetAttribute((const void*)mega, hipFuncAttributeMaxDynamicSharedMemorySize, LDS_BYTES);
    (void)hipOccupancyMaxActiveBlocksPerMultiprocessor(&per_cu, (const void*)mega, 256, LDS_BYTES);
    if (per_cu < 1) per_cu = 1;
    if (per_cu > 2) per_cu = 2;
    grid_blocks = cus * per_cu;
    fprintf(stderr, "kernel_launch: cus %d per_cu %d grid %d\n", cus, per_cu, grid_blocks);
  }
  if (grid_blocks < 0) return;
  Params p;
  memset(&p, 0, sizeof(p));
  for (int i = 0; i < 33; i++) p.in[i] = (const float*)d_in[i];
  p.out = (float*)d_out;
  p.ws = (char*)d_ws;
#if MULTI_LAUNCH
  for (int ph = 0; ph < NPHASES; ph++) {
    hipLaunchKernelGGL(mega, dim3(grid_blocks), dim3(256), LDS_BYTES, stream, p, ph, ph + 1);
  }
#else
  int ph0 = 0, ph1 = NPHASES;
  void* args[] = {&p, &ph0, &ph1};
  hipError_t e = hipLaunchCooperativeKernel((const void*)mega, dim3(grid_blocks), dim3(256), args, LDS_BYTES, stream);
  if (e != hipSuccess) fprintf(stderr, "cooperative launch failed: %s (grid %d)\n", hipGetErrorString(e), grid_blocks);
#endif
}
```

```cpp
#include <hip/hip_runtime.h>
#include <hip/hip_cooperative_groups.h>
#include <stdint.h>
#include <math.h>
#include <stdio.h>
#include <string.h>
namespace cg = cooperative_groups;

#ifndef MULTI_LAUNCH
#define MULTI_LAUNCH 0
#endif

typedef unsigned short u16;
typedef __attribute__((ext_vector_type(8))) short bf16x8;
typedef __attribute__((ext_vector_type(4))) short s16x4;
typedef __attribute__((ext_vector_type(16))) float f32x16;
typedef __attribute__((ext_vector_type(4))) unsigned u32x4;
typedef __attribute__((ext_vector_type(2))) unsigned u32x2;

#define DI __device__ __forceinline__
#define MFMA32(a, b, c) __builtin_amdgcn_mfma_f32_32x32x16_bf16((a), (b), (c), 0, 0, 0)

constexpr int T_ = 65536;
constexpr int L_ = 8192;
constexpr int D_ = 1024;
constexpr int FF_ = 2816;
constexpr float ALPHA_ = 1.41421356237309515f;
constexpr float LN_EPS_ = 1e-5f;
constexpr float LOG2E_ = 1.44269504088896341f;
constexpr int LDS_BYTES = 73728;

constexpr size_t SZ_WGU = (size_t)5632 * 1024 * 2;
constexpr size_t SZ_WD = (size_t)1024 * 2816 * 2;
constexpr size_t SZ_WIN = (size_t)2560 * 1024 * 2;
constexpr size_t SZ_WO = (size_t)1024 * 1024 * 2;
constexpr size_t SZ_WGLU = (size_t)256 * 256 * 2;
constexpr size_t SZ_WPG = (size_t)1024 * 1024 * 2;
constexpr size_t SZ_WPP = (size_t)1024 * 256 * 2;
constexpr size_t OFF_WGU1 = 0;
constexpr size_t OFF_WD1 = OFF_WGU1 + 2 * SZ_WGU;
constexpr size_t OFF_WGU2 = OFF_WD1 + 2 * SZ_WD;
constexpr size_t OFF_WD2 = OFF_WGU2 + 2 * SZ_WGU;
constexpr size_t OFF_WIN = OFF_WD2 + 2 * SZ_WD;
constexpr size_t OFF_WO = OFF_WIN + 2 * SZ_WIN;
constexpr size_t OFF_WGLU = OFF_WO + 2 * SZ_WO;
constexpr size_t OFF_WPG = OFF_WGLU + 2 * SZ_WGLU;
constexpr size_t OFF_WPP = OFF_WPG + 2 * SZ_WPG;
constexpr size_t OFF_COEFA = OFF_WPP + 2 * SZ_WPP;
constexpr size_t OFF_COEFB = OFF_COEFA + 2 * 16 * 64 * 16;
constexpr size_t OFF_LAM = OFF_COEFB + 2 * 16 * 64 * 16 * 8;
constexpr size_t OFF_BIAS = OFF_LAM + 256;
constexpr size_t OFF_XB = OFF_BIAS + 8 * 129 * 4 + 32;
constexpr size_t OFF_PB = OFF_XB + (size_t)T_ * 1024 * 2;
constexpr size_t OFF_H = OFF_PB + (size_t)2 * T_ * 256 * 2;
constexpr size_t SZ_H = (size_t)384 << 20;
constexpr size_t OFF_CC = OFF_H + SZ_H;
constexpr size_t OFF_CANDK = OFF_CC + (size_t)T_ * 1024 * 2;
constexpr int CAP_ = 2048;
constexpr size_t OFF_CANDI = OFF_CANDK + (size_t)512 * 32 * CAP_ * 4;
constexpr size_t WS_END = OFF_CANDI + (size_t)512 * 32 * CAP_ * 2;
constexpr size_t MB_ = (size_t)1 << 20;
constexpr size_t M_QD = 0, M_KD = 64 * MB_, M_VT = 128 * MB_, M_U = 192 * MB_, M_QS = 256 * MB_, M_QI = 288 * MB_, M_YG = 320 * MB_,
                 M_KS = 352 * MB_, M_VS = 360 * MB_, M_KI = 368 * MB_, M_WI = 372 * MB_, M_SEND = 374 * MB_;

struct Params {
  const float* in[33];
  float* out;
  char* ws;
};

DI int tidx() { int t = threadIdx.x; asm volatile("" : "+v"(t)); return t; }
#define GAS __attribute__((address_space(1)))
DI size_t opaque0() { size_t z = 0; asm volatile("" : "+s"(z)); return z; }
DI char* WS(const Params& P) { return P.ws + opaque0(); }
DI float* OUTP(const Params& P) { return P.out + opaque0(); }
DI const float* INP(const Params& P, int i) { return P.in[i]; }
typedef __bf16 bf16v2_ __attribute__((ext_vector_type(2)));
typedef float f32v2_ __attribute__((ext_vector_type(2)));
DI u16 f2bf(float x) { const __bf16 h = (__bf16)x; return __builtin_bit_cast(u16, h); }
DI float bf2f(u16 v) { return __uint_as_float(((unsigned)v) << 16); }
DI unsigned pack2(float a, float b) { f32v2_ v; v.x = a; v.y = b; const bf16v2_ h = __builtin_convertvector(v, bf16v2_); return __builtin_bit_cast(unsigned, h); }
DI int crow(int i, int hh) { return (i & 3) + 8 * (i >> 2) + 4 * hh; }
DI float sigmoidf_(float x) { return __builtin_amdgcn_rcpf(1.f + __expf(-x)); }
DI float wave_sum(float v) { for (int o = 32; o > 0; o >>= 1) v += __shfl_xor(v, o); return v; }
DI float wave_max(float v) { for (int o = 32; o > 0; o >>= 1) v = fmaxf(v, __shfl_xor(v, o)); return v; }
DI f32x16 zero16() { f32x16 z; for (int i = 0; i < 16; i++) z[i] = 0.f; return z; }
DI bf16x8 pack8(const f32x16& x, int s) {
  union { unsigned u[4]; bf16x8 v; } t;
  t.u[0] = pack2(x[8 * s + 0], x[8 * s + 1]); t.u[1] = pack2(x[8 * s + 2], x[8 * s + 3]);
  t.u[2] = pack2(x[8 * s + 4], x[8 * s + 5]); t.u[3] = pack2(x[8 * s + 6], x[8 * s + 7]);
  return t.v;
}

constexpr int GS_ = 72;
constexpr int GT_ = 128 * GS_;

struct GemmPre { u32x4 a0[4], b0[4], a1[4], b1[4]; };
#define G_LOAD(RA, RB, T) _Pragma("unroll") for (int i = 0; i < 4; i++) { RA[i] = *(const u32x4*)(Ap + (size_t)i * 32 * lda + (T) * 64); RB[i] = *(const u32x4*)(Bp + (size_t)i * 32 * ldb + (T) * 64); }
DI void gemm_prefetch(GemmPre& R, const u16* __restrict__ A, int lda, const u16* __restrict__ B, int ldb) {
  const int tid = tidx();
  const int srow = tid >> 3, sk = (tid & 7) * 8;
  const u16* Ap = A + (size_t)srow * lda + sk;
  const u16* Bp = B + (size_t)srow * ldb + sk;
  G_LOAD(R.a0, R.b0, 0)
  G_LOAD(R.a1, R.b1, 1)
}
DI void gemm_main(f32x16 (&acc)[2][2], GemmPre& R, const u16* __restrict__ A, int lda, const u16* __restrict__ B, int ldb, int K, u16* sm) {
  const int tid = tidx(), lane = tid & 63, wave = tid >> 6;
  const int wm = wave >> 1, wn = wave & 1, r = lane & 31, hh = lane >> 5;
  const int srow = tid >> 3, sk = (tid & 7) * 8;
  const u16* Ap = A + (size_t)srow * lda + sk;
  const u16* Bp = B + (size_t)srow * ldb + sk;
#define G_STORE(RA, RB, BUF) { u16* d_ = sm + (BUF) * 2 * GT_; _Pragma("unroll") for (int i = 0; i < 4; i++) { *(u32x4*)(d_ + (srow + i * 32) * GS_ + sk) = RA[i]; *(u32x4*)(d_ + GT_ + (srow + i * 32) * GS_ + sk) = RB[i]; } }
#define G_COMPUTE(BUF) { const u16* sA = sm + (BUF) * 2 * GT_; const u16* sB = sA + GT_; \
    _Pragma("unroll") for (int ks = 0; ks < 4; ks++) { \
      const bf16x8 fa0 = *(const bf16x8*)(sA + (wm * 64 + r) * GS_ + ks * 16 + hh * 8); \
      const bf16x8 fa1 = *(const bf16x8*)(sA + (wm * 64 + 32 + r) * GS_ + ks * 16 + hh * 8); \
      const bf16x8 fb0 = *(const bf16x8*)(sB + (wn * 64 + r) * GS_ + ks * 16 + hh * 8); \
      const bf16x8 fb1 = *(const bf16x8*)(sB + (wn * 64 + 32 + r) * GS_ + ks * 16 + hh * 8); \
      acc[0][0] = MFMA32(fa0, fb0, acc[0][0]); acc[0][1] = MFMA32(fa0, fb1, acc[0][1]); \
      acc[1][0] = MFMA32(fa1, fb0, acc[1][0]); acc[1][1] = MFMA32(fa1, fb1, acc[1][1]); } }
  const int nk = K >> 6;
  __syncthreads();
  G_STORE(R.a0, R.b0, 0)
  G_LOAD(R.a0, R.b0, 2)
  __syncthreads();
  int kt = 0;
#pragma unroll 1
  for (; kt + 4 < nk; kt += 2) {
    G_COMPUTE(0)
    G_STORE(R.a1, R.b1, 1)
    __syncthreads();
    G_LOAD(R.a1, R.b1, kt + 3)
    G_COMPUTE(1)
    G_STORE(R.a0, R.b0, 0)
    __syncthreads();
    G_LOAD(R.a0, R.b0, kt + 4)
  }
  G_COMPUTE(0)
  G_STORE(R.a1, R.b1, 1)
  __syncthreads();
  G_LOAD(R.a1, R.b1, kt + 3)
  G_COMPUTE(1)
  G_STORE(R.a0, R.b0, 0)
  __syncthreads();
  G_COMPUTE(0)
  G_STORE(R.a1, R.b1, 1)
  __syncthreads();
  G_COMPUTE(1)
#undef G_STORE
#undef G_COMPUTE
}
#undef G_LOAD

DI bool tile_at(int it, int bid, int nb, int TM, int TN, int& tm, int& tn) {
  if ((nb & 7) == 0 && (TM & 63) == 0) {
    const int xcd = bid & 7, lw = bid >> 3, nlw = nb >> 3;
    const int lt = lw + it * nlw, per = (TM >> 3) * TN;
    if (lt >= per) return false;
    const int g = lt / (4 * TN), rem = lt - g * 4 * TN;
    tn = rem >> 2; tm = xcd * (TM >> 3) + g * 4 + (rem & 3);
    return true;
  } else {
    const int t = bid + it * nb;
    if (t >= TM * TN) return false;
    tn = t / TM; tm = t - tn * TM;
    return true;
  }
}

template <class AF, class BF, class EPI>
DI void gemm_phase(int TM, int TN, int K, int lda, int ldb, AF a_of, BF b_of, EPI epi, int bid, int nb, u16* sm) {
  GemmPre R;
  int tm, tn;
  bool have = tile_at(0, bid, nb, TM, TN, tm, tn);
  if (have) gemm_prefetch(R, a_of(tm), lda, b_of(tn), ldb);
  for (int it = 0; have; it++) {
    f32x16 acc[2][2] = {{zero16(), zero16()}, {zero16(), zero16()}};
    gemm_main(acc, R, a_of(tm), lda, b_of(tn), ldb, K, sm);
    int tm2 = 0, tn2 = 0;
    const bool have2 = tile_at(it + 1, bid, nb, TM, TN, tm2, tn2);
    if (have2) gemm_prefetch(R, a_of(tm2), lda, b_of(tn2), ldb);
    epi(acc, tm, tn);
    have = have2; tm = tm2; tn = tn2;
  }
}

DI void transpose_job(const float* __restrict__ src, int K, int N, u16* __restrict__ dst, int mode, int bid, int nb, float* tile) {
  const int tid = tidx();
  const int tk = K >> 6, tn = (N + 63) >> 6;
  for (int t = bid; t < tk * tn; t += nb) {
    const int k0 = (t % tk) * 64, n0 = (t / tk) * 64;
    __syncthreads();
#pragma unroll 4
    for (int i = 0; i < 16; i++) {
      const int k = i * 4 + (tid >> 6), n = tid & 63;
      tile[k * 65 + n] = (n0 + n < N) ? src[(size_t)(k0 + k) * N + n0 + n] : 0.f;
    }
    __syncthreads();
#pragma unroll 4
    for (int i = 0; i < 16; i++) {
      const int n = i * 4 + (tid >> 6), k = tid & 63;
      const int ng = n0 + n;
      if (ng < N) {
        int row = ng;
        if (mode == 1) row = (ng >> 5) * 64 + (ng & 31);
        else if (mode == 2) row = (ng >> 5) * 64 + 32 + (ng & 31);
        dst[(size_t)row * K + k0 + k] = f2bf(tile[k * 65 + n]);
      }
    }
  }
}

DI void phase_prep(const Params& P, int bid, int nb, char* smem) {
  float* tile = (float*)smem;
  char* ws = WS(P);
  for (int l = 0; l < 2; l++) {
    transpose_job(INP(P, 3) + (size_t)l * 1024 * FF_, 1024, FF_, (u16*)(ws + OFF_WGU1 + l * SZ_WGU), 1, bid, nb, tile);
    transpose_job(INP(P, 4) + (size_t)l * 1024 * FF_, 1024, FF_, (u16*)(ws + OFF_WGU1 + l * SZ_WGU), 2, bid, nb, tile);
    transpose_job(INP(P, 5) + (size_t)l * FF_ * 1024, FF_, 1024, (u16*)(ws + OFF_WD1 + l * SZ_WD), 0, bid, nb, tile);
    transpose_job(INP(P, 26) + (size_t)l * 1024 * FF_, 1024, FF_, (u16*)(ws + OFF_WGU2 + l * SZ_WGU), 1, bid, nb, tile);
    transpose_job(INP(P, 27) + (size_t)l * 1024 * FF_, 1024, FF_, (u16*)(ws + OFF_WGU2 + l * SZ_WGU), 2, bid, nb, tile);
    transpose_job(INP(P, 28) + (size_t)l * FF_ * 1024, FF_, 1024, (u16*)(ws + OFF_WD2 + l * SZ_WD), 0, bid, nb, tile);
    transpose_job(INP(P, 8) + (size_t)l * 1024 * 2472, 1024, 2472, (u16*)(ws + OFF_WIN + l * SZ_WIN), 0, bid, nb, tile);
    transpose_job(INP(P, 9) + (size_t)l * 1024 * 1024, 1024, 1024, (u16*)(ws + OFF_WO + l * SZ_WO), 0, bid, nb, tile);
    transpose_job(INP(P, 23) + (size_t)l * 256 * 256, 256, 256, (u16*)(ws + OFF_WGLU + l * SZ_WGLU), 0, bid, nb, tile);
    transpose_job(INP(P, 30) + (size_t)l * 1024 * 1024, 1024, 1024, (u16*)(ws + OFF_WPG + l * SZ_WPG), 0, bid, nb, tile);
    transpose_job(INP(P, 29) + (size_t)l * 256 * 1024, 256, 1024, (u16*)(ws + OFF_WPP + l * SZ_WPP), 0, bid, nb, tile);
    u16* win = (u16*)(ws + OFF_WIN + l * SZ_WIN);
    for (int i = bid * 256 + tidx(); i < 88 * 1024; i += nb * 256) win[(size_t)2472 * 1024 + i] = 0;
  }
  const size_t gt = (size_t)bid * 256 + tidx(), gs = (size_t)nb * 256;
  {
    const float4* x4 = (const float4*)INP(P, 0);
    uint2* xb = (uint2*)(ws + OFF_XB);
    for (size_t i = gt; i < (size_t)T_ * 1024 / 4; i += gs) { float4 v = x4[i]; xb[i] = make_uint2(pack2(v.x, v.y), pack2(v.z, v.w)); }
    const float4* p4 = (const float4*)INP(P, 1);
    uint2* pb = (uint2*)(ws + OFF_PB);
    for (size_t i = gt; i < (size_t)2 * T_ * 256 / 4; i += gs) { float4 v = p4[i]; pb[i] = make_uint2(pack2(v.x, v.y), pack2(v.z, v.w)); }
  }
  if (gt < 2 * 16 * 64) {
    const int l = (int)gt >> 10, g = ((int)gt >> 6) & 15, p = (int)gt & 63;
    const int gi = (l * 16 + g) * 64 + p;
    const double lr = INP(P, 15)[gi], li = INP(P, 16)[gi];
    const double dt = exp((double)INP(P, 17)[l * 16 + g]);
    const double mag = exp(lr * dt);
    const double ar = mag * cos(li * dt), ai = mag * sin(li * dt);
    const double mag5 = exp(512.0 * lr * dt);
    const double a5r = mag5 * cos(512.0 * li * dt), a5i = mag5 * sin(512.0 * li * dt);
    ((float4*)(ws + OFF_COEFA))[gi] = make_float4((float)ar, (float)ai, (float)a5r, (float)a5i);
    const double den = lr * lr + li * li, nr = ar - 1.0, ni = ai;
    const double fr = (nr * lr + ni * li) / den, fi = (ni * lr - nr * li) / den;
    float2* cb = (float2*)(ws + OFF_COEFB) + (size_t)gi * 16;
    for (int c = 0; c < 16; c++) {
      const double br = INP(P, 18)[(size_t)gi * 16 + c], bi = INP(P, 19)[(size_t)gi * 16 + c];
      cb[c] = make_float2((float)(fr * br - fi * bi), (float)(fr * bi + fi * br));
    }
  }
  if (gt < 8 * 129) {
    const int hd = (int)gt / 129, n = (int)gt - hd * 129;
    int bk = n;
    if (n >= 16) { bk = 16 + (int)(log((double)n / 16.0) / log(8.0) * 16.0); bk = bk < 31 ? bk : 31; }
    ((float*)(ws + OFF_BIAS))[gt] = INP(P, 2)[bk * 8 + hd];
  }
  if (gt < 2) {
    const int l = (int)gt;
    float s1 = 0.f, s2 = 0.f;
    for (int i = 0; i < 64; i++) { s1 += INP(P, 10)[l * 64 + i] * INP(P, 11)[l * 64 + i]; s2 += INP(P, 12)[l * 64 + i] * INP(P, 13)[l * 64 + i]; }
    const float lam_init = 0.8f - 0.6f * expf(-0.3f * (float)l);
    ((float*)(ws + OFF_LAM))[l] = expf(s1) - expf(s2) + lam_init;
  }
}

DI void phase_ffn_up(const u16* __restrict__ Xb, const u16* __restrict__ Wgu, u16* __restrict__ H, int bid, int nb, u16* sm) {
  const int lane = tidx() & 63, wave = tidx() >> 6, wm = wave >> 1, wn = wave & 1, r = lane & 31, hh = lane >> 5;
  gemm_phase(512, 44, 1024, 1024, 1024,
    [&](int tm) { return Xb + (size_t)tm * 128 * 1024; }, [&](int tn) { return Wgu + (size_t)tn * 128 * 1024; },
    [&](f32x16 (&acc)[2][2], int tm, int tn) {
      const int j = tn * 64 + wn * 32 + r;
#pragma unroll
      for (int mi = 0; mi < 2; mi++)
#pragma unroll
        for (int i = 0; i < 16; i++) {
          const int row = tm * 128 + wm * 64 + mi * 32 + crow(i, hh);
          const float g = acc[mi][0][i], u = acc[mi][1][i];
          H[(size_t)row * FF_ + j] = f2bf(g * sigmoidf_(g) * u);
        }
    }, bid, nb, sm);
}

DI void phase_ffn_down(const u16* __restrict__ H, const u16* __restrict__ Wd, const float* xin, float* xout, const u16* __restrict__ ple, int bid, int nb, u16* sm) {
  const int lane = tidx() & 63, wave = tidx() >> 6, wm = wave >> 1, wn = wave & 1, r = lane & 31, hh = lane >> 5;
  gemm_phase(512, 8, FF_, FF_, FF_,
    [&](int tm) { return H + (size_t)tm * 128 * FF_; }, [&](int tn) { return Wd + (size_t)tn * 128 * FF_; },
    [&](f32x16 (&acc)[2][2], int tm, int tn) {
#pragma unroll
      for (int mi = 0; mi < 2; mi++)
#pragma unroll
        for (int ni = 0; ni < 2; ni++)
#pragma unroll
          for (int i = 0; i < 16; i++) {
            const size_t o = (size_t)(tm * 128 + wm * 64 + mi * 32 + crow(i, hh)) * 1024 + tn * 128 + wn * 64 + ni * 32 + r;
            float v = ALPHA_ * xin[o] + 0.5f * acc[mi][ni][i];
            if (ple) v += bf2f(ple[o]);
            xout[o] = v;
          }
    }, bid, nb, sm);
}

DI void phase_w_o(const u16* __restrict__ CC, const u16* __restrict__ Wo, float* x, int bid, int nb, u16* sm) {
  const int lane = tidx() & 63, wave = tidx() >> 6, wm = wave >> 1, wn = wave & 1, r = lane & 31, hh = lane >> 5;
  gemm_phase(512, 8, 1024, 1024, 1024,
    [&](int tm) { return CC + (size_t)tm * 128 * 1024; }, [&](int tn) { return Wo + (size_t)tn * 128 * 1024; },
    [&](f32x16 (&acc)[2][2], int tm, int tn) {
#pragma unroll
      for (int mi = 0; mi < 2; mi++)
#pragma unroll
        for (int ni = 0; ni < 2; ni++)
#pragma unroll
          for (int i = 0; i < 16; i++) {
            const size_t o = (size_t)(tm * 128 + wm * 64 + mi * 32 + crow(i, hh)) * 1024 + tn * 128 + wn * 64 + ni * 32 + r;
            x[o] = ALPHA_ * x[o] + acc[mi][ni][i];
          }
    }, bid, nb, sm);
}

DI void phase_glu(const u16* __restrict__ Yg, const u16* __restrict__ Wglu, u16* __restrict__ CC, int bid, int nb, u16* sm) {
  const int lane = tidx() & 63, wave = tidx() >> 6, wm = wave >> 1, wn = wave & 1, r = lane & 31, hh = lane >> 5;
  gemm_phase(512, 2, 256, 256, 256,
    [&](int tm) { return Yg + (size_t)tm * 128 * 256; }, [&](int tn) { return Wglu + (size_t)tn * 128 * 256; },
    [&](f32x16 (&acc)[2][2], int tm, int tn) {
#pragma unroll
      for (int mi = 0; mi < 2; mi++)
#pragma unroll
        for (int ni = 0; ni < 2; ni++)
#pragma unroll
          for (int i = 0; i < 16; i++) {
            const int row = tm * 128 + wm * 64 + mi * 32 + crow(i, hh), col = tn * 128 + wn * 64 + ni * 32 + r;
            const float y = bf2f(Yg[(size_t)row * 256 + col]);
            CC[(size_t)row * 1024 + 512 + col] = f2bf(y * sigmoidf_(acc[mi][ni][i]));
          }
    }, bid, nb, sm);
}

DI void phase_ple(const u16* __restrict__ Xb, const u16* __restrict__ Wpg, const u16* __restrict__ Pb, const u16* __restrict__ Wpp, u16* ple, int bid, int nb, u16* sm) {
  const int lane = tidx() & 63, wave = tidx() >> 6, wm = wave >> 1, wn = wave & 1, r = lane & 31, hh = lane >> 5;
  gemm_phase(512, 8, 1024, 1024, 1024,
    [&](int tm) { return Xb + (size_t)tm * 128 * 1024; }, [&](int tn) { return Wpg + (size_t)tn * 128 * 1024; },
    [&](f32x16 (&acc)[2][2], int tm, int tn) {
#pragma unroll
      for (int mi = 0; mi < 2; mi++)
#pragma unroll
        for (int ni = 0; ni < 2; ni++)
#pragma unroll
          for (int i = 0; i < 16; i++) {
            const size_t o = (size_t)(tm * 128 + wm * 64 + mi * 32 + crow(i, hh)) * 1024 + tn * 128 + wn * 64 + ni * 32 + r;
            ple[o] = f2bf(sigmoidf_(acc[mi][ni][i]));
          }
    }, bid, nb, sm);
  gemm_phase(512, 8, 256, 256, 256,
    [&](int tm) { return Pb + (size_t)tm * 128 * 256; }, [&](int tn) { return Wpp + (size_t)tn * 128 * 256; },
    [&](f32x16 (&acc)[2][2], int tm, int tn) {
#pragma unroll
      for (int mi = 0; mi < 2; mi++)
#pragma unroll
        for (int ni = 0; ni < 2; ni++)
#pragma unroll
          for (int i = 0; i < 16; i++) {
            const size_t o = (size_t)(tm * 128 + wm * 64 + mi * 32 + crow(i, hh)) * 1024 + tn * 128 + wn * 64 + ni * 32 + r;
            ple[o] = f2bf(acc[mi][ni][i] * bf2f(ple[o]));
          }
    }, bid, nb, sm);
}

DI void phase_w_in(const u16* __restrict__ Xb, const u16* __restrict__ Win, char* mb, int bid, int nb, u16* sm) {
  const int lane = tidx() & 63, wave = tidx() >> 6, wm = wave >> 1, wn = wave & 1, r = lane & 31, hh = lane >> 5;
  u16* Qd = (u16*)(mb + M_QD); u16* Kd = (u16*)(mb + M_KD); u16* Vt = (u16*)(mb + M_VT); float* U = (float*)(mb + M_U);
  u16* Qs = (u16*)(mb + M_QS); u16* Qi = (u16*)(mb + M_QI); u16* Ks = (u16*)(mb + M_KS); u16* Vs = (u16*)(mb + M_VS);
  u16* Ki = (u16*)(mb + M_KI); float* Wi = (float*)(mb + M_WI);
  gemm_phase(512, 20, 1024, 1024, 1024,
    [&](int tm) { return Xb + (size_t)tm * 128 * 1024; }, [&](int tn) { return Win + (size_t)tn * 128 * 1024; },
    [&](f32x16 (&acc)[2][2], int tm, int tn) {
#pragma unroll
    for (int ni = 0; ni < 2; ni++) {
      const int c0 = tn * 128 + wn * 64 + ni * 32;
      const int c = c0 + r;
#pragma unroll
      for (int mi = 0; mi < 2; mi++) {
        const int rowb = tm * 128 + wm * 64 + mi * 32;
        if (c0 >= 1024 && c0 < 1536) {
          const int cc = c - 1024, head = cc >> 7, dv = cc & 127;
          const int b = rowb >> 13, t0 = rowb & 8191;
#pragma unroll
          for (int g4 = 0; g4 < 4; g4++) {
            uint2 v = make_uint2(pack2(acc[mi][ni][4 * g4], acc[mi][ni][4 * g4 + 1]), pack2(acc[mi][ni][4 * g4 + 2], acc[mi][ni][4 * g4 + 3]));
            const int tt = t0 + 8 * g4 + 4 * hh;
            *(uint2*)(Vt + ((size_t)(((b * 4 + head) * 128 + (tt >> 6)) * 128 + dv)) * 64 + (tt & 63)) = v;
          }
        } else {
#pragma unroll
          for (int i = 0; i < 16; i++) {
            const size_t row = rowb + crow(i, hh);
            const float v = acc[mi][ni][i];
            if (c0 < 512) Qd[row * 512 + c] = f2bf(v);
            else if (c0 < 1024) {
              const int cc = c - 512;
              Kd[((size_t)((((int)(row >> 13) * 4 + (cc >> 7)) * 2 + ((cc >> 6) & 1))) * L_ + (row & 8191)) * 64 + (cc & 63)] = f2bf(v);
            }
            else if (c0 < 1792) U[row * 256 + (c - 1536)] = v;
            else if (c0 < 2048) Qs[row * 256 + (c - 1792)] = f2bf(v);
            else if (c0 < 2112) Ks[row * 64 + (c - 2048)] = f2bf(v);
            else if (c0 < 2176) Vs[row * 64 + (c - 2112)] = f2bf(v);
            else if (c0 < 2432) Qi[row * 256 + (c - 2176)] = f2bf(v);
            else if (c0 < 2464) Ki[row * 32 + (c - 2432)] = f2bf(v);
            else if (c0 == 2464) { if (r < 8) Wi[row * 8 + r] = v * 0.0625f; }
          }
        }
      }
    }
  }, bid, nb, sm);
}

DI void phase_ln(float* x, u16* __restrict__ xb, const float* __restrict__ g, const float* __restrict__ bta, int bid, int nb) {
  const int lane = tidx() & 63, wave = tidx() >> 6;
  float4 gg[4], bb[4];
#pragma unroll
  for (int i = 0; i < 4; i++) { gg[i] = *(const float4*)(g + i * 256 + lane * 4); bb[i] = *(const float4*)(bta + i * 256 + lane * 4); }
  constexpr int RB = 4;
  for (int row0 = (bid * 4 + wave) * RB; row0 < T_; row0 += nb * 4 * RB) {
    float4 v[RB][4];
#pragma unroll
    for (int rr = 0; rr < RB; rr++)
#pragma unroll
      for (int i = 0; i < 4; i++) v[rr][i] = *(const float4*)(x + (size_t)(row0 + rr) * 1024 + i * 256 + lane * 4);
    float s[RB], q[RB];
#pragma unroll
    for (int rr = 0; rr < RB; rr++) {
      s[rr] = 0.f;
#pragma unroll
      for (int i = 0; i < 4; i++) s[rr] += v[rr][i].x + v[rr][i].y + v[rr][i].z + v[rr][i].w;
    }
#pragma unroll
    for (int o = 32; o > 0; o >>= 1)
#pragma unroll
      for (int rr = 0; rr < RB; rr++) s[rr] += __shfl_xor(s[rr], o);
#pragma unroll
    for (int rr = 0; rr < RB; rr++) {
      const float mu = s[rr] * (1.f / 1024.f);
      q[rr] = 0.f;
#pragma unroll
      for (int i = 0; i < 4; i++) {
        v[rr][i].x -= mu; v[rr][i].y -= mu; v[rr][i].z -= mu; v[rr][i].w -= mu;
        q[rr] += v[rr][i].x * v[rr][i].x + v[rr][i].y * v[rr][i].y + v[rr][i].z * v[rr][i].z + v[rr][i].w * v[rr][i].w;
      }
    }
#pragma unroll
    for (int o = 32; o > 0; o >>= 1)
#pragma unroll
      for (int rr = 0; rr < RB; rr++) q[rr] += __shfl_xor(q[rr], o);
#pragma unroll
    for (int rr = 0; rr < RB; rr++) {
      const float rs = rsqrtf(q[rr] * (1.f / 1024.f) + LN_EPS_);
#pragma unroll
      for (int i = 0; i < 4; i++) {
        float4 o;
        o.x = v[rr][i].x * rs * gg[i].x + bb[i].x; o.y = v[rr][i].y * rs * gg[i].y + bb[i].y;
        o.z = v[rr][i].z * rs * gg[i].z + bb[i].z; o.w = v[rr][i].w * rs * gg[i].w + bb[i].w;
        *(float4*)(x + (size_t)(row0 + rr) * 1024 + i * 256 + lane * 4) = o;
        *(uint2*)(xb + (size_t)(row0 + rr) * 1024 + i * 256 + lane * 4) = make_uint2(pack2(o.x, o.y), pack2(o.z, o.w));
      }
    }
  }
}

DI float gelu_tanh(float x) { const float u = 0.7978845608028654f * (x + 0.044715f * x * x * x); return 0.5f * x * (1.f + tanhf(u)); }

typedef __attribute__((ext_vector_type(4))) float f32x4;
template <bool OUT>
DI void ssm_scan(const Params& P, int layer, int widx, char* mb, char* smem) {
  const int lane = tidx() & 63, wave = tidx() >> 6;
  const int b = widx >> 8, g = (widx >> 4) & 15, ch = widx & 15;
  const int gi = (layer * 16 + g) * 64 + lane;
  const float4 ca = ((const float4*)(WS(P) + OFF_COEFA))[gi];
  const float2* cbp = (const float2*)(WS(P) + OFF_COEFB) + (size_t)gi * 16;
  float bre[16], bim[16];
#pragma unroll
  for (int c = 0; c < 16; c++) { float2 t = cbp[c]; bre[c] = t.x; bim[c] = t.y; }
  const float* U = (const float*)(mb + M_U);
  float2* Send = (float2*)(mb + M_SEND);
  const size_t sbase = (size_t)((b * 16 + g) * 16) * 64 + lane;
  float xr = 0.f, xi = 0.f;
  float am[32];
  float4 dsk4 = make_float4(0.f, 0.f, 0.f, 0.f);
  float* Xs = (float*)smem + wave * (128 * 17);
  const int lm = lane & 15, lq = lane >> 4;
  if (OUT) {
    for (int j = 0; j < ch; j++) {
      const float2 e = Send[sbase + (size_t)j * 64];
      const float nr = ca.z * xr - ca.w * xi + e.x, ni = ca.z * xi + ca.w * xr + e.y;
      xr = nr; xi = ni;
    }
    const float* cre = INP(P, 20) + ((size_t)(layer * 16 + g) * 16 + lm) * 64;
    const float* cim = INP(P, 21) + ((size_t)(layer * 16 + g) * 16 + lm) * 64;
#pragma unroll
    for (int kb = 0; kb < 32; kb++) {
      const int kk = 4 * kb + lq;
      am[kb] = (kb < 16) ? cre[kk] : -cim[kk - 64];
    }
    dsk4 = *(const float4*)(INP(P, 22) + layer * 256 + g * 16 + 4 * lq);
  }
  u16* Yg = (u16*)(mb + M_YG);
  const size_t tok0 = (size_t)b * L_ + ch * 512;
  const float* ub = U + (tok0 + (lane >> 2)) * 256 + g * 16 + (lane & 3) * 4;
  float4 cur = *(const float4*)ub;
#pragma unroll 1
  for (int blk = 0; blk < 32; blk++) {
    const float4 nxt = *(const float4*)(ub + (size_t)min(blk + 1, 31) * 16 * 256);
#pragma unroll
    for (int s16 = 0; s16 < 16; s16++) {
      float uu[16];
#pragma unroll
      for (int c = 0; c < 16; c++) {
        const float comp = ((c & 3) == 0) ? cur.x : ((c & 3) == 1) ? cur.y : ((c & 3) == 2) ? cur.z : cur.w;
        uu[c] = __int_as_float(__builtin_amdgcn_readlane(__float_as_int(comp), 4 * s16 + (c >> 2)));
      }
      float br4[4] = {0.f, 0.f, 0.f, 0.f}, bi4[4] = {0.f, 0.f, 0.f, 0.f};
#pragma unroll
      for (int c = 0; c < 16; c++) { br4[c & 3] += bre[c] * uu[c]; bi4[c & 3] += bim[c] * uu[c]; }
      const float br = (br4[0] + br4[1]) + (br4[2] + br4[3]), bi = (bi4[0] + bi4[1]) + (bi4[2] + bi4[3]);
      const float nr = ca.x * xr - ca.y * xi + br, ni = ca.x * xi + ca.y * xr + bi;
      xr = nr; xi = ni;
      if (OUT) { Xs[lane * 17 + s16] = xr; Xs[(64 + lane) * 17 + s16] = xi; }
    }
    if (OUT) {
      __builtin_amdgcn_wave_barrier();
      f32x4 acc = {0.f, 0.f, 0.f, 0.f}, acc2 = {0.f, 0.f, 0.f, 0.f};
#pragma unroll
      for (int kb = 0; kb < 32; kb += 2) {
        const float bv0 = Xs[(4 * kb + lq) * 17 + lm], bv1 = Xs[(4 * kb + 4 + lq) * 17 + lm];
        acc = __builtin_amdgcn_mfma_f32_16x16x4f32(am[kb], bv0, acc, 0, 0, 0);
        acc2 = __builtin_amdgcn_mfma_f32_16x16x4f32(am[kb + 1], bv1, acc2, 0, 0, 0);
      }
      acc += acc2;
      __builtin_amdgcn_wave_barrier();
      const size_t tok = tok0 + blk * 16 + lm;
      const float4 u4 = *(const float4*)(U + tok * 256 + g * 16 + 4 * lq);
      const float y0 = gelu_tanh(acc[0] + dsk4.x * u4.x), y1 = gelu_tanh(acc[1] + dsk4.y * u4.y);
      const float y2 = gelu_tanh(acc[2] + dsk4.z * u4.z), y3 = gelu_tanh(acc[3] + dsk4.w * u4.w);
      *(uint2*)(Yg + tok * 256 + g * 16 + 4 * lq) = make_uint2(pack2(y0, y1), pack2(y2, y3));
    }
    cur = nxt;
  }
  if (!OUT) Send[sbase + (size_t)ch * 64] = make_float2(xr, xi);
}

constexpr int KS_ = 72, VS_ = 68;
DI void da_item(const Params& P, int layer, int b, int h, int qt, char* mb, char* smem) {
  const int tid = tidx(), lane = tid & 63, wave = tid >> 6, r = lane & 31, hh = lane >> 5;
  u16* sK = (u16*)smem;
  u16* sV = sK + 64 * KS_;
  float* sbias = (float*)(sV + 128 * VS_);
  u16* sQw = (u16*)(smem + 28672) + (tidx() >> 6) * 32 * KS_;
  const u16* Qd = (const u16*)(mb + M_QD); const u16* Kd = (const u16*)(mb + M_KD); const u16* Vt = (const u16*)(mb + M_VT);
  u16* CC = (u16*)(WS(P) + OFF_CC);
  const int q0 = qt * 128, qw = q0 + wave * 32, qp = qw + r;
  const size_t tokq = (size_t)b * L_ + qp;
  __syncthreads();
  if (tid < 129) sbias[tid] = ((const float*)(WS(P) + OFF_BIAS))[h * 129 + tid] * LOG2E_;
  __syncthreads();
  const float bfar = sbias[128];
  const float SC = 0.125f * LOG2E_;
  const int nkt = (q0 + 128) >> 6;
  const float lam = ((const float*)(WS(P) + OFF_LAM))[layer];
  const int krow_l = tid >> 3, kch = (tid & 7) * 8;
#pragma unroll 1
  for (int c = 0; c < 2; c++) {
#pragma unroll
    for (int ks = 0; ks < 4; ks++) *(bf16x8*)(sQw + r * KS_ + ks * 16 + hh * 8) = *(const bf16x8*)(Qd + tokq * 512 + h * 128 + c * 64 + ks * 16 + hh * 8);
    f32x16 o[4] = {zero16(), zero16(), zero16(), zero16()};
    float m = -INFINITY, l = 0.f;
    const u16* Kbase = Kd + ((size_t)(((b * 4 + h) * 2 + c)) * L_ + krow_l) * 64 + kch;
    const u16* Vbase = Vt + ((size_t)((b * 4 + h) * 128) * 128 + krow_l) * 64 + kch;
    u32x4 rk[2], rv[4];
#pragma unroll
    for (int i = 0; i < 2; i++) rk[i] = *(const u32x4*)(Kbase + (size_t)(i * 32) * 64);
#pragma unroll
    for (int i = 0; i < 4; i++) rv[i] = *(const u32x4*)(Vbase + (size_t)(i * 32) * 64);
#pragma unroll 1
    for (int kt = 0; kt < nkt; kt++) {
      __syncthreads();
#pragma unroll
      for (int i = 0; i < 2; i++) *(u32x4*)(sK + (krow_l + i * 32) * KS_ + kch) = rk[i];
#pragma unroll
      for (int i = 0; i < 4; i++) {
        u32x2* d = (u32x2*)(sV + (krow_l + i * 32) * VS_ + kch);
        u32x2 lo2, hi2; lo2.x = rv[i].x; lo2.y = rv[i].y; hi2.x = rv[i].z; hi2.y = rv[i].w;
        d[0] = lo2; d[1] = hi2;
      }
      __syncthreads();
      {
        const int ktn = min(kt + 1, nkt - 1);
#pragma unroll
        for (int i = 0; i < 2; i++) rk[i] = *(const u32x4*)(Kbase + (size_t)(ktn * 64 + i * 32) * 64);
#pragma unroll
        for (int i = 0; i < 4; i++) rv[i] = *(const u32x4*)(Vbase + (size_t)ktn * 8192 + (size_t)(i * 32) * 64);
      }
      if (kt * 64 <= qw + 31) {
        f32x16 s[2];
#pragma unroll
        for (int kb = 0; kb < 2; kb++) {
          s[kb] = zero16();
#pragma unroll
          for (int ks = 0; ks < 4; ks++) {
            const bf16x8 kf = *(const bf16x8*)(sK + (kb * 32 + r) * KS_ + ks * 16 + hh * 8);
            const bf16x8 qf = *(const bf16x8*)(sQw + r * KS_ + ks * 16 + hh * 8);
            s[kb] = MFMA32(kf, qf, s[kb]);
          }
        }
        const bool nearb = (kt * 64 + 63 + 128 > qw);
        float mx = -INFINITY;
        if (nearb) {
#pragma unroll
          for (int kb = 0; kb < 2; kb++)
#pragma unroll
            for (int i = 0; i < 16; i++) {
              const int dist = qp - (kt * 64 + kb * 32 + crow(i, hh));
              const float bv = sbias[min(max(dist, 0), 128)];
              float t = s[kb][i] * SC + bv;
              t = (dist >= 0) ? t : -INFINITY;
              s[kb][i] = t; mx = fmaxf(mx, t);
              if ((i & 7) == 7) __builtin_amdgcn_sched_barrier(0);
            }
        } else {
#pragma unroll
          for (int kb = 0; kb < 2; kb++)
#pragma unroll
            for (int i = 0; i < 16; i++) { const float t = s[kb][i] * SC + bfar; s[kb][i] = t; mx = fmaxf(mx, t); }
        }
        mx = fmaxf(mx, __shfl_xor(mx, 32));
        const float mn = fmaxf(m, mx);
        const float corr = __builtin_amdgcn_exp2f(m - mn);
        m = mn;
        float ls = 0.f;
#pragma unroll
        for (int kb = 0; kb < 2; kb++)
#pragma unroll
          for (int i = 0; i < 16; i++) { const float p = __builtin_amdgcn_exp2f(s[kb][i] - mn); s[kb][i] = p; ls += p; }
        l = l * corr + ls;
        if (__ballot(corr != 1.f) != 0ull) {
#pragma unroll
          for (int dt = 0; dt < 4; dt++)
#pragma unroll
            for (int i = 0; i < 16; i++) o[dt][i] *= corr;
        }
#pragma unroll
        for (int kb = 0; kb < 2; kb++)
#pragma unroll
          for (int s2 = 0; s2 < 2; s2++) {
            const bf16x8 pf = pack8(s[kb], s2);
#pragma unroll
            for (int dt = 0; dt < 4; dt++) {
              const u16* vp = sV + (dt * 32 + r) * VS_ + kb * 32 + s2 * 16 + 4 * hh;
              const s16x4 lo = *(const s16x4*)vp, hi = *(const s16x4*)(vp + 8);
              const bf16x8 vf = __builtin_shufflevector(lo, hi, 0, 1, 2, 3, 4, 5, 6, 7);
              o[dt] = MFMA32(vf, pf, o[dt]);
            }
            __builtin_amdgcn_sched_barrier(0);
          }
      }
    }
    const float lt = l + __shfl_xor(l, 32);
    const float inv = 1.f / lt;
    size_t tq = tokq;
    asm volatile("" : "+v"(tq));
    u16* obase = CC + tq * 1024 + h * 128 + 4 * hh;
    if (c == 0) {
#pragma unroll
      for (int dt = 0; dt < 4; dt++)
#pragma unroll
        for (int g4 = 0; g4 < 4; g4++) {
          *(uint2*)(obase + dt * 32 + 8 * g4) = make_uint2(pack2(o[dt][4 * g4] * inv, o[dt][4 * g4 + 1] * inv), pack2(o[dt][4 * g4 + 2] * inv, o[dt][4 * g4 + 3] * inv));
        }
    } else {
      float ss = 0.f;
#pragma unroll
      for (int dt = 0; dt < 4; dt++)
#pragma unroll
        for (int g4 = 0; g4 < 4; g4++) {
          const uint2 pv = *(const uint2*)(obase + dt * 32 + 8 * g4);
          const float a4[4] = {bf2f((u16)(pv.x & 0xffff)), bf2f((u16)(pv.x >> 16)), bf2f((u16)(pv.y & 0xffff)), bf2f((u16)(pv.y >> 16))};
#pragma unroll
          for (int e = 0; e < 4; e++) { const float v = a4[e] - lam * o[dt][4 * g4 + e] * inv; o[dt][4 * g4 + e] = v; ss = __builtin_fmaf(v, v, ss); }
        }
      ss += __shfl_xor(ss, 32);
      const float lam_init = 0.8f - 0.6f * __expf(-0.3f * (float)layer);
      const float rn = rsqrtf(ss * (1.f / 128.f) + LN_EPS_) * (1.f - lam_init);
      int hh2 = hh;
      asm volatile("" : "+v"(hh2));
      const float* sg = INP(P, 14) + layer * 128 + 4 * hh2;
#pragma unroll
      for (int dt = 0; dt < 4; dt++)
#pragma unroll
        for (int g4 = 0; g4 < 4; g4++) {
          const int dv = dt * 32 + 8 * g4 + 4 * hh;
          const float4 gv = *(const float4*)(sg + dt * 32 + 8 * g4);
          uint2 w = make_uint2(pack2(o[dt][4 * g4] * rn * gv.x, o[dt][4 * g4 + 1] * rn * gv.y),
                               pack2(o[dt][4 * g4 + 2] * rn * gv.z, o[dt][4 * g4 + 3] * rn * gv.w));
          *(uint2*)(obase + dv - 4 * hh) = w;
        }
    }
  }
}

DI unsigned sortkey(float f) { const unsigned u = __float_as_uint(f + 0.f); return u ^ (((unsigned)((int)u >> 31)) | 0x80000000u); }

DI void dsa_item(const Params& P, int layer, int b, int qt, char* mb, char* smem) {
  const int tid = tidx(), lane = tid & 63, wave = tid >> 6, r = lane & 31, hh = lane >> 5;
  unsigned* hist = (unsigned*)smem;
  float* sP = (float*)smem;
  float* sQ = (float*)(smem + 16384);
  u16* sidx = (u16*)(smem + 32896);
  unsigned* meta = (unsigned*)(smem + 49280);
  float* sbias = (float*)(smem + 50304);
  const u16* Qi = (const u16*)(mb + M_QI); const u16* Ki = (const u16*)(mb + M_KI); const float* Wi = (const float*)(mb + M_WI);
  const u16* Qs = (const u16*)(mb + M_QS); const u16* Ks = (const u16*)(mb + M_KS); const u16* Vs = (const u16*)(mb + M_VS);
  u16* CC = (u16*)(WS(P) + OFF_CC);
  const int q0 = qt * 32;
  const int qp = q0 + r;
  const size_t tokb = (size_t)b * L_;
  const int nk32 = qt + 1;
  const bool radix = (q0 >= 256);
  __syncthreads();
  for (int i = tid; i < 4 * 129; i += 256) sbias[i] = ((const float*)(WS(P) + OFF_BIAS))[4 * 129 + i];
  meta[tid] = (tid >= 32 && tid < 64) ? 256u : 0u;
  char* sQi = smem + 52384;
  float* sWi = (float*)(smem + 69280);
  constexpr int CAPL_ = 64;
  unsigned* lK = (unsigned*)smem;
  u16* lI = (u16*)(smem + 32 * CAPL_ * 4);
  {
    const int row = tid >> 3, ch = tid & 7;
    const uint4* src = (const uint4*)(Qi + (tokb + q0 + row) * 256 + ch * 32);
    uint4* dst = (uint4*)(sQi + row * 528 + ch * 64);
    dst[0] = src[0]; dst[1] = src[1]; dst[2] = src[2]; dst[3] = src[3];
    sWi[tid] = Wi[(tokb + q0) * 8 + tid];
  }
  int pass = radix ? 0 : 4;
  bool fast = false;
#pragma unroll 1
  while (true) {
    __syncthreads();
    if (pass < 4) { for (int i = tid; i < 32 * 257; i += 256) hist[i] = 0u; }
    __syncthreads();
    const unsigned pref = meta[r];
    const unsigned krem = meta[32 + r];
    auto elems = [&](const f32x16& sc, const int kt, const int lim) __attribute__((always_inline)) {
      if (pass == 0) {
#pragma unroll
        for (int i = 0; i < 16; i++) {
          const int kp = kt * 32 + crow(i, hh);
          const unsigned key = sortkey(sc[i]);
          const unsigned bin = (kp <= lim) ? (key >> 24) : 256u;
          atomicAdd(&hist[r * 257 + bin], 1u);
        }
      } else if (pass < 4) {
        const int sh = 24 - 8 * pass;
#pragma unroll
        for (int i = 0; i < 16; i++) {
          const int kp = kt * 32 + crow(i, hh);
          const unsigned key = sortkey(sc[i]);
          if ((key >> (sh + 8)) == pref && kp <= lim) atomicAdd(&hist[r * 257 + ((key >> sh) & 255u)], 1u);
        }
      } else if (pass == 5) {
        unsigned mc = 0u, ms = 0u;
        unsigned keys[16];
#pragma unroll
        for (int i = 0; i < 16; i++) {
          const int kp = kt * 32 + crow(i, hh);
          keys[i] = sortkey(sc[i]);
          const unsigned bt = keys[i] >> 16;
          const bool valid = (kp <= lim);
          ms |= (valid && bt > pref) ? (1u << i) : 0u;
          mc |= (valid && bt == pref) ? (1u << i) : 0u;
        }
        unsigned base_c = 0u, base_s = 0u;
        if (mc) base_c = atomicAdd(&meta[128 + r], (unsigned)__popc(mc));
        if (ms) base_s = atomicAdd(&meta[64 + r], (unsigned)__popc(ms));
#pragma unroll
        for (int i = 0; i < 16; i++) {
          const int kp = kt * 32 + crow(i, hh);
          if ((mc >> i) & 1u) {
            const unsigned cp = base_c + (unsigned)__popc(mc & ((1u << i) - 1u));
            if (cp < (unsigned)CAPL_) { lK[r * CAPL_ + cp] = keys[i]; lI[r * CAPL_ + cp] = (u16)kp; }
          }
          if ((ms >> i) & 1u) {
            const unsigned pos = base_s + (unsigned)__popc(ms & ((1u << i) - 1u));
            if (pos < 256u) sidx[r * 256 + pos] = (u16)kp;
          }
        }
      } else {
#pragma unroll
        for (int i = 0; i < 16; i++) {
          const int kp = kt * 32 + crow(i, hh);
          const unsigned key = sortkey(sc[i]);
          bool sel = (kp <= lim);
          if (radix) {
            sel = sel && (key >= pref);
            if (sel && key == pref) sel = atomicAdd(&meta[96 + r], 1u) < krem;
          }
          if (sel) { const unsigned pos = atomicAdd(&meta[64 + r], 1u); if (pos < 256u) sidx[r * 256 + pos] = (u16)kp; }
        }
      }
    };
    const int klast = nk32 - 1;
    bf16x8 nA0 = {0, 0, 0, 0, 0, 0, 0, 0}, nA1 = nA0, nB0 = nA0, nB1 = nA0;
    if (wave < nk32) {
      const int ka = wave, kb2 = min(wave + 4, klast);
      nA0 = *(const bf16x8*)(Ki + (tokb + ka * 32 + r) * 32 + hh * 8);
      nA1 = *(const bf16x8*)(Ki + (tokb + ka * 32 + r) * 32 + 16 + hh * 8);
      nB0 = *(const bf16x8*)(Ki + (tokb + kb2 * 32 + r) * 32 + hh * 8);
      nB1 = *(const bf16x8*)(Ki + (tokb + kb2 * 32 + r) * 32 + 16 + hh * 8);
    }
#pragma unroll 1
    for (int kt = wave; kt < nk32; kt += 8) {
      const bf16x8 kA0 = nA0, kA1 = nA1, kB0 = nB0, kB1 = nB1;
      {
        const int ka = min(kt + 8, klast), kb2 = min(kt + 12, klast);
        nA0 = *(const bf16x8*)(Ki + (tokb + ka * 32 + r) * 32 + hh * 8);
        nA1 = *(const bf16x8*)(Ki + (tokb + ka * 32 + r) * 32 + 16 + hh * 8);
        nB0 = *(const bf16x8*)(Ki + (tokb + kb2 * 32 + r) * 32 + hh * 8);
        nB1 = *(const bf16x8*)(Ki + (tokb + kb2 * 32 + r) * 32 + 16 + hh * 8);
      }
      f32x16 scA = zero16(), scB = zero16();
#pragma unroll 2
      for (int hd = 0; hd < 8; hd++) {
        const bf16x8 q0f = *(const bf16x8*)(sQi + r * 528 + hd * 64 + hh * 16);
        const bf16x8 q1f = *(const bf16x8*)(sQi + r * 528 + hd * 64 + 32 + hh * 16);
        const float w = sWi[r * 8 + hd];
        f32x16 sa = MFMA32(kA0, q0f, zero16());
        f32x16 sb = MFMA32(kB0, q0f, zero16());
        sa = MFMA32(kA1, q1f, sa);
        sb = MFMA32(kB1, q1f, sb);
#pragma unroll
        for (int i = 0; i < 16; i++) {
          scA[i] += __int_as_float(max(__float_as_int(sa[i]), 0)) * w;
          scB[i] += __int_as_float(max(__float_as_int(sb[i]), 0)) * w;
        }
      }
      elems(scA, kt, (kt == qt) ? qp : 0x7fffffff);
      if (kt + 4 < nk32) elems(scB, kt + 4, (kt + 4 == qt) ? qp : 0x7fffffff);
    }
    __syncthreads();
    if (pass < 4) {
      for (int j = 0; j < 8; j++) {
        const int qq = wave * 8 + j;
        const unsigned k = meta[32 + qq];
        unsigned c4[4]; unsigned tot = 0;
#pragma unroll
        for (int e = 0; e < 4; e++) { c4[e] = hist[qq * 257 + 255 - 4 * lane - e]; tot += c4[e]; }
        unsigned incl = tot;
        for (int o = 1; o < 64; o <<= 1) { const unsigned t = __shfl_up(incl, o); if (lane >= o) incl += t; }
        unsigned run = incl - tot;
#pragma unroll
        for (int e = 0; e < 4; e++) {
          if (run < k && run + c4[e] >= k) {
            meta[qq] = (meta[qq] << 8) | (unsigned)(255 - 4 * lane - e); meta[32 + qq] = k - run;
            if (pass == 1 && c4[e] > (unsigned)CAPL_) meta[192] = 1u;
          }
          run += c4[e];
        }
      }
    }
    if (pass >= 4) break;
    if (pass == 1) { __syncthreads(); fast = (meta[192] == 0u); pass = fast ? 5 : 2; } else pass++;
  }
  __syncthreads();
  if (fast) {
#pragma unroll 1
    for (int j = 0; j < 8; j++) {
      const int qq = wave * 8 + j;
      const int c = min((int)meta[128 + qq], CAPL_);
      const unsigned k = meta[32 + qq];
      const bool in = lane < c;
      const unsigned mykey = in ? lK[qq * CAPL_ + lane] : 0u;
      const unsigned myidx = in ? (unsigned)lI[qq * CAPL_ + lane] : 0u;
      unsigned rank = 0u;
      for (int t = 0; t < c; t++) {
        const unsigned ok = __shfl(mykey, t);
        rank += (ok > mykey || (ok == mykey && t < lane)) ? 1u : 0u;
      }
      const bool sel = in && (rank < k);
      const unsigned long long m = __ballot(sel);
      const unsigned base = meta[64 + qq];
      if (sel) {
        const unsigned pos = base + (unsigned)__popcll(m & ((1ull << lane) - 1ull));
        if (pos < 256u) sidx[qq * 256 + pos] = (u16)myidx;
      }
      __builtin_amdgcn_wave_barrier();
      if (lane == 0) meta[64 + qq] = base + (unsigned)__popcll(m);
    }
    __syncthreads();
  }
  float* myP = sP + wave * 1024;
  (void)sQ;
#pragma unroll 1
  for (int j = 0; j < 8; j++) {
    const int qq = wave * 8 + j;
    const int qpos = q0 + qq;
    const size_t tok = tokb + qpos;
    const int n = min((int)meta[64 + qq], 256);
    __syncthreads();
    bf16x8 qf[4];
#pragma unroll
    for (int ks = 0; ks < 4; ks++) {
      bf16x8 z = {0, 0, 0, 0, 0, 0, 0, 0};
      if (r < 4) z = *(const bf16x8*)(Qs + tok * 256 + r * 64 + ks * 16 + hh * 8);
      qf[ks] = z;
    }
#pragma unroll 4
    for (int kb = 0; kb < 8; kb++) {
      const int jj = kb * 32 + r;
      const int kidx = (jj < n) ? (int)sidx[qq * 256 + jj] : 0;
      const u16* kp = Ks + (tokb + kidx) * 64 + hh * 8;
      bf16x8 kf[4];
#pragma unroll
      for (int ks = 0; ks < 4; ks++) kf[ks] = *(const bf16x8*)(kp + ks * 16);
      f32x16 sacc = zero16();
#pragma unroll
      for (int ks = 0; ks < 4; ks++) sacc = MFMA32(kf[ks], qf[ks], sacc);
      if (r < 4) {
#pragma unroll
        for (int i = 0; i < 16; i++) myP[(kb * 32 + crow(i, hh)) * 4 + r] = sacc[i];
      }
    }
    __syncthreads();
    float sc[4][4];
#pragma unroll
    for (int rd = 0; rd < 4; rd++) {
      const int jj = rd * 64 + lane;
      const bool valid = jj < n;
      const int kidx = valid ? (int)sidx[qq * 256 + jj] : 0;
      const int dist = min(max(qpos - kidx, 0), 128);
      const float4 d = *(const float4*)(myP + jj * 4);
      sc[rd][0] = valid ? d.x * 0.125f + sbias[0 * 129 + dist] : -INFINITY;
      sc[rd][1] = valid ? d.y * 0.125f + sbias[1 * 129 + dist] : -INFINITY;
      sc[rd][2] = valid ? d.z * 0.125f + sbias[2 * 129 + dist] : -INFINITY;
      sc[rd][3] = valid ? d.w * 0.125f + sbias[3 * 129 + dist] : -INFINITY;
    }
#pragma unroll
    for (int hd = 0; hd < 4; hd++) {
      float mx = fmaxf(fmaxf(sc[0][hd], sc[1][hd]), fmaxf(sc[2][hd], sc[3][hd]));
      mx = wave_max(mx);
      float sm = 0.f;
#pragma unroll
      for (int rd = 0; rd < 4; rd++) { sc[rd][hd] = __expf(sc[rd][hd] - mx); sm += sc[rd][hd]; }
      sm = wave_sum(sm);
      const float inv = 1.f / sm;
#pragma unroll
      for (int rd = 0; rd < 4; rd++) sc[rd][hd] *= inv;
    }
#pragma unroll
    for (int rd = 0; rd < 4; rd++) *(float4*)(myP + (rd * 64 + lane) * 4) = make_float4(sc[rd][0], sc[rd][1], sc[rd][2], sc[rd][3]);
    __syncthreads();
    const int g = lane >> 3, c8 = lane & 7;
    float acc[32];
#pragma unroll
    for (int i = 0; i < 32; i++) acc[i] = 0.f;
#pragma unroll 16
    for (int it = 0; it < 32; it++) {
      const int jj = it * 8 + g;
      const int kidx = (jj < n) ? (int)sidx[qq * 256 + jj] : 0;
      const float4 pj = *(const float4*)(myP + jj * 4);
      const u32x4 vv = *(const u32x4*)(Vs + (tokb + kidx) * 64 + c8 * 8);
      const float vf[8] = {bf2f((u16)(vv.x & 0xffff)), bf2f((u16)(vv.x >> 16)), bf2f((u16)(vv.y & 0xffff)), bf2f((u16)(vv.y >> 16)),
                           bf2f((u16)(vv.z & 0xffff)), bf2f((u16)(vv.z >> 16)), bf2f((u16)(vv.w & 0xffff)), bf2f((u16)(vv.w >> 16))};
#pragma unroll
      for (int e = 0; e < 8; e++) {
        acc[0 * 8 + e] += pj.x * vf[e]; acc[1 * 8 + e] += pj.y * vf[e];
        acc[2 * 8 + e] += pj.z * vf[e]; acc[3 * 8 + e] += pj.w * vf[e];
      }
    }
    const bool b5 = lane & 32, b4 = lane & 16, b3 = lane & 8;
    float w16[16], w8[8], w4[4];
#pragma unroll
    for (int i = 0; i < 16; i++) { const float snd = b5 ? acc[i] : acc[i + 16]; const float rcv = __shfl_xor(snd, 32); w16[i] = (b5 ? acc[i + 16] : acc[i]) + rcv; }
#pragma unroll
    for (int i = 0; i < 8; i++) { const float snd = b4 ? w16[i] : w16[i + 8]; const float rcv = __shfl_xor(snd, 16); w8[i] = (b4 ? w16[i + 8] : w16[i]) + rcv; }
#pragma unroll
    for (int i = 0; i < 4; i++) { const float snd = b3 ? w8[i] : w8[i + 4]; const float rcv = __shfl_xor(snd, 8); w4[i] = (b3 ? w8[i + 4] : w8[i]) + rcv; }
    const int hd = (b5 ? 2 : 0) + (b4 ? 1 : 0);
    *(uint2*)(CC + tok * 1024 + 768 + hd * 64 + c8 * 8 + (b3 ? 4 : 0)) = make_uint2(pack2(w4[0], w4[1]), pack2(w4[2], w4[3]));
  }
}

DI void phase_mix1(const Params& P, int layer, int bid, int nb, char* smem) {
  char* mb = WS(P) + OFF_H;
  for (int w = bid * 4 + (tidx() >> 6); w < 2048; w += nb * 4) ssm_scan<false>(P, layer, w, mb, smem);
  for (int j = 0;; j++) {
    const int idx = (j & 1) ? (j * nb + (nb - 1 - bid)) : (j * nb + bid);
    if (j * nb >= 2048) break;
    if (idx >= 2048) continue;
    const int qt = 255 - (idx >> 3), b = idx & 7;
    dsa_item(P, layer, b, qt, mb, smem);
  }
  for (int j = 0;; j++) {
    const int idx = (j & 1) ? (j * nb + (nb - 1 - bid)) : (j * nb + bid);
    if (j * nb >= 2048) break;
    if (idx >= 2048) continue;
    const int qt = 63 - (idx >> 5), bh = idx & 31;
    da_item(P, layer, bh >> 2, bh & 3, qt, mb, smem);
  }
}

DI void phase_mix2(const Params& P, int layer, int bid, int nb, char* smem) {
  char* mb = WS(P) + OFF_H;
  for (int w = bid * 4 + (tidx() >> 6); w < 2048; w += nb * 4) ssm_scan<true>(P, layer, w, mb, smem);
}

DI void run_phase(const Params& P, int ph, int bid, int nb, char* smem) {
  char* ws = WS(P);
  u16* sm = (u16*)smem;
  if (ph == 0) { phase_prep(P, bid, nb, smem); return; }
  const int l = (ph - 1) / 12, s = (ph - 1) % 12;
  u16* Xb = (u16*)(ws + OFF_XB);
  u16* H = (u16*)(ws + OFF_H);
  u16* CC = (u16*)(ws + OFF_CC);
  float* X = OUTP(P);
  switch (s) {
    case 0: phase_ffn_up(Xb, (const u16*)(ws + OFF_WGU1 + l * SZ_WGU), H, bid, nb, sm); break;
    case 1: phase_ffn_down(H, (const u16*)(ws + OFF_WD1 + l * SZ_WD), (l == 0) ? INP(P, 0) : (const float*)X, X, nullptr, bid, nb, sm); break;
    case 2: phase_ln(X, Xb, INP(P, 6) + l * 1024, INP(P, 7) + l * 1024, bid, nb); break;
    case 3: phase_w_in(Xb, (const u16*)(ws + OFF_WIN + l * SZ_WIN), ws + OFF_H, bid, nb, sm); break;
    case 4: phase_mix1(P, l, bid, nb, smem); break;
    case 5: phase_mix2(P, l, bid, nb, smem); break;
    case 6: phase_glu((const u16*)(ws + OFF_H + M_YG), (const u16*)(ws + OFF_WGLU + l * SZ_WGLU), CC, bid, nb, sm); break;
    case 7: phase_w_o(CC, (const u16*)(ws + OFF_WO + l * SZ_WO), X, bid, nb, sm); break;
    case 8: phase_ln(X, Xb, INP(P, 24) + l * 1024, INP(P, 25) + l * 1024, bid, nb); break;
    case 9:
      phase_ffn_up(Xb, (const u16*)(ws + OFF_WGU2 + l * SZ_WGU), H, bid, nb, sm);
      phase_ple(Xb, (const u16*)(ws + OFF_WPG + l * SZ_WPG), (const u16*)(ws + OFF_PB) + (size_t)l * T_ * 256, (const u16*)(ws + OFF_WPP + l * SZ_WPP), CC, bid, nb, sm);
      break;
    case 10: phase_ffn_down(H, (const u16*)(ws + OFF_WD2 + l * SZ_WD), X, X, CC, bid, nb, sm); break;
    case 11: phase_ln(X, Xb, INP(P, 31) + l * 1024, INP(P, 32) + l * 1024, bid, nb); break;
  }
}

constexpr int NPHASES = 25;

__global__ void __launch_bounds__(256, 2) mega(Params P, int ph0, int ph1) {
  extern __shared__ __attribute__((aligned(16))) char smem[];
  cg::grid_group grid = cg::this_grid();
  const int bid = blockIdx.x, nb = gridDim.x;
#ifndef DUP_MASK
#define DUP_MASK 0
#endif
#define PHASE(k) if (ph0 <= (k) && (k) < ph1) { \
    if ((k) > 0 && ((DUP_MASK >> (((k) - 1) % 12)) & 1)) { run_phase(P, (k), bid, nb, smem); grid.sync(); } \
    run_phase(P, (k), bid, nb, smem); if ((k) + 1 < ph1) grid.sync(); }
  PHASE(0) PHASE(1) PHASE(2) PHASE(3) PHASE(4) PHASE(5) PHASE(6) PHASE(7) PHASE(8) PHASE(9) PHASE(10) PHASE(11) PHASE(12)
  PHASE(13) PHASE(14) PHASE(15) PHASE(16) PHASE(17) PHASE(18) PHASE(19) PHASE(20) PHASE(21) PHASE(22) PHASE(23) PHASE(24)
#undef PHASE
}

extern "C" void kernel_launch(void* const* d_in, const int* in_sizes, int n_in, void* d_out, int out_size, void* d_ws, size_t ws_size, hipStream_t stream) {
  static int grid_blocks = 0;
  if (grid_blocks == 0) {
    if (n_in != 33 || ws_size < WS_END) { fprintf(stderr, "kernel_launch: need 33 inputs and %zu bytes of ws (got %d, %zu)\n", (size_t)WS_END, n_in, ws_size); grid_blocks = -1; return; }
    int dev = 0, cus = 0, per_cu = 0;
    (void)hipGetDevice(&dev);
    (void)hipDeviceGetAttribute(&cus, hipDeviceAttributeMultiprocessorCount, dev);
    (void)hipFuncSetAttribute((const void*)mega, hipFuncAttributeMaxDynamicSharedMemorySize, LDS_BYTES);
    (void)hipOccupancyMaxActiveBlocksPerMultiprocessor(&per_cu, (const void*)mega, 256, LDS_BYTES);
    if (per_cu < 1) per_cu = 1;
    if (per_cu > 2) per_cu = 2;
    grid_blocks = cus * per_cu;
    fprintf(stderr, "kernel_launch: cus %d per_cu %d grid %d\n", cus, per_cu, grid_blocks);
  }
  if (grid_blocks < 0) return;
  Params p;
  memset(&p, 0, sizeof(p));
  for (int i = 0; i < 33; i++) p.in[i] = (const float*)d_in[i];
  p.out = (float*)d_out;
  p.ws = (char*)d_ws;
#if MULTI_LAUNCH
  for (int ph = 0; ph < NPHASES; ph++) {
    hipLaunchKernelGGL(mega, dim3(grid_blocks), dim3(256), LDS_BYTES, stream, p, ph, ph + 1);
  }
#else
  int ph0 = 0, ph1 = NPHASES;
  void* args[] = {&p, &ph0, &ph1};
  hipError_t e = hipLaunchCooperativeKernel((const void*)mega, dim3(grid_blocks), dim3(256), args, LDS_BYTES, stream);
  if (e != hipSuccess) fprintf(stderr, "cooperative launch failed: %s (grid %d)\n", hipGetErrorString(e), grid_blocks);
#endif
}
```

```cpp
#include <hip/hip_runtime.h>
#include <hip/hip_cooperative_groups.h>
#include <stdint.h>
#include <math.h>
#include <stdio.h>
#include <string.h>
namespace cg = cooperative_groups;

#ifndef MULTI_LAUNCH
#define MULTI_LAUNCH 0
#endif

typedef unsigned short u16;
typedef __attribute__((ext_vector_type(8))) short bf16x8;
typedef __attribute__((ext_vector_type(4))) short s16x4;
typedef __attribute__((ext_vector_type(16))) float f32x16;
typedef __attribute__((ext_vector_type(4))) unsigned u32x4;
typedef __attribute__((ext_vector_type(2))) unsigned u32x2;

#define DI __device__ __forceinline__
#define MFMA32(a, b, c) __builtin_amdgcn_mfma_f32_32x32x16_bf16((a), (b), (c), 0, 0, 0)

constexpr int T_ = 65536;
constexpr int L_ = 8192;
constexpr int D_ = 1024;
constexpr int FF_ = 2816;
constexpr float ALPHA_ = 1.41421356237309515f;
constexpr float LN_EPS_ = 1e-5f;
constexpr float LOG2E_ = 1.44269504088896341f;
constexpr int LDS_BYTES = 73728;

constexpr size_t SZ_WGU = (size_t)5632 * 1024 * 2;
constexpr size_t SZ_WD = (size_t)1024 * 2816 * 2;
constexpr size_t SZ_WIN = (size_t)2560 * 1024 * 2;
constexpr size_t SZ_WO = (size_t)1024 * 1024 * 2;
constexpr size_t SZ_WGLU = (size_t)256 * 256 * 2;
constexpr size_t SZ_WPG = (size_t)1024 * 1024 * 2;
constexpr size_t SZ_WPP = (size_t)1024 * 256 * 2;
constexpr size_t OFF_WGU1 = 0;
constexpr size_t OFF_WD1 = OFF_WGU1 + 2 * SZ_WGU;
constexpr size_t OFF_WGU2 = OFF_WD1 + 2 * SZ_WD;
constexpr size_t OFF_WD2 = OFF_WGU2 + 2 * SZ_WGU;
constexpr size_t OFF_WIN = OFF_WD2 + 2 * SZ_WD;
constexpr size_t OFF_WO = OFF_WIN + 2 * SZ_WIN;
constexpr size_t OFF_WGLU = OFF_WO + 2 * SZ_WO;
constexpr size_t OFF_WPG = OFF_WGLU + 2 * SZ_WGLU;
constexpr size_t OFF_WPP = OFF_WPG + 2 * SZ_WPG;
constexpr size_t OFF_COEFA = OFF_WPP + 2 * SZ_WPP;
constexpr size_t OFF_COEFB = OFF_COEFA + 2 * 16 * 64 * 16;
constexpr size_t OFF_LAM = OFF_COEFB + 2 * 16 * 64 * 16 * 8;
constexpr size_t OFF_BIAS = OFF_LAM + 256;
constexpr size_t OFF_XB = OFF_BIAS + 8 * 129 * 4 + 32;
constexpr size_t OFF_PB = OFF_XB + (size_t)T_ * 1024 * 2;
constexpr size_t OFF_H = OFF_PB + (size_t)2 * T_ * 256 * 2;
constexpr size_t SZ_H = (size_t)384 << 20;
constexpr size_t OFF_CC = OFF_H + SZ_H;
constexpr size_t OFF_CANDK = OFF_CC + (size_t)T_ * 1024 * 2;
constexpr int CAP_ = 2048;
constexpr size_t OFF_CANDI = OFF_CANDK + (size_t)512 * 32 * CAP_ * 4;
constexpr size_t WS_END = OFF_CANDI + (size_t)512 * 32 * CAP_ * 2;
constexpr size_t MB_ = (size_t)1 << 20;
constexpr size_t M_QD = 0, M_KD = 64 * MB_, M_VT = 128 * MB_, M_U = 192 * MB_, M_QS = 256 * MB_, M_QI = 288 * MB_, M_YG = 320 * MB_,
                 M_KS = 352 * MB_, M_VS = 360 * MB_, M_KI = 368 * MB_, M_WI = 372 * MB_, M_SEND = 374 * MB_;

struct Params {
  const float* in[33];
  float* out;
  char* ws;
};

DI int tidx() { int t = threadIdx.x; asm volatile("" : "+v"(t)); return t; }
#define GAS __attribute__((address_space(1)))
DI size_t opaque0() { size_t z = 0; asm volatile("" : "+s"(z)); return z; }
DI char* WS(const Params& P) { return P.ws + opaque0(); }
DI float* OUTP(const Params& P) { return P.out + opaque0(); }
DI const float* INP(const Params& P, int i) { return P.in[i]; }
typedef __bf16 bf16v2_ __attribute__((ext_vector_type(2)));
typedef float f32v2_ __attribute__((ext_vector_type(2)));
DI u16 f2bf(float x) { const __bf16 h = (__bf16)x; return __builtin_bit_cast(u16, h); }
DI float bf2f(u16 v) { return __uint_as_float(((unsigned)v) << 16); }
DI unsigned pack2(float a, float b) { f32v2_ v; v.x = a; v.y = b; const bf16v2_ h = __builtin_convertvector(v, bf16v2_); return __builtin_bit_cast(unsigned, h); }
DI int crow(int i, int hh) { return (i & 3) + 8 * (i >> 2) + 4 * hh; }
DI float sigmoidf_(float x) { return __builtin_amdgcn_rcpf(1.f + __expf(-x)); }
DI float wave_sum(float v) { for (int o = 32; o > 0; o >>= 1) v += __shfl_xor(v, o); return v; }
DI float wave_max(float v) { for (int o = 32; o > 0; o >>= 1) v = fmaxf(v, __shfl_xor(v, o)); return v; }
DI f32x16 zero16() { f32x16 z; for (int i = 0; i < 16; i++) z[i] = 0.f; return z; }
DI bf16x8 pack8(const f32x16& x, int s) {
  union { unsigned u[4]; bf16x8 v; } t;
  t.u[0] = pack2(x[8 * s + 0], x[8 * s + 1]); t.u[1] = pack2(x[8 * s + 2], x[8 * s + 3]);
  t.u[2] = pack2(x[8 * s + 4], x[8 * s + 5]); t.u[3] = pack2(x[8 * s + 6], x[8 * s + 7]);
  return t.v;
}

constexpr int GS_ = 72;
constexpr int GT_ = 128 * GS_;

constexpr int GST_ = 32768;
DI void gemm_stage(const u16* __restrict__ A, int lda, const u16* __restrict__ B, int ldb, int kt, char* sbuf) {
  const int tid = tidx(), lane = tid & 63, wave = __builtin_amdgcn_readfirstlane(tid >> 6);
  const int pp = lane >> 4, pos = lane & 15;
#pragma unroll
  for (int i = 0; i < 4; i++) {
    const int blk = i * 4 + wave;
    const int p = blk * 4 + pp;
    const int row = 2 * p + (pos >> 3), c8 = (pos & 7) ^ (p & 7);
    const u16* ga = A + (size_t)row * lda + kt * 64 + c8 * 8;
    const u16* gb = B + (size_t)row * ldb + kt * 64 + c8 * 8;
    __builtin_amdgcn_global_load_lds((const GAS void*)ga, (__attribute__((address_space(3))) void*)(sbuf + blk * 1024), 16, 0, 0);
    __builtin_amdgcn_global_load_lds((const GAS void*)gb, (__attribute__((address_space(3))) void*)(sbuf + 16384 + blk * 1024), 16, 0, 0);
  }
}
DI void gemm_main(f32x16 (&acc)[2][2], const u16* __restrict__ A, int lda, const u16* __restrict__ B, int ldb, int K, u16* sm) {
  const int tid = tidx(), lane = tid & 63, wave = tid >> 6;
  const int wm = wave >> 1, wn = wave & 1, r = lane & 31, hh = lane >> 5;
  char* sb = (char*)sm;
  const int rowa = wm * 64 + r, rowb = wn * 64 + r;
  const int baseA = (rowa >> 1) * 256 + ((rowa & 1) << 7), xa = (rowa >> 1) & 7;
  const int baseB = 16384 + (rowb >> 1) * 256 + ((rowb & 1) << 7), xb = (rowb >> 1) & 7;
  const int nk = K >> 6;
  asm volatile("s_waitcnt vmcnt(0)" ::: "memory");
  __syncthreads();
#pragma unroll 1
  for (int kt = 0; kt < nk; kt++) {
    if (kt + 1 < nk) gemm_stage(A, lda, B, ldb, kt + 1, sb + ((kt + 1) & 1) * GST_);
    const char* st = sb + (kt & 1) * GST_;
#pragma unroll
    for (int ks = 0; ks < 4; ks++) {
      const int ca = ((ks * 2 + hh) ^ xa) << 4, cb = ((ks * 2 + hh) ^ xb) << 4;
      const bf16x8 fa0 = *(const bf16x8*)(st + baseA + ca);
      const bf16x8 fa1 = *(const bf16x8*)(st + baseA + 4096 + ca);
      const bf16x8 fb0 = *(const bf16x8*)(st + baseB + cb);
      const bf16x8 fb1 = *(const bf16x8*)(st + baseB + 4096 + cb);
      acc[0][0] = MFMA32(fa0, fb0, acc[0][0]); acc[0][1] = MFMA32(fa0, fb1, acc[0][1]);
      acc[1][0] = MFMA32(fa1, fb0, acc[1][0]); acc[1][1] = MFMA32(fa1, fb1, acc[1][1]);
    }
    asm volatile("s_waitcnt vmcnt(0)" ::: "memory");
    __syncthreads();
  }
}

DI bool tile_at(int it, int bid, int nb, int TM, int TN, int& tm, int& tn) {
  if ((nb & 7) == 0 && (TM & 63) == 0) {
    const int xcd = bid & 7, lw = bid >> 3, nlw = nb >> 3;
    const int lt = lw + it * nlw, per = (TM >> 3) * TN;
    if (lt >= per) return false;
    const int g = lt / (4 * TN), rem = lt - g * 4 * TN;
    tn = rem >> 2; tm = xcd * (TM >> 3) + g * 4 + (rem & 3);
    return true;
  } else {
    const int t = bid + it * nb;
    if (t >= TM * TN) return false;
    tn = t / TM; tm = t - tn * TM;
    return true;
  }
}

template <class AF, class BF, class EPI>
DI void gemm_phase(int TM, int TN, int K, int lda, int ldb, AF a_of, BF b_of, EPI epi, int bid, int nb, u16* sm) {
  int tm, tn;
  bool have = tile_at(0, bid, nb, TM, TN, tm, tn);
  __syncthreads();
  if (have) gemm_stage(a_of(tm), lda, b_of(tn), ldb, 0, (char*)sm);
  for (int it = 0; have; it++) {
    f32x16 acc[2][2] = {{zero16(), zero16()}, {zero16(), zero16()}};
    gemm_main(acc, a_of(tm), lda, b_of(tn), ldb, K, sm);
    int tm2 = 0, tn2 = 0;
    const bool have2 = tile_at(it + 1, bid, nb, TM, TN, tm2, tn2);
    if (have2) gemm_stage(a_of(tm2), lda, b_of(tn2), ldb, 0, (char*)sm);
    epi(acc, tm, tn);
    have = have2; tm = tm2; tn = tn2;
  }
  asm volatile("s_waitcnt vmcnt(0)" ::: "memory");
}

DI void transpose_job(const float* __restrict__ src, int K, int N, u16* __restrict__ dst, int mode, int bid, int nb, float* tile) {
  const int tid = tidx();
  const int tk = K >> 6, tn = (N + 63) >> 6;
  for (int t = bid; t < tk * tn; t += nb) {
    const int k0 = (t % tk) * 64, n0 = (t / tk) * 64;
    __syncthreads();
#pragma unroll 4
    for (int i = 0; i < 16; i++) {
      const int k = i * 4 + (tid >> 6), n = tid & 63;
      tile[k * 65 + n] = (n0 + n < N) ? src[(size_t)(k0 + k) * N + n0 + n] : 0.f;
    }
    __syncthreads();
#pragma unroll 4
    for (int i = 0; i < 16; i++) {
      const int n = i * 4 + (tid >> 6), k = tid & 63;
      const int ng = n0 + n;
      if (ng < N) {
        int row = ng;
        if (mode == 1) row = (ng >> 5) * 64 + (ng & 31);
        else if (mode == 2) row = (ng >> 5) * 64 + 32 + (ng & 31);
        dst[(size_t)row * K + k0 + k] = f2bf(tile[k * 65 + n]);
      }
    }
  }
}

DI void phase_prep(const Params& P, int bid, int nb, char* smem) {
  float* tile = (float*)smem;
  char* ws = WS(P);
  for (int l = 0; l < 2; l++) {
    transpose_job(INP(P, 3) + (size_t)l * 1024 * FF_, 1024, FF_, (u16*)(ws + OFF_WGU1 + l * SZ_WGU), 1, bid, nb, tile);
    transpose_job(INP(P, 4) + (size_t)l * 1024 * FF_, 1024, FF_, (u16*)(ws + OFF_WGU1 + l * SZ_WGU), 2, bid, nb, tile);
    transpose_job(INP(P, 5) + (size_t)l * FF_ * 1024, FF_, 1024, (u16*)(ws + OFF_WD1 + l * SZ_WD), 0, bid, nb, tile);
    transpose_job(INP(P, 26) + (size_t)l * 1024 * FF_, 1024, FF_, (u16*)(ws + OFF_WGU2 + l * SZ_WGU), 1, bid, nb, tile);
    transpose_job(INP(P, 27) + (size_t)l * 1024 * FF_, 1024, FF_, (u16*)(ws + OFF_WGU2 + l * SZ_WGU), 2, bid, nb, tile);
    transpose_job(INP(P, 28) + (size_t)l * FF_ * 1024, FF_, 1024, (u16*)(ws + OFF_WD2 + l * SZ_WD), 0, bid, nb, tile);
    transpose_job(INP(P, 8) + (size_t)l * 1024 * 2472, 1024, 2472, (u16*)(ws + OFF_WIN + l * SZ_WIN), 0, bid, nb, tile);
    transpose_job(INP(P, 9) + (size_t)l * 1024 * 1024, 1024, 1024, (u16*)(ws + OFF_WO + l * SZ_WO), 0, bid, nb, tile);
    transpose_job(INP(P, 23) + (size_t)l * 256 * 256, 256, 256, (u16*)(ws + OFF_WGLU + l * SZ_WGLU), 0, bid, nb, tile);
    transpose_job(INP(P, 30) + (size_t)l * 1024 * 1024, 1024, 1024, (u16*)(ws + OFF_WPG + l * SZ_WPG), 0, bid, nb, tile);
    transpose_job(INP(P, 29) + (size_t)l * 256 * 1024, 256, 1024, (u16*)(ws + OFF_WPP + l * SZ_WPP), 0, bid, nb, tile);
    u16* win = (u16*)(ws + OFF_WIN + l * SZ_WIN);
    for (int i = bid * 256 + tidx(); i < 88 * 1024; i += nb * 256) win[(size_t)2472 * 1024 + i] = 0;
  }
  const size_t gt = (size_t)bid * 256 + tidx(), gs = (size_t)nb * 256;
  {
    const float4* x4 = (const float4*)INP(P, 0);
    uint2* xb = (uint2*)(ws + OFF_XB);
    for (size_t i = gt; i < (size_t)T_ * 1024 / 4; i += gs) { float4 v = x4[i]; xb[i] = make_uint2(pack2(v.x, v.y), pack2(v.z, v.w)); }
    const float4* p4 = (const float4*)INP(P, 1);
    uint2* pb = (uint2*)(ws + OFF_PB);
    for (size_t i = gt; i < (size_t)2 * T_ * 256 / 4; i += gs) { float4 v = p4[i]; pb[i] = make_uint2(pack2(v.x, v.y), pack2(v.z, v.w)); }
  }
  if (gt < 2 * 16 * 64) {
    const int l = (int)gt >> 10, g = ((int)gt >> 6) & 15, p = (int)gt & 63;
    const int gi = (l * 16 + g) * 64 + p;
    const double lr = INP(P, 15)[gi], li = INP(P, 16)[gi];
    const double dt = exp((double)INP(P, 17)[l * 16 + g]);
    const double mag = exp(lr * dt);
    const double ar = mag * cos(li * dt), ai = mag * sin(li * dt);
    const double mag5 = exp(512.0 * lr * dt);
    const double a5r = mag5 * cos(512.0 * li * dt), a5i = mag5 * sin(512.0 * li * dt);
    ((float4*)(ws + OFF_COEFA))[gi] = make_float4((float)ar, (float)ai, (float)a5r, (float)a5i);
    const double den = lr * lr + li * li, nr = ar - 1.0, ni = ai;
    const double fr = (nr * lr + ni * li) / den, fi = (ni * lr - nr * li) / den;
    float2* cb = (float2*)(ws + OFF_COEFB) + (size_t)gi * 16;
    for (int c = 0; c < 16; c++) {
      const double br = INP(P, 18)[(size_t)gi * 16 + c], bi = INP(P, 19)[(size_t)gi * 16 + c];
      cb[c] = make_float2((float)(fr * br - fi * bi), (float)(fr * bi + fi * br));
    }
  }
  if (gt < 8 * 129) {
    const int hd = (int)gt / 129, n = (int)gt - hd * 129;
    int bk = n;
    if (n >= 16) { bk = 16 + (int)(log((double)n / 16.0) / log(8.0) * 16.0); bk = bk < 31 ? bk : 31; }
    ((float*)(ws + OFF_BIAS))[gt] = INP(P, 2)[bk * 8 + hd];
  }
  if (gt < 2) {
    const int l = (int)gt;
    float s1 = 0.f, s2 = 0.f;
    for (int i = 0; i < 64; i++) { s1 += INP(P, 10)[l * 64 + i] * INP(P, 11)[l * 64 + i]; s2 += INP(P, 12)[l * 64 + i] * INP(P, 13)[l * 64 + i]; }
    const float lam_init = 0.8f - 0.6f * expf(-0.3f * (float)l);
    ((float*)(ws + OFF_LAM))[l] = expf(s1) - expf(s2) + lam_init;
  }
}

DI void phase_ffn_up(const u16* __restrict__ Xb, const u16* __restrict__ Wgu, u16* __restrict__ H, int bid, int nb, u16* sm) {
  const int lane = tidx() & 63, wave = tidx() >> 6, wm = wave >> 1, wn = wave & 1, r = lane & 31, hh = lane >> 5;
  gemm_phase(512, 44, 1024, 1024, 1024,
    [&](int tm) { return Xb + (size_t)tm * 128 * 1024; }, [&](int tn) { return Wgu + (size_t)tn * 128 * 1024; },
    [&](f32x16 (&acc)[2][2], int tm, int tn) {
      const int j = tn * 64 + wn * 32 + r;
#pragma unroll
      for (int mi = 0; mi < 2; mi++)
#pragma unroll
        for (int i = 0; i < 16; i++) {
          const int row = tm * 128 + wm * 64 + mi * 32 + crow(i, hh);
          const float g = acc[mi][0][i], u = acc[mi][1][i];
          H[(size_t)row * FF_ + j] = f2bf(g * sigmoidf_(g) * u);
        }
    }, bid, nb, sm);
}

DI void phase_ffn_down(const u16* __restrict__ H, const u16* __restrict__ Wd, const float* xin, float* xout, const u16* __restrict__ ple, int bid, int nb, u16* sm) {
  const int lane = tidx() & 63, wave = tidx() >> 6, wm = wave >> 1, wn = wave & 1, r = lane & 31, hh = lane >> 5;
  gemm_phase(512, 8, FF_, FF_, FF_,
    [&](int tm) { return H + (size_t)tm * 128 * FF_; }, [&](int tn) { return Wd + (size_t)tn * 128 * FF_; },
    [&](f32x16 (&acc)[2][2], int tm, int tn) {
#pragma unroll
      for (int mi = 0; mi < 2; mi++)
#pragma unroll
        for (int ni = 0; ni < 2; ni++)
#pragma unroll
          for (int i = 0; i < 16; i++) {
            const size_t o = (size_t)(tm * 128 + wm * 64 + mi * 32 + crow(i, hh)) * 1024 + tn * 128 + wn * 64 + ni * 32 + r;
            float v = ALPHA_ * xin[o] + 0.5f * acc[mi][ni][i];
            if (ple) v += bf2f(ple[o]);
            xout[o] = v;
          }
    }, bid, nb, sm);
}

DI void phase_w_o(const u16* __restrict__ CC, const u16* __restrict__ Wo, float* x, int bid, int nb, u16* sm) {
  const int lane = tidx() & 63, wave = tidx() >> 6, wm = wave >> 1, wn = wave & 1, r = lane & 31, hh = lane >> 5;
  gemm_phase(512, 8, 1024, 1024, 1024,
    [&](int tm) { return CC + (size_t)tm * 128 * 1024; }, [&](int tn) { return Wo + (size_t)tn * 128 * 1024; },
    [&](f32x16 (&acc)[2][2], int tm, int tn) {
#pragma unroll
      for (int mi = 0; mi < 2; mi++)
#pragma unroll
        for (int ni = 0; ni < 2; ni++)
#pragma unroll
          for (int i = 0; i < 16; i++) {
            const size_t o = (size_t)(tm * 128 + wm * 64 + mi * 32 + crow(i, hh)) * 1024 + tn * 128 + wn * 64 + ni * 32 + r;
            x[o] = ALPHA_ * x[o] + acc[mi][ni][i];
          }
    }, bid, nb, sm);
}

DI void phase_glu(const u16* __restrict__ Yg, const u16* __restrict__ Wglu, u16* __restrict__ CC, int bid, int nb, u16* sm) {
  const int lane = tidx() & 63, wave = tidx() >> 6, wm = wave >> 1, wn = wave & 1, r = lane & 31, hh = lane >> 5;
  gemm_phase(512, 2, 256, 256, 256,
    [&](int tm) { return Yg + (size_t)tm * 128 * 256; }, [&](int tn) { return Wglu + (size_t)tn * 128 * 256; },
    [&](f32x16 (&acc)[2][2], int tm, int tn) {
#pragma unroll
      for (int mi = 0; mi < 2; mi++)
#pragma unroll
        for (int ni = 0; ni < 2; ni++)
#pragma unroll
          for (int i = 0; i < 16; i++) {
            const int row = tm * 128 + wm * 64 + mi * 32 + crow(i, hh), col = tn * 128 + wn * 64 + ni * 32 + r;
            const float y = bf2f(Yg[(size_t)row * 256 + col]);
            CC[(size_t)row * 1024 + 512 + col] = f2bf(y * sigmoidf_(acc[mi][ni][i]));
          }
    }, bid, nb, sm);
}

DI void phase_ple(const u16* __restrict__ Xb, const u16* __restrict__ Wpg, const u16* __restrict__ Pb, const u16* __restrict__ Wpp, u16* ple, int bid, int nb, u16* sm) {
  const int lane = tidx() & 63, wave = tidx() >> 6, wm = wave >> 1, wn = wave & 1, r = lane & 31, hh = lane >> 5;
  gemm_phase(512, 8, 1024, 1024, 1024,
    [&](int tm) { return Xb + (size_t)tm * 128 * 1024; }, [&](int tn) { return Wpg + (size_t)tn * 128 * 1024; },
    [&](f32x16 (&acc)[2][2], int tm, int tn) {
#pragma unroll
      for (int mi = 0; mi < 2; mi++)
#pragma unroll
        for (int ni = 0; ni < 2; ni++)
#pragma unroll
          for (int i = 0; i < 16; i++) {
            const size_t o = (size_t)(tm * 128 + wm * 64 + mi * 32 + crow(i, hh)) * 1024 + tn * 128 + wn * 64 + ni * 32 + r;
            ple[o] = f2bf(sigmoidf_(acc[mi][ni][i]));
          }
    }, bid, nb, sm);
  gemm_phase(512, 8, 256, 256, 256,
    [&](int tm) { return Pb + (size_t)tm * 128 * 256; }, [&](int tn) { return Wpp + (size_t)tn * 128 * 256; },
    [&](f32x16 (&acc)[2][2], int tm, int tn) {
#pragma unroll
      for (int mi = 0; mi < 2; mi++)
#pragma unroll
        for (int ni = 0; ni < 2; ni++)
#pragma unroll
          for (int i = 0; i < 16; i++) {
            const size_t o = (size_t)(tm * 128 + wm * 64 + mi * 32 + crow(i, hh)) * 1024 + tn * 128 + wn * 64 + ni * 32 + r;
            ple[o] = f2bf(acc[mi][ni][i] * bf2f(ple[o]));
          }
    }, bid, nb, sm);
}

DI void phase_w_in(const u16* __restrict__ Xb, const u16* __restrict__ Win, char* mb, int bid, int nb, u16* sm) {
  const int lane = tidx() & 63, wave = tidx() >> 6, wm = wave >> 1, wn = wave & 1, r = lane & 31, hh = lane >> 5;
  u16* Qd = (u16*)(mb + M_QD); u16* Kd = (u16*)(mb + M_KD); u16* Vt = (u16*)(mb + M_VT); float* U = (float*)(mb + M_U);
  u16* Qs = (u16*)(mb + M_QS); u16* Qi = (u16*)(mb + M_QI); u16* Ks = (u16*)(mb + M_KS); u16* Vs = (u16*)(mb + M_VS);
  u16* Ki = (u16*)(mb + M_KI); float* Wi = (float*)(mb + M_WI);
  gemm_phase(512, 20, 1024, 1024, 1024,
    [&](int tm) { return Xb + (size_t)tm * 128 * 1024; }, [&](int tn) { return Win + (size_t)tn * 128 * 1024; },
    [&](f32x16 (&acc)[2][2], int tm, int tn) {
#pragma unroll
    for (int ni = 0; ni < 2; ni++) {
      const int c0 = tn * 128 + wn * 64 + ni * 32;
      const int c = c0 + r;
#pragma unroll
      for (int mi = 0; mi < 2; mi++) {
        const int rowb = tm * 128 + wm * 64 + mi * 32;
        if (c0 >= 1024 && c0 < 1536) {
          const int cc = c - 1024, head = cc >> 7, dv = cc & 127;
          const int b = rowb >> 13, t0 = rowb & 8191;
#pragma unroll
          for (int g4 = 0; g4 < 4; g4++) {
            uint2 v = make_uint2(pack2(acc[mi][ni][4 * g4], acc[mi][ni][4 * g4 + 1]), pack2(acc[mi][ni][4 * g4 + 2], acc[mi][ni][4 * g4 + 3]));
            const int tt = t0 + 8 * g4 + 4 * hh;
            *(uint2*)(Vt + ((size_t)(((b * 4 + head) * 128 + (tt >> 6)) * 128 + dv)) * 64 + (tt & 63)) = v;
          }
        } else {
#pragma unroll
          for (int i = 0; i < 16; i++) {
            const size_t row = rowb + crow(i, hh);
            const float v = acc[mi][ni][i];
            if (c0 < 512) Qd[row * 512 + c] = f2bf(v);
            else if (c0 < 1024) {
              const int cc = c - 512;
              Kd[((size_t)((((int)(row >> 13) * 4 + (cc >> 7)) * 2 + ((cc >> 6) & 1))) * L_ + (row & 8191)) * 64 + (cc & 63)] = f2bf(v);
            }
            else if (c0 < 1792) U[row * 256 + (c - 1536)] = v;
            else if (c0 < 2048) Qs[row * 256 + (c - 1792)] = f2bf(v);
            else if (c0 < 2112) Ks[row * 64 + (c - 2048)] = f2bf(v);
            else if (c0 < 2176) Vs[row * 64 + (c - 2112)] = f2bf(v);
            else if (c0 < 2432) Qi[row * 256 + (c - 2176)] = f2bf(v);
            else if (c0 < 2464) Ki[row * 32 + (c - 2432)] = f2bf(v);
            else if (c0 == 2464) { if (r < 8) Wi[row * 8 + r] = v * 0.0625f; }
          }
        }
      }
    }
  }, bid, nb, sm);
}

DI void phase_ln(float* x, u16* __restrict__ xb, const float* __restrict__ g, const float* __restrict__ bta, int bid, int nb) {
  const int lane = tidx() & 63, wave = tidx() >> 6;
  float4 gg[4], bb[4];
#pragma unroll
  for (int i = 0; i < 4; i++) { gg[i] = *(const float4*)(g + i * 256 + lane * 4); bb[i] = *(const float4*)(bta + i * 256 + lane * 4); }
  constexpr int RB = 4;
  for (int row0 = (bid * 4 + wave) * RB; row0 < T_; row0 += nb * 4 * RB) {
    float4 v[RB][4];
#pragma unroll
    for (int rr = 0; rr < RB; rr++)
#pragma unroll
      for (int i = 0; i < 4; i++) v[rr][i] = *(const float4*)(x + (size_t)(row0 + rr) * 1024 + i * 256 + lane * 4);
    float s[RB], q[RB];
#pragma unroll
    for (int rr = 0; rr < RB; rr++) {
      s[rr] = 0.f;
#pragma unroll
      for (int i = 0; i < 4; i++) s[rr] += v[rr][i].x + v[rr][i].y + v[rr][i].z + v[rr][i].w;
    }
#pragma unroll
    for (int o = 32; o > 0; o >>= 1)
#pragma unroll
      for (int rr = 0; rr < RB; rr++) s[rr] += __shfl_xor(s[rr], o);
#pragma unroll
    for (int rr = 0; rr < RB; rr++) {
      const float mu = s[rr] * (1.f / 1024.f);
      q[rr] = 0.f;
#pragma unroll
      for (int i = 0; i < 4; i++) {
        v[rr][i].x -= mu; v[rr][i].y -= mu; v[rr][i].z -= mu; v[rr][i].w -= mu;
        q[rr] += v[rr][i].x * v[rr][i].x + v[rr][i].y * v[rr][i].y + v[rr][i].z * v[rr][i].z + v[rr][i].w * v[rr][i].w;
      }
    }
#pragma unroll
    for (int o = 32; o > 0; o >>= 1)
#pragma unroll
      for (int rr = 0; rr < RB; rr++) q[rr] += __shfl_xor(q[rr], o);
#pragma unroll
    for (int rr = 0; rr < RB; rr++) {
      const float rs = rsqrtf(q[rr] * (1.f / 1024.f) + LN_EPS_);
#pragma unroll
      for (int i = 0; i < 4; i++) {
        float4 o;
        o.x = v[rr][i].x * rs * gg[i].x + bb[i].x; o.y = v[rr][i].y * rs * gg[i].y + bb[i].y;
        o.z = v[rr][i].z * rs * gg[i].z + bb[i].z; o.w = v[rr][i].w * rs * gg[i].w + bb[i].w;
        *(float4*)(x + (size_t)(row0 + rr) * 1024 + i * 256 + lane * 4) = o;
        *(uint2*)(xb + (size_t)(row0 + rr) * 1024 + i * 256 + lane * 4) = make_uint2(pack2(o.x, o.y), pack2(o.z, o.w));
      }
    }
  }
}

DI float gelu_tanh(float x) { const float u = 0.7978845608028654f * (x + 0.044715f * x * x * x); return 0.5f * x * (1.f + tanhf(u)); }

typedef __attribute__((ext_vector_type(4))) float f32x4;
template <bool OUT>
DI void ssm_scan(const Params& P, int layer, int widx, char* mb, char* smem) {
  const int lane = tidx() & 63, wave = tidx() >> 6;
  const int b = widx >> 8, g = (widx >> 4) & 15, ch = widx & 15;
  const int gi = (layer * 16 + g) * 64 + lane;
  const float4 ca = ((const float4*)(WS(P) + OFF_COEFA))[gi];
  const float2* cbp = (const float2*)(WS(P) + OFF_COEFB) + (size_t)gi * 16;
  float bre[16], bim[16];
#pragma unroll
  for (int c = 0; c < 16; c++) { float2 t = cbp[c]; bre[c] = t.x; bim[c] = t.y; }
  const float* U = (const float*)(mb + M_U);
  float2* Send = (float2*)(mb + M_SEND);
  const size_t sbase = (size_t)((b * 16 + g) * 16) * 64 + lane;
  float xr = 0.f, xi = 0.f;
  float am[32];
  float4 dsk4 = make_float4(0.f, 0.f, 0.f, 0.f);
  float* Xs = (float*)smem + wave * (128 * 17);
  const int lm = lane & 15, lq = lane >> 4;
  if (OUT) {
    for (int j = 0; j < ch; j++) {
      const float2 e = Send[sbase + (size_t)j * 64];
      const float nr = ca.z * xr - ca.w * xi + e.x, ni = ca.z * xi + ca.w * xr + e.y;
      xr = nr; xi = ni;
    }
    const float* cre = INP(P, 20) + ((size_t)(layer * 16 + g) * 16 + lm) * 64;
    const float* cim = INP(P, 21) + ((size_t)(layer * 16 + g) * 16 + lm) * 64;
#pragma unroll
    for (int kb = 0; kb < 32; kb++) {
      const int kk = 4 * kb + lq;
      am[kb] = (kb < 16) ? cre[kk] : -cim[kk - 64];
    }
    dsk4 = *(const float4*)(INP(P, 22) + layer * 256 + g * 16 + 4 * lq);
  }
  u16* Yg = (u16*)(mb + M_YG);
  const size_t tok0 = (size_t)b * L_ + ch * 512;
  const float* ub = U + (tok0 + (lane >> 2)) * 256 + g * 16 + (lane & 3) * 4;
  float4 cur = *(const float4*)ub;
#pragma unroll 1
  for (int blk = 0; blk < 32; blk++) {
    const float4 nxt = *(const float4*)(ub + (size_t)min(blk + 1, 31) * 16 * 256);
#pragma unroll
    for (int s16 = 0; s16 < 16; s16++) {
      float uu[16];
#pragma unroll
      for (int c = 0; c < 16; c++) {
        const float comp = ((c & 3) == 0) ? cur.x : ((c & 3) == 1) ? cur.y : ((c & 3) == 2) ? cur.z : cur.w;
        uu[c] = __int_as_float(__builtin_amdgcn_readlane(__float_as_int(comp), 4 * s16 + (c >> 2)));
      }
      float br4[4] = {0.f, 0.f, 0.f, 0.f}, bi4[4] = {0.f, 0.f, 0.f, 0.f};
#pragma unroll
      for (int c = 0; c < 16; c++) { br4[c & 3] += bre[c] * uu[c]; bi4[c & 3] += bim[c] * uu[c]; }
      const float br = (br4[0] + br4[1]) + (br4[2] + br4[3]), bi = (bi4[0] + bi4[1]) + (bi4[2] + bi4[3]);
      const float nr = ca.x * xr - ca.y * xi + br, ni = ca.x * xi + ca.y * xr + bi;
      xr = nr; xi = ni;
      if (OUT) { Xs[lane * 17 + s16] = xr; Xs[(64 + lane) * 17 + s16] = xi; }
    }
    if (OUT) {
      __builtin_amdgcn_wave_barrier();
      f32x4 acc = {0.f, 0.f, 0.f, 0.f}, acc2 = {0.f, 0.f, 0.f, 0.f};
#pragma unroll
      for (int kb = 0; kb < 32; kb += 2) {
        const float bv0 = Xs[(4 * kb + lq) * 17 + lm], bv1 = Xs[(4 * kb + 4 + lq) * 17 + lm];
        acc = __builtin_amdgcn_mfma_f32_16x16x4f32(am[kb], bv0, acc, 0, 0, 0);
        acc2 = __builtin_amdgcn_mfma_f32_16x16x4f32(am[kb + 1], bv1, acc2, 0, 0, 0);
      }
      acc += acc2;
      __builtin_amdgcn_wave_barrier();
      const size_t tok = tok0 + blk * 16 + lm;
      const float4 u4 = *(const float4*)(U + tok * 256 + g * 16 + 4 * lq);
      const float y0 = gelu_tanh(acc[0] + dsk4.x * u4.x), y1 = gelu_tanh(acc[1] + dsk4.y * u4.y);
      const float y2 = gelu_tanh(acc[2] + dsk4.z * u4.z), y3 = gelu_tanh(acc[3] + dsk4.w * u4.w);
      *(uint2*)(Yg + tok * 256 + g * 16 + 4 * lq) = make_uint2(pack2(y0, y1), pack2(y2, y3));
    }
    cur = nxt;
  }
  if (!OUT) Send[sbase + (size_t)ch * 64] = make_float2(xr, xi);
}

constexpr int KS_ = 72, VS_ = 68;
DI void da_item(const Params& P, int layer, int b, int h, int qt, char* mb, char* smem) {
  const int tid = tidx(), lane = tid & 63, wave = tid >> 6, r = lane & 31, hh = lane >> 5;
  u16* sK0 = (u16*)smem;
  u16* sV0 = sK0 + 2 * 64 * KS_;
  float* sbias = (float*)(sV0 + 2 * 128 * VS_);
  u16* sQw = (u16*)(smem + 54272) + (tidx() >> 6) * 32 * KS_;
  const u16* Qd = (const u16*)(mb + M_QD); const u16* Kd = (const u16*)(mb + M_KD); const u16* Vt = (const u16*)(mb + M_VT);
  u16* CC = (u16*)(WS(P) + OFF_CC);
  const int q0 = qt * 128, qw = q0 + wave * 32, qp = qw + r;
  const size_t tokq = (size_t)b * L_ + qp;
  __syncthreads();
  if (tid < 129) sbias[tid] = ((const float*)(WS(P) + OFF_BIAS))[h * 129 + tid] * LOG2E_;
  __syncthreads();
  const float bfar = sbias[128];
  const float SC = 0.125f * LOG2E_;
  const int nkt = (q0 + 128) >> 6;
  const float lam = ((const float*)(WS(P) + OFF_LAM))[layer];
  const int krow_l = tid >> 3, kch = (tid & 7) * 8;
#pragma unroll 1
  for (int c = 0; c < 2; c++) {
#pragma unroll
    for (int ks = 0; ks < 4; ks++) *(bf16x8*)(sQw + r * KS_ + ks * 16 + hh * 8) = *(const bf16x8*)(Qd + tokq * 512 + h * 128 + c * 64 + ks * 16 + hh * 8);
    f32x16 o[4] = {zero16(), zero16(), zero16(), zero16()};
    float m = -INFINITY, l = 0.f;
    const u16* Kbase = Kd + ((size_t)(((b * 4 + h) * 2 + c)) * L_ + krow_l) * 64 + kch;
    const u16* Vbase = Vt + ((size_t)((b * 4 + h) * 128) * 128 + krow_l) * 64 + kch;
    u32x4 rk[2], rv[4];
#pragma unroll
    for (int i = 0; i < 2; i++) rk[i] = *(const u32x4*)(Kbase + (size_t)(i * 32) * 64);
#pragma unroll
    for (int i = 0; i < 4; i++) rv[i] = *(const u32x4*)(Vbase + (size_t)(i * 32) * 64);
#define DA_STAGE(BUF) { u16* sKw = sK0 + (BUF) * 64 * KS_; u16* sVw = sV0 + (BUF) * 128 * VS_; \
      _Pragma("unroll") for (int i = 0; i < 2; i++) *(u32x4*)(sKw + (krow_l + i * 32) * KS_ + kch) = rk[i]; \
      _Pragma("unroll") for (int i = 0; i < 4; i++) { u32x2* d = (u32x2*)(sVw + (krow_l + i * 32) * VS_ + kch); \
        u32x2 lo2, hi2; lo2.x = rv[i].x; lo2.y = rv[i].y; hi2.x = rv[i].z; hi2.y = rv[i].w; d[0] = lo2; d[1] = hi2; } }
#define DA_FETCH(T) { const int ktn_ = min((T), nkt - 1); \
      _Pragma("unroll") for (int i = 0; i < 2; i++) rk[i] = *(const u32x4*)(Kbase + (size_t)(ktn_ * 64 + i * 32) * 64); \
      _Pragma("unroll") for (int i = 0; i < 4; i++) rv[i] = *(const u32x4*)(Vbase + (size_t)ktn_ * 8192 + (size_t)(i * 32) * 64); }
    __syncthreads();
    DA_STAGE(0)
    DA_FETCH(1)
    __syncthreads();
#pragma unroll 1
    for (int kt = 0; kt < nkt; kt++) {
      const u16* sK = sK0 + (kt & 1) * 64 * KS_;
      const u16* sV = sV0 + (kt & 1) * 128 * VS_;
      if (kt + 1 < nkt) { DA_STAGE((kt + 1) & 1) }
      DA_FETCH(kt + 2)
      if (kt * 64 <= qw + 31) {
        f32x16 s[2];
#pragma unroll
        for (int kb = 0; kb < 2; kb++) {
          s[kb] = zero16();
#pragma unroll
          for (int ks = 0; ks < 4; ks++) {
            const bf16x8 kf = *(const bf16x8*)(sK + (kb * 32 + r) * KS_ + ks * 16 + hh * 8);
            const bf16x8 qf = *(const bf16x8*)(sQw + r * KS_ + ks * 16 + hh * 8);
            s[kb] = MFMA32(kf, qf, s[kb]);
          }
        }
        const bool nearb = (kt * 64 + 63 + 128 > qw);
        float mx = -INFINITY;
        if (nearb) {
#pragma unroll
          for (int kb = 0; kb < 2; kb++)
#pragma unroll
            for (int i = 0; i < 16; i++) {
              const int dist = qp - (kt * 64 + kb * 32 + crow(i, hh));
              const float bv = sbias[min(max(dist, 0), 128)];
              float t = s[kb][i] * SC + bv;
              t = (dist >= 0) ? t : -INFINITY;
              s[kb][i] = t; mx = fmaxf(mx, t);
              if ((i & 7) == 7) __builtin_amdgcn_sched_barrier(0);
            }
        } else {
#pragma unroll
          for (int kb = 0; kb < 2; kb++)
#pragma unroll
            for (int i = 0; i < 16; i++) { const float t = s[kb][i] * SC + bfar; s[kb][i] = t; mx = fmaxf(mx, t); }
        }
        mx = fmaxf(mx, __shfl_xor(mx, 32));
        const float mn = fmaxf(m, mx);
        const float corr = __builtin_amdgcn_exp2f(m - mn);
        m = mn;
        float ls = 0.f;
#pragma unroll
        for (int kb = 0; kb < 2; kb++)
#pragma unroll
          for (int i = 0; i < 16; i++) { const float p = __builtin_amdgcn_exp2f(s[kb][i] - mn); s[kb][i] = p; ls += p; }
        l = l * corr + ls;
        if (__ballot(corr != 1.f) != 0ull) {
#pragma unroll
          for (int dt = 0; dt < 4; dt++)
#pragma unroll
            for (int i = 0; i < 16; i++) o[dt][i] *= corr;
        }
#pragma unroll
        for (int kb = 0; kb < 2; kb++)
#pragma unroll
          for (int s2 = 0; s2 < 2; s2++) {
            const bf16x8 pf = pack8(s[kb], s2);
#pragma unroll
            for (int dt = 0; dt < 4; dt++) {
              const u16* vp = sV + (dt * 32 + r) * VS_ + kb * 32 + s2 * 16 + 4 * hh;
              const s16x4 lo = *(const s16x4*)vp, hi = *(const s16x4*)(vp + 8);
              const bf16x8 vf = __builtin_shufflevector(lo, hi, 0, 1, 2, 3, 4, 5, 6, 7);
              o[dt] = MFMA32(vf, pf, o[dt]);
            }
            __builtin_amdgcn_sched_barrier(0);
          }
      }
      __syncthreads();
    }
#undef DA_STAGE
#undef DA_FETCH
    const float lt = l + __shfl_xor(l, 32);
    const float inv = 1.f / lt;
    size_t tq = tokq;
    asm volatile("" : "+v"(tq));
    u16* obase = CC + tq * 1024 + h * 128 + 4 * hh;
    if (c == 0) {
#pragma unroll
      for (int dt = 0; dt < 4; dt++)
#pragma unroll
        for (int g4 = 0; g4 < 4; g4++) {
          *(uint2*)(obase + dt * 32 + 8 * g4) = make_uint2(pack2(o[dt][4 * g4] * inv, o[dt][4 * g4 + 1] * inv), pack2(o[dt][4 * g4 + 2] * inv, o[dt][4 * g4 + 3] * inv));
        }
    } else {
      float ss = 0.f;
#pragma unroll
      for (int dt = 0; dt < 4; dt++)
#pragma unroll
        for (int g4 = 0; g4 < 4; g4++) {
          const uint2 pv = *(const uint2*)(obase + dt * 32 + 8 * g4);
          const float a4[4] = {bf2f((u16)(pv.x & 0xffff)), bf2f((u16)(pv.x >> 16)), bf2f((u16)(pv.y & 0xffff)), bf2f((u16)(pv.y >> 16))};
#pragma unroll
          for (int e = 0; e < 4; e++) { const float v = a4[e] - lam * o[dt][4 * g4 + e] * inv; o[dt][4 * g4 + e] = v; ss = __builtin_fmaf(v, v, ss); }
        }
      ss += __shfl_xor(ss, 32);
      const float lam_init = 0.8f - 0.6f * __expf(-0.3f * (float)layer);
      const float rn = rsqrtf(ss * (1.f / 128.f) + LN_EPS_) * (1.f - lam_init);
      int hh2 = hh;
      asm volatile("" : "+v"(hh2));
      const float* sg = INP(P, 14) + layer * 128 + 4 * hh2;
#pragma unroll
      for (int dt = 0; dt < 4; dt++)
#pragma unroll
        for (int g4 = 0; g4 < 4; g4++) {
          const int dv = dt * 32 + 8 * g4 + 4 * hh;
          const float4 gv = *(const float4*)(sg + dt * 32 + 8 * g4);
          uint2 w = make_uint2(pack2(o[dt][4 * g4] * rn * gv.x, o[dt][4 * g4 + 1] * rn * gv.y),
                               pack2(o[dt][4 * g4 + 2] * rn * gv.z, o[dt][4 * g4 + 3] * rn * gv.w));
          *(uint2*)(obase + dv - 4 * hh) = w;
        }
    }
  }
}

DI unsigned sortkey(float f) { const unsigned u = __float_as_uint(f + 0.f); return u ^ (((unsigned)((int)u >> 31)) | 0x80000000u); }

DI void dsa_item(const Params& P, int layer, int b, int qt, char* mb, char* smem) {
  const int tid = tidx(), lane = tid & 63, wave = tid >> 6, r = lane & 31, hh = lane >> 5;
  unsigned* hist = (unsigned*)smem;
  float* sP = (float*)smem;
  float* sQ = (float*)(smem + 16384);
  u16* sidx = (u16*)(smem + 32896);
  unsigned* meta = (unsigned*)(smem + 49280);
  float* sbias = (float*)(smem + 50304);
  const u16* Qi = (const u16*)(mb + M_QI); const u16* Ki = (const u16*)(mb + M_KI); const float* Wi = (const float*)(mb + M_WI);
  const u16* Qs = (const u16*)(mb + M_QS); const u16* Ks = (const u16*)(mb + M_KS); const u16* Vs = (const u16*)(mb + M_VS);
  u16* CC = (u16*)(WS(P) + OFF_CC);
  const int q0 = qt * 32;
  const int qp = q0 + r;
  const size_t tokb = (size_t)b * L_;
  const int nk32 = qt + 1;
  const bool radix = (q0 >= 256);
  __syncthreads();
  for (int i = tid; i < 4 * 129; i += 256) sbias[i] = ((const float*)(WS(P) + OFF_BIAS))[4 * 129 + i];
  meta[tid] = (tid >= 32 && tid < 64) ? 256u : 0u;
  char* sQi = smem + 52384;
  float* sWi = (float*)(smem + 69280);
  constexpr int CAPL_ = 64;
  unsigned* lK = (unsigned*)smem;
  u16* lI = (u16*)(smem + 32 * CAPL_ * 4);
  {
    const int row = tid >> 3, ch = tid & 7;
    const uint4* src = (const uint4*)(Qi + (tokb + q0 + row) * 256 + ch * 32);
    uint4* dst = (uint4*)(sQi + row * 528 + ch * 64);
    dst[0] = src[0]; dst[1] = src[1]; dst[2] = src[2]; dst[3] = src[3];
    sWi[tid] = Wi[(tokb + q0) * 8 + tid];
  }
  int pass = radix ? 0 : 4;
  bool fast = false;
#pragma unroll 1
  while (true) {
    __syncthreads();
    if (pass < 4) { for (int i = tid; i < 32 * 257; i += 256) hist[i] = 0u; }
    __syncthreads();
    const unsigned pref = meta[r];
    const unsigned krem = meta[32 + r];
    auto elems = [&](const f32x16& sc, const int kt, const int lim) __attribute__((always_inline)) {
      if (pass == 0) {
#pragma unroll
        for (int i = 0; i < 16; i++) {
          const int kp = kt * 32 + crow(i, hh);
          const unsigned key = sortkey(sc[i]);
          const unsigned bin = (kp <= lim) ? (key >> 24) : 256u;
          atomicAdd(&hist[r * 257 + bin], 1u);
        }
      } else if (pass < 4) {
        const int sh = 24 - 8 * pass;
#pragma unroll
        for (int i = 0; i < 16; i++) {
          const int kp = kt * 32 + crow(i, hh);
          const unsigned key = sortkey(sc[i]);
          if ((key >> (sh + 8)) == pref && kp <= lim) atomicAdd(&hist[r * 257 + ((key >> sh) & 255u)], 1u);
        }
      } else if (pass == 5) {
        unsigned mc = 0u, ms = 0u;
        unsigned keys[16];
#pragma unroll
        for (int i = 0; i < 16; i++) {
          const int kp = kt * 32 + crow(i, hh);
          keys[i] = sortkey(sc[i]);
          const unsigned bt = keys[i] >> 16;
          const bool valid = (kp <= lim);
          ms |= (valid && bt > pref) ? (1u << i) : 0u;
          mc |= (valid && bt == pref) ? (1u << i) : 0u;
        }
        unsigned base_c = 0u, base_s = 0u;
        if (mc) base_c = atomicAdd(&meta[128 + r], (unsigned)__popc(mc));
        if (ms) base_s = atomicAdd(&meta[64 + r], (unsigned)__popc(ms));
#pragma unroll
        for (int i = 0; i < 16; i++) {
          const int kp = kt * 32 + crow(i, hh);
          if ((mc >> i) & 1u) {
            const unsigned cp = base_c + (unsigned)__popc(mc & ((1u << i) - 1u));
            if (cp < (unsigned)CAPL_) { lK[r * CAPL_ + cp] = keys[i]; lI[r * CAPL_ + cp] = (u16)kp; }
          }
          if ((ms >> i) & 1u) {
            const unsigned pos = base_s + (unsigned)__popc(ms & ((1u << i) - 1u));
            if (pos < 256u) sidx[r * 256 + pos] = (u16)kp;
          }
        }
      } else {
#pragma unroll
        for (int i = 0; i < 16; i++) {
          const int kp = kt * 32 + crow(i, hh);
          const unsigned key = sortkey(sc[i]);
          bool sel = (kp <= lim);
          if (radix) {
            sel = sel && (key >= pref);
            if (sel && key == pref) sel = atomicAdd(&meta[96 + r], 1u) < krem;
          }
          if (sel) { const unsigned pos = atomicAdd(&meta[64 + r], 1u); if (pos < 256u) sidx[r * 256 + pos] = (u16)kp; }
        }
      }
    };
    const int klast = nk32 - 1;
    bf16x8 nA0 = {0, 0, 0, 0, 0, 0, 0, 0}, nA1 = nA0, nB0 = nA0, nB1 = nA0;
    if (wave < nk32) {
      const int ka = wave, kb2 = min(wave + 4, klast);
      nA0 = *(const bf16x8*)(Ki + (tokb + ka * 32 + r) * 32 + hh * 8);
      nA1 = *(const bf16x8*)(Ki + (tokb + ka * 32 + r) * 32 + 16 + hh * 8);
      nB0 = *(const bf16x8*)(Ki + (tokb + kb2 * 32 + r) * 32 + hh * 8);
      nB1 = *(const bf16x8*)(Ki + (tokb + kb2 * 32 + r) * 32 + 16 + hh * 8);
    }
#pragma unroll 1
    for (int kt = wave; kt < nk32; kt += 8) {
      const bf16x8 kA0 = nA0, kA1 = nA1, kB0 = nB0, kB1 = nB1;
      {
        const int ka = min(kt + 8, klast), kb2 = min(kt + 12, klast);
        nA0 = *(const bf16x8*)(Ki + (tokb + ka * 32 + r) * 32 + hh * 8);
        nA1 = *(const bf16x8*)(Ki + (tokb + ka * 32 + r) * 32 + 16 + hh * 8);
        nB0 = *(const bf16x8*)(Ki + (tokb + kb2 * 32 + r) * 32 + hh * 8);
        nB1 = *(const bf16x8*)(Ki + (tokb + kb2 * 32 + r) * 32 + 16 + hh * 8);
      }
      f32x16 scA = zero16(), scB = zero16();
#pragma unroll 2
      for (int hd = 0; hd < 8; hd++) {
        const bf16x8 q0f = *(const bf16x8*)(sQi + r * 528 + hd * 64 + hh * 16);
        const bf16x8 q1f = *(const bf16x8*)(sQi + r * 528 + hd * 64 + 32 + hh * 16);
        const float w = sWi[r * 8 + hd];
        f32x16 sa = MFMA32(kA0, q0f, zero16());
        f32x16 sb = MFMA32(kB0, q0f, zero16());
        sa = MFMA32(kA1, q1f, sa);
        sb = MFMA32(kB1, q1f, sb);
#pragma unroll
        for (int i = 0; i < 16; i++) {
          scA[i] += __int_as_float(max(__float_as_int(sa[i]), 0)) * w;
          scB[i] += __int_as_float(max(__float_as_int(sb[i]), 0)) * w;
        }
      }
      elems(scA, kt, (kt == qt) ? qp : 0x7fffffff);
      if (kt + 4 < nk32) elems(scB, kt + 4, (kt + 4 == qt) ? qp : 0x7fffffff);
    }
    __syncthreads();
    if (pass < 4) {
      for (int j = 0; j < 8; j++) {
        const int qq = wave * 8 + j;
        const unsigned k = meta[32 + qq];
        unsigned c4[4]; unsigned tot = 0;
#pragma unroll
        for (int e = 0; e < 4; e++) { c4[e] = hist[qq * 257 + 255 - 4 * lane - e]; tot += c4[e]; }
        unsigned incl = tot;
        for (int o = 1; o < 64; o <<= 1) { const unsigned t = __shfl_up(incl, o); if (lane >= o) incl += t; }
        unsigned run = incl - tot;
#pragma unroll
        for (int e = 0; e < 4; e++) {
          if (run < k && run + c4[e] >= k) {
            meta[qq] = (meta[qq] << 8) | (unsigned)(255 - 4 * lane - e); meta[32 + qq] = k - run;
            if (pass == 1 && c4[e] > (unsigned)CAPL_) meta[192] = 1u;
          }
          run += c4[e];
        }
      }
    }
    if (pass >= 4) break;
    if (pass == 1) { __syncthreads(); fast = (meta[192] == 0u); pass = fast ? 5 : 2; } else pass++;
  }
  __syncthreads();
  if (fast) {
#pragma unroll 1
    for (int j = 0; j < 8; j++) {
      const int qq = wave * 8 + j;
      const int c = min((int)meta[128 + qq], CAPL_);
      const unsigned k = meta[32 + qq];
      const bool in = lane < c;
      const unsigned mykey = in ? lK[qq * CAPL_ + lane] : 0u;
      const unsigned myidx = in ? (unsigned)lI[qq * CAPL_ + lane] : 0u;
      unsigned rank = 0u;
      for (int t = 0; t < c; t++) {
        const unsigned ok = __shfl(mykey, t);
        rank += (ok > mykey || (ok == mykey && t < lane)) ? 1u : 0u;
      }
      const bool sel = in && (rank < k);
      const unsigned long long m = __ballot(sel);
      const unsigned base = meta[64 + qq];
      if (sel) {
        const unsigned pos = base + (unsigned)__popcll(m & ((1ull << lane) - 1ull));
        if (pos < 256u) sidx[qq * 256 + pos] = (u16)myidx;
      }
      __builtin_amdgcn_wave_barrier();
      if (lane == 0) meta[64 + qq] = base + (unsigned)__popcll(m);
    }
    __syncthreads();
  }
  float* myP = sP + wave * 1024;
  (void)sQ;
#pragma unroll 1
  for (int j = 0; j < 8; j++) {
    const int qq = wave * 8 + j;
    const int qpos = q0 + qq;
    const size_t tok = tokb + qpos;
    const int n = min((int)meta[64 + qq], 256);
    __syncthreads();
    bf16x8 qf[4];
#pragma unroll
    for (int ks = 0; ks < 4; ks++) {
      bf16x8 z = {0, 0, 0, 0, 0, 0, 0, 0};
      if (r < 4) z = *(const bf16x8*)(Qs + tok * 256 + r * 64 + ks * 16 + hh * 8);
      qf[ks] = z;
    }
#pragma unroll 4
    for (int kb = 0; kb < 8; kb++) {
      const int jj = kb * 32 + r;
      const int kidx = (jj < n) ? (int)sidx[qq * 256 + jj] : 0;
      const u16* kp = Ks + (tokb + kidx) * 64 + hh * 8;
      bf16x8 kf[4];
#pragma unroll
      for (int ks = 0; ks < 4; ks++) kf[ks] = *(const bf16x8*)(kp + ks * 16);
      f32x16 sacc = zero16();
#pragma unroll
      for (int ks = 0; ks < 4; ks++) sacc = MFMA32(kf[ks], qf[ks], sacc);
      if (r < 4) {
#pragma unroll
        for (int i = 0; i < 16; i++) myP[(kb * 32 + crow(i, hh)) * 4 + r] = sacc[i];
      }
    }
    __syncthreads();
    float sc[4][4];
#pragma unroll
    for (int rd = 0; rd < 4; rd++) {
      const int jj = rd * 64 + lane;
      const bool valid = jj < n;
      const int kidx = valid ? (int)sidx[qq * 256 + jj] : 0;
      const int dist = min(max(qpos - kidx, 0), 128);
      const float4 d = *(const float4*)(myP + jj * 4);
      sc[rd][0] = valid ? d.x * 0.125f + sbias[0 * 129 + dist] : -INFINITY;
      sc[rd][1] = valid ? d.y * 0.125f + sbias[1 * 129 + dist] : -INFINITY;
      sc[rd][2] = valid ? d.z * 0.125f + sbias[2 * 129 + dist] : -INFINITY;
      sc[rd][3] = valid ? d.w * 0.125f + sbias[3 * 129 + dist] : -INFINITY;
    }
#pragma unroll
    for (int hd = 0; hd < 4; hd++) {
      float mx = fmaxf(fmaxf(sc[0][hd], sc[1][hd]), fmaxf(sc[2][hd], sc[3][hd]));
      mx = wave_max(mx);
      float sm = 0.f;
#pragma unroll
      for (int rd = 0; rd < 4; rd++) { sc[rd][hd] = __expf(sc[rd][hd] - mx); sm += sc[rd][hd]; }
      sm = wave_sum(sm);
      const float inv = 1.f / sm;
#pragma unroll
      for (int rd = 0; rd < 4; rd++) sc[rd][hd] *= inv;
    }
#pragma unroll
    for (int rd = 0; rd < 4; rd++) *(float4*)(myP + (rd * 64 + lane) * 4) = make_float4(sc[rd][0], sc[rd][1], sc[rd][2], sc[rd][3]);
    __syncthreads();
    const int g = lane >> 3, c8 = lane & 7;
    float acc[32];
#pragma unroll
    for (int i = 0; i < 32; i++) acc[i] = 0.f;
#pragma unroll 16
    for (int it = 0; it < 32; it++) {
      const int jj = it * 8 + g;
      const int kidx = (jj < n) ? (int)sidx[qq * 256 + jj] : 0;
      const float4 pj = *(const float4*)(myP + jj * 4);
      const u32x4 vv = *(const u32x4*)(Vs + (tokb + kidx) * 64 + c8 * 8);
      const float vf[8] = {bf2f((u16)(vv.x & 0xffff)), bf2f((u16)(vv.x >> 16)), bf2f((u16)(vv.y & 0xffff)), bf2f((u16)(vv.y >> 16)),
                           bf2f((u16)(vv.z & 0xffff)), bf2f((u16)(vv.z >> 16)), bf2f((u16)(vv.w & 0xffff)), bf2f((u16)(vv.w >> 16))};
#pragma unroll
      for (int e = 0; e < 8; e++) {
        acc[0 * 8 + e] += pj.x * vf[e]; acc[1 * 8 + e] += pj.y * vf[e];
        acc[2 * 8 + e] += pj.z * vf[e]; acc[3 * 8 + e] += pj.w * vf[e];
      }
    }
    const bool b5 = lane & 32, b4 = lane & 16, b3 = lane & 8;
    float w16[16], w8[8], w4[4];
#pragma unroll
    for (int i = 0; i < 16; i++) { const float snd = b5 ? acc[i] : acc[i + 16]; const float rcv = __shfl_xor(snd, 32); w16[i] = (b5 ? acc[i + 16] : acc[i]) + rcv; }
#pragma unroll
    for (int i = 0; i < 8; i++) { const float snd = b4 ? w16[i] : w16[i + 8]; const float rcv = __shfl_xor(snd, 16); w8[i] = (b4 ? w16[i + 8] : w16[i]) + rcv; }
#pragma unroll
    for (int i = 0; i < 4; i++) { const float snd = b3 ? w8[i] : w8[i + 4]; const float rcv = __shfl_xor(snd, 8); w4[i] = (b3 ? w8[i + 4] : w8[i]) + rcv; }
    const int hd = (b5 ? 2 : 0) + (b4 ? 1 : 0);
    *(uint2*)(CC + tok * 1024 + 768 + hd * 64 + c8 * 8 + (b3 ? 4 : 0)) = make_uint2(pack2(w4[0], w4[1]), pack2(w4[2], w4[3]));
  }
}

DI void phase_mix1(const Params& P, int layer, int bid, int nb, char* smem) {
  char* mb = WS(P) + OFF_H;
  for (int w = bid * 4 + (tidx() >> 6); w < 2048; w += nb * 4) ssm_scan<false>(P, layer, w, mb, smem);
  for (int j = 0;; j++) {
    const int idx = (j & 1) ? (j * nb + (nb - 1 - bid)) : (j * nb + bid);
    if (j * nb >= 2048) break;
    if (idx >= 2048) continue;
    const int qt = 255 - (idx >> 3), b = idx & 7;
    dsa_item(P, layer, b, qt, mb, smem);
  }
  for (int j = 0;; j++) {
    const int idx = (j & 1) ? (j * nb + (nb - 1 - bid)) : (j * nb + bid);
    if (j * nb >= 2048) break;
    if (idx >= 2048) continue;
    const int qt = 63 - (idx >> 5), bh = idx & 31;
    da_item(P, layer, bh >> 2, bh & 3, qt, mb, smem);
  }
}

DI void phase_mix2(const Params& P, int layer, int bid, int nb, char* smem) {
  char* mb = WS(P) + OFF_H;
  for (int w = bid * 4 + (tidx() >> 6); w < 2048; w += nb * 4) ssm_scan<true>(P, layer, w, mb, smem);
}

DI void run_phase(const Params& P, int ph, int bid, int nb, char* smem) {
  char* ws = WS(P);
  u16* sm = (u16*)smem;
  if (ph == 0) { phase_prep(P, bid, nb, smem); return; }
  const int l = (ph - 1) / 12, s = (ph - 1) % 12;
  u16* Xb = (u16*)(ws + OFF_XB);
  u16* H = (u16*)(ws + OFF_H);
  u16* CC = (u16*)(ws + OFF_CC);
  float* X = OUTP(P);
  switch (s) {
    case 0: phase_ffn_up(Xb, (const u16*)(ws + OFF_WGU1 + l * SZ_WGU), H, bid, nb, sm); break;
    case 1: phase_ffn_down(H, (const u16*)(ws + OFF_WD1 + l * SZ_WD), (l == 0) ? INP(P, 0) : (const float*)X, X, nullptr, bid, nb, sm); break;
    case 2: phase_ln(X, Xb, INP(P, 6) + l * 1024, INP(P, 7) + l * 1024, bid, nb); break;
    case 3: phase_w_in(Xb, (const u16*)(ws + OFF_WIN + l * SZ_WIN), ws + OFF_H, bid, nb, sm); break;
    case 4: phase_mix1(P, l, bid, nb, smem); break;
    case 5: phase_mix2(P, l, bid, nb, smem); break;
    case 6: phase_glu((const u16*)(ws + OFF_H + M_YG), (const u16*)(ws + OFF_WGLU + l * SZ_WGLU), CC, bid, nb, sm); break;
    case 7: phase_w_o(CC, (const u16*)(ws + OFF_WO + l * SZ_WO), X, bid, nb, sm); break;
    case 8: phase_ln(X, Xb, INP(P, 24) + l * 1024, INP(P, 25) + l * 1024, bid, nb); break;
    case 9:
      phase_ffn_up(Xb, (const u16*)(ws + OFF_WGU2 + l * SZ_WGU), H, bid, nb, sm);
      phase_ple(Xb, (const u16*)(ws + OFF_WPG + l * SZ_WPG), (const u16*)(ws + OFF_PB) + (size_t)l * T_ * 256, (const u16*)(ws + OFF_WPP + l * SZ_WPP), CC, bid, nb, sm);
      break;
    case 10: phase_ffn_down(H, (const u16*)(ws + OFF_WD2 + l * SZ_WD), X, X, CC, bid, nb, sm); break;
    case 11: phase_ln(X, Xb, INP(P, 31) + l * 1024, INP(P, 32) + l * 1024, bid, nb); break;
  }
}

constexpr int NPHASES = 25;

__global__ void __launch_bounds__(256, 2) mega(Params P, int ph0, int ph1) {
  extern __shared__ __attribute__((aligned(16))) char smem[];
  cg::grid_group grid = cg::this_grid();
  const int bid = blockIdx.x, nb = gridDim.x;
#ifndef DUP_MASK
#define DUP_MASK 0
#endif
#define PHASE(k) if (ph0 <= (k) && (k) < ph1) { \
    if ((k) > 0 && ((DUP_MASK >> (((k) - 1) % 12)) & 1)) { run_phase(P, (k), bid, nb, smem); grid.sync(); } \
    run_phase(P, (k), bid, nb, smem); if ((k) + 1 < ph1) grid.sync(); }
  PHASE(0) PHASE(1) PHASE(2) PHASE(3) PHASE(4) PHASE(5) PHASE(6) PHASE(7) PHASE(8) PHASE(9) PHASE(10) PHASE(11) PHASE(12)
  PHASE(13) PHASE(14) PHASE(15) PHASE(16) PHASE(17) PHASE(18) PHASE(19) PHASE(20) PHASE(21) PHASE(22) PHASE(23) PHASE(24)
#undef PHASE
}

extern "C" void kernel_launch(void* const* d_in, const int* in_sizes, int n_in, void* d_out, int out_size, void* d_ws, size_t ws_size, hipStream_t stream) {
  static int grid_blocks = 0;
  if (grid_blocks == 0) {
    if (n_in != 33 || ws_size < WS_END) { fprintf(stderr, "kernel_launch: need 33 inputs and %zu bytes of ws (got %d, %zu)\n", (size_t)WS_END, n_in, ws_size); grid_blocks = -1; return; }
    int dev = 0, cus = 0, per_cu = 0;
    (void)hipGetDevice(&dev);
    (void)hipDeviceGetAttribute(&cus, hipDeviceAttributeMultiprocessorCount, dev);
    (void)hipFuncSetAttribute((const void*)mega, hipFuncAttributeMaxDynamicSharedMemorySize, LDS_BYTES);
    (void)hipOccupancyMaxActiveBlocksPerMultiprocessor(&per_cu, (const void*)mega, 256, LDS_BYTES);
    if (per_cu < 1) per_cu = 1;
    if (per_cu > 2) per_cu = 2;
    grid_blocks = cus * per_cu;
    fprintf(stderr, "kernel_launch: cus %d per_cu %d grid %d\n", cus, per_cu, grid_blocks);
  }
  if (grid_blocks < 0) return;
  Params p;
  memset(&p, 0, sizeof(p));
  for (int i = 0; i < 33; i++) p.in[i] = (const float*)d_in[i];
  p.out = (float*)d_out;
  p.ws = (char*)d_ws;
#if MULTI_LAUNCH
  for (int ph = 0; ph < NPHASES; ph++) {
    hipLaunchKernelGGL(mega, dim3(grid_blocks), dim3(256), LDS_BYTES, stream, p, ph, ph + 1);
  }
#else
  int ph0 = 0, ph1 = NPHASES;
  void* args[] = {&p, &ph0, &ph1};
  hipError_t e = hipLaunchCooperativeKernel((const void*)mega, dim3(grid_blocks), dim3(256), args, LDS_BYTES, stream);
  if (e != hipSuccess) fprintf(stderr, "cooperative launch failed: %s (grid %d)\n", hipGetErrorString(e), grid_blocks);
#endif
}
```

```cpp
#include <hip/hip_runtime.h>
#include <hip/hip_cooperative_groups.h>
#include <stdint.h>
#include <math.h>
#include <stdio.h>
#include <string.h>
namespace cg = cooperative_groups;

#ifndef MULTI_LAUNCH
#define MULTI_LAUNCH 0
#endif

typedef unsigned short u16;
typedef __attribute__((ext_vector_type(8))) short bf16x8;
typedef __attribute__((ext_vector_type(4))) short s16x4;
typedef __attribute__((ext_vector_type(16))) float f32x16;
typedef __attribute__((ext_vector_type(4))) unsigned u32x4;
typedef __attribute__((ext_vector_type(2))) unsigned u32x2;

#define DI __device__ __forceinline__
#define MFMA32(a, b, c) __builtin_amdgcn_mfma_f32_32x32x16_bf16((a), (b), (c), 0, 0, 0)

constexpr int T_ = 65536;
constexpr int L_ = 8192;
constexpr int D_ = 1024;
constexpr int FF_ = 2816;
constexpr float ALPHA_ = 1.41421356237309515f;
constexpr float LN_EPS_ = 1e-5f;
constexpr float LOG2E_ = 1.44269504088896341f;
constexpr int LDS_BYTES = 73728;

constexpr size_t SZ_WGU = (size_t)5632 * 1024 * 2;
constexpr size_t SZ_WD = (size_t)1024 * 2816 * 2;
constexpr size_t SZ_WIN = (size_t)2560 * 1024 * 2;
constexpr size_t SZ_WO = (size_t)1024 * 1024 * 2;
constexpr size_t SZ_WGLU = (size_t)256 * 256 * 2;
constexpr size_t SZ_WPG = (size_t)1024 * 1024 * 2;
constexpr size_t SZ_WPP = (size_t)1024 * 256 * 2;
constexpr size_t OFF_WGU1 = 0;
constexpr size_t OFF_WD1 = OFF_WGU1 + 2 * SZ_WGU;
constexpr size_t OFF_WGU2 = OFF_WD1 + 2 * SZ_WD;
constexpr size_t OFF_WD2 = OFF_WGU2 + 2 * SZ_WGU;
constexpr size_t OFF_WIN = OFF_WD2 + 2 * SZ_WD;
constexpr size_t OFF_WO = OFF_WIN + 2 * SZ_WIN;
constexpr size_t OFF_WGLU = OFF_WO + 2 * SZ_WO;
constexpr size_t OFF_WPG = OFF_WGLU + 2 * SZ_WGLU;
constexpr size_t OFF_WPP = OFF_WPG + 2 * SZ_WPG;
constexpr size_t OFF_COEFA = OFF_WPP + 2 * SZ_WPP;
constexpr size_t OFF_COEFB = OFF_COEFA + 2 * 16 * 64 * 16;
constexpr size_t OFF_LAM = OFF_COEFB + 2 * 16 * 64 * 16 * 8;
constexpr size_t OFF_BIAS = OFF_LAM + 256;
constexpr size_t OFF_XBAR = OFF_BIAS + 8 * 129 * 4 + 32;
constexpr size_t OFF_XB = OFF_XBAR + 16384;
constexpr size_t OFF_PB = OFF_XB + (size_t)T_ * 1024 * 2;
constexpr size_t OFF_H = OFF_PB + (size_t)2 * T_ * 256 * 2;
constexpr size_t SZ_H = (size_t)384 << 20;
constexpr size_t OFF_CC = OFF_H + SZ_H;
constexpr size_t OFF_CANDK = OFF_CC + (size_t)T_ * 1024 * 2;
constexpr int CAP_ = 2048;
constexpr size_t OFF_CANDI = OFF_CANDK + (size_t)512 * 32 * CAP_ * 4;
constexpr size_t WS_END = OFF_CANDI + (size_t)512 * 32 * CAP_ * 2;
constexpr size_t MB_ = (size_t)1 << 20;
constexpr size_t M_QD = 0, M_KD = 64 * MB_, M_VT = 128 * MB_, M_U = 192 * MB_, M_QS = 256 * MB_, M_QI = 288 * MB_, M_YG = 320 * MB_,
                 M_KS = 352 * MB_, M_VS = 360 * MB_, M_KI = 368 * MB_, M_WI = 372 * MB_, M_SEND = 374 * MB_;

struct Params {
  const float* in[33];
  float* out;
  char* ws;
};

DI int tidx() { int t = threadIdx.x; asm volatile("" : "+v"(t)); return t; }
#define GAS __attribute__((address_space(1)))
DI size_t opaque0() { size_t z = 0; asm volatile("" : "+s"(z)); return z; }
DI char* WS(const Params& P) { return P.ws + opaque0(); }
DI float* OUTP(const Params& P) { return P.out + opaque0(); }
DI const float* INP(const Params& P, int i) { return P.in[i]; }
typedef __bf16 bf16v2_ __attribute__((ext_vector_type(2)));
typedef float f32v2_ __attribute__((ext_vector_type(2)));
DI u16 f2bf(float x) { const __bf16 h = (__bf16)x; return __builtin_bit_cast(u16, h); }
DI float bf2f(u16 v) { return __uint_as_float(((unsigned)v) << 16); }
DI unsigned pack2(float a, float b) { f32v2_ v; v.x = a; v.y = b; const bf16v2_ h = __builtin_convertvector(v, bf16v2_); return __builtin_bit_cast(unsigned, h); }
DI int crow(int i, int hh) { return (i & 3) + 8 * (i >> 2) + 4 * hh; }
DI float sigmoidf_(float x) { return __builtin_amdgcn_rcpf(1.f + __expf(-x)); }
DI float wave_sum(float v) { for (int o = 32; o > 0; o >>= 1) v += __shfl_xor(v, o); return v; }
DI float wave_max(float v) { for (int o = 32; o > 0; o >>= 1) v = fmaxf(v, __shfl_xor(v, o)); return v; }
DI f32x16 zero16() { f32x16 z; for (int i = 0; i < 16; i++) z[i] = 0.f; return z; }
DI bf16x8 pack8(const f32x16& x, int s) {
  union { unsigned u[4]; bf16x8 v; } t;
  t.u[0] = pack2(x[8 * s + 0], x[8 * s + 1]); t.u[1] = pack2(x[8 * s + 2], x[8 * s + 3]);
  t.u[2] = pack2(x[8 * s + 4], x[8 * s + 5]); t.u[3] = pack2(x[8 * s + 6], x[8 * s + 7]);
  return t.v;
}

constexpr int GS_ = 72;
constexpr int GT_ = 128 * GS_;

constexpr int GST_ = 32768;
DI void gemm_stage(const u16* __restrict__ A, int lda, const u16* __restrict__ B, int ldb, int kt, char* sbuf) {
  const int tid = tidx(), lane = tid & 63, wave = __builtin_amdgcn_readfirstlane(tid >> 6);
  const int pp = lane >> 4, pos = lane & 15;
#pragma unroll
  for (int i = 0; i < 4; i++) {
    const int blk = i * 4 + wave;
    const int p = blk * 4 + pp;
    const int row = 2 * p + (pos >> 3), c8 = (pos & 7) ^ (p & 7);
    const u16* ga = A + (size_t)row * lda + kt * 64 + c8 * 8;
    const u16* gb = B + (size_t)row * ldb + kt * 64 + c8 * 8;
    __builtin_amdgcn_global_load_lds((const GAS void*)ga, (__attribute__((address_space(3))) void*)(sbuf + blk * 1024), 16, 0, 0);
    __builtin_amdgcn_global_load_lds((const GAS void*)gb, (__attribute__((address_space(3))) void*)(sbuf + 16384 + blk * 1024), 16, 0, 0);
  }
}
DI void gemm_main(f32x16 (&acc)[2][2], const u16* __restrict__ A, int lda, const u16* __restrict__ B, int ldb, int K, u16* sm) {
  const int tid = tidx(), lane = tid & 63, wave = tid >> 6;
  const int wm = wave >> 1, wn = wave & 1, r = lane & 31, hh = lane >> 5;
  char* sb = (char*)sm;
  const int rowa = wm * 64 + r, rowb = wn * 64 + r;
  const int baseA = (rowa >> 1) * 256 + ((rowa & 1) << 7), xa = (rowa >> 1) & 7;
  const int baseB = 16384 + (rowb >> 1) * 256 + ((rowb & 1) << 7), xb = (rowb >> 1) & 7;
  const int nk = K >> 6;
  asm volatile("s_waitcnt vmcnt(0)" ::: "memory");
  __syncthreads();
#pragma unroll 1
  for (int kt = 0; kt < nk; kt++) {
    if (kt + 1 < nk) gemm_stage(A, lda, B, ldb, kt + 1, sb + ((kt + 1) & 1) * GST_);
    const char* st = sb + (kt & 1) * GST_;
#pragma unroll
    for (int ks = 0; ks < 4; ks++) {
      const int ca = ((ks * 2 + hh) ^ xa) << 4, cb = ((ks * 2 + hh) ^ xb) << 4;
      const bf16x8 fa0 = *(const bf16x8*)(st + baseA + ca);
      const bf16x8 fa1 = *(const bf16x8*)(st + baseA + 4096 + ca);
      const bf16x8 fb0 = *(const bf16x8*)(st + baseB + cb);
      const bf16x8 fb1 = *(const bf16x8*)(st + baseB + 4096 + cb);
      acc[0][0] = MFMA32(fa0, fb0, acc[0][0]); acc[0][1] = MFMA32(fa0, fb1, acc[0][1]);
      acc[1][0] = MFMA32(fa1, fb0, acc[1][0]); acc[1][1] = MFMA32(fa1, fb1, acc[1][1]);
    }
    asm volatile("s_waitcnt vmcnt(0)" ::: "memory");
    __syncthreads();
  }
}

DI bool tile_at(int it, int bid, int nb, int TM, int TN, int& tm, int& tn) {
  if ((nb & 7) == 0 && (TM & 63) == 0) {
    const int xcd = bid & 7, lw = bid >> 3, nlw = nb >> 3;
    const int lt = lw + it * nlw, per = (TM >> 3) * TN;
    if (lt >= per) return false;
    const int g = lt / (4 * TN), rem = lt - g * 4 * TN;
    tn = rem >> 2; tm = xcd * (TM >> 3) + g * 4 + (rem & 3);
    return true;
  } else {
    const int t = bid + it * nb;
    if (t >= TM * TN) return false;
    tn = t / TM; tm = t - tn * TM;
    return true;
  }
}

template <class AF, class BF, class EPI>
DI void gemm_phase(int TM, int TN, int K, int lda, int ldb, AF a_of, BF b_of, EPI epi, int bid, int nb, u16* sm) {
  int tm, tn;
  bool have = tile_at(0, bid, nb, TM, TN, tm, tn);
  __syncthreads();
  if (have) gemm_stage(a_of(tm), lda, b_of(tn), ldb, 0, (char*)sm);
  for (int it = 0; have; it++) {
    f32x16 acc[2][2] = {{zero16(), zero16()}, {zero16(), zero16()}};
    gemm_main(acc, a_of(tm), lda, b_of(tn), ldb, K, sm);
    int tm2 = 0, tn2 = 0;
    const bool have2 = tile_at(it + 1, bid, nb, TM, TN, tm2, tn2);
    if (have2) gemm_stage(a_of(tm2), lda, b_of(tn2), ldb, 0, (char*)sm);
    epi(acc, tm, tn);
    have = have2; tm = tm2; tn = tn2;
  }
  asm volatile("s_waitcnt vmcnt(0)" ::: "memory");
}

DI void transpose_job(const float* __restrict__ src, int K, int N, u16* __restrict__ dst, int mode, int bid, int nb, float* tile) {
  const int tid = tidx();
  const int tk = K >> 6, tn = (N + 63) >> 6;
  for (int t = bid; t < tk * tn; t += nb) {
    const int k0 = (t % tk) * 64, n0 = (t / tk) * 64;
    __syncthreads();
#pragma unroll 4
    for (int i = 0; i < 16; i++) {
      const int k = i * 4 + (tid >> 6), n = tid & 63;
      tile[k * 65 + n] = (n0 + n < N) ? src[(size_t)(k0 + k) * N + n0 + n] : 0.f;
    }
    __syncthreads();
#pragma unroll 4
    for (int i = 0; i < 16; i++) {
      const int n = i * 4 + (tid >> 6), k = tid & 63;
      const int ng = n0 + n;
      if (ng < N) {
        int row = ng;
        if (mode == 1) row = (ng >> 5) * 64 + (ng & 31);
        else if (mode == 2) row = (ng >> 5) * 64 + 32 + (ng & 31);
        dst[(size_t)row * K + k0 + k] = f2bf(tile[k * 65 + n]);
      }
    }
  }
}

DI void phase_prep(const Params& P, int bid, int nb, char* smem) {
  float* tile = (float*)smem;
  char* ws = WS(P);
  for (int l = 0; l < 2; l++) {
    transpose_job(INP(P, 3) + (size_t)l * 1024 * FF_, 1024, FF_, (u16*)(ws + OFF_WGU1 + l * SZ_WGU), 1, bid, nb, tile);
    transpose_job(INP(P, 4) + (size_t)l * 1024 * FF_, 1024, FF_, (u16*)(ws + OFF_WGU1 + l * SZ_WGU), 2, bid, nb, tile);
    transpose_job(INP(P, 5) + (size_t)l * FF_ * 1024, FF_, 1024, (u16*)(ws + OFF_WD1 + l * SZ_WD), 0, bid, nb, tile);
    transpose_job(INP(P, 26) + (size_t)l * 1024 * FF_, 1024, FF_, (u16*)(ws + OFF_WGU2 + l * SZ_WGU), 1, bid, nb, tile);
    transpose_job(INP(P, 27) + (size_t)l * 1024 * FF_, 1024, FF_, (u16*)(ws + OFF_WGU2 + l * SZ_WGU), 2, bid, nb, tile);
    transpose_job(INP(P, 28) + (size_t)l * FF_ * 1024, FF_, 1024, (u16*)(ws + OFF_WD2 + l * SZ_WD), 0, bid, nb, tile);
    transpose_job(INP(P, 8) + (size_t)l * 1024 * 2472, 1024, 2472, (u16*)(ws + OFF_WIN + l * SZ_WIN), 0, bid, nb, tile);
    transpose_job(INP(P, 9) + (size_t)l * 1024 * 1024, 1024, 1024, (u16*)(ws + OFF_WO + l * SZ_WO), 0, bid, nb, tile);
    transpose_job(INP(P, 23) + (size_t)l * 256 * 256, 256, 256, (u16*)(ws + OFF_WGLU + l * SZ_WGLU), 0, bid, nb, tile);
    transpose_job(INP(P, 30) + (size_t)l * 1024 * 1024, 1024, 1024, (u16*)(ws + OFF_WPG + l * SZ_WPG), 0, bid, nb, tile);
    transpose_job(INP(P, 29) + (size_t)l * 256 * 1024, 256, 1024, (u16*)(ws + OFF_WPP + l * SZ_WPP), 0, bid, nb, tile);
    u16* win = (u16*)(ws + OFF_WIN + l * SZ_WIN);
    for (int i = bid * 256 + tidx(); i < 88 * 1024; i += nb * 256) win[(size_t)2472 * 1024 + i] = 0;
  }
  const size_t gt = (size_t)bid * 256 + tidx(), gs = (size_t)nb * 256;
  {
    const float4* x4 = (const float4*)INP(P, 0);
    uint2* xb = (uint2*)(ws + OFF_XB);
    for (size_t i = gt; i < (size_t)T_ * 1024 / 4; i += gs) { float4 v = x4[i]; xb[i] = make_uint2(pack2(v.x, v.y), pack2(v.z, v.w)); }
    const float4* p4 = (const float4*)INP(P, 1);
    uint2* pb = (uint2*)(ws + OFF_PB);
    for (size_t i = gt; i < (size_t)2 * T_ * 256 / 4; i += gs) { float4 v = p4[i]; pb[i] = make_uint2(pack2(v.x, v.y), pack2(v.z, v.w)); }
  }
  if (gt < 2 * 16 * 64) {
    const int l = (int)gt >> 10, g = ((int)gt >> 6) & 15, p = (int)gt & 63;
    const int gi = (l * 16 + g) * 64 + p;
    const double lr = INP(P, 15)[gi], li = INP(P, 16)[gi];
    const double dt = exp((double)INP(P, 17)[l * 16 + g]);
    const double mag = exp(lr * dt);
    const double ar = mag * cos(li * dt), ai = mag * sin(li * dt);
    const double mag5 = exp(512.0 * lr * dt);
    const double a5r = mag5 * cos(512.0 * li * dt), a5i = mag5 * sin(512.0 * li * dt);
    ((float4*)(ws + OFF_COEFA))[gi] = make_float4((float)ar, (float)ai, (float)a5r, (float)a5i);
    const double den = lr * lr + li * li, nr = ar - 1.0, ni = ai;
    const double fr = (nr * lr + ni * li) / den, fi = (ni * lr - nr * li) / den;
    float2* cb = (float2*)(ws + OFF_COEFB) + (size_t)gi * 16;
    for (int c = 0; c < 16; c++) {
      const double br = INP(P, 18)[(size_t)gi * 16 + c], bi = INP(P, 19)[(size_t)gi * 16 + c];
      cb[c] = make_float2((float)(fr * br - fi * bi), (float)(fr * bi + fi * br));
    }
  }
  if (gt < 8 * 129) {
    const int hd = (int)gt / 129, n = (int)gt - hd * 129;
    int bk = n;
    if (n >= 16) { bk = 16 + (int)(log((double)n / 16.0) / log(8.0) * 16.0); bk = bk < 31 ? bk : 31; }
    ((float*)(ws + OFF_BIAS))[gt] = INP(P, 2)[bk * 8 + hd];
  }
  if (gt < 2) {
    const int l = (int)gt;
    float s1 = 0.f, s2 = 0.f;
    for (int i = 0; i < 64; i++) { s1 += INP(P, 10)[l * 64 + i] * INP(P, 11)[l * 64 + i]; s2 += INP(P, 12)[l * 64 + i] * INP(P, 13)[l * 64 + i]; }
    const float lam_init = 0.8f - 0.6f * expf(-0.3f * (float)l);
    ((float*)(ws + OFF_LAM))[l] = expf(s1) - expf(s2) + lam_init;
  }
}

DI void phase_ffn_up(const u16* __restrict__ Xb, const u16* __restrict__ Wgu, u16* __restrict__ H, int bid, int nb, u16* sm) {
  const int lane = tidx() & 63, wave = tidx() >> 6, wm = wave >> 1, wn = wave & 1, r = lane & 31, hh = lane >> 5;
  gemm_phase(512, 44, 1024, 1024, 1024,
    [&](int tm) { return Xb + (size_t)tm * 128 * 1024; }, [&](int tn) { return Wgu + (size_t)tn * 128 * 1024; },
    [&](f32x16 (&acc)[2][2], int tm, int tn) {
      const int j = tn * 64 + wn * 32 + r;
#pragma unroll
      for (int mi = 0; mi < 2; mi++)
#pragma unroll
        for (int i = 0; i < 16; i++) {
          const int row = tm * 128 + wm * 64 + mi * 32 + crow(i, hh);
          const float g = acc[mi][0][i], u = acc[mi][1][i];
          H[(size_t)row * FF_ + j] = f2bf(g * sigmoidf_(g) * u);
        }
    }, bid, nb, sm);
}

DI void phase_ffn_down(const u16* __restrict__ H, const u16* __restrict__ Wd, const float* xin, float* xout, const u16* __restrict__ ple, int bid, int nb, u16* sm) {
  const int lane = tidx() & 63, wave = tidx() >> 6, wm = wave >> 1, wn = wave & 1, r = lane & 31, hh = lane >> 5;
  gemm_phase(512, 8, FF_, FF_, FF_,
    [&](int tm) { return H + (size_t)tm * 128 * FF_; }, [&](int tn) { return Wd + (size_t)tn * 128 * FF_; },
    [&](f32x16 (&acc)[2][2], int tm, int tn) {
#pragma unroll
      for (int mi = 0; mi < 2; mi++)
#pragma unroll
        for (int ni = 0; ni < 2; ni++)
#pragma unroll
          for (int i = 0; i < 16; i++) {
            const size_t o = (size_t)(tm * 128 + wm * 64 + mi * 32 + crow(i, hh)) * 1024 + tn * 128 + wn * 64 + ni * 32 + r;
            float v = ALPHA_ * xin[o] + 0.5f * acc[mi][ni][i];
            if (ple) v += bf2f(ple[o]);
            xout[o] = v;
          }
    }, bid, nb, sm);
}

DI void phase_w_o(const u16* __restrict__ CC, const u16* __restrict__ Wo, float* x, int bid, int nb, u16* sm) {
  const int lane = tidx() & 63, wave = tidx() >> 6, wm = wave >> 1, wn = wave & 1, r = lane & 31, hh = lane >> 5;
  gemm_phase(512, 8, 1024, 1024, 1024,
    [&](int tm) { return CC + (size_t)tm * 128 * 1024; }, [&](int tn) { return Wo + (size_t)tn * 128 * 1024; },
    [&](f32x16 (&acc)[2][2], int tm, int tn) {
#pragma unroll
      for (int mi = 0; mi < 2; mi++)
#pragma unroll
        for (int ni = 0; ni < 2; ni++)
#pragma unroll
          for (int i = 0; i < 16; i++) {
            const size_t o = (size_t)(tm * 128 + wm * 64 + mi * 32 + crow(i, hh)) * 1024 + tn * 128 + wn * 64 + ni * 32 + r;
            x[o] = ALPHA_ * x[o] + acc[mi][ni][i];
          }
    }, bid, nb, sm);
}

DI void phase_glu(const u16* __restrict__ Yg, const u16* __restrict__ Wglu, u16* __restrict__ CC, int bid, int nb, u16* sm) {
  const int lane = tidx() & 63, wave = tidx() >> 6, wm = wave >> 1, wn = wave & 1, r = lane & 31, hh = lane >> 5;
  gemm_phase(512, 2, 256, 256, 256,
    [&](int tm) { return Yg + (size_t)tm * 128 * 256; }, [&](int tn) { return Wglu + (size_t)tn * 128 * 256; },
    [&](f32x16 (&acc)[2][2], int tm, int tn) {
#pragma unroll
      for (int mi = 0; mi < 2; mi++)
#pragma unroll
        for (int ni = 0; ni < 2; ni++)
#pragma unroll
          for (int i = 0; i < 16; i++) {
            const int row = tm * 128 + wm * 64 + mi * 32 + crow(i, hh), col = tn * 128 + wn * 64 + ni * 32 + r;
            const float y = bf2f(Yg[(size_t)row * 256 + col]);
            CC[(size_t)row * 1024 + 512 + col] = f2bf(y * sigmoidf_(acc[mi][ni][i]));
          }
    }, bid, nb, sm);
}

DI void phase_ple(const u16* __restrict__ Xb, const u16* __restrict__ Wpg, const u16* __restrict__ Pb, const u16* __restrict__ Wpp, u16* ple, int bid, int nb, u16* sm) {
  const int lane = tidx() & 63, wave = tidx() >> 6, wm = wave >> 1, wn = wave & 1, r = lane & 31, hh = lane >> 5;
  gemm_phase(512, 8, 1024, 1024, 1024,
    [&](int tm) { return Xb + (size_t)tm * 128 * 1024; }, [&](int tn) { return Wpg + (size_t)tn * 128 * 1024; },
    [&](f32x16 (&acc)[2][2], int tm, int tn) {
#pragma unroll
      for (int mi = 0; mi < 2; mi++)
#pragma unroll
        for (int ni = 0; ni < 2; ni++)
#pragma unroll
          for (int i = 0; i < 16; i++) {
            const size_t o = (size_t)(tm * 128 + wm * 64 + mi * 32 + crow(i, hh)) * 1024 + tn * 128 + wn * 64 + ni * 32 + r;
            ple[o] = f2bf(sigmoidf_(acc[mi][ni][i]));
          }
    }, bid, nb, sm);
  gemm_phase(512, 8, 256, 256, 256,
    [&](int tm) { return Pb + (size_t)tm * 128 * 256; }, [&](int tn) { return Wpp + (size_t)tn * 128 * 256; },
    [&](f32x16 (&acc)[2][2], int tm, int tn) {
#pragma unroll
      for (int mi = 0; mi < 2; mi++)
#pragma unroll
        for (int ni = 0; ni < 2; ni++)
#pragma unroll
          for (int i = 0; i < 16; i++) {
            const size_t o = (size_t)(tm * 128 + wm * 64 + mi * 32 + crow(i, hh)) * 1024 + tn * 128 + wn * 64 + ni * 32 + r;
            ple[o] = f2bf(acc[mi][ni][i] * bf2f(ple[o]));
          }
    }, bid, nb, sm);
}

DI void phase_w_in(const u16* __restrict__ Xb, const u16* __restrict__ Win, char* mb, int bid, int nb, u16* sm) {
  const int lane = tidx() & 63, wave = tidx() >> 6, wm = wave >> 1, wn = wave & 1, r = lane & 31, hh = lane >> 5;
  u16* Qd = (u16*)(mb + M_QD); u16* Kd = (u16*)(mb + M_KD); u16* Vt = (u16*)(mb + M_VT); float* U = (float*)(mb + M_U);
  u16* Qs = (u16*)(mb + M_QS); u16* Qi = (u16*)(mb + M_QI); u16* Ks = (u16*)(mb + M_KS); u16* Vs = (u16*)(mb + M_VS);
  u16* Ki = (u16*)(mb + M_KI); float* Wi = (float*)(mb + M_WI);
  gemm_phase(512, 20, 1024, 1024, 1024,
    [&](int tm) { return Xb + (size_t)tm * 128 * 1024; }, [&](int tn) { return Win + (size_t)tn * 128 * 1024; },
    [&](f32x16 (&acc)[2][2], int tm, int tn) {
#pragma unroll
    for (int ni = 0; ni < 2; ni++) {
      const int c0 = tn * 128 + wn * 64 + ni * 32;
      const int c = c0 + r;
#pragma unroll
      for (int mi = 0; mi < 2; mi++) {
        const int rowb = tm * 128 + wm * 64 + mi * 32;
        if (c0 >= 1024 && c0 < 1536) {
          const int cc = c - 1024, head = cc >> 7, dv = cc & 127;
          const int b = rowb >> 13, t0 = rowb & 8191;
#pragma unroll
          for (int g4 = 0; g4 < 4; g4++) {
            uint2 v = make_uint2(pack2(acc[mi][ni][4 * g4], acc[mi][ni][4 * g4 + 1]), pack2(acc[mi][ni][4 * g4 + 2], acc[mi][ni][4 * g4 + 3]));
            const int tt = t0 + 8 * g4 + 4 * hh;
            *(uint2*)(Vt + ((size_t)(((b * 4 + head) * 128 + (tt >> 6)) * 128 + dv)) * 64 + (tt & 63)) = v;
          }
        } else {
#pragma unroll
          for (int i = 0; i < 16; i++) {
            const size_t row = rowb + crow(i, hh);
            const float v = acc[mi][ni][i];
            if (c0 < 512) Qd[row * 512 + c] = f2bf(v);
            else if (c0 < 1024) {
              const int cc = c - 512;
              Kd[((size_t)((((int)(row >> 13) * 4 + (cc >> 7)) * 2 + ((cc >> 6) & 1))) * L_ + (row & 8191)) * 64 + (cc & 63)] = f2bf(v);
            }
            else if (c0 < 1792) U[row * 256 + (c - 1536)] = v;
            else if (c0 < 2048) Qs[row * 256 + (c - 1792)] = f2bf(v);
            else if (c0 < 2112) Ks[row * 64 + (c - 2048)] = f2bf(v);
            else if (c0 < 2176) Vs[row * 64 + (c - 2112)] = f2bf(v);
            else if (c0 < 2432) Qi[row * 256 + (c - 2176)] = f2bf(v);
            else if (c0 < 2464) Ki[row * 32 + (c - 2432)] = f2bf(v);
            else if (c0 == 2464) { if (r < 8) Wi[row * 8 + r] = v * 0.0625f; }
          }
        }
      }
    }
  }, bid, nb, sm);
}

DI void phase_ln(float* x, u16* __restrict__ xb, const float* __restrict__ g, const float* __restrict__ bta, int bid, int nb) {
  const int lane = tidx() & 63, wave = tidx() >> 6;
  float4 gg[4], bb[4];
#pragma unroll
  for (int i = 0; i < 4; i++) { gg[i] = *(const float4*)(g + i * 256 + lane * 4); bb[i] = *(const float4*)(bta + i * 256 + lane * 4); }
  constexpr int RB = 4;
  for (int row0 = (bid * 4 + wave) * RB; row0 < T_; row0 += nb * 4 * RB) {
    float4 v[RB][4];
#pragma unroll
    for (int rr = 0; rr < RB; rr++)
#pragma unroll
      for (int i = 0; i < 4; i++) v[rr][i] = *(const float4*)(x + (size_t)(row0 + rr) * 1024 + i * 256 + lane * 4);
    float s[RB], q[RB];
#pragma unroll
    for (int rr = 0; rr < RB; rr++) {
      s[rr] = 0.f;
#pragma unroll
      for (int i = 0; i < 4; i++) s[rr] += v[rr][i].x + v[rr][i].y + v[rr][i].z + v[rr][i].w;
    }
#pragma unroll
    for (int o = 32; o > 0; o >>= 1)
#pragma unroll
      for (int rr = 0; rr < RB; rr++) s[rr] += __shfl_xor(s[rr], o);
#pragma unroll
    for (int rr = 0; rr < RB; rr++) {
      const float mu = s[rr] * (1.f / 1024.f);
      q[rr] = 0.f;
#pragma unroll
      for (int i = 0; i < 4; i++) {
        v[rr][i].x -= mu; v[rr][i].y -= mu; v[rr][i].z -= mu; v[rr][i].w -= mu;
        q[rr] += v[rr][i].x * v[rr][i].x + v[rr][i].y * v[rr][i].y + v[rr][i].z * v[rr][i].z + v[rr][i].w * v[rr][i].w;
      }
    }
#pragma unroll
    for (int o = 32; o > 0; o >>= 1)
#pragma unroll
      for (int rr = 0; rr < RB; rr++) q[rr] += __shfl_xor(q[rr], o);
#pragma unroll
    for (int rr = 0; rr < RB; rr++) {
      const float rs = rsqrtf(q[rr] * (1.f / 1024.f) + LN_EPS_);
#pragma unroll
      for (int i = 0; i < 4; i++) {
        float4 o;
        o.x = v[rr][i].x * rs * gg[i].x + bb[i].x; o.y = v[rr][i].y * rs * gg[i].y + bb[i].y;
        o.z = v[rr][i].z * rs * gg[i].z + bb[i].z; o.w = v[rr][i].w * rs * gg[i].w + bb[i].w;
        *(float4*)(x + (size_t)(row0 + rr) * 1024 + i * 256 + lane * 4) = o;
        *(uint2*)(xb + (size_t)(row0 + rr) * 1024 + i * 256 + lane * 4) = make_uint2(pack2(o.x, o.y), pack2(o.z, o.w));
      }
    }
  }
}

DI float gelu_tanh(float x) { const float u = 0.7978845608028654f * (x + 0.044715f * x * x * x); return 0.5f * x * (1.f + tanhf(u)); }

typedef __attribute__((ext_vector_type(4))) float f32x4;
template <bool OUT>
DI void ssm_scan(const Params& P, int layer, int widx, char* mb, char* smem) {
  const int lane = tidx() & 63, wave = tidx() >> 6;
  const int b = widx >> 8, g = (widx >> 4) & 15, ch = widx & 15;
  const int gi = (layer * 16 + g) * 64 + lane;
  const float4 ca = ((const float4*)(WS(P) + OFF_COEFA))[gi];
  const float2* cbp = (const float2*)(WS(P) + OFF_COEFB) + (size_t)gi * 16;
  float bre[16], bim[16];
#pragma unroll
  for (int c = 0; c < 16; c++) { float2 t = cbp[c]; bre[c] = t.x; bim[c] = t.y; }
  const float* U = (const float*)(mb + M_U);
  float2* Send = (float2*)(mb + M_SEND);
  const size_t sbase = (size_t)((b * 16 + g) * 16) * 64 + lane;
  float xr = 0.f, xi = 0.f;
  float am[32];
  float4 dsk4 = make_float4(0.f, 0.f, 0.f, 0.f);
  float* Xs = (float*)smem + wave * (128 * 17);
  const int lm = lane & 15, lq = lane >> 4;
  if (OUT) {
    for (int j = 0; j < ch; j++) {
      const float2 e = Send[sbase + (size_t)j * 64];
      const float nr = ca.z * xr - ca.w * xi + e.x, ni = ca.z * xi + ca.w * xr + e.y;
      xr = nr; xi = ni;
    }
    const float* cre = INP(P, 20) + ((size_t)(layer * 16 + g) * 16 + lm) * 64;
    const float* cim = INP(P, 21) + ((size_t)(layer * 16 + g) * 16 + lm) * 64;
#pragma unroll
    for (int kb = 0; kb < 32; kb++) {
      const int kk = 4 * kb + lq;
      am[kb] = (kb < 16) ? cre[kk] : -cim[kk - 64];
    }
    dsk4 = *(const float4*)(INP(P, 22) + layer * 256 + g * 16 + 4 * lq);
  }
  u16* Yg = (u16*)(mb + M_YG);
  const size_t tok0 = (size_t)b * L_ + ch * 512;
  const float* ub = U + (tok0 + (lane >> 2)) * 256 + g * 16 + (lane & 3) * 4;
  float4 cur = *(const float4*)ub;
#pragma unroll 1
  for (int blk = 0; blk < 32; blk++) {
    const float4 nxt = *(const float4*)(ub + (size_t)min(blk + 1, 31) * 16 * 256);
#pragma unroll
    for (int s16 = 0; s16 < 16; s16++) {
      float uu[16];
#pragma unroll
      for (int c = 0; c < 16; c++) {
        const float comp = ((c & 3) == 0) ? cur.x : ((c & 3) == 1) ? cur.y : ((c & 3) == 2) ? cur.z : cur.w;
        uu[c] = __int_as_float(__builtin_amdgcn_readlane(__float_as_int(comp), 4 * s16 + (c >> 2)));
      }
      float br4[4] = {0.f, 0.f, 0.f, 0.f}, bi4[4] = {0.f, 0.f, 0.f, 0.f};
#pragma unroll
      for (int c = 0; c < 16; c++) { br4[c & 3] += bre[c] * uu[c]; bi4[c & 3] += bim[c] * uu[c]; }
      const float br = (br4[0] + br4[1]) + (br4[2] + br4[3]), bi = (bi4[0] + bi4[1]) + (bi4[2] + bi4[3]);
      const float nr = ca.x * xr - ca.y * xi + br, ni = ca.x * xi + ca.y * xr + bi;
      xr = nr; xi = ni;
      if (OUT) { Xs[lane * 17 + s16] = xr; Xs[(64 + lane) * 17 + s16] = xi; }
    }
    if (OUT) {
      __builtin_amdgcn_wave_barrier();
      f32x4 acc = {0.f, 0.f, 0.f, 0.f}, acc2 = {0.f, 0.f, 0.f, 0.f};
#pragma unroll
      for (int kb = 0; kb < 32; kb += 2) {
        const float bv0 = Xs[(4 * kb + lq) * 17 + lm], bv1 = Xs[(4 * kb + 4 + lq) * 17 + lm];
        acc = __builtin_amdgcn_mfma_f32_16x16x4f32(am[kb], bv0, acc, 0, 0, 0);
        acc2 = __builtin_amdgcn_mfma_f32_16x16x4f32(am[kb + 1], bv1, acc2, 0, 0, 0);
      }
      acc += acc2;
      __builtin_amdgcn_wave_barrier();
      const size_t tok = tok0 + blk * 16 + lm;
      const float4 u4 = *(const float4*)(U + tok * 256 + g * 16 + 4 * lq);
      const float y0 = gelu_tanh(acc[0] + dsk4.x * u4.x), y1 = gelu_tanh(acc[1] + dsk4.y * u4.y);
      const float y2 = gelu_tanh(acc[2] + dsk4.z * u4.z), y3 = gelu_tanh(acc[3] + dsk4.w * u4.w);
      *(uint2*)(Yg + tok * 256 + g * 16 + 4 * lq) = make_uint2(pack2(y0, y1), pack2(y2, y3));
    }
    cur = nxt;
  }
  if (!OUT) Send[sbase + (size_t)ch * 64] = make_float2(xr, xi);
}

constexpr int KS_ = 72, VS_ = 68;
DI void da_item(const Params& P, int layer, int b, int h, int qt, char* mb, char* smem) {
  const int tid = tidx(), lane = tid & 63, wave = tid >> 6, r = lane & 31, hh = lane >> 5;
  u16* sK0 = (u16*)smem;
  u16* sV0 = sK0 + 2 * 64 * KS_;
  float* sbias = (float*)(sV0 + 2 * 128 * VS_);
  u16* sQw = (u16*)(smem + 54272) + (tidx() >> 6) * 32 * KS_;
  const u16* Qd = (const u16*)(mb + M_QD); const u16* Kd = (const u16*)(mb + M_KD); const u16* Vt = (const u16*)(mb + M_VT);
  u16* CC = (u16*)(WS(P) + OFF_CC);
  const int q0 = qt * 128, qw = q0 + wave * 32, qp = qw + r;
  const size_t tokq = (size_t)b * L_ + qp;
  __syncthreads();
  if (tid < 129) sbias[tid] = ((const float*)(WS(P) + OFF_BIAS))[h * 129 + tid] * LOG2E_;
  __syncthreads();
  const float bfar = sbias[128];
  const float SC = 0.125f * LOG2E_;
  const int nkt = (q0 + 128) >> 6;
  const float lam = ((const float*)(WS(P) + OFF_LAM))[layer];
  const int krow_l = tid >> 3, kch = (tid & 7) * 8;
#pragma unroll 1
  for (int c = 0; c < 2; c++) {
#pragma unroll
    for (int ks = 0; ks < 4; ks++) *(bf16x8*)(sQw + r * KS_ + ks * 16 + hh * 8) = *(const bf16x8*)(Qd + tokq * 512 + h * 128 + c * 64 + ks * 16 + hh * 8);
    f32x16 o[4] = {zero16(), zero16(), zero16(), zero16()};
    float m = -INFINITY, l = 0.f;
    const u16* Kbase = Kd + ((size_t)(((b * 4 + h) * 2 + c)) * L_ + krow_l) * 64 + kch;
    const u16* Vbase = Vt + ((size_t)((b * 4 + h) * 128) * 128 + krow_l) * 64 + kch;
    u32x4 rk[2], rv[4];
#pragma unroll
    for (int i = 0; i < 2; i++) rk[i] = *(const u32x4*)(Kbase + (size_t)(i * 32) * 64);
#pragma unroll
    for (int i = 0; i < 4; i++) rv[i] = *(const u32x4*)(Vbase + (size_t)(i * 32) * 64);
#define DA_STAGE(BUF) { u16* sKw = sK0 + (BUF) * 64 * KS_; u16* sVw = sV0 + (BUF) * 128 * VS_; \
      _Pragma("unroll") for (int i = 0; i < 2; i++) *(u32x4*)(sKw + (krow_l + i * 32) * KS_ + kch) = rk[i]; \
      _Pragma("unroll") for (int i = 0; i < 4; i++) { u32x2* d = (u32x2*)(sVw + (krow_l + i * 32) * VS_ + kch); \
        u32x2 lo2, hi2; lo2.x = rv[i].x; lo2.y = rv[i].y; hi2.x = rv[i].z; hi2.y = rv[i].w; d[0] = lo2; d[1] = hi2; } }
#define DA_FETCH(T) { const int ktn_ = min((T), nkt - 1); \
      _Pragma("unroll") for (int i = 0; i < 2; i++) rk[i] = *(const u32x4*)(Kbase + (size_t)(ktn_ * 64 + i * 32) * 64); \
      _Pragma("unroll") for (int i = 0; i < 4; i++) rv[i] = *(const u32x4*)(Vbase + (size_t)ktn_ * 8192 + (size_t)(i * 32) * 64); }
    __syncthreads();
    DA_STAGE(0)
    DA_FETCH(1)
    __syncthreads();
#pragma unroll 1
    for (int kt = 0; kt < nkt; kt++) {
      const u16* sK = sK0 + (kt & 1) * 64 * KS_;
      const u16* sV = sV0 + (kt & 1) * 128 * VS_;
      if (kt + 1 < nkt) { DA_STAGE((kt + 1) & 1) }
      DA_FETCH(kt + 2)
      if (kt * 64 <= qw + 31) {
        f32x16 s[2];
#pragma unroll
        for (int kb = 0; kb < 2; kb++) {
          s[kb] = zero16();
#pragma unroll
          for (int ks = 0; ks < 4; ks++) {
            const bf16x8 kf = *(const bf16x8*)(sK + (kb * 32 + r) * KS_ + ks * 16 + hh * 8);
            const bf16x8 qf = *(const bf16x8*)(sQw + r * KS_ + ks * 16 + hh * 8);
            s[kb] = MFMA32(kf, qf, s[kb]);
          }
        }
        const bool nearb = (kt * 64 + 63 + 128 > qw);
        float mx = -INFINITY;
        if (nearb) {
#pragma unroll
          for (int kb = 0; kb < 2; kb++)
#pragma unroll
            for (int i = 0; i < 16; i++) {
              const int dist = qp - (kt * 64 + kb * 32 + crow(i, hh));
              const float bv = sbias[min(max(dist, 0), 128)];
              float t = s[kb][i] * SC + bv;
              t = (dist >= 0) ? t : -INFINITY;
              s[kb][i] = t; mx = fmaxf(mx, t);
              if ((i & 7) == 7) __builtin_amdgcn_sched_barrier(0);
            }
        } else {
#pragma unroll
          for (int kb = 0; kb < 2; kb++)
#pragma unroll
            for (int i = 0; i < 16; i++) { const float t = s[kb][i] * SC + bfar; s[kb][i] = t; mx = fmaxf(mx, t); }
        }
        mx = fmaxf(mx, __shfl_xor(mx, 32));
        const float mn = fmaxf(m, mx);
        const float corr = __builtin_amdgcn_exp2f(m - mn);
        m = mn;
        float ls = 0.f;
#pragma unroll
        for (int kb = 0; kb < 2; kb++)
#pragma unroll
          for (int i = 0; i < 16; i++) { const float p = __builtin_amdgcn_exp2f(s[kb][i] - mn); s[kb][i] = p; ls += p; }
        l = l * corr + ls;
        if (__ballot(corr != 1.f) != 0ull) {
#pragma unroll
          for (int dt = 0; dt < 4; dt++)
#pragma unroll
            for (int i = 0; i < 16; i++) o[dt][i] *= corr;
        }
#pragma unroll
        for (int kb = 0; kb < 2; kb++)
#pragma unroll
          for (int s2 = 0; s2 < 2; s2++) {
            const bf16x8 pf = pack8(s[kb], s2);
#pragma unroll
            for (int dt = 0; dt < 4; dt++) {
              const u16* vp = sV + (dt * 32 + r) * VS_ + kb * 32 + s2 * 16 + 4 * hh;
              const s16x4 lo = *(const s16x4*)vp, hi = *(const s16x4*)(vp + 8);
              const bf16x8 vf = __builtin_shufflevector(lo, hi, 0, 1, 2, 3, 4, 5, 6, 7);
              o[dt] = MFMA32(vf, pf, o[dt]);
            }
            __builtin_amdgcn_sched_barrier(0);
          }
      }
      __syncthreads();
    }
#undef DA_STAGE
#undef DA_FETCH
    const float lt = l + __shfl_xor(l, 32);
    const float inv = 1.f / lt;
    size_t tq = tokq;
    asm volatile("" : "+v"(tq));
    u16* obase = CC + tq * 1024 + h * 128 + 4 * hh;
    if (c == 0) {
#pragma unroll
      for (int dt = 0; dt < 4; dt++)
#pragma unroll
        for (int g4 = 0; g4 < 4; g4++) {
          *(uint2*)(obase + dt * 32 + 8 * g4) = make_uint2(pack2(o[dt][4 * g4] * inv, o[dt][4 * g4 + 1] * inv), pack2(o[dt][4 * g4 + 2] * inv, o[dt][4 * g4 + 3] * inv));
        }
    } else {
      float ss = 0.f;
#pragma unroll
      for (int dt = 0; dt < 4; dt++)
#pragma unroll
        for (int g4 = 0; g4 < 4; g4++) {
          const uint2 pv = *(const uint2*)(obase + dt * 32 + 8 * g4);
          const float a4[4] = {bf2f((u16)(pv.x & 0xffff)), bf2f((u16)(pv.x >> 16)), bf2f((u16)(pv.y & 0xffff)), bf2f((u16)(pv.y >> 16))};
#pragma unroll
          for (int e = 0; e < 4; e++) { const float v = a4[e] - lam * o[dt][4 * g4 + e] * inv; o[dt][4 * g4 + e] = v; ss = __builtin_fmaf(v, v, ss); }
        }
      ss += __shfl_xor(ss, 32);
      const float lam_init = 0.8f - 0.6f * __expf(-0.3f * (float)layer);
      const float rn = rsqrtf(ss * (1.f / 128.f) + LN_EPS_) * (1.f - lam_init);
      int hh2 = hh;
      asm volatile("" : "+v"(hh2));
      const float* sg = INP(P, 14) + layer * 128 + 4 * hh2;
#pragma unroll
      for (int dt = 0; dt < 4; dt++)
#pragma unroll
        for (int g4 = 0; g4 < 4; g4++) {
          const int dv = dt * 32 + 8 * g4 + 4 * hh;
          const float4 gv = *(const float4*)(sg + dt * 32 + 8 * g4);
          uint2 w = make_uint2(pack2(o[dt][4 * g4] * rn * gv.x, o[dt][4 * g4 + 1] * rn * gv.y),
                               pack2(o[dt][4 * g4 + 2] * rn * gv.z, o[dt][4 * g4 + 3] * rn * gv.w));
          *(uint2*)(obase + dv - 4 * hh) = w;
        }
    }
  }
}

DI unsigned sortkey(float f) { const unsigned u = __float_as_uint(f + 0.f); return u ^ (((unsigned)((int)u >> 31)) | 0x80000000u); }

DI void dsa_item(const Params& P, int layer, int b, int qt, char* mb, char* smem) {
  const int tid = tidx(), lane = tid & 63, wave = tid >> 6, r = lane & 31, hh = lane >> 5;
  unsigned* hist = (unsigned*)smem;
  float* sP = (float*)smem;
  float* sQ = (float*)(smem + 16384);
  u16* sidx = (u16*)(smem + 32896);
  unsigned* meta = (unsigned*)(smem + 49280);
  float* sbias = (float*)(smem + 50304);
  const u16* Qi = (const u16*)(mb + M_QI); const u16* Ki = (const u16*)(mb + M_KI); const float* Wi = (const float*)(mb + M_WI);
  const u16* Qs = (const u16*)(mb + M_QS); const u16* Ks = (const u16*)(mb + M_KS); const u16* Vs = (const u16*)(mb + M_VS);
  u16* CC = (u16*)(WS(P) + OFF_CC);
  const int q0 = qt * 32;
  const int qp = q0 + r;
  const size_t tokb = (size_t)b * L_;
  const int nk32 = qt + 1;
  const bool radix = (q0 >= 256);
  __syncthreads();
  for (int i = tid; i < 4 * 129; i += 256) sbias[i] = ((const float*)(WS(P) + OFF_BIAS))[4 * 129 + i];
  meta[tid] = (tid >= 32 && tid < 64) ? 256u : 0u;
  char* sQi = smem + 52384;
  float* sWi = (float*)(smem + 69280);
  constexpr int CAPL_ = 64;
  unsigned* lK = (unsigned*)smem;
  u16* lI = (u16*)(smem + 32 * CAPL_ * 4);
  {
    const int row = tid >> 3, ch = tid & 7;
    const uint4* src = (const uint4*)(Qi + (tokb + q0 + row) * 256 + ch * 32);
    uint4* dst = (uint4*)(sQi + row * 528 + ch * 64);
    dst[0] = src[0]; dst[1] = src[1]; dst[2] = src[2]; dst[3] = src[3];
    sWi[tid] = Wi[(tokb + q0) * 8 + tid];
  }
  int pass = radix ? 0 : 4;
  bool fast = false;
#pragma unroll 1
  while (true) {
    __syncthreads();
    if (pass < 4) { for (int i = tid; i < 32 * 257; i += 256) hist[i] = 0u; }
    __syncthreads();
    const unsigned pref = meta[r];
    const unsigned krem = meta[32 + r];
    auto elems = [&](const f32x16& sc, const int kt, const int lim) __attribute__((always_inline)) {
      if (pass == 0) {
#pragma unroll
        for (int i = 0; i < 16; i++) {
          const int kp = kt * 32 + crow(i, hh);
          const unsigned key = sortkey(sc[i]);
          const unsigned bin = (kp <= lim) ? (key >> 24) : 256u;
          atomicAdd(&hist[r * 257 + bin], 1u);
        }
      } else if (pass < 4) {
        const int sh = 24 - 8 * pass;
#pragma unroll
        for (int i = 0; i < 16; i++) {
          const int kp = kt * 32 + crow(i, hh);
          const unsigned key = sortkey(sc[i]);
          if ((key >> (sh + 8)) == pref && kp <= lim) atomicAdd(&hist[r * 257 + ((key >> sh) & 255u)], 1u);
        }
      } else if (pass == 5) {
        unsigned mc = 0u, ms = 0u;
        unsigned keys[16];
#pragma unroll
        for (int i = 0; i < 16; i++) {
          const int kp = kt * 32 + crow(i, hh);
          keys[i] = sortkey(sc[i]);
          const unsigned bt = keys[i] >> 16;
          const bool valid = (kp <= lim);
          ms |= (valid && bt > pref) ? (1u << i) : 0u;
          mc |= (valid && bt == pref) ? (1u << i) : 0u;
        }
        unsigned base_c = 0u, base_s = 0u;
        if (mc) base_c = atomicAdd(&meta[128 + r], (unsigned)__popc(mc));
        if (ms) base_s = atomicAdd(&meta[64 + r], (unsigned)__popc(ms));
#pragma unroll
        for (int i = 0; i < 16; i++) {
          const int kp = kt * 32 + crow(i, hh);
          if ((mc >> i) & 1u) {
            const unsigned cp = base_c + (unsigned)__popc(mc & ((1u << i) - 1u));
            if (cp < (unsigned)CAPL_) { lK[r * CAPL_ + cp] = keys[i]; lI[r * CAPL_ + cp] = (u16)kp; }
          }
          if ((ms >> i) & 1u) {
            const unsigned pos = base_s + (unsigned)__popc(ms & ((1u << i) - 1u));
            if (pos < 256u) sidx[r * 256 + pos] = (u16)kp;
          }
        }
      } else {
#pragma unroll
        for (int i = 0; i < 16; i++) {
          const int kp = kt * 32 + crow(i, hh);
          const unsigned key = sortkey(sc[i]);
          bool sel = (kp <= lim);
          if (radix) {
            sel = sel && (key >= pref);
            if (sel && key == pref) sel = atomicAdd(&meta[96 + r], 1u) < krem;
          }
          if (sel) { const unsigned pos = atomicAdd(&meta[64 + r], 1u); if (pos < 256u) sidx[r * 256 + pos] = (u16)kp; }
        }
      }
    };
    const int klast = nk32 - 1;
    bf16x8 nA0 = {0, 0, 0, 0, 0, 0, 0, 0}, nA1 = nA0, nB0 = nA0, nB1 = nA0;
    if (wave < nk32) {
      const int ka = wave, kb2 = min(wave + 4, klast);
      nA0 = *(const bf16x8*)(Ki + (tokb + ka * 32 + r) * 32 + hh * 8);
      nA1 = *(const bf16x8*)(Ki + (tokb + ka * 32 + r) * 32 + 16 + hh * 8);
      nB0 = *(const bf16x8*)(Ki + (tokb + kb2 * 32 + r) * 32 + hh * 8);
      nB1 = *(const bf16x8*)(Ki + (tokb + kb2 * 32 + r) * 32 + 16 + hh * 8);
    }
#pragma unroll 1
    for (int kt = wave; kt < nk32; kt += 8) {
      const bf16x8 kA0 = nA0, kA1 = nA1, kB0 = nB0, kB1 = nB1;
      {
        const int ka = min(kt + 8, klast), kb2 = min(kt + 12, klast);
        nA0 = *(const bf16x8*)(Ki + (tokb + ka * 32 + r) * 32 + hh * 8);
        nA1 = *(const bf16x8*)(Ki + (tokb + ka * 32 + r) * 32 + 16 + hh * 8);
        nB0 = *(const bf16x8*)(Ki + (tokb + kb2 * 32 + r) * 32 + hh * 8);
        nB1 = *(const bf16x8*)(Ki + (tokb + kb2 * 32 + r) * 32 + 16 + hh * 8);
      }
      f32x16 scA = zero16(), scB = zero16();
#pragma unroll 2
      for (int hd = 0; hd < 8; hd++) {
        const bf16x8 q0f = *(const bf16x8*)(sQi + r * 528 + hd * 64 + hh * 16);
        const bf16x8 q1f = *(const bf16x8*)(sQi + r * 528 + hd * 64 + 32 + hh * 16);
        const float w = sWi[r * 8 + hd];
        f32x16 sa = MFMA32(kA0, q0f, zero16());
        f32x16 sb = MFMA32(kB0, q0f, zero16());
        sa = MFMA32(kA1, q1f, sa);
        sb = MFMA32(kB1, q1f, sb);
#pragma unroll
        for (int i = 0; i < 16; i++) {
          scA[i] += __int_as_float(max(__float_as_int(sa[i]), 0)) * w;
          scB[i] += __int_as_float(max(__float_as_int(sb[i]), 0)) * w;
        }
      }
      elems(scA, kt, (kt == qt) ? qp : 0x7fffffff);
      if (kt + 4 < nk32) elems(scB, kt + 4, (kt + 4 == qt) ? qp : 0x7fffffff);
    }
    __syncthreads();
    if (pass < 4) {
      for (int j = 0; j < 8; j++) {
        const int qq = wave * 8 + j;
        const unsigned k = meta[32 + qq];
        unsigned c4[4]; unsigned tot = 0;
#pragma unroll
        for (int e = 0; e < 4; e++) { c4[e] = hist[qq * 257 + 255 - 4 * lane - e]; tot += c4[e]; }
        unsigned incl = tot;
        for (int o = 1; o < 64; o <<= 1) { const unsigned t = __shfl_up(incl, o); if (lane >= o) incl += t; }
        unsigned run = incl - tot;
#pragma unroll
        for (int e = 0; e < 4; e++) {
          if (run < k && run + c4[e] >= k) {
            meta[qq] = (meta[qq] << 8) | (unsigned)(255 - 4 * lane - e); meta[32 + qq] = k - run;
            if (pass == 1 && c4[e] > (unsigned)CAPL_) meta[192] = 1u;
          }
          run += c4[e];
        }
      }
    }
    if (pass >= 4) break;
    if (pass == 1) { __syncthreads(); fast = (meta[192] == 0u); pass = fast ? 5 : 2; } else pass++;
  }
  __syncthreads();
  if (fast) {
#pragma unroll 1
    for (int j = 0; j < 8; j++) {
      const int qq = wave * 8 + j;
      const int c = min((int)meta[128 + qq], CAPL_);
      const unsigned k = meta[32 + qq];
      const bool in = lane < c;
      const unsigned mykey = in ? lK[qq * CAPL_ + lane] : 0u;
      const unsigned myidx = in ? (unsigned)lI[qq * CAPL_ + lane] : 0u;
      unsigned rank = 0u;
      for (int t = 0; t < c; t++) {
        const unsigned ok = __shfl(mykey, t);
        rank += (ok > mykey || (ok == mykey && t < lane)) ? 1u : 0u;
      }
      const bool sel = in && (rank < k);
      const unsigned long long m = __ballot(sel);
      const unsigned base = meta[64 + qq];
      if (sel) {
        const unsigned pos = base + (unsigned)__popcll(m & ((1ull << lane) - 1ull));
        if (pos < 256u) sidx[qq * 256 + pos] = (u16)myidx;
      }
      __builtin_amdgcn_wave_barrier();
      if (lane == 0) meta[64 + qq] = base + (unsigned)__popcll(m);
    }
    __syncthreads();
  }
  float* myP = sP + wave * 1024;
  (void)sQ;
#pragma unroll 1
  for (int j = 0; j < 8; j++) {
    const int qq = wave * 8 + j;
    const int qpos = q0 + qq;
    const size_t tok = tokb + qpos;
    const int n = min((int)meta[64 + qq], 256);
    __syncthreads();
    bf16x8 qf[4];
#pragma unroll
    for (int ks = 0; ks < 4; ks++) {
      bf16x8 z = {0, 0, 0, 0, 0, 0, 0, 0};
      if (r < 4) z = *(const bf16x8*)(Qs + tok * 256 + r * 64 + ks * 16 + hh * 8);
      qf[ks] = z;
    }
#pragma unroll 4
    for (int kb = 0; kb < 8; kb++) {
      const int jj = kb * 32 + r;
      const int kidx = (jj < n) ? (int)sidx[qq * 256 + jj] : 0;
      const u16* kp = Ks + (tokb + kidx) * 64 + hh * 8;
      bf16x8 kf[4];
#pragma unroll
      for (int ks = 0; ks < 4; ks++) kf[ks] = *(const bf16x8*)(kp + ks * 16);
      f32x16 sacc = zero16();
#pragma unroll
      for (int ks = 0; ks < 4; ks++) sacc = MFMA32(kf[ks], qf[ks], sacc);
      if (r < 4) {
#pragma unroll
        for (int i = 0; i < 16; i++) myP[(kb * 32 + crow(i, hh)) * 4 + r] = sacc[i];
      }
    }
    __syncthreads();
    float sc[4][4];
#pragma unroll
    for (int rd = 0; rd < 4; rd++) {
      const int jj = rd * 64 + lane;
      const bool valid = jj < n;
      const int kidx = valid ? (int)sidx[qq * 256 + jj] : 0;
      const int dist = min(max(qpos - kidx, 0), 128);
      const float4 d = *(const float4*)(myP + jj * 4);
      sc[rd][0] = valid ? d.x * 0.125f + sbias[0 * 129 + dist] : -INFINITY;
      sc[rd][1] = valid ? d.y * 0.125f + sbias[1 * 129 + dist] : -INFINITY;
      sc[rd][2] = valid ? d.z * 0.125f + sbias[2 * 129 + dist] : -INFINITY;
      sc[rd][3] = valid ? d.w * 0.125f + sbias[3 * 129 + dist] : -INFINITY;
    }
#pragma unroll
    for (int hd = 0; hd < 4; hd++) {
      float mx = fmaxf(fmaxf(sc[0][hd], sc[1][hd]), fmaxf(sc[2][hd], sc[3][hd]));
      mx = wave_max(mx);
      float sm = 0.f;
#pragma unroll
      for (int rd = 0; rd < 4; rd++) { sc[rd][hd] = __expf(sc[rd][hd] - mx); sm += sc[rd][hd]; }
      sm = wave_sum(sm);
      const float inv = 1.f / sm;
#pragma unroll
      for (int rd = 0; rd < 4; rd++) sc[rd][hd] *= inv;
    }
#pragma unroll
    for (int rd = 0; rd < 4; rd++) *(float4*)(myP + (rd * 64 + lane) * 4) = make_float4(sc[rd][0], sc[rd][1], sc[rd][2], sc[rd][3]);
    __syncthreads();
    const int g = lane >> 3, c8 = lane & 7;
    float acc[32];
#pragma unroll
    for (int i = 0; i < 32; i++) acc[i] = 0.f;
#pragma unroll 16
    for (int it = 0; it < 32; it++) {
      const int jj = it * 8 + g;
      const int kidx = (jj < n) ? (int)sidx[qq * 256 + jj] : 0;
      const float4 pj = *(const float4*)(myP + jj * 4);
      const u32x4 vv = *(const u32x4*)(Vs + (tokb + kidx) * 64 + c8 * 8);
      const float vf[8] = {bf2f((u16)(vv.x & 0xffff)), bf2f((u16)(vv.x >> 16)), bf2f((u16)(vv.y & 0xffff)), bf2f((u16)(vv.y >> 16)),
                           bf2f((u16)(vv.z & 0xffff)), bf2f((u16)(vv.z >> 16)), bf2f((u16)(vv.w & 0xffff)), bf2f((u16)(vv.w >> 16))};
#pragma unroll
      for (int e = 0; e < 8; e++) {
        acc[0 * 8 + e] += pj.x * vf[e]; acc[1 * 8 + e] += pj.y * vf[e];
        acc[2 * 8 + e] += pj.z * vf[e]; acc[3 * 8 + e] += pj.w * vf[e];
      }
    }
    const bool b5 = lane & 32, b4 = lane & 16, b3 = lane & 8;
    float w16[16], w8[8], w4[4];
#pragma unroll
    for (int i = 0; i < 16; i++) { const float snd = b5 ? acc[i] : acc[i + 16]; const float rcv = __shfl_xor(snd, 32); w16[i] = (b5 ? acc[i + 16] : acc[i]) + rcv; }
#pragma unroll
    for (int i = 0; i < 8; i++) { const float snd = b4 ? w16[i] : w16[i + 8]; const float rcv = __shfl_xor(snd, 16); w8[i] = (b4 ? w16[i + 8] : w16[i]) + rcv; }
#pragma unroll
    for (int i = 0; i < 4; i++) { const float snd = b3 ? w8[i] : w8[i + 4]; const float rcv = __shfl_xor(snd, 8); w4[i] = (b3 ? w8[i + 4] : w8[i]) + rcv; }
    const int hd = (b5 ? 2 : 0) + (b4 ? 1 : 0);
    *(uint2*)(CC + tok * 1024 + 768 + hd * 64 + c8 * 8 + (b3 ? 4 : 0)) = make_uint2(pack2(w4[0], w4[1]), pack2(w4[2], w4[3]));
  }
}

DI void phase_mix1(const Params& P, int layer, int bid, int nb, char* smem) {
  char* mb = WS(P) + OFF_H;
  for (int w = bid * 4 + (tidx() >> 6); w < 2048; w += nb * 4) ssm_scan<false>(P, layer, w, mb, smem);
  for (int j = 0;; j++) {
    const int idx = (j & 1) ? (j * nb + (nb - 1 - bid)) : (j * nb + bid);
    if (j * nb >= 2048) break;
    if (idx >= 2048) continue;
    const int qt = 255 - (idx >> 3), b = idx & 7;
    dsa_item(P, layer, b, qt, mb, smem);
  }
  for (int j = 0;; j++) {
    const int idx = (j & 1) ? (j * nb + (nb - 1 - bid)) : (j * nb + bid);
    if (j * nb >= 2048) break;
    if (idx >= 2048) continue;
    const int qt = 63 - (idx >> 5), bh = idx & 31;
    da_item(P, layer, bh >> 2, bh & 3, qt, mb, smem);
  }
}

DI void phase_mix2(const Params& P, int layer, int bid, int nb, char* smem) {
  char* mb = WS(P) + OFF_H;
  for (int w = bid * 4 + (tidx() >> 6); w < 2048; w += nb * 4) ssm_scan<true>(P, layer, w, mb, smem);
}

DI void run_phase(const Params& P, int ph, int bid, int nb, char* smem) {
  char* ws = WS(P);
  u16* sm = (u16*)smem;
  if (ph == 0) { phase_prep(P, bid, nb, smem); return; }
  const int l = (ph - 1) / 12, s = (ph - 1) % 12;
  u16* Xb = (u16*)(ws + OFF_XB);
  u16* H = (u16*)(ws + OFF_H);
  u16* CC = (u16*)(ws + OFF_CC);
  float* X = OUTP(P);
  switch (s) {
    case 0: phase_ffn_up(Xb, (const u16*)(ws + OFF_WGU1 + l * SZ_WGU), H, bid, nb, sm); break;
    case 1: phase_ffn_down(H, (const u16*)(ws + OFF_WD1 + l * SZ_WD), (l == 0) ? INP(P, 0) : (const float*)X, X, nullptr, bid, nb, sm); break;
    case 2: phase_ln(X, Xb, INP(P, 6) + l * 1024, INP(P, 7) + l * 1024, bid, nb); break;
    case 3: phase_w_in(Xb, (const u16*)(ws + OFF_WIN + l * SZ_WIN), ws + OFF_H, bid, nb, sm); break;
    case 4: phase_mix1(P, l, bid, nb, smem); break;
    case 5: phase_mix2(P, l, bid, nb, smem); break;
    case 6: phase_glu((const u16*)(ws + OFF_H + M_YG), (const u16*)(ws + OFF_WGLU + l * SZ_WGLU), CC, bid, nb, sm); break;
    case 7: phase_w_o(CC, (const u16*)(ws + OFF_WO + l * SZ_WO), X, bid, nb, sm); break;
    case 8: phase_ln(X, Xb, INP(P, 24) + l * 1024, INP(P, 25) + l * 1024, bid, nb); break;
    case 9:
      phase_ffn_up(Xb, (const u16*)(ws + OFF_WGU2 + l * SZ_WGU), H, bid, nb, sm);
      phase_ple(Xb, (const u16*)(ws + OFF_WPG + l * SZ_WPG), (const u16*)(ws + OFF_PB) + (size_t)l * T_ * 256, (const u16*)(ws + OFF_WPP + l * SZ_WPP), CC, bid, nb, sm);
      break;
    case 10: phase_ffn_down(H, (const u16*)(ws + OFF_WD2 + l * SZ_WD), X, X, CC, bid, nb, sm); break;
    case 11: phase_ln(X, Xb, INP(P, 31) + l * 1024, INP(P, 32) + l * 1024, bid, nb); break;
  }
}

#define XB_TMO      128
#define XB_XCNT(j)  (256  + 64 * (j))
#define XB_XSUB(j)  (1280 + 64 * (j))
#define XB_XGEN(j)  (2304 + 64 * (j))
#define XB_TOP      3328
#define XB_TOPGEN   3392
#define XCD_BAR_WORDS 3456
#define XB_SPIN_CAP (1u << 22)
#define LAS __attribute__((address_space(3)))

__device__ __forceinline__ unsigned xb_ld(unsigned* p)              { return __hip_atomic_load(p, __ATOMIC_RELAXED, __HIP_MEMORY_SCOPE_AGENT); }
__device__ __forceinline__ unsigned xb_add(unsigned* p, unsigned v) { return __hip_atomic_fetch_add(p, v, __ATOMIC_RELAXED, __HIP_MEMORY_SCOPE_AGENT); }
__device__ __forceinline__ unsigned xb_xcc_id() { return (unsigned)__builtin_amdgcn_s_getreg((3 << 11) | 20) & 0xFu; }
#define XB_SPIN(cond, bar) do { unsigned _sp = 0; while (cond) { __builtin_amdgcn_s_sleep(1); \
    if ((++_sp & 255u) == 0u) { if (xb_ld(&(bar)[XB_TMO])) break; if (_sp > XB_SPIN_CAP) { atomicAdd(&(bar)[XB_TMO], 1u); break; } } } } while (0)

struct XcdBarrier {
    unsigned* bar; unsigned x;
    volatile LAS unsigned* st;
};

__device__ __forceinline__ XcdBarrier xcd_barrier_post(unsigned* bar, volatile LAS unsigned* st) {
    XcdBarrier b; b.bar = bar; b.x = xb_xcc_id(); b.st = st;
    if (threadIdx.x == 0) (void)xb_add(&bar[XB_XCNT(b.x)], 1u);
    return b;
}
__device__ __forceinline__ void xcd_barrier_complete(unsigned* bar, unsigned x, unsigned& nloc, unsigned& nx) {
    const unsigned G = gridDim.x * gridDim.y * gridDim.z;
    unsigned sum, cnt, mine, sp = 0u;
    for (;;) {
        sum = 0u; cnt = 0u; mine = 0u;
#pragma unroll
        for (unsigned j = 0; j < 16; ++j) { const unsigned c = xb_ld(&bar[XB_XCNT(j)]); sum += c; cnt += (c > 0u) ? 1u : 0u; mine = (j == x) ? c : mine; }
        if (sum == G) break;
        __builtin_amdgcn_s_sleep(1);
        if ((++sp & 255u) == 0u) { if (xb_ld(&bar[XB_TMO])) break; if (sp > XB_SPIN_CAP) { atomicAdd(&bar[XB_TMO], 1u); break; } }
    }
    nloc = mine > 0u ? mine : 1u; nx = cnt > 0u ? cnt : 1u;
}

__device__ __forceinline__ void xcd_barrier(const XcdBarrier& b) {
    asm volatile("s_waitcnt vmcnt(0)" ::: "memory");
    __syncthreads();
    if (threadIdx.x == 0) {
        unsigned* bar = b.bar;
        __builtin_amdgcn_s_waitcnt(0);
        unsigned nloc = b.st[0], nx = b.st[1];
        if (nloc == 0u) { xcd_barrier_complete(bar, b.x, nloc, nx); b.st[0] = nloc; b.st[1] = nx; }
        const unsigned old = xb_add(&bar[XB_XSUB(b.x)], 1u);
        const unsigned gen = old / nloc;
        if (old + 1u == (gen + 1u) * nloc) {
            __builtin_amdgcn_fence(__ATOMIC_RELEASE, "agent");
            asm volatile("s_waitcnt vmcnt(0)" ::: "memory");
            const unsigned og = xb_add(&bar[XB_TOP], 1u);
            const unsigned tg = og / nx;
            if (og + 1u == (tg + 1u) * nx) xb_add(&bar[XB_TOPGEN], 1u);
            else XB_SPIN(xb_ld(&bar[XB_TOPGEN]) == tg, bar);
            __builtin_amdgcn_fence(__ATOMIC_ACQUIRE, "agent");
            xb_add(&bar[XB_XGEN(b.x)], 1u);
            asm volatile("s_waitcnt vmcnt(0)" ::: "memory");
        } else {
            XB_SPIN(xb_ld(&bar[XB_XGEN(b.x)]) == gen, bar);
            __builtin_amdgcn_fence(__ATOMIC_ACQUIRE, "agent");
            asm volatile("s_waitcnt vmcnt(0)" ::: "memory");
        }
    }
    __syncthreads();
}


constexpr int NPHASES = 25;

__global__ void __launch_bounds__(256, 2) mega(Params P, int ph0, int ph1) {
  extern __shared__ __attribute__((aligned(16))) char smem[];
  cg::grid_group grid = cg::this_grid();
  const int bid = blockIdx.x, nb = gridDim.x;
  volatile LAS unsigned* xst = (volatile LAS unsigned*)(smem + 73712);
  if (threadIdx.x == 0) { xst[0] = 0u; xst[1] = 0u; xst[2] = 0u; xst[3] = 0u; }
  __syncthreads();
  const XcdBarrier xbar = xcd_barrier_post((unsigned*)(P.ws + OFF_XBAR), xst);
#ifndef DUP_MASK
#define DUP_MASK 0
#endif
#define PHASE(k) if (ph0 <= (k) && (k) < ph1) { \
    if ((k) > 0 && ((DUP_MASK >> (((k) - 1) % 12)) & 1)) { run_phase(P, (k), bid, nb, smem); grid.sync(); } \
    run_phase(P, (k), bid, nb, smem); if ((k) + 1 < ph1) { if ((k) == 0) grid.sync(); else xcd_barrier(xbar); } }
  PHASE(0) PHASE(1) PHASE(2) PHASE(3) PHASE(4) PHASE(5) PHASE(6) PHASE(7) PHASE(8) PHASE(9) PHASE(10) PHASE(11) PHASE(12)
  PHASE(13) PHASE(14) PHASE(15) PHASE(16) PHASE(17) PHASE(18) PHASE(19) PHASE(20) PHASE(21) PHASE(22) PHASE(23) PHASE(24)
#undef PHASE
}

extern "C" void kernel_launch(void* const* d_in, const int* in_sizes, int n_in, void* d_out, int out_size, void* d_ws, size_t ws_size, hipStream_t stream) {
  static int grid_blocks = 0;
  if (grid_blocks == 0) {
    if (n_in != 33 || ws_size < WS_END) { fprintf(stderr, "kernel_launch: need 33 inputs and %zu bytes of ws (got %d, %zu)\n", (size_t)WS_END, n_in, ws_size); grid_blocks = -1; return; }
    int dev = 0, cus = 0, per_cu = 0;
    (void)hipGetDevice(&dev);
    (void)hipDeviceGetAttribute(&cus, hipDeviceAttributeMultiprocessorCount, dev);
    (void)hipFuncSetAttribute((const void*)mega, hipFuncAttributeMaxDynamicSharedMemorySize, LDS_BYTES);
    (void)hipOccupancyMaxActiveBlocksPerMultiprocessor(&per_cu, (const void*)mega, 256, LDS_BYTES);
    if (per_cu < 1) per_cu = 1;
    if (per_cu > 2) per_cu = 2;
    grid_blocks = cus * per_cu;
    fprintf(stderr, "kernel_launch: cus %d per_cu %d grid %d\n", cus, per_cu, grid_blocks);
  }
  if (grid_blocks < 0) return;
  Params p;
  memset(&p, 0, sizeof(p));
  for (int i = 0; i < 33; i++) p.in[i] = (const float*)d_in[i];
  p.out = (float*)d_out;
  p.ws = (char*)d_ws;
#if MULTI_LAUNCH
  for (int ph = 0; ph < NPHASES; ph++) {
    hipLaunchKernelGGL(mega, dim3(grid_blocks), dim3(256), LDS_BYTES, stream, p, ph, ph + 1);
  }
#else
  int ph0 = 0, ph1 = NPHASES;
  (void)hipMemsetAsync((char*)d_ws + OFF_XBAR, 0, XCD_BAR_WORDS * 4, stream);
  void* args[] = {&p, &ph0, &ph1};
  hipError_t e = hipLaunchCooperativeKernel((const void*)mega, dim3(grid_blocks), dim3(256), args, LDS_BYTES, stream);
  if (e != hipSuccess) fprintf(stderr, "cooperative launch failed: %s (grid %d)\n", hipGetErrorString(e), grid_blocks);
#endif
}
```

```cpp
#include <hip/hip_runtime.h>
#include <hip/hip_cooperative_groups.h>
#include <stdint.h>
#include <math.h>
#include <stdio.h>
#include <string.h>
namespace cg = cooperative_groups;

#ifndef MULTI_LAUNCH
#define MULTI_LAUNCH 0
#endif

typedef unsigned short u16;
typedef __attribute__((ext_vector_type(8))) short bf16x8;
typedef __attribute__((ext_vector_type(4))) short s16x4;
typedef __attribute__((ext_vector_type(16))) float f32x16;
typedef __attribute__((ext_vector_type(4))) unsigned u32x4;
typedef __attribute__((ext_vector_type(2))) unsigned u32x2;

#define DI __device__ __forceinline__
#define MFMA32(a, b, c) __builtin_amdgcn_mfma_f32_32x32x16_bf16((a), (b), (c), 0, 0, 0)

constexpr int T_ = 65536;
constexpr int L_ = 8192;
constexpr int D_ = 1024;
constexpr int FF_ = 2816;
constexpr float ALPHA_ = 1.41421356237309515f;
constexpr float LN_EPS_ = 1e-5f;
constexpr float LOG2E_ = 1.44269504088896341f;
constexpr int LDS_BYTES = 73728;

constexpr size_t SZ_WGU = (size_t)5632 * 1024 * 2;
constexpr size_t SZ_WD = (size_t)1024 * 2816 * 2;
constexpr size_t SZ_WIN = (size_t)2560 * 1024 * 2;
constexpr size_t SZ_WO = (size_t)1024 * 1024 * 2;
constexpr size_t SZ_WGLU = (size_t)256 * 256 * 2;
constexpr size_t SZ_WPG = (size_t)1024 * 1024 * 2;
constexpr size_t SZ_WPP = (size_t)1024 * 256 * 2;
constexpr size_t OFF_WGU1 = 0;
constexpr size_t OFF_WD1 = OFF_WGU1 + 2 * SZ_WGU;
constexpr size_t OFF_WGU2 = OFF_WD1 + 2 * SZ_WD;
constexpr size_t OFF_WD2 = OFF_WGU2 + 2 * SZ_WGU;
constexpr size_t OFF_WIN = OFF_WD2 + 2 * SZ_WD;
constexpr size_t OFF_WO = OFF_WIN + 2 * SZ_WIN;
constexpr size_t OFF_WGLU = OFF_WO + 2 * SZ_WO;
constexpr size_t OFF_WPG = OFF_WGLU + 2 * SZ_WGLU;
constexpr size_t OFF_WPP = OFF_WPG + 2 * SZ_WPG;
constexpr size_t OFF_COEFA = OFF_WPP + 2 * SZ_WPP;
constexpr size_t OFF_COEFB = OFF_COEFA + 2 * 16 * 64 * 16;
constexpr size_t OFF_LAM = OFF_COEFB + 2 * 16 * 64 * 16 * 8;
constexpr size_t OFF_BIAS = OFF_LAM + 256;
constexpr size_t OFF_XBAR = OFF_BIAS + 8 * 129 * 4 + 32;
constexpr size_t OFF_XB = OFF_XBAR + 16384;
constexpr size_t OFF_PB = OFF_XB + (size_t)T_ * 1024 * 2;
constexpr size_t OFF_H = OFF_PB + (size_t)2 * T_ * 256 * 2;
constexpr size_t SZ_H = (size_t)384 << 20;
constexpr size_t OFF_CC = OFF_H + SZ_H;
constexpr size_t OFF_CANDK = OFF_CC + (size_t)T_ * 1024 * 2;
constexpr int CAP_ = 2048;
constexpr size_t OFF_CANDI = OFF_CANDK + (size_t)512 * 32 * CAP_ * 4;
constexpr size_t WS_END = OFF_CANDI + (size_t)512 * 32 * CAP_ * 2;
constexpr size_t MB_ = (size_t)1 << 20;
constexpr size_t M_QD = 0, M_KD = 64 * MB_, M_VT = 128 * MB_, M_U = 192 * MB_, M_QS = 256 * MB_, M_QI = 288 * MB_, M_YG = 320 * MB_,
                 M_KS = 352 * MB_, M_VS = 360 * MB_, M_KI = 368 * MB_, M_WI = 372 * MB_, M_SEND = 374 * MB_;

struct Params {
  const float* in[33];
  float* out;
  char* ws;
};

DI int tidx() { int t = threadIdx.x; asm volatile("" : "+v"(t)); return t; }
#define GAS __attribute__((address_space(1)))
DI size_t opaque0() { size_t z = 0; asm volatile("" : "+s"(z)); return z; }
DI char* WS(const Params& P) { return P.ws + opaque0(); }
DI float* OUTP(const Params& P) { return P.out + opaque0(); }
DI const float* INP(const Params& P, int i) { return P.in[i]; }
typedef __bf16 bf16v2_ __attribute__((ext_vector_type(2)));
typedef float f32v2_ __attribute__((ext_vector_type(2)));
DI u16 f2bf(float x) { const __bf16 h = (__bf16)x; return __builtin_bit_cast(u16, h); }
DI float bf2f(u16 v) { return __uint_as_float(((unsigned)v) << 16); }
DI unsigned pack2(float a, float b) { f32v2_ v; v.x = a; v.y = b; const bf16v2_ h = __builtin_convertvector(v, bf16v2_); return __builtin_bit_cast(unsigned, h); }
DI int crow(int i, int hh) { return (i & 3) + 8 * (i >> 2) + 4 * hh; }
DI float sigmoidf_(float x) { return __builtin_amdgcn_rcpf(1.f + __expf(-x)); }
DI float wave_sum(float v) { for (int o = 32; o > 0; o >>= 1) v += __shfl_xor(v, o); return v; }
DI float wave_max(float v) { for (int o = 32; o > 0; o >>= 1) v = fmaxf(v, __shfl_xor(v, o)); return v; }
DI f32x16 zero16() { f32x16 z; for (int i = 0; i < 16; i++) z[i] = 0.f; return z; }
DI bf16x8 pack8(const f32x16& x, int s) {
  union { unsigned u[4]; bf16x8 v; } t;
  t.u[0] = pack2(x[8 * s + 0], x[8 * s + 1]); t.u[1] = pack2(x[8 * s + 2], x[8 * s + 3]);
  t.u[2] = pack2(x[8 * s + 4], x[8 * s + 5]); t.u[3] = pack2(x[8 * s + 6], x[8 * s + 7]);
  return t.v;
}

constexpr int GS_ = 72;
constexpr int GT_ = 128 * GS_;

constexpr int GST_ = 32768;
DI void gemm_stage(const u16* __restrict__ A, int lda, const u16* __restrict__ B, int ldb, int kt, char* sbuf) {
  const int tid = tidx(), lane = tid & 63, wave = __builtin_amdgcn_readfirstlane(tid >> 6);
  const int pp = lane >> 4, pos = lane & 15;
#pragma unroll
  for (int i = 0; i < 4; i++) {
    const int blk = i * 4 + wave;
    const int p = blk * 4 + pp;
    const int row = 2 * p + (pos >> 3), c8 = (pos & 7) ^ (p & 7);
    const u16* ga = A + (size_t)row * lda + kt * 64 + c8 * 8;
    const u16* gb = B + (size_t)row * ldb + kt * 64 + c8 * 8;
    __builtin_amdgcn_global_load_lds((const GAS void*)ga, (__attribute__((address_space(3))) void*)(sbuf + blk * 1024), 16, 0, 0);
    __builtin_amdgcn_global_load_lds((const GAS void*)gb, (__attribute__((address_space(3))) void*)(sbuf + 16384 + blk * 1024), 16, 0, 0);
  }
}
DI void gemm_main(f32x16 (&acc)[2][2], const u16* __restrict__ A, int lda, const u16* __restrict__ B, int ldb, int K, u16* sm) {
  const int tid = tidx(), lane = tid & 63, wave = tid >> 6;
  const int wm = wave >> 1, wn = wave & 1, r = lane & 31, hh = lane >> 5;
  char* sb = (char*)sm;
  const int rowa = wm * 64 + r, rowb = wn * 64 + r;
  const int baseA = (rowa >> 1) * 256 + ((rowa & 1) << 7), xa = (rowa >> 1) & 7;
  const int baseB = 16384 + (rowb >> 1) * 256 + ((rowb & 1) << 7), xb = (rowb >> 1) & 7;
  const int nk = K >> 6;
  asm volatile("s_waitcnt vmcnt(0)" ::: "memory");
  __syncthreads();
#pragma unroll 1
  for (int kt = 0; kt < nk; kt++) {
    if (kt + 1 < nk) gemm_stage(A, lda, B, ldb, kt + 1, sb + ((kt + 1) & 1) * GST_);
    const char* st = sb + (kt & 1) * GST_;
#pragma unroll
    for (int ks = 0; ks < 4; ks++) {
      const int ca = ((ks * 2 + hh) ^ xa) << 4, cb = ((ks * 2 + hh) ^ xb) << 4;
      const bf16x8 fa0 = *(const bf16x8*)(st + baseA + ca);
      const bf16x8 fa1 = *(const bf16x8*)(st + baseA + 4096 + ca);
      const bf16x8 fb0 = *(const bf16x8*)(st + baseB + cb);
      const bf16x8 fb1 = *(const bf16x8*)(st + baseB + 4096 + cb);
      acc[0][0] = MFMA32(fa0, fb0, acc[0][0]); acc[0][1] = MFMA32(fa0, fb1, acc[0][1]);
      acc[1][0] = MFMA32(fa1, fb0, acc[1][0]); acc[1][1] = MFMA32(fa1, fb1, acc[1][1]);
    }
    asm volatile("s_waitcnt vmcnt(0)" ::: "memory");
    __syncthreads();
  }
}

DI bool tile_at(int it, int bid, int nb, int TM, int TN, int& tm, int& tn) {
  if ((nb & 7) == 0 && (TM & 63) == 0) {
    const int xcd = bid & 7, lw = bid >> 3, nlw = nb >> 3;
    const int lt = lw + it * nlw, per = (TM >> 3) * TN;
    if (lt >= per) return false;
    const int g = lt / (4 * TN), rem = lt - g * 4 * TN;
    tn = rem >> 2; tm = xcd * (TM >> 3) + g * 4 + (rem & 3);
    return true;
  } else {
    const int t = bid + it * nb;
    if (t >= TM * TN) return false;
    tn = t / TM; tm = t - tn * TM;
    return true;
  }
}

template <class AF, class BF, class INI, class EPI>
DI void gemm_phase_init(int TM, int TN, int K, int lda, int ldb, AF a_of, BF b_of, INI ini, EPI epi, int bid, int nb, u16* sm) {
  int tm, tn;
  bool have = tile_at(0, bid, nb, TM, TN, tm, tn);
  __syncthreads();
  if (have) gemm_stage(a_of(tm), lda, b_of(tn), ldb, 0, (char*)sm);
  for (int it = 0; have; it++) {
    f32x16 acc[2][2];
    ini(acc, tm, tn);
    gemm_main(acc, a_of(tm), lda, b_of(tn), ldb, K, sm);
    int tm2 = 0, tn2 = 0;
    const bool have2 = tile_at(it + 1, bid, nb, TM, TN, tm2, tn2);
    if (have2) gemm_stage(a_of(tm2), lda, b_of(tn2), ldb, 0, (char*)sm);
    epi(acc, tm, tn);
    have = have2; tm = tm2; tn = tn2;
  }
  asm volatile("s_waitcnt vmcnt(0)" ::: "memory");
}
template <class AF, class BF, class EPI>
DI void gemm_phase(int TM, int TN, int K, int lda, int ldb, AF a_of, BF b_of, EPI epi, int bid, int nb, u16* sm) {
  gemm_phase_init(TM, TN, K, lda, ldb, a_of, b_of,
    [&](f32x16 (&acc)[2][2], int, int) { acc[0][0] = zero16(); acc[0][1] = zero16(); acc[1][0] = zero16(); acc[1][1] = zero16(); },
    epi, bid, nb, sm);
}

DI void transpose_job(const float* __restrict__ src, int K, int N, u16* __restrict__ dst, int mode, int bid, int nb, float* tile) {
  const int tid = tidx();
  const int tk = K >> 6, tn = (N + 63) >> 6;
  for (int t = bid; t < tk * tn; t += nb) {
    const int k0 = (t % tk) * 64, n0 = (t / tk) * 64;
    __syncthreads();
#pragma unroll 4
    for (int i = 0; i < 16; i++) {
      const int k = i * 4 + (tid >> 6), n = tid & 63;
      tile[k * 65 + n] = (n0 + n < N) ? src[(size_t)(k0 + k) * N + n0 + n] : 0.f;
    }
    __syncthreads();
#pragma unroll 4
    for (int i = 0; i < 16; i++) {
      const int n = i * 4 + (tid >> 6), k = tid & 63;
      const int ng = n0 + n;
      if (ng < N) {
        int row = ng;
        if (mode == 1) row = (ng >> 5) * 64 + (ng & 31);
        else if (mode == 2) row = (ng >> 5) * 64 + 32 + (ng & 31);
        dst[(size_t)row * K + k0 + k] = f2bf(tile[k * 65 + n]);
      }
    }
  }
}

DI void phase_prep(const Params& P, int bid, int nb, char* smem) {
  float* tile = (float*)smem;
  char* ws = WS(P);
  for (int l = 0; l < 2; l++) {
    transpose_job(INP(P, 3) + (size_t)l * 1024 * FF_, 1024, FF_, (u16*)(ws + OFF_WGU1 + l * SZ_WGU), 1, bid, nb, tile);
    transpose_job(INP(P, 4) + (size_t)l * 1024 * FF_, 1024, FF_, (u16*)(ws + OFF_WGU1 + l * SZ_WGU), 2, bid, nb, tile);
    transpose_job(INP(P, 5) + (size_t)l * FF_ * 1024, FF_, 1024, (u16*)(ws + OFF_WD1 + l * SZ_WD), 0, bid, nb, tile);
    transpose_job(INP(P, 26) + (size_t)l * 1024 * FF_, 1024, FF_, (u16*)(ws + OFF_WGU2 + l * SZ_WGU), 1, bid, nb, tile);
    transpose_job(INP(P, 27) + (size_t)l * 1024 * FF_, 1024, FF_, (u16*)(ws + OFF_WGU2 + l * SZ_WGU), 2, bid, nb, tile);
    transpose_job(INP(P, 28) + (size_t)l * FF_ * 1024, FF_, 1024, (u16*)(ws + OFF_WD2 + l * SZ_WD), 0, bid, nb, tile);
    transpose_job(INP(P, 8) + (size_t)l * 1024 * 2472, 1024, 2472, (u16*)(ws + OFF_WIN + l * SZ_WIN), 0, bid, nb, tile);
    transpose_job(INP(P, 9) + (size_t)l * 1024 * 1024, 1024, 1024, (u16*)(ws + OFF_WO + l * SZ_WO), 0, bid, nb, tile);
    transpose_job(INP(P, 23) + (size_t)l * 256 * 256, 256, 256, (u16*)(ws + OFF_WGLU + l * SZ_WGLU), 0, bid, nb, tile);
    transpose_job(INP(P, 30) + (size_t)l * 1024 * 1024, 1024, 1024, (u16*)(ws + OFF_WPG + l * SZ_WPG), 0, bid, nb, tile);
    transpose_job(INP(P, 29) + (size_t)l * 256 * 1024, 256, 1024, (u16*)(ws + OFF_WPP + l * SZ_WPP), 0, bid, nb, tile);
    u16* win = (u16*)(ws + OFF_WIN + l * SZ_WIN);
    for (int i = bid * 256 + tidx(); i < 88 * 1024; i += nb * 256) win[(size_t)2472 * 1024 + i] = 0;
  }
  const size_t gt = (size_t)bid * 256 + tidx(), gs = (size_t)nb * 256;
  {
    const float4* x4 = (const float4*)INP(P, 0);
    uint2* xb = (uint2*)(ws + OFF_XB);
    for (size_t i = gt; i < (size_t)T_ * 1024 / 4; i += gs) { float4 v = x4[i]; xb[i] = make_uint2(pack2(v.x, v.y), pack2(v.z, v.w)); }
    const float4* p4 = (const float4*)INP(P, 1);
    uint2* pb = (uint2*)(ws + OFF_PB);
    for (size_t i = gt; i < (size_t)2 * T_ * 256 / 4; i += gs) { float4 v = p4[i]; pb[i] = make_uint2(pack2(v.x, v.y), pack2(v.z, v.w)); }
  }
  if (gt < 2 * 16 * 64) {
    const int l = (int)gt >> 10, g = ((int)gt >> 6) & 15, p = (int)gt & 63;
    const int gi = (l * 16 + g) * 64 + p;
    const double lr = INP(P, 15)[gi], li = INP(P, 16)[gi];
    const double dt = exp((double)INP(P, 17)[l * 16 + g]);
    const double mag = exp(lr * dt);
    const double ar = mag * cos(li * dt), ai = mag * sin(li * dt);
    const double mag5 = exp(512.0 * lr * dt);
    const double a5r = mag5 * cos(512.0 * li * dt), a5i = mag5 * sin(512.0 * li * dt);
    ((float4*)(ws + OFF_COEFA))[gi] = make_float4((float)ar, (float)ai, (float)a5r, (float)a5i);
    const double den = lr * lr + li * li, nr = ar - 1.0, ni = ai;
    const double fr = (nr * lr + ni * li) / den, fi = (ni * lr - nr * li) / den;
    float2* cb = (float2*)(ws + OFF_COEFB) + (size_t)gi * 16;
    for (int c = 0; c < 16; c++) {
      const double br = INP(P, 18)[(size_t)gi * 16 + c], bi = INP(P, 19)[(size_t)gi * 16 + c];
      cb[c] = make_float2((float)(fr * br - fi * bi), (float)(fr * bi + fi * br));
    }
  }
  if (gt < 8 * 129) {
    const int hd = (int)gt / 129, n = (int)gt - hd * 129;
    int bk = n;
    if (n >= 16) { bk = 16 + (int)(log((double)n / 16.0) / log(8.0) * 16.0); bk = bk < 31 ? bk : 31; }
    ((float*)(ws + OFF_BIAS))[gt] = INP(P, 2)[bk * 8 + hd];
  }
  if (gt < 2) {
    const int l = (int)gt;
    float s1 = 0.f, s2 = 0.f;
    for (int i = 0; i < 64; i++) { s1 += INP(P, 10)[l * 64 + i] * INP(P, 11)[l * 64 + i]; s2 += INP(P, 12)[l * 64 + i] * INP(P, 13)[l * 64 + i]; }
    const float lam_init = 0.8f - 0.6f * expf(-0.3f * (float)l);
    ((float*)(ws + OFF_LAM))[l] = expf(s1) - expf(s2) + lam_init;
  }
}

DI void phase_ffn_up(const u16* __restrict__ Xb, const u16* __restrict__ Wgu, u16* __restrict__ H, int bid, int nb, u16* sm) {
  const int lane = tidx() & 63, wave = tidx() >> 6, wm = wave >> 1, wn = wave & 1, r = lane & 31, hh = lane >> 5;
  gemm_phase(512, 44, 1024, 1024, 1024,
    [&](int tm) { return Xb + (size_t)tm * 128 * 1024; }, [&](int tn) { return Wgu + (size_t)tn * 128 * 1024; },
    [&](f32x16 (&acc)[2][2], int tm, int tn) {
      const int j = tn * 64 + wn * 32 + r;
#pragma unroll
      for (int mi = 0; mi < 2; mi++)
#pragma unroll
        for (int i = 0; i < 16; i++) {
          const int row = tm * 128 + wm * 64 + mi * 32 + crow(i, hh);
          const float g = acc[mi][0][i], u = acc[mi][1][i];
          H[(size_t)row * FF_ + j] = f2bf(g * sigmoidf_(g) * u);
        }
    }, bid, nb, sm);
}

DI void phase_ffn_down(const u16* __restrict__ H, const u16* __restrict__ Wd, const float* xin, float* xout, const u16* __restrict__ ple, int bid, int nb, u16* sm) {
  const int lane = tidx() & 63, wave = tidx() >> 6, wm = wave >> 1, wn = wave & 1, r = lane & 31, hh = lane >> 5;
  gemm_phase_init(512, 8, FF_, FF_, FF_,
    [&](int tm) { return H + (size_t)tm * 128 * FF_; }, [&](int tn) { return Wd + (size_t)tn * 128 * FF_; },
    [&](f32x16 (&acc)[2][2], int tm, int tn) {
#pragma unroll
      for (int mi = 0; mi < 2; mi++)
#pragma unroll
        for (int ni = 0; ni < 2; ni++)
#pragma unroll
          for (int i = 0; i < 16; i++) {
            const size_t o = (size_t)(tm * 128 + wm * 64 + mi * 32 + crow(i, hh)) * 1024 + tn * 128 + wn * 64 + ni * 32 + r;
            float v = 2.f * ALPHA_ * xin[o];
            if (ple) v += 2.f * bf2f(ple[o]);
            acc[mi][ni][i] = v;
          }
    },
    [&](f32x16 (&acc)[2][2], int tm, int tn) {
#pragma unroll
      for (int mi = 0; mi < 2; mi++)
#pragma unroll
        for (int ni = 0; ni < 2; ni++)
#pragma unroll
          for (int i = 0; i < 16; i++) {
            const size_t o = (size_t)(tm * 128 + wm * 64 + mi * 32 + crow(i, hh)) * 1024 + tn * 128 + wn * 64 + ni * 32 + r;
            xout[o] = 0.5f * acc[mi][ni][i];
          }
    }, bid, nb, sm);
}

DI void phase_w_o(const u16* __restrict__ CC, const u16* __restrict__ Wo, float* x, int bid, int nb, u16* sm) {
  const int lane = tidx() & 63, wave = tidx() >> 6, wm = wave >> 1, wn = wave & 1, r = lane & 31, hh = lane >> 5;
  gemm_phase_init(512, 8, 1024, 1024, 1024,
    [&](int tm) { return CC + (size_t)tm * 128 * 1024; }, [&](int tn) { return Wo + (size_t)tn * 128 * 1024; },
    [&](f32x16 (&acc)[2][2], int tm, int tn) {
#pragma unroll
      for (int mi = 0; mi < 2; mi++)
#pragma unroll
        for (int ni = 0; ni < 2; ni++)
#pragma unroll
          for (int i = 0; i < 16; i++) {
            const size_t o = (size_t)(tm * 128 + wm * 64 + mi * 32 + crow(i, hh)) * 1024 + tn * 128 + wn * 64 + ni * 32 + r;
            acc[mi][ni][i] = ALPHA_ * x[o];
          }
    },
    [&](f32x16 (&acc)[2][2], int tm, int tn) {
#pragma unroll
      for (int mi = 0; mi < 2; mi++)
#pragma unroll
        for (int ni = 0; ni < 2; ni++)
#pragma unroll
          for (int i = 0; i < 16; i++) {
            const size_t o = (size_t)(tm * 128 + wm * 64 + mi * 32 + crow(i, hh)) * 1024 + tn * 128 + wn * 64 + ni * 32 + r;
            x[o] = acc[mi][ni][i];
          }
    }, bid, nb, sm);
}

DI void phase_glu(const u16* __restrict__ Yg, const u16* __restrict__ Wglu, u16* __restrict__ CC, int bid, int nb, u16* sm) {
  const int lane = tidx() & 63, wave = tidx() >> 6, wm = wave >> 1, wn = wave & 1, r = lane & 31, hh = lane >> 5;
  gemm_phase(512, 2, 256, 256, 256,
    [&](int tm) { return Yg + (size_t)tm * 128 * 256; }, [&](int tn) { return Wglu + (size_t)tn * 128 * 256; },
    [&](f32x16 (&acc)[2][2], int tm, int tn) {
#pragma unroll
      for (int mi = 0; mi < 2; mi++)
#pragma unroll
        for (int ni = 0; ni < 2; ni++)
#pragma unroll
          for (int i = 0; i < 16; i++) {
            const int row = tm * 128 + wm * 64 + mi * 32 + crow(i, hh), col = tn * 128 + wn * 64 + ni * 32 + r;
            const float y = bf2f(Yg[(size_t)row * 256 + col]);
            CC[(size_t)row * 1024 + 512 + col] = f2bf(y * sigmoidf_(acc[mi][ni][i]));
          }
    }, bid, nb, sm);
}

DI void phase_ple(const u16* __restrict__ Xb, const u16* __restrict__ Wpg, const u16* __restrict__ Pb, const u16* __restrict__ Wpp, u16* ple, int bid, int nb, u16* sm) {
  const int lane = tidx() & 63, wave = tidx() >> 6, wm = wave >> 1, wn = wave & 1, r = lane & 31, hh = lane >> 5;
  gemm_phase(512, 8, 1024, 1024, 1024,
    [&](int tm) { return Xb + (size_t)tm * 128 * 1024; }, [&](int tn) { return Wpg + (size_t)tn * 128 * 1024; },
    [&](f32x16 (&acc)[2][2], int tm, int tn) {
#pragma unroll
      for (int mi = 0; mi < 2; mi++)
#pragma unroll
        for (int ni = 0; ni < 2; ni++)
#pragma unroll
          for (int i = 0; i < 16; i++) {
            const size_t o = (size_t)(tm * 128 + wm * 64 + mi * 32 + crow(i, hh)) * 1024 + tn * 128 + wn * 64 + ni * 32 + r;
            ple[o] = f2bf(sigmoidf_(acc[mi][ni][i]));
          }
    }, bid, nb, sm);
  gemm_phase(512, 8, 256, 256, 256,
    [&](int tm) { return Pb + (size_t)tm * 128 * 256; }, [&](int tn) { return Wpp + (size_t)tn * 128 * 256; },
    [&](f32x16 (&acc)[2][2], int tm, int tn) {
#pragma unroll
      for (int mi = 0; mi < 2; mi++)
#pragma unroll
        for (int ni = 0; ni < 2; ni++)
#pragma unroll
          for (int i = 0; i < 16; i++) {
            const size_t o = (size_t)(tm * 128 + wm * 64 + mi * 32 + crow(i, hh)) * 1024 + tn * 128 + wn * 64 + ni * 32 + r;
            ple[o] = f2bf(acc[mi][ni][i] * bf2f(ple[o]));
          }
    }, bid, nb, sm);
}

DI void phase_w_in(const u16* __restrict__ Xb, const u16* __restrict__ Win, char* mb, int bid, int nb, u16* sm) {
  const int lane = tidx() & 63, wave = tidx() >> 6, wm = wave >> 1, wn = wave & 1, r = lane & 31, hh = lane >> 5;
  u16* Qd = (u16*)(mb + M_QD); u16* Kd = (u16*)(mb + M_KD); u16* Vt = (u16*)(mb + M_VT); float* U = (float*)(mb + M_U);
  u16* Qs = (u16*)(mb + M_QS); u16* Qi = (u16*)(mb + M_QI); u16* Ks = (u16*)(mb + M_KS); u16* Vs = (u16*)(mb + M_VS);
  u16* Ki = (u16*)(mb + M_KI); float* Wi = (float*)(mb + M_WI);
  gemm_phase(512, 20, 1024, 1024, 1024,
    [&](int tm) { return Xb + (size_t)tm * 128 * 1024; }, [&](int tn) { return Win + (size_t)tn * 128 * 1024; },
    [&](f32x16 (&acc)[2][2], int tm, int tn) {
#pragma unroll
    for (int ni = 0; ni < 2; ni++) {
      const int c0 = tn * 128 + wn * 64 + ni * 32;
      const int c = c0 + r;
#pragma unroll
      for (int mi = 0; mi < 2; mi++) {
        const int rowb = tm * 128 + wm * 64 + mi * 32;
        if (c0 >= 1024 && c0 < 1536) {
          const int cc = c - 1024, head = cc >> 7, dv = cc & 127;
          const int b = rowb >> 13, t0 = rowb & 8191;
#pragma unroll
          for (int g4 = 0; g4 < 4; g4++) {
            uint2 v = make_uint2(pack2(acc[mi][ni][4 * g4], acc[mi][ni][4 * g4 + 1]), pack2(acc[mi][ni][4 * g4 + 2], acc[mi][ni][4 * g4 + 3]));
            const int tt = t0 + 8 * g4 + 4 * hh;
            *(uint2*)(Vt + ((size_t)(((b * 4 + head) * 128 + (tt >> 6)) * 128 + dv)) * 64 + (tt & 63)) = v;
          }
        } else {
#pragma unroll
          for (int i = 0; i < 16; i++) {
            const size_t row = rowb + crow(i, hh);
            const float v = acc[mi][ni][i];
            if (c0 < 512) Qd[row * 512 + c] = f2bf(v);
            else if (c0 < 1024) {
              const int cc = c - 512;
              Kd[((size_t)((((int)(row >> 13) * 4 + (cc >> 7)) * 2 + ((cc >> 6) & 1))) * L_ + (row & 8191)) * 64 + (cc & 63)] = f2bf(v);
            }
            else if (c0 < 1792) U[row * 256 + (c - 1536)] = v;
            else if (c0 < 2048) Qs[row * 256 + (c - 1792)] = f2bf(v);
            else if (c0 < 2112) Ks[row * 64 + (c - 2048)] = f2bf(v);
            else if (c0 < 2176) Vs[row * 64 + (c - 2112)] = f2bf(v);
            else if (c0 < 2432) Qi[row * 256 + (c - 2176)] = f2bf(v);
            else if (c0 < 2464) Ki[row * 32 + (c - 2432)] = f2bf(v);
            else if (c0 == 2464) { if (r < 8) Wi[row * 8 + r] = v * 0.0625f; }
          }
        }
      }
    }
  }, bid, nb, sm);
}

DI void phase_ln(float* x, u16* __restrict__ xb, const float* __restrict__ g, const float* __restrict__ bta, int bid, int nb) {
  const int lane = tidx() & 63, wave = tidx() >> 6;
  float4 gg[4], bb[4];
#pragma unroll
  for (int i = 0; i < 4; i++) { gg[i] = *(const float4*)(g + i * 256 + lane * 4); bb[i] = *(const float4*)(bta + i * 256 + lane * 4); }
  constexpr int RB = 4;
  for (int row0 = (bid * 4 + wave) * RB; row0 < T_; row0 += nb * 4 * RB) {
    float4 v[RB][4];
#pragma unroll
    for (int rr = 0; rr < RB; rr++)
#pragma unroll
      for (int i = 0; i < 4; i++) v[rr][i] = *(const float4*)(x + (size_t)(row0 + rr) * 1024 + i * 256 + lane * 4);
    float s[RB], q[RB];
#pragma unroll
    for (int rr = 0; rr < RB; rr++) {
      s[rr] = 0.f;
#pragma unroll
      for (int i = 0; i < 4; i++) s[rr] += v[rr][i].x + v[rr][i].y + v[rr][i].z + v[rr][i].w;
    }
#pragma unroll
    for (int o = 32; o > 0; o >>= 1)
#pragma unroll
      for (int rr = 0; rr < RB; rr++) s[rr] += __shfl_xor(s[rr], o);
#pragma unroll
    for (int rr = 0; rr < RB; rr++) {
      const float mu = s[rr] * (1.f / 1024.f);
      q[rr] = 0.f;
#pragma unroll
      for (int i = 0; i < 4; i++) {
        v[rr][i].x -= mu; v[rr][i].y -= mu; v[rr][i].z -= mu; v[rr][i].w -= mu;
        q[rr] += v[rr][i].x * v[rr][i].x + v[rr][i].y * v[rr][i].y + v[rr][i].z * v[rr][i].z + v[rr][i].w * v[rr][i].w;
      }
    }
#pragma unroll
    for (int o = 32; o > 0; o >>= 1)
#pragma unroll
      for (int rr = 0; rr < RB; rr++) q[rr] += __shfl_xor(q[rr], o);
#pragma unroll
    for (int rr = 0; rr < RB; rr++) {
      const float rs = rsqrtf(q[rr] * (1.f / 1024.f) + LN_EPS_);
#pragma unroll
      for (int i = 0; i < 4; i++) {
        float4 o;
        o.x = v[rr][i].x * rs * gg[i].x + bb[i].x; o.y = v[rr][i].y * rs * gg[i].y + bb[i].y;
        o.z = v[rr][i].z * rs * gg[i].z + bb[i].z; o.w = v[rr][i].w * rs * gg[i].w + bb[i].w;
        *(float4*)(x + (size_t)(row0 + rr) * 1024 + i * 256 + lane * 4) = o;
        *(uint2*)(xb + (size_t)(row0 + rr) * 1024 + i * 256 + lane * 4) = make_uint2(pack2(o.x, o.y), pack2(o.z, o.w));
      }
    }
  }
}

DI float gelu_tanh(float x) { const float u = 0.7978845608028654f * (x + 0.044715f * x * x * x); return 0.5f * x * (1.f + tanhf(u)); }

typedef __attribute__((ext_vector_type(4))) float f32x4;
template <bool OUT>
DI void ssm_scan(const Params& P, int layer, int widx, char* mb, char* smem) {
  const int lane = tidx() & 63, wave = tidx() >> 6;
  const int b = widx >> 8, g = (widx >> 4) & 15, ch = widx & 15;
  const int gi = (layer * 16 + g) * 64 + lane;
  const float4 ca = ((const float4*)(WS(P) + OFF_COEFA))[gi];
  const float2* cbp = (const float2*)(WS(P) + OFF_COEFB) + (size_t)gi * 16;
  float bre[16], bim[16];
#pragma unroll
  for (int c = 0; c < 16; c++) { float2 t = cbp[c]; bre[c] = t.x; bim[c] = t.y; }
  const float* U = (const float*)(mb + M_U);
  float2* Send = (float2*)(mb + M_SEND);
  const size_t sbase = (size_t)((b * 16 + g) * 16) * 64 + lane;
  float xr = 0.f, xi = 0.f;
  float am[32];
  float4 dsk4 = make_float4(0.f, 0.f, 0.f, 0.f);
  float* Xs = (float*)smem + wave * (128 * 17);
  const int lm = lane & 15, lq = lane >> 4;
  if (OUT) {
    for (int j = 0; j < ch; j++) {
      const float2 e = Send[sbase + (size_t)j * 64];
      const float nr = ca.z * xr - ca.w * xi + e.x, ni = ca.z * xi + ca.w * xr + e.y;
      xr = nr; xi = ni;
    }
    const float* cre = INP(P, 20) + ((size_t)(layer * 16 + g) * 16 + lm) * 64;
    const float* cim = INP(P, 21) + ((size_t)(layer * 16 + g) * 16 + lm) * 64;
#pragma unroll
    for (int kb = 0; kb < 32; kb++) {
      const int kk = 4 * kb + lq;
      am[kb] = (kb < 16) ? cre[kk] : -cim[kk - 64];
    }
    dsk4 = *(const float4*)(INP(P, 22) + layer * 256 + g * 16 + 4 * lq);
  }
  u16* Yg = (u16*)(mb + M_YG);
  const size_t tok0 = (size_t)b * L_ + ch * 512;
  const float* ub = U + (tok0 + (lane >> 2)) * 256 + g * 16 + (lane & 3) * 4;
  float4 cur = *(const float4*)ub;
#pragma unroll 1
  for (int blk = 0; blk < 32; blk++) {
    const float4 nxt = *(const float4*)(ub + (size_t)min(blk + 1, 31) * 16 * 256);
#pragma unroll
    for (int s16 = 0; s16 < 16; s16++) {
      float uu[16];
#pragma unroll
      for (int c = 0; c < 16; c++) {
        const float comp = ((c & 3) == 0) ? cur.x : ((c & 3) == 1) ? cur.y : ((c & 3) == 2) ? cur.z : cur.w;
        uu[c] = __int_as_float(__builtin_amdgcn_readlane(__float_as_int(comp), 4 * s16 + (c >> 2)));
      }
      float br4[4] = {0.f, 0.f, 0.f, 0.f}, bi4[4] = {0.f, 0.f, 0.f, 0.f};
#pragma unroll
      for (int c = 0; c < 16; c++) { br4[c & 3] += bre[c] * uu[c]; bi4[c & 3] += bim[c] * uu[c]; }
      const float br = (br4[0] + br4[1]) + (br4[2] + br4[3]), bi = (bi4[0] + bi4[1]) + (bi4[2] + bi4[3]);
      const float nr = ca.x * xr - ca.y * xi + br, ni = ca.x * xi + ca.y * xr + bi;
      xr = nr; xi = ni;
      if (OUT) { Xs[lane * 17 + s16] = xr; Xs[(64 + lane) * 17 + s16] = xi; }
    }
    if (OUT) {
      __builtin_amdgcn_wave_barrier();
      f32x4 acc = {0.f, 0.f, 0.f, 0.f}, acc2 = {0.f, 0.f, 0.f, 0.f};
#pragma unroll
      for (int kb = 0; kb < 32; kb += 2) {
        const float bv0 = Xs[(4 * kb + lq) * 17 + lm], bv1 = Xs[(4 * kb + 4 + lq) * 17 + lm];
        acc = __builtin_amdgcn_mfma_f32_16x16x4f32(am[kb], bv0, acc, 0, 0, 0);
        acc2 = __builtin_amdgcn_mfma_f32_16x16x4f32(am[kb + 1], bv1, acc2, 0, 0, 0);
      }
      acc += acc2;
      __builtin_amdgcn_wave_barrier();
      const size_t tok = tok0 + blk * 16 + lm;
      const float4 u4 = *(const float4*)(U + tok * 256 + g * 16 + 4 * lq);
      const float y0 = gelu_tanh(acc[0] + dsk4.x * u4.x), y1 = gelu_tanh(acc[1] + dsk4.y * u4.y);
      const float y2 = gelu_tanh(acc[2] + dsk4.z * u4.z), y3 = gelu_tanh(acc[3] + dsk4.w * u4.w);
      *(uint2*)(Yg + tok * 256 + g * 16 + 4 * lq) = make_uint2(pack2(y0, y1), pack2(y2, y3));
    }
    cur = nxt;
  }
  if (!OUT) Send[sbase + (size_t)ch * 64] = make_float2(xr, xi);
}

constexpr int KS_ = 72, VS_ = 68;
DI void da_item(const Params& P, int layer, int b, int h, int qt, char* mb, char* smem) {
  const int tid = tidx(), lane = tid & 63, wave = tid >> 6, r = lane & 31, hh = lane >> 5;
  u16* sK0 = (u16*)smem;
  u16* sV0 = sK0 + 2 * 64 * KS_;
  float* sbias = (float*)(sV0 + 2 * 128 * VS_);
  u16* sQw = (u16*)(smem + 54272) + (tidx() >> 6) * 32 * KS_;
  const u16* Qd = (const u16*)(mb + M_QD); const u16* Kd = (const u16*)(mb + M_KD); const u16* Vt = (const u16*)(mb + M_VT);
  u16* CC = (u16*)(WS(P) + OFF_CC);
  const int q0 = qt * 128, qw = q0 + wave * 32, qp = qw + r;
  const size_t tokq = (size_t)b * L_ + qp;
  __syncthreads();
  if (tid < 129) sbias[tid] = ((const float*)(WS(P) + OFF_BIAS))[h * 129 + tid] * LOG2E_;
  __syncthreads();
  const float bfar = sbias[128];
  const float SC = 0.125f * LOG2E_;
  const int nkt = (q0 + 128) >> 6;
  const float lam = ((const float*)(WS(P) + OFF_LAM))[layer];
  const int krow_l = tid >> 3, kch = (tid & 7) * 8;
#pragma unroll 1
  for (int c = 0; c < 2; c++) {
#pragma unroll
    for (int ks = 0; ks < 4; ks++) *(bf16x8*)(sQw + r * KS_ + ks * 16 + hh * 8) = *(const bf16x8*)(Qd + tokq * 512 + h * 128 + c * 64 + ks * 16 + hh * 8);
    f32x16 o[4] = {zero16(), zero16(), zero16(), zero16()};
    float m = -INFINITY, l = 0.f;
    const u16* Kbase = Kd + ((size_t)(((b * 4 + h) * 2 + c)) * L_ + krow_l) * 64 + kch;
    const u16* Vbase = Vt + ((size_t)((b * 4 + h) * 128) * 128 + krow_l) * 64 + kch;
    u32x4 rk[2], rv[4];
#pragma unroll
    for (int i = 0; i < 2; i++) rk[i] = *(const u32x4*)(Kbase + (size_t)(i * 32) * 64);
#pragma unroll
    for (int i = 0; i < 4; i++) rv[i] = *(const u32x4*)(Vbase + (size_t)(i * 32) * 64);
#define DA_STAGE(BUF) { u16* sKw = sK0 + (BUF) * 64 * KS_; u16* sVw = sV0 + (BUF) * 128 * VS_; \
      _Pragma("unroll") for (int i = 0; i < 2; i++) *(u32x4*)(sKw + (krow_l + i * 32) * KS_ + kch) = rk[i]; \
      _Pragma("unroll") for (int i = 0; i < 4; i++) { u32x2* d = (u32x2*)(sVw + (krow_l + i * 32) * VS_ + kch); \
        u32x2 lo2, hi2; lo2.x = rv[i].x; lo2.y = rv[i].y; hi2.x = rv[i].z; hi2.y = rv[i].w; d[0] = lo2; d[1] = hi2; } }
#define DA_FETCH(T) { const int ktn_ = min((T), nkt - 1); \
      _Pragma("unroll") for (int i = 0; i < 2; i++) rk[i] = *(const u32x4*)(Kbase + (size_t)(ktn_ * 64 + i * 32) * 64); \
      _Pragma("unroll") for (int i = 0; i < 4; i++) rv[i] = *(const u32x4*)(Vbase + (size_t)ktn_ * 8192 + (size_t)(i * 32) * 64); }
    __syncthreads();
    DA_STAGE(0)
    DA_FETCH(1)
    __syncthreads();
#pragma unroll 1
    for (int kt = 0; kt < nkt; kt++) {
      const u16* sK = sK0 + (kt & 1) * 64 * KS_;
      const u16* sV = sV0 + (kt & 1) * 128 * VS_;
      if (kt + 1 < nkt) { DA_STAGE((kt + 1) & 1) }
      DA_FETCH(kt + 2)
      if (kt * 64 <= qw + 31) {
        f32x16 s[2];
#pragma unroll
        for (int kb = 0; kb < 2; kb++) {
          s[kb] = zero16();
#pragma unroll
          for (int ks = 0; ks < 4; ks++) {
            const bf16x8 kf = *(const bf16x8*)(sK + (kb * 32 + r) * KS_ + ks * 16 + hh * 8);
            const bf16x8 qf = *(const bf16x8*)(sQw + r * KS_ + ks * 16 + hh * 8);
            s[kb] = MFMA32(kf, qf, s[kb]);
          }
        }
        const bool nearb = (kt * 64 + 63 + 128 > qw);
        float mx = -INFINITY;
        if (nearb) {
#pragma unroll
          for (int kb = 0; kb < 2; kb++)
#pragma unroll
            for (int i = 0; i < 16; i++) {
              const int dist = qp - (kt * 64 + kb * 32 + crow(i, hh));
              const float bv = sbias[min(max(dist, 0), 128)];
              float t = s[kb][i] * SC + bv;
              t = (dist >= 0) ? t : -INFINITY;
              s[kb][i] = t; mx = fmaxf(mx, t);
              if ((i & 7) == 7) __builtin_amdgcn_sched_barrier(0);
            }
        } else {
#pragma unroll
          for (int kb = 0; kb < 2; kb++)
#pragma unroll
            for (int i = 0; i < 16; i++) { const float t = s[kb][i] * SC + bfar; s[kb][i] = t; mx = fmaxf(mx, t); }
        }
        mx = fmaxf(mx, __shfl_xor(mx, 32));
        const float mn = fmaxf(m, mx);
        const float corr = __builtin_amdgcn_exp2f(m - mn);
        m = mn;
        float ls = 0.f;
#pragma unroll
        for (int kb = 0; kb < 2; kb++)
#pragma unroll
          for (int i = 0; i < 16; i++) { const float p = __builtin_amdgcn_exp2f(s[kb][i] - mn); s[kb][i] = p; ls += p; }
        l = l * corr + ls;
        if (__ballot(corr != 1.f) != 0ull) {
#pragma unroll
          for (int dt = 0; dt < 4; dt++)
#pragma unroll
            for (int i = 0; i < 16; i++) o[dt][i] *= corr;
        }
#pragma unroll
        for (int kb = 0; kb < 2; kb++)
#pragma unroll
          for (int s2 = 0; s2 < 2; s2++) {
            const bf16x8 pf = pack8(s[kb], s2);
#pragma unroll
            for (int dt = 0; dt < 4; dt++) {
              const u16* vp = sV + (dt * 32 + r) * VS_ + kb * 32 + s2 * 16 + 4 * hh;
              const s16x4 lo = *(const s16x4*)vp, hi = *(const s16x4*)(vp + 8);
              const bf16x8 vf = __builtin_shufflevector(lo, hi, 0, 1, 2, 3, 4, 5, 6, 7);
              o[dt] = MFMA32(vf, pf, o[dt]);
            }
            __builtin_amdgcn_sched_barrier(0);
          }
      }
      __syncthreads();
    }
#undef DA_STAGE
#undef DA_FETCH
    const float lt = l + __shfl_xor(l, 32);
    const float inv = 1.f / lt;
    size_t tq = tokq;
    asm volatile("" : "+v"(tq));
    u16* obase = CC + tq * 1024 + h * 128 + 4 * hh;
    if (c == 0) {
#pragma unroll
      for (int dt = 0; dt < 4; dt++)
#pragma unroll
        for (int g4 = 0; g4 < 4; g4++) {
          *(uint2*)(obase + dt * 32 + 8 * g4) = make_uint2(pack2(o[dt][4 * g4] * inv, o[dt][4 * g4 + 1] * inv), pack2(o[dt][4 * g4 + 2] * inv, o[dt][4 * g4 + 3] * inv));
        }
    } else {
      float ss = 0.f;
#pragma unroll
      for (int dt = 0; dt < 4; dt++)
#pragma unroll
        for (int g4 = 0; g4 < 4; g4++) {
          const uint2 pv = *(const uint2*)(obase + dt * 32 + 8 * g4);
          const float a4[4] = {bf2f((u16)(pv.x & 0xffff)), bf2f((u16)(pv.x >> 16)), bf2f((u16)(pv.y & 0xffff)), bf2f((u16)(pv.y >> 16))};
#pragma unroll
          for (int e = 0; e < 4; e++) { const float v = a4[e] - lam * o[dt][4 * g4 + e] * inv; o[dt][4 * g4 + e] = v; ss = __builtin_fmaf(v, v, ss); }
        }
      ss += __shfl_xor(ss, 32);
      const float lam_init = 0.8f - 0.6f * __expf(-0.3f * (float)layer);
      const float rn = rsqrtf(ss * (1.f / 128.f) + LN_EPS_) * (1.f - lam_init);
      int hh2 = hh;
      asm volatile("" : "+v"(hh2));
      const float* sg = INP(P, 14) + layer * 128 + 4 * hh2;
#pragma unroll
      for (int dt = 0; dt < 4; dt++)
#pragma unroll
        for (int g4 = 0; g4 < 4; g4++) {
          const int dv = dt * 32 + 8 * g4 + 4 * hh;
          const float4 gv = *(const float4*)(sg + dt * 32 + 8 * g4);
          uint2 w = make_uint2(pack2(o[dt][4 * g4] * rn * gv.x, o[dt][4 * g4 + 1] * rn * gv.y),
                               pack2(o[dt][4 * g4 + 2] * rn * gv.z, o[dt][4 * g4 + 3] * rn * gv.w));
          *(uint2*)(obase + dv - 4 * hh) = w;
        }
    }
  }
}

DI unsigned sortkey(float f) { const unsigned u = __float_as_uint(f + 0.f); return u ^ (((unsigned)((int)u >> 31)) | 0x80000000u); }

DI void dsa_item(const Params& P, int layer, int b, int qt, char* mb, char* smem) {
  const int tid = tidx(), lane = tid & 63, wave = tid >> 6, r = lane & 31, hh = lane >> 5;
  unsigned* hist = (unsigned*)smem;
  float* sP = (float*)smem;
  float* sQ = (float*)(smem + 16384);
  u16* sidx = (u16*)(smem + 32896);
  unsigned* meta = (unsigned*)(smem + 49280);
  float* sbias = (float*)(smem + 50304);
  const u16* Qi = (const u16*)(mb + M_QI); const u16* Ki = (const u16*)(mb + M_KI); const float* Wi = (const float*)(mb + M_WI);
  const u16* Qs = (const u16*)(mb + M_QS); const u16* Ks = (const u16*)(mb + M_KS); const u16* Vs = (const u16*)(mb + M_VS);
  u16* CC = (u16*)(WS(P) + OFF_CC);
  const int q0 = qt * 32;
  const int qp = q0 + r;
  const size_t tokb = (size_t)b * L_;
  const int nk32 = qt + 1;
  const bool radix = (q0 >= 256);
  __syncthreads();
  for (int i = tid; i < 4 * 129; i += 256) sbias[i] = ((const float*)(WS(P) + OFF_BIAS))[4 * 129 + i];
  meta[tid] = (tid >= 32 && tid < 64) ? 256u : 0u;
  char* sQi = smem + 52384;
  float* sWi = (float*)(smem + 69280);
  constexpr int CAPL_ = 64;
  unsigned* lK = (unsigned*)smem;
  u16* lI = (u16*)(smem + 32 * CAPL_ * 4);
  {
    const int row = tid >> 3, ch = tid & 7;
    const uint4* src = (const uint4*)(Qi + (tokb + q0 + row) * 256 + ch * 32);
    uint4* dst = (uint4*)(sQi + row * 528 + ch * 64);
    dst[0] = src[0]; dst[1] = src[1]; dst[2] = src[2]; dst[3] = src[3];
    sWi[tid] = Wi[(tokb + q0) * 8 + tid];
  }
  int pass = radix ? 0 : 4;
  bool fast = false;
#pragma unroll 1
  while (true) {
    __syncthreads();
    if (pass < 4) { for (int i = tid; i < 32 * 257; i += 256) hist[i] = 0u; }
    __syncthreads();
    const unsigned pref = meta[r];
    const unsigned krem = meta[32 + r];
    auto elems = [&](const f32x16& sc, const int kt, const int lim) __attribute__((always_inline)) {
      if (pass == 0) {
#pragma unroll
        for (int i = 0; i < 16; i++) {
          const int kp = kt * 32 + crow(i, hh);
          const unsigned key = sortkey(sc[i]);
          const unsigned bin = (kp <= lim) ? (key >> 24) : 256u;
          atomicAdd(&hist[r * 257 + bin], 1u);
        }
      } else if (pass < 4) {
        const int sh = 24 - 8 * pass;
#pragma unroll
        for (int i = 0; i < 16; i++) {
          const int kp = kt * 32 + crow(i, hh);
          const unsigned key = sortkey(sc[i]);
          if ((key >> (sh + 8)) == pref && kp <= lim) atomicAdd(&hist[r * 257 + ((key >> sh) & 255u)], 1u);
        }
      } else if (pass == 5) {
        unsigned mc = 0u, ms = 0u;
        unsigned keys[16];
#pragma unroll
        for (int i = 0; i < 16; i++) {
          const int kp = kt * 32 + crow(i, hh);
          keys[i] = sortkey(sc[i]);
          const unsigned bt = keys[i] >> 16;
          const bool valid = (kp <= lim);
          ms |= (valid && bt > pref) ? (1u << i) : 0u;
          mc |= (valid && bt == pref) ? (1u << i) : 0u;
        }
        unsigned base_c = 0u, base_s = 0u;
        if (mc) base_c = atomicAdd(&meta[128 + r], (unsigned)__popc(mc));
        if (ms) base_s = atomicAdd(&meta[64 + r], (unsigned)__popc(ms));
#pragma unroll
        for (int i = 0; i < 16; i++) {
          const int kp = kt * 32 + crow(i, hh);
          if ((mc >> i) & 1u) {
            const unsigned cp = base_c + (unsigned)__popc(mc & ((1u << i) - 1u));
            if (cp < (unsigned)CAPL_) { lK[r * CAPL_ + cp] = keys[i]; lI[r * CAPL_ + cp] = (u16)kp; }
          }
          if ((ms >> i) & 1u) {
            const unsigned pos = base_s + (unsigned)__popc(ms & ((1u << i) - 1u));
            if (pos < 256u) sidx[r * 256 + pos] = (u16)kp;
          }
        }
      } else {
#pragma unroll
        for (int i = 0; i < 16; i++) {
          const int kp = kt * 32 + crow(i, hh);
          const unsigned key = sortkey(sc[i]);
          bool sel = (kp <= lim);
          if (radix) {
            sel = sel && (key >= pref);
            if (sel && key == pref) sel = atomicAdd(&meta[96 + r], 1u) < krem;
          }
          if (sel) { const unsigned pos = atomicAdd(&meta[64 + r], 1u); if (pos < 256u) sidx[r * 256 + pos] = (u16)kp; }
        }
      }
    };
    const int klast = nk32 - 1;
    bf16x8 nA0 = {0, 0, 0, 0, 0, 0, 0, 0}, nA1 = nA0, nB0 = nA0, nB1 = nA0;
    if (wave < nk32) {
      const int ka = wave, kb2 = min(wave + 4, klast);
      nA0 = *(const bf16x8*)(Ki + (tokb + ka * 32 + r) * 32 + hh * 8);
      nA1 = *(const bf16x8*)(Ki + (tokb + ka * 32 + r) * 32 + 16 + hh * 8);
      nB0 = *(const bf16x8*)(Ki + (tokb + kb2 * 32 + r) * 32 + hh * 8);
      nB1 = *(const bf16x8*)(Ki + (tokb + kb2 * 32 + r) * 32 + 16 + hh * 8);
    }
#pragma unroll 1
    for (int kt = wave; kt < nk32; kt += 8) {
      const bf16x8 kA0 = nA0, kA1 = nA1, kB0 = nB0, kB1 = nB1;
      {
        const int ka = min(kt + 8, klast), kb2 = min(kt + 12, klast);
        nA0 = *(const bf16x8*)(Ki + (tokb + ka * 32 + r) * 32 + hh * 8);
        nA1 = *(const bf16x8*)(Ki + (tokb + ka * 32 + r) * 32 + 16 + hh * 8);
        nB0 = *(const bf16x8*)(Ki + (tokb + kb2 * 32 + r) * 32 + hh * 8);
        nB1 = *(const bf16x8*)(Ki + (tokb + kb2 * 32 + r) * 32 + 16 + hh * 8);
      }
      f32x16 scA = zero16(), scB = zero16();
#pragma unroll 2
      for (int hd = 0; hd < 8; hd++) {
        const bf16x8 q0f = *(const bf16x8*)(sQi + r * 528 + hd * 64 + hh * 16);
        const bf16x8 q1f = *(const bf16x8*)(sQi + r * 528 + hd * 64 + 32 + hh * 16);
        const float w = sWi[r * 8 + hd];
        f32x16 sa = MFMA32(kA0, q0f, zero16());
        f32x16 sb = MFMA32(kB0, q0f, zero16());
        sa = MFMA32(kA1, q1f, sa);
        sb = MFMA32(kB1, q1f, sb);
#pragma unroll
        for (int i = 0; i < 16; i++) {
          scA[i] += __int_as_float(max(__float_as_int(sa[i]), 0)) * w;
          scB[i] += __int_as_float(max(__float_as_int(sb[i]), 0)) * w;
        }
      }
      elems(scA, kt, (kt == qt) ? qp : 0x7fffffff);
      if (kt + 4 < nk32) elems(scB, kt + 4, (kt + 4 == qt) ? qp : 0x7fffffff);
    }
    __syncthreads();
    if (pass < 4) {
      for (int j = 0; j < 8; j++) {
        const int qq = wave * 8 + j;
        const unsigned k = meta[32 + qq];
        unsigned c4[4]; unsigned tot = 0;
#pragma unroll
        for (int e = 0; e < 4; e++) { c4[e] = hist[qq * 257 + 255 - 4 * lane - e]; tot += c4[e]; }
        unsigned incl = tot;
        for (int o = 1; o < 64; o <<= 1) { const unsigned t = __shfl_up(incl, o); if (lane >= o) incl += t; }
        unsigned run = incl - tot;
#pragma unroll
        for (int e = 0; e < 4; e++) {
          if (run < k && run + c4[e] >= k) {
            meta[qq] = (meta[qq] << 8) | (unsigned)(255 - 4 * lane - e); meta[32 + qq] = k - run;
            if (pass == 1 && c4[e] > (unsigned)CAPL_) meta[192] = 1u;
          }
          run += c4[e];
        }
      }
    }
    if (pass >= 4) break;
    if (pass == 1) { __syncthreads(); fast = (meta[192] == 0u); pass = fast ? 5 : 2; } else pass++;
  }
  __syncthreads();
  if (fast) {
#pragma unroll 1
    for (int j = 0; j < 8; j++) {
      const int qq = wave * 8 + j;
      const int c = min((int)meta[128 + qq], CAPL_);
      const unsigned k = meta[32 + qq];
      const bool in = lane < c;
      const unsigned mykey = in ? lK[qq * CAPL_ + lane] : 0u;
      const unsigned myidx = in ? (unsigned)lI[qq * CAPL_ + lane] : 0u;
      unsigned rank = 0u;
      for (int t = 0; t < c; t++) {
        const unsigned ok = __shfl(mykey, t);
        rank += (ok > mykey || (ok == mykey && t < lane)) ? 1u : 0u;
      }
      const bool sel = in && (rank < k);
      const unsigned long long m = __ballot(sel);
      const unsigned base = meta[64 + qq];
      if (sel) {
        const unsigned pos = base + (unsigned)__popcll(m & ((1ull << lane) - 1ull));
        if (pos < 256u) sidx[qq * 256 + pos] = (u16)myidx;
      }
      __builtin_amdgcn_wave_barrier();
      if (lane == 0) meta[64 + qq] = base + (unsigned)__popcll(m);
    }
    __syncthreads();
  }
  float* myP = sP + wave * 1024;
  (void)sQ;
#pragma unroll 1
  for (int j = 0; j < 8; j++) {
    const int qq = wave * 8 + j;
    const int qpos = q0 + qq;
    const size_t tok = tokb + qpos;
    const int n = min((int)meta[64 + qq], 256);
    __syncthreads();
    bf16x8 qf[4];
#pragma unroll
    for (int ks = 0; ks < 4; ks++) {
      bf16x8 z = {0, 0, 0, 0, 0, 0, 0, 0};
      if (r < 4) z = *(const bf16x8*)(Qs + tok * 256 + r * 64 + ks * 16 + hh * 8);
      qf[ks] = z;
    }
#pragma unroll 4
    for (int kb = 0; kb < 8; kb++) {
      const int jj = kb * 32 + r;
      const int kidx = (jj < n) ? (int)sidx[qq * 256 + jj] : 0;
      const u16* kp = Ks + (tokb + kidx) * 64 + hh * 8;
      bf16x8 kf[4];
#pragma unroll
      for (int ks = 0; ks < 4; ks++) kf[ks] = *(const bf16x8*)(kp + ks * 16);
      f32x16 sacc = zero16();
#pragma unroll
      for (int ks = 0; ks < 4; ks++) sacc = MFMA32(kf[ks], qf[ks], sacc);
      if (r < 4) {
#pragma unroll
        for (int i = 0; i < 16; i++) myP[(kb * 32 + crow(i, hh)) * 4 + r] = sacc[i];
      }
    }
    __syncthreads();
    float sc[4][4];
#pragma unroll
    for (int rd = 0; rd < 4; rd++) {
      const int jj = rd * 64 + lane;
      const bool valid = jj < n;
      const int kidx = valid ? (int)sidx[qq * 256 + jj] : 0;
      const int dist = min(max(qpos - kidx, 0), 128);
      const float4 d = *(const float4*)(myP + jj * 4);
      sc[rd][0] = valid ? d.x * 0.125f + sbias[0 * 129 + dist] : -INFINITY;
      sc[rd][1] = valid ? d.y * 0.125f + sbias[1 * 129 + dist] : -INFINITY;
      sc[rd][2] = valid ? d.z * 0.125f + sbias[2 * 129 + dist] : -INFINITY;
      sc[rd][3] = valid ? d.w * 0.125f + sbias[3 * 129 + dist] : -INFINITY;
    }
#pragma unroll
    for (int hd = 0; hd < 4; hd++) {
      float mx = fmaxf(fmaxf(sc[0][hd], sc[1][hd]), fmaxf(sc[2][hd], sc[3][hd]));
      mx = wave_max(mx);
      float sm = 0.f;
#pragma unroll
      for (int rd = 0; rd < 4; rd++) { sc[rd][hd] = __expf(sc[rd][hd] - mx); sm += sc[rd][hd]; }
      sm = wave_sum(sm);
      const float inv = 1.f / sm;
#pragma unroll
      for (int rd = 0; rd < 4; rd++) sc[rd][hd] *= inv;
    }
#pragma unroll
    for (int rd = 0; rd < 4; rd++) *(float4*)(myP + (rd * 64 + lane) * 4) = make_float4(sc[rd][0], sc[rd][1], sc[rd][2], sc[rd][3]);
    __syncthreads();
    const int g = lane >> 3, c8 = lane & 7;
    float acc[32];
#pragma unroll
    for (int i = 0; i < 32; i++) acc[i] = 0.f;
#pragma unroll 16
    for (int it = 0; it < 32; it++) {
      const int jj = it * 8 + g;
      const int kidx = (jj < n) ? (int)sidx[qq * 256 + jj] : 0;
      const float4 pj = *(const float4*)(myP + jj * 4);
      const u32x4 vv = *(const u32x4*)(Vs + (tokb + kidx) * 64 + c8 * 8);
      const float vf[8] = {bf2f((u16)(vv.x & 0xffff)), bf2f((u16)(vv.x >> 16)), bf2f((u16)(vv.y & 0xffff)), bf2f((u16)(vv.y >> 16)),
                           bf2f((u16)(vv.z & 0xffff)), bf2f((u16)(vv.z >> 16)), bf2f((u16)(vv.w & 0xffff)), bf2f((u16)(vv.w >> 16))};
#pragma unroll
      for (int e = 0; e < 8; e++) {
        acc[0 * 8 + e] += pj.x * vf[e]; acc[1 * 8 + e] += pj.y * vf[e];
        acc[2 * 8 + e] += pj.z * vf[e]; acc[3 * 8 + e] += pj.w * vf[e];
      }
    }
    const bool b5 = lane & 32, b4 = lane & 16, b3 = lane & 8;
    float w16[16], w8[8], w4[4];
#pragma unroll
    for (int i = 0; i < 16; i++) { const float snd = b5 ? acc[i] : acc[i + 16]; const float rcv = __shfl_xor(snd, 32); w16[i] = (b5 ? acc[i + 16] : acc[i]) + rcv; }
#pragma unroll
    for (int i = 0; i < 8; i++) { const float snd = b4 ? w16[i] : w16[i + 8]; const float rcv = __shfl_xor(snd, 16); w8[i] = (b4 ? w16[i + 8] : w16[i]) + rcv; }
#pragma unroll
    for (int i = 0; i < 4; i++) { const float snd = b3 ? w8[i] : w8[i + 4]; const float rcv = __shfl_xor(snd, 8); w4[i] = (b3 ? w8[i + 4] : w8[i]) + rcv; }
    const int hd = (b5 ? 2 : 0) + (b4 ? 1 : 0);
    *(uint2*)(CC + tok * 1024 + 768 + hd * 64 + c8 * 8 + (b3 ? 4 : 0)) = make_uint2(pack2(w4[0], w4[1]), pack2(w4[2], w4[3]));
  }
}

DI void phase_mix1(const Params& P, int layer, int bid, int nb, char* smem) {
  char* mb = WS(P) + OFF_H;
  for (int w = bid * 4 + (tidx() >> 6); w < 2048; w += nb * 4) ssm_scan<false>(P, layer, w, mb, smem);
  for (int j = 0;; j++) {
    const int idx = (j & 1) ? (j * nb + (nb - 1 - bid)) : (j * nb + bid);
    if (j * nb >= 2048) break;
    if (idx >= 2048) continue;
    const int qt = 255 - (idx >> 3), b = idx & 7;
    dsa_item(P, layer, b, qt, mb, smem);
  }
  for (int j = 0;; j++) {
    const int idx = (j & 1) ? (j * nb + (nb - 1 - bid)) : (j * nb + bid);
    if (j * nb >= 2048) break;
    if (idx >= 2048) continue;
    const int qt = 63 - (idx >> 5), bh = idx & 31;
    da_item(P, layer, bh >> 2, bh & 3, qt, mb, smem);
  }
}

DI void phase_mix2(const Params& P, int layer, int bid, int nb, char* smem) {
  char* mb = WS(P) + OFF_H;
  for (int w = bid * 4 + (tidx() >> 6); w < 2048; w += nb * 4) ssm_scan<true>(P, layer, w, mb, smem);
}

DI void run_phase(const Params& P, int ph, int bid, int nb, char* smem) {
  char* ws = WS(P);
  u16* sm = (u16*)smem;
  if (ph == 0) { phase_prep(P, bid, nb, smem); return; }
  const int l = (ph - 1) / 12, s = (ph - 1) % 12;
  u16* Xb = (u16*)(ws + OFF_XB);
  u16* H = (u16*)(ws + OFF_H);
  u16* CC = (u16*)(ws + OFF_CC);
  float* X = OUTP(P);
  switch (s) {
    case 0: phase_ffn_up(Xb, (const u16*)(ws + OFF_WGU1 + l * SZ_WGU), H, bid, nb, sm); break;
    case 1: phase_ffn_down(H, (const u16*)(ws + OFF_WD1 + l * SZ_WD), (l == 0) ? INP(P, 0) : (const float*)X, X, nullptr, bid, nb, sm); break;
    case 2: phase_ln(X, Xb, INP(P, 6) + l * 1024, INP(P, 7) + l * 1024, bid, nb); break;
    case 3: phase_w_in(Xb, (const u16*)(ws + OFF_WIN + l * SZ_WIN), ws + OFF_H, bid, nb, sm); break;
    case 4: phase_mix1(P, l, bid, nb, smem); break;
    case 5: phase_mix2(P, l, bid, nb, smem); break;
    case 6: phase_glu((const u16*)(ws + OFF_H + M_YG), (const u16*)(ws + OFF_WGLU + l * SZ_WGLU), CC, bid, nb, sm); break;
    case 7: phase_w_o(CC, (const u16*)(ws + OFF_WO + l * SZ_WO), X, bid, nb, sm); break;
    case 8: phase_ln(X, Xb, INP(P, 24) + l * 1024, INP(P, 25) + l * 1024, bid, nb); break;
    case 9:
      phase_ffn_up(Xb, (const u16*)(ws + OFF_WGU2 + l * SZ_WGU), H, bid, nb, sm);
      phase_ple(Xb, (const u16*)(ws + OFF_WPG + l * SZ_WPG), (const u16*)(ws + OFF_PB) + (size_t)l * T_ * 256, (const u16*)(ws + OFF_WPP + l * SZ_WPP), CC, bid, nb, sm);
      break;
    case 10: phase_ffn_down(H, (const u16*)(ws + OFF_WD2 + l * SZ_WD), X, X, CC, bid, nb, sm); break;
    case 11: phase_ln(X, Xb, INP(P, 31) + l * 1024, INP(P, 32) + l * 1024, bid, nb); break;
  }
}

#define XB_TMO      128
#define XB_XCNT(j)  (256  + 64 * (j))
#define XB_XSUB(j)  (1280 + 64 * (j))
#define XB_XGEN(j)  (2304 + 64 * (j))
#define XB_TOP      3328
#define XB_TOPGEN   3392
#define XCD_BAR_WORDS 3456
#define XB_SPIN_CAP (1u << 22)
#define LAS __attribute__((address_space(3)))

__device__ __forceinline__ unsigned xb_ld(unsigned* p)              { return __hip_atomic_load(p, __ATOMIC_RELAXED, __HIP_MEMORY_SCOPE_AGENT); }
__device__ __forceinline__ unsigned xb_add(unsigned* p, unsigned v) { return __hip_atomic_fetch_add(p, v, __ATOMIC_RELAXED, __HIP_MEMORY_SCOPE_AGENT); }
__device__ __forceinline__ unsigned xb_xcc_id() { return (unsigned)__builtin_amdgcn_s_getreg((3 << 11) | 20) & 0xFu; }
#define XB_SPIN(cond, bar) do { unsigned _sp = 0; while (cond) { __builtin_amdgcn_s_sleep(1); \
    if ((++_sp & 255u) == 0u) { if (xb_ld(&(bar)[XB_TMO])) break; if (_sp > XB_SPIN_CAP) { atomicAdd(&(bar)[XB_TMO], 1u); break; } } } } while (0)

struct XcdBarrier {
    unsigned* bar; unsigned x;
    volatile LAS unsigned* st;
};

__device__ __forceinline__ XcdBarrier xcd_barrier_post(unsigned* bar, volatile LAS unsigned* st) {
    XcdBarrier b; b.bar = bar; b.x = xb_xcc_id(); b.st = st;
    if (threadIdx.x == 0) (void)xb_add(&bar[XB_XCNT(b.x)], 1u);
    return b;
}
__device__ __forceinline__ void xcd_barrier_complete(unsigned* bar, unsigned x, unsigned& nloc, unsigned& nx) {
    const unsigned G = gridDim.x * gridDim.y * gridDim.z;
    unsigned sum, cnt, mine, sp = 0u;
    for (;;) {
        sum = 0u; cnt = 0u; mine = 0u;
#pragma unroll
        for (unsigned j = 0; j < 16; ++j) { const unsigned c = xb_ld(&bar[XB_XCNT(j)]); sum += c; cnt += (c > 0u) ? 1u : 0u; mine = (j == x) ? c : mine; }
        if (sum == G) break;
        __builtin_amdgcn_s_sleep(1);
        if ((++sp & 255u) == 0u) { if (xb_ld(&bar[XB_TMO])) break; if (sp > XB_SPIN_CAP) { atomicAdd(&bar[XB_TMO], 1u); break; } }
    }
    nloc = mine > 0u ? mine : 1u; nx = cnt > 0u ? cnt : 1u;
}

__device__ __forceinline__ void xcd_barrier(const XcdBarrier& b) {
    asm volatile("s_waitcnt vmcnt(0)" ::: "memory");
    __syncthreads();
    if (threadIdx.x == 0) {
        unsigned* bar = b.bar;
        __builtin_amdgcn_s_waitcnt(0);
        unsigned nloc = b.st[0], nx = b.st[1];
        if (nloc == 0u) { xcd_barrier_complete(bar, b.x, nloc, nx); b.st[0] = nloc; b.st[1] = nx; }
        const unsigned old = xb_add(&bar[XB_XSUB(b.x)], 1u);
        const unsigned gen = old / nloc;
        if (old + 1u == (gen + 1u) * nloc) {
            __builtin_amdgcn_fence(__ATOMIC_RELEASE, "agent");
            asm volatile("s_waitcnt vmcnt(0)" ::: "memory");
            const unsigned og = xb_add(&bar[XB_TOP], 1u);
            const unsigned tg = og / nx;
            if (og + 1u == (tg + 1u) * nx) xb_add(&bar[XB_TOPGEN], 1u);
            else XB_SPIN(xb_ld(&bar[XB_TOPGEN]) == tg, bar);
            __builtin_amdgcn_fence(__ATOMIC_ACQUIRE, "agent");
            xb_add(&bar[XB_XGEN(b.x)], 1u);
            asm volatile("s_waitcnt vmcnt(0)" ::: "memory");
        } else {
            XB_SPIN(xb_ld(&bar[XB_XGEN(b.x)]) == gen, bar);
            __builtin_amdgcn_fence(__ATOMIC_ACQUIRE, "agent");
            asm volatile("s_waitcnt vmcnt(0)" ::: "memory");
        }
    }
    __syncthreads();
}


constexpr int NPHASES = 25;

__global__ void __launch_bounds__(256, 2) mega(Params P, int ph0, int ph1) {
  extern __shared__ __attribute__((aligned(16))) char smem[];
  cg::grid_group grid = cg::this_grid();
  const int bid = blockIdx.x, nb = gridDim.x;
  volatile LAS unsigned* xst = (volatile LAS unsigned*)(smem + 73712);
  if (threadIdx.x == 0) { xst[0] = 0u; xst[1] = 0u; xst[2] = 0u; xst[3] = 0u; }
  __syncthreads();
  const XcdBarrier xbar = xcd_barrier_post((unsigned*)(P.ws + OFF_XBAR), xst);
#ifndef DUP_MASK
#define DUP_MASK 0
#endif
#define PHASE(k) if (ph0 <= (k) && (k) < ph1) { \
    if ((k) > 0 && ((DUP_MASK >> (((k) - 1) % 12)) & 1)) { run_phase(P, (k), bid, nb, smem); grid.sync(); } \
    run_phase(P, (k), bid, nb, smem); if ((k) + 1 < ph1) { if ((k) == 0) grid.sync(); else xcd_barrier(xbar); } }
  PHASE(0) PHASE(1) PHASE(2) PHASE(3) PHASE(4) PHASE(5) PHASE(6) PHASE(7) PHASE(8) PHASE(9) PHASE(10) PHASE(11) PHASE(12)
  PHASE(13) PHASE(14) PHASE(15) PHASE(16) PHASE(17) PHASE(18) PHASE(19) PHASE(20) PHASE(21) PHASE(22) PHASE(23) PHASE(24)
#undef PHASE
}

extern "C" void kernel_launch(void* const* d_in, const int* in_sizes, int n_in, void* d_out, int out_size, void* d_ws, size_t ws_size, hipStream_t stream) {
  static int grid_blocks = 0;
  if (grid_blocks == 0) {
    if (n_in != 33 || ws_size < WS_END) { fprintf(stderr, "kernel_launch: need 33 inputs and %zu bytes of ws (got %d, %zu)\n", (size_t)WS_END, n_in, ws_size); grid_blocks = -1; return; }
    int dev = 0, cus = 0, per_cu = 0;
    (void)hipGetDevice(&dev);
    (void)hipDeviceGetAttribute(&cus, hipDeviceAttributeMultiprocessorCount, dev);
    (void)hipFuncSetAttribute((const void*)mega, hipFuncAttributeMaxDynamicSharedMemorySize, LDS_BYTES);
    (void)hipOccupancyMaxActiveBlocksPerMultiprocessor(&per_cu, (const void*)mega, 256, LDS_BYTES);
    if (per_cu < 1) per_cu = 1;
    if (per_cu > 2) per_cu = 2;
    grid_blocks = cus * per_cu;
    fprintf(stderr, "kernel_launch: cus %d per_cu %d grid %d\n", cus, per_cu, grid_blocks);
  }
  if (grid_blocks < 0) return;
  Params p;
  memset(&p, 0, sizeof(p));
  for (int i = 0; i < 33; i++) p.in[i] = (const float*)d_in[i];
  p.out = (float*)d_out;
  p.ws = (char*)d_ws;
#if MULTI_LAUNCH
  for (int ph = 0; ph < NPHASES; ph++) {
    hipLaunchKernelGGL(mega, dim3(grid_blocks), dim3(256), LDS_BYTES, stream, p, ph, ph + 1);
  }
#else
  int ph0 = 0, ph1 = NPHASES;
  (void)hipMemsetAsync((char*)d_ws + OFF_XBAR, 0, XCD_BAR_WORDS * 4, stream);
  void* args[] = {&p, &ph0, &ph1};
  hipError_t e = hipLaunchCooperativeKernel((const void*)mega, dim3(grid_blocks), dim3(256), args, LDS_BYTES, stream);
  if (e != hipSuccess) fprintf(stderr, "cooperative launch failed: %s (grid %d)\n", hipGetErrorString(e), grid_blocks);
#endif
}
```

```cpp
#include <hip/hip_runtime.h>
#include <hip/hip_cooperative_groups.h>
#include <stdint.h>
#include <math.h>
#include <stdio.h>
#include <string.h>
namespace cg = cooperative_groups;

#ifndef MULTI_LAUNCH
#define MULTI_LAUNCH 0
#endif

typedef unsigned short u16;
typedef __attribute__((ext_vector_type(8))) short bf16x8;
typedef __attribute__((ext_vector_type(4))) short s16x4;
typedef __attribute__((ext_vector_type(16))) float f32x16;
typedef __attribute__((ext_vector_type(4))) unsigned u32x4;
typedef __attribute__((ext_vector_type(2))) unsigned u32x2;

#define DI __device__ __forceinline__
#define MFMA32(a, b, c) __builtin_amdgcn_mfma_f32_32x32x16_bf16((a), (b), (c), 0, 0, 0)

constexpr int T_ = 65536;
constexpr int L_ = 8192;
constexpr int D_ = 1024;
constexpr int FF_ = 2816;
constexpr float ALPHA_ = 1.41421356237309515f;
constexpr float LN_EPS_ = 1e-5f;
constexpr float LOG2E_ = 1.44269504088896341f;
constexpr int LDS_BYTES = 73728;

constexpr size_t SZ_WGU = (size_t)5632 * 1024 * 2;
constexpr size_t SZ_WD = (size_t)1024 * 2816 * 2;
constexpr size_t SZ_WIN = (size_t)2560 * 1024 * 2;
constexpr size_t SZ_WO = (size_t)1024 * 1024 * 2;
constexpr size_t SZ_WGLU = (size_t)256 * 256 * 2;
constexpr size_t SZ_WPG = (size_t)1024 * 1024 * 2;
constexpr size_t SZ_WPP = (size_t)1024 * 256 * 2;
constexpr size_t OFF_WGU1 = 0;
constexpr size_t OFF_WD1 = OFF_WGU1 + 2 * SZ_WGU;
constexpr size_t OFF_WGU2 = OFF_WD1 + 2 * SZ_WD;
constexpr size_t OFF_WD2 = OFF_WGU2 + 2 * SZ_WGU;
constexpr size_t OFF_WIN = OFF_WD2 + 2 * SZ_WD;
constexpr size_t OFF_WO = OFF_WIN + 2 * SZ_WIN;
constexpr size_t OFF_WGLU = OFF_WO + 2 * SZ_WO;
constexpr size_t OFF_WPG = OFF_WGLU + 2 * SZ_WGLU;
constexpr size_t OFF_WPP = OFF_WPG + 2 * SZ_WPG;
constexpr size_t OFF_COEFA = OFF_WPP + 2 * SZ_WPP;
constexpr size_t OFF_COEFB = OFF_COEFA + 2 * 16 * 64 * 16;
constexpr size_t OFF_LAM = OFF_COEFB + 2 * 16 * 64 * 16 * 8;
constexpr size_t OFF_BIAS = OFF_LAM + 256;
constexpr size_t OFF_XBAR = OFF_BIAS + 8 * 129 * 4 + 32;
constexpr size_t OFF_XB = OFF_XBAR + 16384;
constexpr size_t OFF_PB = OFF_XB + (size_t)T_ * 1024 * 2;
constexpr size_t OFF_H = OFF_PB + (size_t)2 * T_ * 256 * 2;
constexpr size_t SZ_H = (size_t)384 << 20;
constexpr size_t OFF_CC = OFF_H + SZ_H;
constexpr size_t OFF_CANDK = OFF_CC + (size_t)T_ * 1024 * 2;
constexpr int CAP_ = 2048;
constexpr size_t OFF_CANDI = OFF_CANDK + (size_t)512 * 32 * CAP_ * 4;
constexpr size_t WS_END = OFF_CANDI + (size_t)512 * 32 * CAP_ * 2;
constexpr size_t MB_ = (size_t)1 << 20;
constexpr size_t M_QD = 0, M_KD = 64 * MB_, M_VT = 128 * MB_, M_U = 192 * MB_, M_QS = 256 * MB_, M_QI = 288 * MB_, M_YG = 320 * MB_,
                 M_KS = 352 * MB_, M_VS = 360 * MB_, M_KI = 368 * MB_, M_WI = 372 * MB_, M_SEND = 374 * MB_;

struct Params {
  const float* in[33];
  float* out;
  char* ws;
};

DI int tidx() { int t = threadIdx.x; asm volatile("" : "+v"(t)); return t; }
#define GAS __attribute__((address_space(1)))
DI size_t opaque0() { size_t z = 0; asm volatile("" : "+s"(z)); return z; }
DI char* WS(const Params& P) { return P.ws + opaque0(); }
DI float* OUTP(const Params& P) { return P.out + opaque0(); }
DI const float* INP(const Params& P, int i) { return P.in[i]; }
typedef __bf16 bf16v2_ __attribute__((ext_vector_type(2)));
typedef float f32v2_ __attribute__((ext_vector_type(2)));
DI u16 f2bf(float x) { const __bf16 h = (__bf16)x; return __builtin_bit_cast(u16, h); }
DI float bf2f(u16 v) { return __uint_as_float(((unsigned)v) << 16); }
DI unsigned pack2(float a, float b) { f32v2_ v; v.x = a; v.y = b; const bf16v2_ h = __builtin_convertvector(v, bf16v2_); return __builtin_bit_cast(unsigned, h); }
DI int crow(int i, int hh) { return (i & 3) + 8 * (i >> 2) + 4 * hh; }
DI float sigmoidf_(float x) { return __builtin_amdgcn_rcpf(1.f + __expf(-x)); }
DI float wave_sum(float v) { for (int o = 32; o > 0; o >>= 1) v += __shfl_xor(v, o); return v; }
DI float wave_max(float v) { for (int o = 32; o > 0; o >>= 1) v = fmaxf(v, __shfl_xor(v, o)); return v; }
DI f32x16 zero16() { f32x16 z; for (int i = 0; i < 16; i++) z[i] = 0.f; return z; }
DI bf16x8 pack8(const f32x16& x, int s) {
  union { unsigned u[4]; bf16x8 v; } t;
  t.u[0] = pack2(x[8 * s + 0], x[8 * s + 1]); t.u[1] = pack2(x[8 * s + 2], x[8 * s + 3]);
  t.u[2] = pack2(x[8 * s + 4], x[8 * s + 5]); t.u[3] = pack2(x[8 * s + 6], x[8 * s + 7]);
  return t.v;
}

constexpr int GS_ = 72;
constexpr int GT_ = 128 * GS_;

constexpr int GST_ = 32768;
DI void gemm_stage(const u16* __restrict__ A, int lda, const u16* __restrict__ B, int ldb, int kt, char* sbuf) {
  const int tid = tidx(), lane = tid & 63, wave = __builtin_amdgcn_readfirstlane(tid >> 6);
  const int pp = lane >> 4, pos = lane & 15;
#pragma unroll
  for (int i = 0; i < 4; i++) {
    const int blk = i * 4 + wave;
    const int p = blk * 4 + pp;
    const int row = 2 * p + (pos >> 3), c8 = (pos & 7) ^ (p & 7);
    const u16* ga = A + (size_t)row * lda + kt * 64 + c8 * 8;
    const u16* gb = B + (size_t)row * ldb + kt * 64 + c8 * 8;
    __builtin_amdgcn_global_load_lds((const GAS void*)ga, (__attribute__((address_space(3))) void*)(sbuf + blk * 1024), 16, 0, 0);
    __builtin_amdgcn_global_load_lds((const GAS void*)gb, (__attribute__((address_space(3))) void*)(sbuf + 16384 + blk * 1024), 16, 0, 0);
  }
}
DI void gemm_main(f32x16 (&acc)[2][2], const u16* __restrict__ A, int lda, const u16* __restrict__ B, int ldb, int K, u16* sm) {
  const int tid = tidx(), lane = tid & 63, wave = tid >> 6;
  const int wm = wave >> 1, wn = wave & 1, r = lane & 31, hh = lane >> 5;
  char* sb = (char*)sm;
  const int rowa = wm * 64 + r, rowb = wn * 64 + r;
  const int baseA = (rowa >> 1) * 256 + ((rowa & 1) << 7), xa = (rowa >> 1) & 7;
  const int baseB = 16384 + (rowb >> 1) * 256 + ((rowb & 1) << 7), xb = (rowb >> 1) & 7;
  const int nk = K >> 6;
  asm volatile("s_waitcnt vmcnt(0)" ::: "memory");
  __syncthreads();
#pragma unroll 1
  for (int kt = 0; kt < nk; kt++) {
    if (kt + 1 < nk) gemm_stage(A, lda, B, ldb, kt + 1, sb + ((kt + 1) & 1) * GST_);
    const char* st = sb + (kt & 1) * GST_;
#pragma unroll
    for (int ks = 0; ks < 4; ks++) {
      const int ca = ((ks * 2 + hh) ^ xa) << 4, cb = ((ks * 2 + hh) ^ xb) << 4;
      const bf16x8 fa0 = *(const bf16x8*)(st + baseA + ca);
      const bf16x8 fa1 = *(const bf16x8*)(st + baseA + 4096 + ca);
      const bf16x8 fb0 = *(const bf16x8*)(st + baseB + cb);
      const bf16x8 fb1 = *(const bf16x8*)(st + baseB + 4096 + cb);
      acc[0][0] = MFMA32(fa0, fb0, acc[0][0]); acc[0][1] = MFMA32(fa0, fb1, acc[0][1]);
      acc[1][0] = MFMA32(fa1, fb0, acc[1][0]); acc[1][1] = MFMA32(fa1, fb1, acc[1][1]);
    }
    asm volatile("s_waitcnt vmcnt(0)" ::: "memory");
    __syncthreads();
  }
}

DI bool tile_at(int it, int bid, int nb, int TM, int TN, int& tm, int& tn) {
  if ((nb & 7) == 0 && (TM & 63) == 0) {
    const int xcd = bid & 7, lw = bid >> 3, nlw = nb >> 3;
    const int lt = lw + it * nlw, per = (TM >> 3) * TN;
    if (lt >= per) return false;
    const int g = lt / (4 * TN), rem = lt - g * 4 * TN;
    tn = rem >> 2; tm = xcd * (TM >> 3) + g * 4 + (rem & 3);
    return true;
  } else {
    const int t = bid + it * nb;
    if (t >= TM * TN) return false;
    tn = t / TM; tm = t - tn * TM;
    return true;
  }
}

template <class AF, class BF, class INI, class EPI>
DI void gemm_phase_init(int TM, int TN, int K, int lda, int ldb, AF a_of, BF b_of, INI ini, EPI epi, int bid, int nb, u16* sm) {
  int tm, tn;
  bool have = tile_at(0, bid, nb, TM, TN, tm, tn);
  __syncthreads();
  if (have) gemm_stage(a_of(tm), lda, b_of(tn), ldb, 0, (char*)sm);
  for (int it = 0; have; it++) {
    f32x16 acc[2][2];
    ini(acc, tm, tn);
    gemm_main(acc, a_of(tm), lda, b_of(tn), ldb, K, sm);
    int tm2 = 0, tn2 = 0;
    const bool have2 = tile_at(it + 1, bid, nb, TM, TN, tm2, tn2);
    if (have2) gemm_stage(a_of(tm2), lda, b_of(tn2), ldb, 0, (char*)sm);
    epi(acc, tm, tn);
    have = have2; tm = tm2; tn = tn2;
  }
  asm volatile("s_waitcnt vmcnt(0)" ::: "memory");
}
template <class AF, class BF, class EPI>
DI void gemm_phase(int TM, int TN, int K, int lda, int ldb, AF a_of, BF b_of, EPI epi, int bid, int nb, u16* sm) {
  gemm_phase_init(TM, TN, K, lda, ldb, a_of, b_of,
    [&](f32x16 (&acc)[2][2], int, int) { acc[0][0] = zero16(); acc[0][1] = zero16(); acc[1][0] = zero16(); acc[1][1] = zero16(); },
    epi, bid, nb, sm);
}

DI void transpose_job(const float* __restrict__ src, int K, int N, u16* __restrict__ dst, int mode, int bid, int nb, float* tile) {
  const int tid = tidx();
  const int tk = K >> 6, tn = (N + 63) >> 6;
  for (int t = bid; t < tk * tn; t += nb) {
    const int k0 = (t % tk) * 64, n0 = (t / tk) * 64;
    __syncthreads();
#pragma unroll 4
    for (int i = 0; i < 16; i++) {
      const int k = i * 4 + (tid >> 6), n = tid & 63;
      tile[k * 65 + n] = (n0 + n < N) ? src[(size_t)(k0 + k) * N + n0 + n] : 0.f;
    }
    __syncthreads();
#pragma unroll 4
    for (int i = 0; i < 16; i++) {
      const int n = i * 4 + (tid >> 6), k = tid & 63;
      const int ng = n0 + n;
      if (ng < N) {
        int row = ng;
        if (mode == 1) row = (ng >> 5) * 64 + (ng & 31);
        else if (mode == 2) row = (ng >> 5) * 64 + 32 + (ng & 31);
        dst[(size_t)row * K + k0 + k] = f2bf(tile[k * 65 + n]);
      }
    }
  }
}

DI void phase_prep(const Params& P, int bid, int nb, char* smem) {
  float* tile = (float*)smem;
  char* ws = WS(P);
  for (int l = 0; l < 2; l++) {
    transpose_job(INP(P, 3) + (size_t)l * 1024 * FF_, 1024, FF_, (u16*)(ws + OFF_WGU1 + l * SZ_WGU), 1, bid, nb, tile);
    transpose_job(INP(P, 4) + (size_t)l * 1024 * FF_, 1024, FF_, (u16*)(ws + OFF_WGU1 + l * SZ_WGU), 2, bid, nb, tile);
    transpose_job(INP(P, 5) + (size_t)l * FF_ * 1024, FF_, 1024, (u16*)(ws + OFF_WD1 + l * SZ_WD), 0, bid, nb, tile);
    transpose_job(INP(P, 26) + (size_t)l * 1024 * FF_, 1024, FF_, (u16*)(ws + OFF_WGU2 + l * SZ_WGU), 1, bid, nb, tile);
    transpose_job(INP(P, 27) + (size_t)l * 1024 * FF_, 1024, FF_, (u16*)(ws + OFF_WGU2 + l * SZ_WGU), 2, bid, nb, tile);
    transpose_job(INP(P, 28) + (size_t)l * FF_ * 1024, FF_, 1024, (u16*)(ws + OFF_WD2 + l * SZ_WD), 0, bid, nb, tile);
    transpose_job(INP(P, 8) + (size_t)l * 1024 * 2472, 1024, 2472, (u16*)(ws + OFF_WIN + l * SZ_WIN), 0, bid, nb, tile);
    transpose_job(INP(P, 9) + (size_t)l * 1024 * 1024, 1024, 1024, (u16*)(ws + OFF_WO + l * SZ_WO), 0, bid, nb, tile);
    transpose_job(INP(P, 23) + (size_t)l * 256 * 256, 256, 256, (u16*)(ws + OFF_WGLU + l * SZ_WGLU), 0, bid, nb, tile);
    transpose_job(INP(P, 30) + (size_t)l * 1024 * 1024, 1024, 1024, (u16*)(ws + OFF_WPG + l * SZ_WPG), 0, bid, nb, tile);
    transpose_job(INP(P, 29) + (size_t)l * 256 * 1024, 256, 1024, (u16*)(ws + OFF_WPP + l * SZ_WPP), 0, bid, nb, tile);
    u16* win = (u16*)(ws + OFF_WIN + l * SZ_WIN);
    for (int i = bid * 256 + tidx(); i < 88 * 1024; i += nb * 256) win[(size_t)2472 * 1024 + i] = 0;
  }
  const size_t gt = (size_t)bid * 256 + tidx(), gs = (size_t)nb * 256;
  {
    const float4* x4 = (const float4*)INP(P, 0);
    uint2* xb = (uint2*)(ws + OFF_XB);
    for (size_t i = gt; i < (size_t)T_ * 1024 / 4; i += gs) { float4 v = x4[i]; xb[i] = make_uint2(pack2(v.x, v.y), pack2(v.z, v.w)); }
    const float4* p4 = (const float4*)INP(P, 1);
    uint2* pb = (uint2*)(ws + OFF_PB);
    for (size_t i = gt; i < (size_t)2 * T_ * 256 / 4; i += gs) { float4 v = p4[i]; pb[i] = make_uint2(pack2(v.x, v.y), pack2(v.z, v.w)); }
  }
  if (gt < 2 * 16 * 64) {
    const int l = (int)gt >> 10, g = ((int)gt >> 6) & 15, p = (int)gt & 63;
    const int gi = (l * 16 + g) * 64 + p;
    const double lr = INP(P, 15)[gi], li = INP(P, 16)[gi];
    const double dt = exp((double)INP(P, 17)[l * 16 + g]);
    const double mag = exp(lr * dt);
    const double ar = mag * cos(li * dt), ai = mag * sin(li * dt);
    const double mag5 = exp(512.0 * lr * dt);
    const double a5r = mag5 * cos(512.0 * li * dt), a5i = mag5 * sin(512.0 * li * dt);
    ((float4*)(ws + OFF_COEFA))[gi] = make_float4((float)ar, (float)ai, (float)a5r, (float)a5i);
    const double den = lr * lr + li * li, nr = ar - 1.0, ni = ai;
    const double fr = (nr * lr + ni * li) / den, fi = (ni * lr - nr * li) / den;
    float2* cb = (float2*)(ws + OFF_COEFB) + (size_t)gi * 16;
    for (int c = 0; c < 16; c++) {
      const double br = INP(P, 18)[(size_t)gi * 16 + c], bi = INP(P, 19)[(size_t)gi * 16 + c];
      cb[c] = make_float2((float)(fr * br - fi * bi), (float)(fr * bi + fi * br));
    }
  }
  if (gt < 8 * 129) {
    const int hd = (int)gt / 129, n = (int)gt - hd * 129;
    int bk = n;
    if (n >= 16) { bk = 16 + (int)(log((double)n / 16.0) / log(8.0) * 16.0); bk = bk < 31 ? bk : 31; }
    ((float*)(ws + OFF_BIAS))[gt] = INP(P, 2)[bk * 8 + hd];
  }
  if (gt < 2) {
    const int l = (int)gt;
    float s1 = 0.f, s2 = 0.f;
    for (int i = 0; i < 64; i++) { s1 += INP(P, 10)[l * 64 + i] * INP(P, 11)[l * 64 + i]; s2 += INP(P, 12)[l * 64 + i] * INP(P, 13)[l * 64 + i]; }
    const float lam_init = 0.8f - 0.6f * expf(-0.3f * (float)l);
    ((float*)(ws + OFF_LAM))[l] = expf(s1) - expf(s2) + lam_init;
  }
}

DI void phase_ffn_up(const u16* __restrict__ Xb, const u16* __restrict__ Wgu, u16* __restrict__ H, int bid, int nb, u16* sm) {
  const int lane = tidx() & 63, wave = tidx() >> 6, wm = wave >> 1, wn = wave & 1, r = lane & 31, hh = lane >> 5;
  gemm_phase(512, 44, 1024, 1024, 1024,
    [&](int tm) { return Xb + (size_t)tm * 128 * 1024; }, [&](int tn) { return Wgu + (size_t)tn * 128 * 1024; },
    [&](f32x16 (&acc)[2][2], int tm, int tn) {
      const int j = tn * 64 + wn * 32 + r;
#pragma unroll
      for (int mi = 0; mi < 2; mi++)
#pragma unroll
        for (int i = 0; i < 16; i++) {
          const int row = tm * 128 + wm * 64 + mi * 32 + crow(i, hh);
          const float g = acc[mi][0][i], u = acc[mi][1][i];
          H[(size_t)row * FF_ + j] = f2bf(g * sigmoidf_(g) * u);
        }
    }, bid, nb, sm);
}

DI void phase_ffn_down(const u16* __restrict__ H, const u16* __restrict__ Wd, const float* xin, const u16* __restrict__ xinb, float* xout, const u16* __restrict__ ple, int bid, int nb, u16* sm) {
  const int lane = tidx() & 63, wave = tidx() >> 6, wm = wave >> 1, wn = wave & 1, r = lane & 31, hh = lane >> 5;
  gemm_phase_init(512, 8, FF_, FF_, FF_,
    [&](int tm) { return H + (size_t)tm * 128 * FF_; }, [&](int tn) { return Wd + (size_t)tn * 128 * FF_; },
    [&](f32x16 (&acc)[2][2], int tm, int tn) {
#pragma unroll
      for (int mi = 0; mi < 2; mi++)
#pragma unroll
        for (int ni = 0; ni < 2; ni++)
#pragma unroll
          for (int i = 0; i < 16; i++) {
            const size_t o = (size_t)(tm * 128 + wm * 64 + mi * 32 + crow(i, hh)) * 1024 + tn * 128 + wn * 64 + ni * 32 + r;
            float v = 2.f * ALPHA_ * (xin ? xin[o] : bf2f(xinb[o]));
            if (ple) v += 2.f * bf2f(ple[o]);
            acc[mi][ni][i] = v;
          }
    },
    [&](f32x16 (&acc)[2][2], int tm, int tn) {
#pragma unroll
      for (int mi = 0; mi < 2; mi++)
#pragma unroll
        for (int ni = 0; ni < 2; ni++)
#pragma unroll
          for (int i = 0; i < 16; i++) {
            const size_t o = (size_t)(tm * 128 + wm * 64 + mi * 32 + crow(i, hh)) * 1024 + tn * 128 + wn * 64 + ni * 32 + r;
            xout[o] = 0.5f * acc[mi][ni][i];
          }
    }, bid, nb, sm);
}

DI void phase_w_o(const u16* __restrict__ CC, const u16* __restrict__ Wo, float* x, const u16* __restrict__ xb, int bid, int nb, u16* sm) {
  const int lane = tidx() & 63, wave = tidx() >> 6, wm = wave >> 1, wn = wave & 1, r = lane & 31, hh = lane >> 5;
  gemm_phase_init(512, 8, 1024, 1024, 1024,
    [&](int tm) { return CC + (size_t)tm * 128 * 1024; }, [&](int tn) { return Wo + (size_t)tn * 128 * 1024; },
    [&](f32x16 (&acc)[2][2], int tm, int tn) {
#pragma unroll
      for (int mi = 0; mi < 2; mi++)
#pragma unroll
        for (int ni = 0; ni < 2; ni++)
#pragma unroll
          for (int i = 0; i < 16; i++) {
            const size_t o = (size_t)(tm * 128 + wm * 64 + mi * 32 + crow(i, hh)) * 1024 + tn * 128 + wn * 64 + ni * 32 + r;
            acc[mi][ni][i] = ALPHA_ * bf2f(xb[o]);
          }
    },
    [&](f32x16 (&acc)[2][2], int tm, int tn) {
#pragma unroll
      for (int mi = 0; mi < 2; mi++)
#pragma unroll
        for (int ni = 0; ni < 2; ni++)
#pragma unroll
          for (int i = 0; i < 16; i++) {
            const size_t o = (size_t)(tm * 128 + wm * 64 + mi * 32 + crow(i, hh)) * 1024 + tn * 128 + wn * 64 + ni * 32 + r;
            x[o] = acc[mi][ni][i];
          }
    }, bid, nb, sm);
}

DI void phase_glu(const u16* __restrict__ Yg, const u16* __restrict__ Wglu, u16* __restrict__ CC, int bid, int nb, u16* sm) {
  const int lane = tidx() & 63, wave = tidx() >> 6, wm = wave >> 1, wn = wave & 1, r = lane & 31, hh = lane >> 5;
  gemm_phase(512, 2, 256, 256, 256,
    [&](int tm) { return Yg + (size_t)tm * 128 * 256; }, [&](int tn) { return Wglu + (size_t)tn * 128 * 256; },
    [&](f32x16 (&acc)[2][2], int tm, int tn) {
#pragma unroll
      for (int mi = 0; mi < 2; mi++)
#pragma unroll
        for (int ni = 0; ni < 2; ni++)
#pragma unroll
          for (int i = 0; i < 16; i++) {
            const int row = tm * 128 + wm * 64 + mi * 32 + crow(i, hh), col = tn * 128 + wn * 64 + ni * 32 + r;
            const float y = bf2f(Yg[(size_t)row * 256 + col]);
            CC[(size_t)row * 1024 + 512 + col] = f2bf(y * sigmoidf_(acc[mi][ni][i]));
          }
    }, bid, nb, sm);
}

DI void phase_ple(const u16* __restrict__ Xb, const u16* __restrict__ Wpg, const u16* __restrict__ Pb, const u16* __restrict__ Wpp, u16* ple, int bid, int nb, u16* sm) {
  const int lane = tidx() & 63, wave = tidx() >> 6, wm = wave >> 1, wn = wave & 1, r = lane & 31, hh = lane >> 5;
  gemm_phase(512, 8, 1024, 1024, 1024,
    [&](int tm) { return Xb + (size_t)tm * 128 * 1024; }, [&](int tn) { return Wpg + (size_t)tn * 128 * 1024; },
    [&](f32x16 (&acc)[2][2], int tm, int tn) {
#pragma unroll
      for (int mi = 0; mi < 2; mi++)
#pragma unroll
        for (int ni = 0; ni < 2; ni++)
#pragma unroll
          for (int i = 0; i < 16; i++) {
            const size_t o = (size_t)(tm * 128 + wm * 64 + mi * 32 + crow(i, hh)) * 1024 + tn * 128 + wn * 64 + ni * 32 + r;
            ple[o] = f2bf(sigmoidf_(acc[mi][ni][i]));
          }
    }, bid, nb, sm);
  gemm_phase(512, 8, 256, 256, 256,
    [&](int tm) { return Pb + (size_t)tm * 128 * 256; }, [&](int tn) { return Wpp + (size_t)tn * 128 * 256; },
    [&](f32x16 (&acc)[2][2], int tm, int tn) {
#pragma unroll
      for (int mi = 0; mi < 2; mi++)
#pragma unroll
        for (int ni = 0; ni < 2; ni++)
#pragma unroll
          for (int i = 0; i < 16; i++) {
            const size_t o = (size_t)(tm * 128 + wm * 64 + mi * 32 + crow(i, hh)) * 1024 + tn * 128 + wn * 64 + ni * 32 + r;
            ple[o] = f2bf(acc[mi][ni][i] * bf2f(ple[o]));
          }
    }, bid, nb, sm);
}

DI void phase_w_in(const u16* __restrict__ Xb, const u16* __restrict__ Win, char* mb, int bid, int nb, u16* sm) {
  const int lane = tidx() & 63, wave = tidx() >> 6, wm = wave >> 1, wn = wave & 1, r = lane & 31, hh = lane >> 5;
  u16* Qd = (u16*)(mb + M_QD); u16* Kd = (u16*)(mb + M_KD); u16* Vt = (u16*)(mb + M_VT); float* U = (float*)(mb + M_U);
  u16* Qs = (u16*)(mb + M_QS); u16* Qi = (u16*)(mb + M_QI); u16* Ks = (u16*)(mb + M_KS); u16* Vs = (u16*)(mb + M_VS);
  u16* Ki = (u16*)(mb + M_KI); float* Wi = (float*)(mb + M_WI);
  gemm_phase(512, 20, 1024, 1024, 1024,
    [&](int tm) { return Xb + (size_t)tm * 128 * 1024; }, [&](int tn) { return Win + (size_t)tn * 128 * 1024; },
    [&](f32x16 (&acc)[2][2], int tm, int tn) {
#pragma unroll
    for (int ni = 0; ni < 2; ni++) {
      const int c0 = tn * 128 + wn * 64 + ni * 32;
      const int c = c0 + r;
#pragma unroll
      for (int mi = 0; mi < 2; mi++) {
        const int rowb = tm * 128 + wm * 64 + mi * 32;
        if (c0 >= 1024 && c0 < 1536) {
          const int cc = c - 1024, head = cc >> 7, dv = cc & 127;
          const int b = rowb >> 13, t0 = rowb & 8191;
#pragma unroll
          for (int g4 = 0; g4 < 4; g4++) {
            uint2 v = make_uint2(pack2(acc[mi][ni][4 * g4], acc[mi][ni][4 * g4 + 1]), pack2(acc[mi][ni][4 * g4 + 2], acc[mi][ni][4 * g4 + 3]));
            const int tt = t0 + 8 * g4 + 4 * hh;
            *(uint2*)(Vt + ((size_t)(((b * 4 + head) * 128 + (tt >> 6)) * 128 + dv)) * 64 + (tt & 63)) = v;
          }
        } else {
#pragma unroll
          for (int i = 0; i < 16; i++) {
            const size_t row = rowb + crow(i, hh);
            const float v = acc[mi][ni][i];
            if (c0 < 512) Qd[row * 512 + c] = f2bf(v);
            else if (c0 < 1024) {
              const int cc = c - 512;
              Kd[((size_t)((((int)(row >> 13) * 4 + (cc >> 7)) * 2 + ((cc >> 6) & 1))) * L_ + (row & 8191)) * 64 + (cc & 63)] = f2bf(v);
            }
            else if (c0 < 1792) U[row * 256 + (c - 1536)] = v;
            else if (c0 < 2048) Qs[row * 256 + (c - 1792)] = f2bf(v);
            else if (c0 < 2112) Ks[row * 64 + (c - 2048)] = f2bf(v);
            else if (c0 < 2176) Vs[row * 64 + (c - 2112)] = f2bf(v);
            else if (c0 < 2432) Qi[row * 256 + (c - 2176)] = f2bf(v);
            else if (c0 < 2464) Ki[row * 32 + (c - 2432)] = f2bf(v);
            else if (c0 == 2464) { if (r < 8) Wi[row * 8 + r] = v * 0.0625f; }
          }
        }
      }
    }
  }, bid, nb, sm);
}

DI void phase_ln(float* x, u16* __restrict__ xb, const float* __restrict__ g, const float* __restrict__ bta, bool write_f32, int bid, int nb) {
  const int lane = tidx() & 63, wave = tidx() >> 6;
  float4 gg[4], bb[4];
#pragma unroll
  for (int i = 0; i < 4; i++) { gg[i] = *(const float4*)(g + i * 256 + lane * 4); bb[i] = *(const float4*)(bta + i * 256 + lane * 4); }
  constexpr int RB = 4;
  for (int row0 = (bid * 4 + wave) * RB; row0 < T_; row0 += nb * 4 * RB) {
    float4 v[RB][4];
#pragma unroll
    for (int rr = 0; rr < RB; rr++)
#pragma unroll
      for (int i = 0; i < 4; i++) v[rr][i] = *(const float4*)(x + (size_t)(row0 + rr) * 1024 + i * 256 + lane * 4);
    float s[RB], q[RB];
#pragma unroll
    for (int rr = 0; rr < RB; rr++) {
      s[rr] = 0.f;
#pragma unroll
      for (int i = 0; i < 4; i++) s[rr] += v[rr][i].x + v[rr][i].y + v[rr][i].z + v[rr][i].w;
    }
#pragma unroll
    for (int o = 32; o > 0; o >>= 1)
#pragma unroll
      for (int rr = 0; rr < RB; rr++) s[rr] += __shfl_xor(s[rr], o);
#pragma unroll
    for (int rr = 0; rr < RB; rr++) {
      const float mu = s[rr] * (1.f / 1024.f);
      q[rr] = 0.f;
#pragma unroll
      for (int i = 0; i < 4; i++) {
        v[rr][i].x -= mu; v[rr][i].y -= mu; v[rr][i].z -= mu; v[rr][i].w -= mu;
        q[rr] += v[rr][i].x * v[rr][i].x + v[rr][i].y * v[rr][i].y + v[rr][i].z * v[rr][i].z + v[rr][i].w * v[rr][i].w;
      }
    }
#pragma unroll
    for (int o = 32; o > 0; o >>= 1)
#pragma unroll
      for (int rr = 0; rr < RB; rr++) q[rr] += __shfl_xor(q[rr], o);
#pragma unroll
    for (int rr = 0; rr < RB; rr++) {
      const float rs = rsqrtf(q[rr] * (1.f / 1024.f) + LN_EPS_);
#pragma unroll
      for (int i = 0; i < 4; i++) {
        float4 o;
        o.x = v[rr][i].x * rs * gg[i].x + bb[i].x; o.y = v[rr][i].y * rs * gg[i].y + bb[i].y;
        o.z = v[rr][i].z * rs * gg[i].z + bb[i].z; o.w = v[rr][i].w * rs * gg[i].w + bb[i].w;
        if (write_f32) *(float4*)(x + (size_t)(row0 + rr) * 1024 + i * 256 + lane * 4) = o;
        *(uint2*)(xb + (size_t)(row0 + rr) * 1024 + i * 256 + lane * 4) = make_uint2(pack2(o.x, o.y), pack2(o.z, o.w));
      }
    }
  }
}

DI float gelu_tanh(float x) { const float u = 0.7978845608028654f * (x + 0.044715f * x * x * x); return 0.5f * x * (1.f + tanhf(u)); }

typedef __attribute__((ext_vector_type(4))) float f32x4;
template <bool OUT>
DI void ssm_scan(const Params& P, int layer, int widx, char* mb, char* smem) {
  const int lane = tidx() & 63, wave = tidx() >> 6;
  const int b = widx >> 8, g = (widx >> 4) & 15, ch = widx & 15;
  const int gi = (layer * 16 + g) * 64 + lane;
  const float4 ca = ((const float4*)(WS(P) + OFF_COEFA))[gi];
  const float2* cbp = (const float2*)(WS(P) + OFF_COEFB) + (size_t)gi * 16;
  float bre[16], bim[16];
#pragma unroll
  for (int c = 0; c < 16; c++) { float2 t = cbp[c]; bre[c] = t.x; bim[c] = t.y; }
  const float* U = (const float*)(mb + M_U);
  float2* Send = (float2*)(mb + M_SEND);
  const size_t sbase = (size_t)((b * 16 + g) * 16) * 64 + lane;
  float xr = 0.f, xi = 0.f;
  float am[32];
  float4 dsk4 = make_float4(0.f, 0.f, 0.f, 0.f);
  float* Xs = (float*)smem + wave * (128 * 17);
  const int lm = lane & 15, lq = lane >> 4;
  if (OUT) {
    for (int j = 0; j < ch; j++) {
      const float2 e = Send[sbase + (size_t)j * 64];
      const float nr = ca.z * xr - ca.w * xi + e.x, ni = ca.z * xi + ca.w * xr + e.y;
      xr = nr; xi = ni;
    }
    const float* cre = INP(P, 20) + ((size_t)(layer * 16 + g) * 16 + lm) * 64;
    const float* cim = INP(P, 21) + ((size_t)(layer * 16 + g) * 16 + lm) * 64;
#pragma unroll
    for (int kb = 0; kb < 32; kb++) {
      const int kk = 4 * kb + lq;
      am[kb] = (kb < 16) ? cre[kk] : -cim[kk - 64];
    }
    dsk4 = *(const float4*)(INP(P, 22) + layer * 256 + g * 16 + 4 * lq);
  }
  u16* Yg = (u16*)(mb + M_YG);
  const size_t tok0 = (size_t)b * L_ + ch * 512;
  const float* ub = U + (tok0 + (lane >> 2)) * 256 + g * 16 + (lane & 3) * 4;
  float4 cur = *(const float4*)ub;
#pragma unroll 1
  for (int blk = 0; blk < 32; blk++) {
    const float4 nxt = *(const float4*)(ub + (size_t)min(blk + 1, 31) * 16 * 256);
#pragma unroll
    for (int s16 = 0; s16 < 16; s16++) {
      float uu[16];
#pragma unroll
      for (int c = 0; c < 16; c++) {
        const float comp = ((c & 3) == 0) ? cur.x : ((c & 3) == 1) ? cur.y : ((c & 3) == 2) ? cur.z : cur.w;
        uu[c] = __int_as_float(__builtin_amdgcn_readlane(__float_as_int(comp), 4 * s16 + (c >> 2)));
      }
      float br4[4] = {0.f, 0.f, 0.f, 0.f}, bi4[4] = {0.f, 0.f, 0.f, 0.f};
#pragma unroll
      for (int c = 0; c < 16; c++) { br4[c & 3] += bre[c] * uu[c]; bi4[c & 3] += bim[c] * uu[c]; }
      const float br = (br4[0] + br4[1]) + (br4[2] + br4[3]), bi = (bi4[0] + bi4[1]) + (bi4[2] + bi4[3]);
      const float nr = ca.x * xr - ca.y * xi + br, ni = ca.x * xi + ca.y * xr + bi;
      xr = nr; xi = ni;
      if (OUT) { Xs[lane * 17 + s16] = xr; Xs[(64 + lane) * 17 + s16] = xi; }
    }
    if (OUT) {
      __builtin_amdgcn_wave_barrier();
      f32x4 acc = {0.f, 0.f, 0.f, 0.f}, acc2 = {0.f, 0.f, 0.f, 0.f};
#pragma unroll
      for (int kb = 0; kb < 32; kb += 2) {
        const float bv0 = Xs[(4 * kb + lq) * 17 + lm], bv1 = Xs[(4 * kb + 4 + lq) * 17 + lm];
        acc = __builtin_amdgcn_mfma_f32_16x16x4f32(am[kb], bv0, acc, 0, 0, 0);
        acc2 = __builtin_amdgcn_mfma_f32_16x16x4f32(am[kb + 1], bv1, acc2, 0, 0, 0);
      }
      acc += acc2;
      __builtin_amdgcn_wave_barrier();
      const size_t tok = tok0 + blk * 16 + lm;
      const float4 u4 = *(const float4*)(U + tok * 256 + g * 16 + 4 * lq);
      const float y0 = gelu_tanh(acc[0] + dsk4.x * u4.x), y1 = gelu_tanh(acc[1] + dsk4.y * u4.y);
      const float y2 = gelu_tanh(acc[2] + dsk4.z * u4.z), y3 = gelu_tanh(acc[3] + dsk4.w * u4.w);
      *(uint2*)(Yg + tok * 256 + g * 16 + 4 * lq) = make_uint2(pack2(y0, y1), pack2(y2, y3));
    }
    cur = nxt;
  }
  if (!OUT) Send[sbase + (size_t)ch * 64] = make_float2(xr, xi);
}

constexpr int KS_ = 72, VS_ = 68;
DI void da_item(const Params& P, int layer, int b, int h, int qt, char* mb, char* smem) {
  const int tid = tidx(), lane = tid & 63, wave = tid >> 6, r = lane & 31, hh = lane >> 5;
  u16* sK0 = (u16*)smem;
  u16* sV0 = sK0 + 2 * 64 * KS_;
  float* sbias = (float*)(sV0 + 2 * 128 * VS_);
  u16* sQw = (u16*)(smem + 54272) + (tidx() >> 6) * 32 * KS_;
  const u16* Qd = (const u16*)(mb + M_QD); const u16* Kd = (const u16*)(mb + M_KD); const u16* Vt = (const u16*)(mb + M_VT);
  u16* CC = (u16*)(WS(P) + OFF_CC);
  const int q0 = qt * 128, qw = q0 + wave * 32, qp = qw + r;
  const size_t tokq = (size_t)b * L_ + qp;
  __syncthreads();
  if (tid < 129) sbias[tid] = ((const float*)(WS(P) + OFF_BIAS))[h * 129 + tid] * LOG2E_;
  __syncthreads();
  const float bfar = sbias[128];
  const float SC = 0.125f * LOG2E_;
  const int nkt = (q0 + 128) >> 6;
  const float lam = ((const float*)(WS(P) + OFF_LAM))[layer];
  const int krow_l = tid >> 3, kch = (tid & 7) * 8;
#pragma unroll 1
  for (int c = 0; c < 2; c++) {
#pragma unroll
    for (int ks = 0; ks < 4; ks++) *(bf16x8*)(sQw + r * KS_ + ks * 16 + hh * 8) = *(const bf16x8*)(Qd + tokq * 512 + h * 128 + c * 64 + ks * 16 + hh * 8);
    f32x16 o[4] = {zero16(), zero16(), zero16(), zero16()};
    float m = -INFINITY, l = 0.f;
    const u16* Kbase = Kd + ((size_t)(((b * 4 + h) * 2 + c)) * L_ + krow_l) * 64 + kch;
    const u16* Vbase = Vt + ((size_t)((b * 4 + h) * 128) * 128 + krow_l) * 64 + kch;
    u32x4 rk[2], rv[4];
#pragma unroll
    for (int i = 0; i < 2; i++) rk[i] = *(const u32x4*)(Kbase + (size_t)(i * 32) * 64);
#pragma unroll
    for (int i = 0; i < 4; i++) rv[i] = *(const u32x4*)(Vbase + (size_t)(i * 32) * 64);
#define DA_STAGE(BUF) { u16* sKw = sK0 + (BUF) * 64 * KS_; u16* sVw = sV0 + (BUF) * 128 * VS_; \
      _Pragma("unroll") for (int i = 0; i < 2; i++) *(u32x4*)(sKw + (krow_l + i * 32) * KS_ + kch) = rk[i]; \
      _Pragma("unroll") for (int i = 0; i < 4; i++) { u32x2* d = (u32x2*)(sVw + (krow_l + i * 32) * VS_ + kch); \
        u32x2 lo2, hi2; lo2.x = rv[i].x; lo2.y = rv[i].y; hi2.x = rv[i].z; hi2.y = rv[i].w; d[0] = lo2; d[1] = hi2; } }
#define DA_FETCH(T) { const int ktn_ = min((T), nkt - 1); \
      _Pragma("unroll") for (int i = 0; i < 2; i++) rk[i] = *(const u32x4*)(Kbase + (size_t)(ktn_ * 64 + i * 32) * 64); \
      _Pragma("unroll") for (int i = 0; i < 4; i++) rv[i] = *(const u32x4*)(Vbase + (size_t)ktn_ * 8192 + (size_t)(i * 32) * 64); }
    __syncthreads();
    DA_STAGE(0)
    DA_FETCH(1)
    __syncthreads();
#pragma unroll 1
    for (int kt = 0; kt < nkt; kt++) {
      const u16* sK = sK0 + (kt & 1) * 64 * KS_;
      const u16* sV = sV0 + (kt & 1) * 128 * VS_;
      if (kt + 1 < nkt) { DA_STAGE((kt + 1) & 1) }
      DA_FETCH(kt + 2)
      if (kt * 64 <= qw + 31) {
        f32x16 s[2];
#pragma unroll
        for (int kb = 0; kb < 2; kb++) {
          s[kb] = zero16();
#pragma unroll
          for (int ks = 0; ks < 4; ks++) {
            const bf16x8 kf = *(const bf16x8*)(sK + (kb * 32 + r) * KS_ + ks * 16 + hh * 8);
            const bf16x8 qf = *(const bf16x8*)(sQw + r * KS_ + ks * 16 + hh * 8);
            s[kb] = MFMA32(kf, qf, s[kb]);
          }
        }
        const bool nearb = (kt * 64 + 63 + 128 > qw);
        float mx = -INFINITY;
        if (nearb) {
#pragma unroll
          for (int kb = 0; kb < 2; kb++)
#pragma unroll
            for (int i = 0; i < 16; i++) {
              const int dist = qp - (kt * 64 + kb * 32 + crow(i, hh));
              const float bv = sbias[min(max(dist, 0), 128)];
              float t = s[kb][i] * SC + bv;
              t = (dist >= 0) ? t : -INFINITY;
              s[kb][i] = t; mx = fmaxf(mx, t);
              if ((i & 7) == 7) __builtin_amdgcn_sched_barrier(0);
            }
        } else {
#pragma unroll
          for (int kb = 0; kb < 2; kb++)
#pragma unroll
            for (int i = 0; i < 16; i++) { const float t = s[kb][i] * SC + bfar; s[kb][i] = t; mx = fmaxf(mx, t); }
        }
        mx = fmaxf(mx, __shfl_xor(mx, 32));
        const float mn = fmaxf(m, mx);
        const float corr = __builtin_amdgcn_exp2f(m - mn);
        m = mn;
        float ls = 0.f;
#pragma unroll
        for (int kb = 0; kb < 2; kb++)
#pragma unroll
          for (int i = 0; i < 16; i++) { const float p = __builtin_amdgcn_exp2f(s[kb][i] - mn); s[kb][i] = p; ls += p; }
        l = l * corr + ls;
        if (__ballot(corr != 1.f) != 0ull) {
#pragma unroll
          for (int dt = 0; dt < 4; dt++)
#pragma unroll
            for (int i = 0; i < 16; i++) o[dt][i] *= corr;
        }
#pragma unroll
        for (int kb = 0; kb < 2; kb++)
#pragma unroll
          for (int s2 = 0; s2 < 2; s2++) {
            const bf16x8 pf = pack8(s[kb], s2);
#pragma unroll
            for (int dt = 0; dt < 4; dt++) {
              const u16* vp = sV + (dt * 32 + r) * VS_ + kb * 32 + s2 * 16 + 4 * hh;
              const s16x4 lo = *(const s16x4*)vp, hi = *(const s16x4*)(vp + 8);
              const bf16x8 vf = __builtin_shufflevector(lo, hi, 0, 1, 2, 3, 4, 5, 6, 7);
              o[dt] = MFMA32(vf, pf, o[dt]);
            }
            __builtin_amdgcn_sched_barrier(0);
          }
      }
      __syncthreads();
    }
#undef DA_STAGE
#undef DA_FETCH
    const float lt = l + __shfl_xor(l, 32);
    const float inv = 1.f / lt;
    size_t tq = tokq;
    asm volatile("" : "+v"(tq));
    u16* obase = CC + tq * 1024 + h * 128 + 4 * hh;
    if (c == 0) {
#pragma unroll
      for (int dt = 0; dt < 4; dt++)
#pragma unroll
        for (int g4 = 0; g4 < 4; g4++) {
          *(uint2*)(obase + dt * 32 + 8 * g4) = make_uint2(pack2(o[dt][4 * g4] * inv, o[dt][4 * g4 + 1] * inv), pack2(o[dt][4 * g4 + 2] * inv, o[dt][4 * g4 + 3] * inv));
        }
    } else {
      float ss = 0.f;
#pragma unroll
      for (int dt = 0; dt < 4; dt++)
#pragma unroll
        for (int g4 = 0; g4 < 4; g4++) {
          const uint2 pv = *(const uint2*)(obase + dt * 32 + 8 * g4);
          const float a4[4] = {bf2f((u16)(pv.x & 0xffff)), bf2f((u16)(pv.x >> 16)), bf2f((u16)(pv.y & 0xffff)), bf2f((u16)(pv.y >> 16))};
#pragma unroll
          for (int e = 0; e < 4; e++) { const float v = a4[e] - lam * o[dt][4 * g4 + e] * inv; o[dt][4 * g4 + e] = v; ss = __builtin_fmaf(v, v, ss); }
        }
      ss += __shfl_xor(ss, 32);
      const float lam_init = 0.8f - 0.6f * __expf(-0.3f * (float)layer);
      const float rn = rsqrtf(ss * (1.f / 128.f) + LN_EPS_) * (1.f - lam_init);
      int hh2 = hh;
      asm volatile("" : "+v"(hh2));
      const float* sg = INP(P, 14) + layer * 128 + 4 * hh2;
#pragma unroll
      for (int dt = 0; dt < 4; dt++)
#pragma unroll
        for (int g4 = 0; g4 < 4; g4++) {
          const int dv = dt * 32 + 8 * g4 + 4 * hh;
          const float4 gv = *(const float4*)(sg + dt * 32 + 8 * g4);
          uint2 w = make_uint2(pack2(o[dt][4 * g4] * rn * gv.x, o[dt][4 * g4 + 1] * rn * gv.y),
                               pack2(o[dt][4 * g4 + 2] * rn * gv.z, o[dt][4 * g4 + 3] * rn * gv.w));
          *(uint2*)(obase + dv - 4 * hh) = w;
        }
    }
  }
}

DI unsigned sortkey(float f) { const unsigned u = __float_as_uint(f + 0.f); return u ^ (((unsigned)((int)u >> 31)) | 0x80000000u); }

DI void dsa_item(const Params& P, int layer, int b, int qt, char* mb, char* smem) {
  const int tid = tidx(), lane = tid & 63, wave = tid >> 6, r = lane & 31, hh = lane >> 5;
  unsigned* hist = (unsigned*)smem;
  float* sP = (float*)smem;
  float* sQ = (float*)(smem + 16384);
  u16* sidx = (u16*)(smem + 32896);
  unsigned* meta = (unsigned*)(smem + 49280);
  float* sbias = (float*)(smem + 50304);
  const u16* Qi = (const u16*)(mb + M_QI); const u16* Ki = (const u16*)(mb + M_KI); const float* Wi = (const float*)(mb + M_WI);
  const u16* Qs = (const u16*)(mb + M_QS); const u16* Ks = (const u16*)(mb + M_KS); const u16* Vs = (const u16*)(mb + M_VS);
  u16* CC = (u16*)(WS(P) + OFF_CC);
  const int q0 = qt * 32;
  const int qp = q0 + r;
  const size_t tokb = (size_t)b * L_;
  const int nk32 = qt + 1;
  const bool radix = (q0 >= 256);
  __syncthreads();
  for (int i = tid; i < 4 * 129; i += 256) sbias[i] = ((const float*)(WS(P) + OFF_BIAS))[4 * 129 + i];
  meta[tid] = (tid >= 32 && tid < 64) ? 256u : 0u;
  char* sQi = smem + 52384;
  float* sWi = (float*)(smem + 69280);
  constexpr int CAPL_ = 64;
  unsigned* lK = (unsigned*)smem;
  u16* lI = (u16*)(smem + 32 * CAPL_ * 4);
  {
    const int row = tid >> 3, ch = tid & 7;
    const uint4* src = (const uint4*)(Qi + (tokb + q0 + row) * 256 + ch * 32);
    uint4* dst = (uint4*)(sQi + row * 528 + ch * 64);
    dst[0] = src[0]; dst[1] = src[1]; dst[2] = src[2]; dst[3] = src[3];
    sWi[tid] = Wi[(tokb + q0) * 8 + tid];
  }
  int pass = radix ? 0 : 4;
  bool fast = false;
#pragma unroll 1
  while (true) {
    __syncthreads();
    if (pass < 4) { for (int i = tid; i < 32 * 257; i += 256) hist[i] = 0u; }
    __syncthreads();
    const unsigned pref = meta[r];
    const unsigned krem = meta[32 + r];
    auto elems = [&](const f32x16& sc, const int kt, const int lim) __attribute__((always_inline)) {
      if (pass == 0) {
#pragma unroll
        for (int i = 0; i < 16; i++) {
          const int kp = kt * 32 + crow(i, hh);
          const unsigned key = sortkey(sc[i]);
          const unsigned bin = (kp <= lim) ? (key >> 24) : 256u;
          atomicAdd(&hist[r * 257 + bin], 1u);
        }
      } else if (pass < 4) {
        const int sh = 24 - 8 * pass;
#pragma unroll
        for (int i = 0; i < 16; i++) {
          const int kp = kt * 32 + crow(i, hh);
          const unsigned key = sortkey(sc[i]);
          if ((key >> (sh + 8)) == pref && kp <= lim) atomicAdd(&hist[r * 257 + ((key >> sh) & 255u)], 1u);
        }
      } else if (pass == 5) {
        unsigned mc = 0u, ms = 0u;
        unsigned keys[16];
#pragma unroll
        for (int i = 0; i < 16; i++) {
          const int kp = kt * 32 + crow(i, hh);
          keys[i] = sortkey(sc[i]);
          const unsigned bt = keys[i] >> 16;
          const bool valid = (kp <= lim);
          ms |= (valid && bt > pref) ? (1u << i) : 0u;
          mc |= (valid && bt == pref) ? (1u << i) : 0u;
        }
        unsigned base_c = 0u, base_s = 0u;
        if (mc) base_c = atomicAdd(&meta[128 + r], (unsigned)__popc(mc));
        if (ms) base_s = atomicAdd(&meta[64 + r], (unsigned)__popc(ms));
#pragma unroll
        for (int i = 0; i < 16; i++) {
          const int kp = kt * 32 + crow(i, hh);
          if ((mc >> i) & 1u) {
            const unsigned cp = base_c + (unsigned)__popc(mc & ((1u << i) - 1u));
            if (cp < (unsigned)CAPL_) { lK[r * CAPL_ + cp] = keys[i]; lI[r * CAPL_ + cp] = (u16)kp; }
          }
          if ((ms >> i) & 1u) {
            const unsigned pos = base_s + (unsigned)__popc(ms & ((1u << i) - 1u));
            if (pos < 256u) sidx[r * 256 + pos] = (u16)kp;
          }
        }
      } else {
#pragma unroll
        for (int i = 0; i < 16; i++) {
          const int kp = kt * 32 + crow(i, hh);
          const unsigned key = sortkey(sc[i]);
          bool sel = (kp <= lim);
          if (radix) {
            sel = sel && (key >= pref);
            if (sel && key == pref) sel = atomicAdd(&meta[96 + r], 1u) < krem;
          }
          if (sel) { const unsigned pos = atomicAdd(&meta[64 + r], 1u); if (pos < 256u) sidx[r * 256 + pos] = (u16)kp; }
        }
      }
    };
    const int klast = nk32 - 1;
    bf16x8 nA0 = {0, 0, 0, 0, 0, 0, 0, 0}, nA1 = nA0, nB0 = nA0, nB1 = nA0;
    if (wave < nk32) {
      const int ka = wave, kb2 = min(wave + 4, klast);
      nA0 = *(const bf16x8*)(Ki + (tokb + ka * 32 + r) * 32 + hh * 8);
      nA1 = *(const bf16x8*)(Ki + (tokb + ka * 32 + r) * 32 + 16 + hh * 8);
      nB0 = *(const bf16x8*)(Ki + (tokb + kb2 * 32 + r) * 32 + hh * 8);
      nB1 = *(const bf16x8*)(Ki + (tokb + kb2 * 32 + r) * 32 + 16 + hh * 8);
    }
#pragma unroll 1
    for (int kt = wave; kt < nk32; kt += 8) {
      const bf16x8 kA0 = nA0, kA1 = nA1, kB0 = nB0, kB1 = nB1;
      {
        const int ka = min(kt + 8, klast), kb2 = min(kt + 12, klast);
        nA0 = *(const bf16x8*)(Ki + (tokb + ka * 32 + r) * 32 + hh * 8);
        nA1 = *(const bf16x8*)(Ki + (tokb + ka * 32 + r) * 32 + 16 + hh * 8);
        nB0 = *(const bf16x8*)(Ki + (tokb + kb2 * 32 + r) * 32 + hh * 8);
        nB1 = *(const bf16x8*)(Ki + (tokb + kb2 * 32 + r) * 32 + 16 + hh * 8);
      }
      f32x16 scA = zero16(), scB = zero16();
#pragma unroll 2
      for (int hd = 0; hd < 8; hd++) {
        const bf16x8 q0f = *(const bf16x8*)(sQi + r * 528 + hd * 64 + hh * 16);
        const bf16x8 q1f = *(const bf16x8*)(sQi + r * 528 + hd * 64 + 32 + hh * 16);
        const float w = sWi[r * 8 + hd];
        f32x16 sa = MFMA32(kA0, q0f, zero16());
        f32x16 sb = MFMA32(kB0, q0f, zero16());
        sa = MFMA32(kA1, q1f, sa);
        sb = MFMA32(kB1, q1f, sb);
#pragma unroll
        for (int i = 0; i < 16; i++) {
          scA[i] += __int_as_float(max(__float_as_int(sa[i]), 0)) * w;
          scB[i] += __int_as_float(max(__float_as_int(sb[i]), 0)) * w;
        }
      }
      elems(scA, kt, (kt == qt) ? qp : 0x7fffffff);
      if (kt + 4 < nk32) elems(scB, kt + 4, (kt + 4 == qt) ? qp : 0x7fffffff);
    }
    __syncthreads();
    if (pass < 4) {
      for (int j = 0; j < 8; j++) {
        const int qq = wave * 8 + j;
        const unsigned k = meta[32 + qq];
        unsigned c4[4]; unsigned tot = 0;
#pragma unroll
        for (int e = 0; e < 4; e++) { c4[e] = hist[qq * 257 + 255 - 4 * lane - e]; tot += c4[e]; }
        unsigned incl = tot;
        for (int o = 1; o < 64; o <<= 1) { const unsigned t = __shfl_up(incl, o); if (lane >= o) incl += t; }
        unsigned run = incl - tot;
#pragma unroll
        for (int e = 0; e < 4; e++) {
          if (run < k && run + c4[e] >= k) {
            meta[qq] = (meta[qq] << 8) | (unsigned)(255 - 4 * lane - e); meta[32 + qq] = k - run;
            if (pass == 1 && c4[e] > (unsigned)CAPL_) meta[192] = 1u;
          }
          run += c4[e];
        }
      }
    }
    if (pass >= 4) break;
    if (pass == 1) { __syncthreads(); fast = (meta[192] == 0u); pass = fast ? 5 : 2; } else pass++;
  }
  __syncthreads();
  if (fast) {
#pragma unroll 1
    for (int j = 0; j < 8; j++) {
      const int qq = wave * 8 + j;
      const int c = min((int)meta[128 + qq], CAPL_);
      const unsigned k = meta[32 + qq];
      const bool in = lane < c;
      const unsigned mykey = in ? lK[qq * CAPL_ + lane] : 0u;
      const unsigned myidx = in ? (unsigned)lI[qq * CAPL_ + lane] : 0u;
      unsigned rank = 0u;
      for (int t = 0; t < c; t++) {
        const unsigned ok = __shfl(mykey, t);
        rank += (ok > mykey || (ok == mykey && t < lane)) ? 1u : 0u;
      }
      const bool sel = in && (rank < k);
      const unsigned long long m = __ballot(sel);
      const unsigned base = meta[64 + qq];
      if (sel) {
        const unsigned pos = base + (unsigned)__popcll(m & ((1ull << lane) - 1ull));
        if (pos < 256u) sidx[qq * 256 + pos] = (u16)myidx;
      }
      __builtin_amdgcn_wave_barrier();
      if (lane == 0) meta[64 + qq] = base + (unsigned)__popcll(m);
    }
    __syncthreads();
  }
  float* myP = sP + wave * 1024;
  (void)sQ;
#pragma unroll 1
  for (int j = 0; j < 8; j++) {
    const int qq = wave * 8 + j;
    const int qpos = q0 + qq;
    const size_t tok = tokb + qpos;
    const int n = min((int)meta[64 + qq], 256);
    __syncthreads();
    bf16x8 qf[4];
#pragma unroll
    for (int ks = 0; ks < 4; ks++) {
      bf16x8 z = {0, 0, 0, 0, 0, 0, 0, 0};
      if (r < 4) z = *(const bf16x8*)(Qs + tok * 256 + r * 64 + ks * 16 + hh * 8);
      qf[ks] = z;
    }
#pragma unroll 4
    for (int kb = 0; kb < 8; kb++) {
      const int jj = kb * 32 + r;
      const int kidx = (jj < n) ? (int)sidx[qq * 256 + jj] : 0;
      const u16* kp = Ks + (tokb + kidx) * 64 + hh * 8;
      bf16x8 kf[4];
#pragma unroll
      for (int ks = 0; ks < 4; ks++) kf[ks] = *(const bf16x8*)(kp + ks * 16);
      f32x16 sacc = zero16();
#pragma unroll
      for (int ks = 0; ks < 4; ks++) sacc = MFMA32(kf[ks], qf[ks], sacc);
      if (r < 4) {
#pragma unroll
        for (int i = 0; i < 16; i++) myP[(kb * 32 + crow(i, hh)) * 4 + r] = sacc[i];
      }
    }
    __syncthreads();
    float sc[4][4];
#pragma unroll
    for (int rd = 0; rd < 4; rd++) {
      const int jj = rd * 64 + lane;
      const bool valid = jj < n;
      const int kidx = valid ? (int)sidx[qq * 256 + jj] : 0;
      const int dist = min(max(qpos - kidx, 0), 128);
      const float4 d = *(const float4*)(myP + jj * 4);
      sc[rd][0] = valid ? d.x * 0.125f + sbias[0 * 129 + dist] : -INFINITY;
      sc[rd][1] = valid ? d.y * 0.125f + sbias[1 * 129 + dist] : -INFINITY;
      sc[rd][2] = valid ? d.z * 0.125f + sbias[2 * 129 + dist] : -INFINITY;
      sc[rd][3] = valid ? d.w * 0.125f + sbias[3 * 129 + dist] : -INFINITY;
    }
#pragma unroll
    for (int hd = 0; hd < 4; hd++) {
      float mx = fmaxf(fmaxf(sc[0][hd], sc[1][hd]), fmaxf(sc[2][hd], sc[3][hd]));
      mx = wave_max(mx);
      float sm = 0.f;
#pragma unroll
      for (int rd = 0; rd < 4; rd++) { sc[rd][hd] = __expf(sc[rd][hd] - mx); sm += sc[rd][hd]; }
      sm = wave_sum(sm);
      const float inv = 1.f / sm;
#pragma unroll
      for (int rd = 0; rd < 4; rd++) sc[rd][hd] *= inv;
    }
#pragma unroll
    for (int rd = 0; rd < 4; rd++) *(float4*)(myP + (rd * 64 + lane) * 4) = make_float4(sc[rd][0], sc[rd][1], sc[rd][2], sc[rd][3]);
    __syncthreads();
    const int g = lane >> 3, c8 = lane & 7;
    float acc[32];
#pragma unroll
    for (int i = 0; i < 32; i++) acc[i] = 0.f;
#pragma unroll 16
    for (int it = 0; it < 32; it++) {
      const int jj = it * 8 + g;
      const int kidx = (jj < n) ? (int)sidx[qq * 256 + jj] : 0;
      const float4 pj = *(const float4*)(myP + jj * 4);
      const u32x4 vv = *(const u32x4*)(Vs + (tokb + kidx) * 64 + c8 * 8);
      const float vf[8] = {bf2f((u16)(vv.x & 0xffff)), bf2f((u16)(vv.x >> 16)), bf2f((u16)(vv.y & 0xffff)), bf2f((u16)(vv.y >> 16)),
                           bf2f((u16)(vv.z & 0xffff)), bf2f((u16)(vv.z >> 16)), bf2f((u16)(vv.w & 0xffff)), bf2f((u16)(vv.w >> 16))};
#pragma unroll
      for (int e = 0; e < 8; e++) {
        acc[0 * 8 + e] += pj.x * vf[e]; acc[1 * 8 + e] += pj.y * vf[e];
        acc[2 * 8 + e] += pj.z * vf[e]; acc[3 * 8 + e] += pj.w * vf[e];
      }
    }
    const bool b5 = lane & 32, b4 = lane & 16, b3 = lane & 8;
    float w16[16], w8[8], w4[4];
#pragma unroll
    for (int i = 0; i < 16; i++) { const float snd = b5 ? acc[i] : acc[i + 16]; const float rcv = __shfl_xor(snd, 32); w16[i] = (b5 ? acc[i + 16] : acc[i]) + rcv; }
#pragma unroll
    for (int i = 0; i < 8; i++) { const float snd = b4 ? w16[i] : w16[i + 8]; const float rcv = __shfl_xor(snd, 16); w8[i] = (b4 ? w16[i + 8] : w16[i]) + rcv; }
#pragma unroll
    for (int i = 0; i < 4; i++) { const float snd = b3 ? w8[i] : w8[i + 4]; const float rcv = __shfl_xor(snd, 8); w4[i] = (b3 ? w8[i + 4] : w8[i]) + rcv; }
    const int hd = (b5 ? 2 : 0) + (b4 ? 1 : 0);
    *(uint2*)(CC + tok * 1024 + 768 + hd * 64 + c8 * 8 + (b3 ? 4 : 0)) = make_uint2(pack2(w4[0], w4[1]), pack2(w4[2], w4[3]));
  }
}

DI void phase_mix1(const Params& P, int layer, int bid, int nb, char* smem) {
  char* mb = WS(P) + OFF_H;
  for (int w = bid * 4 + (tidx() >> 6); w < 2048; w += nb * 4) ssm_scan<false>(P, layer, w, mb, smem);
  for (int j = 0;; j++) {
    const int idx = (j & 1) ? (j * nb + (nb - 1 - bid)) : (j * nb + bid);
    if (j * nb >= 2048) break;
    if (idx >= 2048) continue;
    const int qt = 255 - (idx >> 3), b = idx & 7;
    dsa_item(P, layer, b, qt, mb, smem);
  }
  for (int j = 0;; j++) {
    const int idx = (j & 1) ? (j * nb + (nb - 1 - bid)) : (j * nb + bid);
    if (j * nb >= 2048) break;
    if (idx >= 2048) continue;
    const int qt = 63 - (idx >> 5), bh = idx & 31;
    da_item(P, layer, bh >> 2, bh & 3, qt, mb, smem);
  }
}

DI void phase_mix2(const Params& P, int layer, int bid, int nb, char* smem) {
  char* mb = WS(P) + OFF_H;
  for (int w = bid * 4 + (tidx() >> 6); w < 2048; w += nb * 4) ssm_scan<true>(P, layer, w, mb, smem);
}

DI void run_phase(const Params& P, int ph, int bid, int nb, char* smem) {
  char* ws = WS(P);
  u16* sm = (u16*)smem;
  if (ph == 0) { phase_prep(P, bid, nb, smem); return; }
  const int l = (ph - 1) / 12, s = (ph - 1) % 12;
  u16* Xb = (u16*)(ws + OFF_XB);
  u16* H = (u16*)(ws + OFF_H);
  u16* CC = (u16*)(ws + OFF_CC);
  float* X = OUTP(P);
  switch (s) {
    case 0: phase_ffn_up(Xb, (const u16*)(ws + OFF_WGU1 + l * SZ_WGU), H, bid, nb, sm); break;
    case 1: phase_ffn_down(H, (const u16*)(ws + OFF_WD1 + l * SZ_WD), (l == 0) ? INP(P, 0) : (const float*)nullptr, Xb, X, nullptr, bid, nb, sm); break;
    case 2: phase_ln(X, Xb, INP(P, 6) + l * 1024, INP(P, 7) + l * 1024, false, bid, nb); break;
    case 3: phase_w_in(Xb, (const u16*)(ws + OFF_WIN + l * SZ_WIN), ws + OFF_H, bid, nb, sm); break;
    case 4: phase_mix1(P, l, bid, nb, smem); break;
    case 5: phase_mix2(P, l, bid, nb, smem); break;
    case 6: phase_glu((const u16*)(ws + OFF_H + M_YG), (const u16*)(ws + OFF_WGLU + l * SZ_WGLU), CC, bid, nb, sm); break;
    case 7: phase_w_o(CC, (const u16*)(ws + OFF_WO + l * SZ_WO), X, Xb, bid, nb, sm); break;
    case 8: phase_ln(X, Xb, INP(P, 24) + l * 1024, INP(P, 25) + l * 1024, false, bid, nb); break;
    case 9:
      phase_ffn_up(Xb, (const u16*)(ws + OFF_WGU2 + l * SZ_WGU), H, bid, nb, sm);
      phase_ple(Xb, (const u16*)(ws + OFF_WPG + l * SZ_WPG), (const u16*)(ws + OFF_PB) + (size_t)l * T_ * 256, (const u16*)(ws + OFF_WPP + l * SZ_WPP), CC, bid, nb, sm);
      break;
    case 10: phase_ffn_down(H, (const u16*)(ws + OFF_WD2 + l * SZ_WD), (const float*)nullptr, Xb, X, CC, bid, nb, sm); break;
    case 11: phase_ln(X, Xb, INP(P, 31) + l * 1024, INP(P, 32) + l * 1024, l == 1, bid, nb); break;
  }
}

#define XB_TMO      128
#define XB_XCNT(j)  (256  + 64 * (j))
#define XB_XSUB(j)  (1280 + 64 * (j))
#define XB_XGEN(j)  (2304 + 64 * (j))
#define XB_TOP      3328
#define XB_TOPGEN   3392
#define XCD_BAR_WORDS 3456
#define XB_SPIN_CAP (1u << 22)
#define LAS __attribute__((address_space(3)))

__device__ __forceinline__ unsigned xb_ld(unsigned* p)              { return __hip_atomic_load(p, __ATOMIC_RELAXED, __HIP_MEMORY_SCOPE_AGENT); }
__device__ __forceinline__ unsigned xb_add(unsigned* p, unsigned v) { return __hip_atomic_fetch_add(p, v, __ATOMIC_RELAXED, __HIP_MEMORY_SCOPE_AGENT); }
__device__ __forceinline__ unsigned xb_xcc_id() { return (unsigned)__builtin_amdgcn_s_getreg((3 << 11) | 20) & 0xFu; }
#define XB_SPIN(cond, bar) do { unsigned _sp = 0; while (cond) { __builtin_amdgcn_s_sleep(1); \
    if ((++_sp & 255u) == 0u) { if (xb_ld(&(bar)[XB_TMO])) break; if (_sp > XB_SPIN_CAP) { atomicAdd(&(bar)[XB_TMO], 1u); break; } } } } while (0)

struct XcdBarrier {
    unsigned* bar; unsigned x;
    volatile LAS unsigned* st;
};

__device__ __forceinline__ XcdBarrier xcd_barrier_post(unsigned* bar, volatile LAS unsigned* st) {
    XcdBarrier b; b.bar = bar; b.x = xb_xcc_id(); b.st = st;
    if (threadIdx.x == 0) (void)xb_add(&bar[XB_XCNT(b.x)], 1u);
    return b;
}
__device__ __forceinline__ void xcd_barrier_complete(unsigned* bar, unsigned x, unsigned& nloc, unsigned& nx) {
    const unsigned G = gridDim.x * gridDim.y * gridDim.z;
    unsigned sum, cnt, mine, sp = 0u;
    for (;;) {
        sum = 0u; cnt = 0u; mine = 0u;
#pragma unroll
        for (unsigned j = 0; j < 16; ++j) { const unsigned c = xb_ld(&bar[XB_XCNT(j)]); sum += c; cnt += (c > 0u) ? 1u : 0u; mine = (j == x) ? c : mine; }
        if (sum == G) break;
        __builtin_amdgcn_s_sleep(1);
        if ((++sp & 255u) == 0u) { if (xb_ld(&bar[XB_TMO])) break; if (sp > XB_SPIN_CAP) { atomicAdd(&bar[XB_TMO], 1u); break; } }
    }
    nloc = mine > 0u ? mine : 1u; nx = cnt > 0u ? cnt : 1u;
}

__device__ __forceinline__ void xcd_barrier(const XcdBarrier& b) {
    asm volatile("s_waitcnt vmcnt(0)" ::: "memory");
    __syncthreads();
    if (threadIdx.x == 0) {
        unsigned* bar = b.bar;
        __builtin_amdgcn_s_waitcnt(0);
        unsigned nloc = b.st[0], nx = b.st[1];
        if (nloc == 0u) { xcd_barrier_complete(bar, b.x, nloc, nx); b.st[0] = nloc; b.st[1] = nx; }
        const unsigned old = xb_add(&bar[XB_XSUB(b.x)], 1u);
        const unsigned gen = old / nloc;
        if (old + 1u == (gen + 1u) * nloc) {
            __builtin_amdgcn_fence(__ATOMIC_RELEASE, "agent");
            asm volatile("s_waitcnt vmcnt(0)" ::: "memory");
            const unsigned og = xb_add(&bar[XB_TOP], 1u);
            const unsigned tg = og / nx;
            if (og + 1u == (tg + 1u) * nx) xb_add(&bar[XB_TOPGEN], 1u);
            else XB_SPIN(xb_ld(&bar[XB_TOPGEN]) == tg, bar);
            __builtin_amdgcn_fence(__ATOMIC_ACQUIRE, "agent");
            xb_add(&bar[XB_XGEN(b.x)], 1u);
            asm volatile("s_waitcnt vmcnt(0)" ::: "memory");
        } else {
            XB_SPIN(xb_ld(&bar[XB_XGEN(b.x)]) == gen, bar);
            __builtin_amdgcn_fence(__ATOMIC_ACQUIRE, "agent");
            asm volatile("s_waitcnt vmcnt(0)" ::: "memory");
        }
    }
    __syncthreads();
}


constexpr int NPHASES = 25;

__global__ void __launch_bounds__(256, 2) mega(Params P, int ph0, int ph1) {
  extern __shared__ __attribute__((aligned(16))) char smem[];
  cg::grid_group grid = cg::this_grid();
  const int bid = blockIdx.x, nb = gridDim.x;
  volatile LAS unsigned* xst = (volatile LAS unsigned*)(smem + 73712);
  if (threadIdx.x == 0) { xst[0] = 0u; xst[1] = 0u; xst[2] = 0u; xst[3] = 0u; }
  __syncthreads();
  const XcdBarrier xbar = xcd_barrier_post((unsigned*)(P.ws + OFF_XBAR), xst);
#ifndef DUP_MASK
#define DUP_MASK 0
#endif
#define PHASE(k) if (ph0 <= (k) && (k) < ph1) { \
    if ((k) > 0 && ((DUP_MASK >> (((k) - 1) % 12)) & 1)) { run_phase(P, (k), bid, nb, smem); grid.sync(); } \
    run_phase(P, (k), bid, nb, smem); if ((k) + 1 < ph1) { if ((k) == 0) grid.sync(); else xcd_barrier(xbar); } }
  PHASE(0) PHASE(1) PHASE(2) PHASE(3) PHASE(4) PHASE(5) PHASE(6) PHASE(7) PHASE(8) PHASE(9) PHASE(10) PHASE(11) PHASE(12)
  PHASE(13) PHASE(14) PHASE(15) PHASE(16) PHASE(17) PHASE(18) PHASE(19) PHASE(20) PHASE(21) PHASE(22) PHASE(23) PHASE(24)
#undef PHASE
}

extern "C" void kernel_launch(void* const* d_in, const int* in_sizes, int n_in, void* d_out, int out_size, void* d_ws, size_t ws_size, hipStream_t stream) {
  static int grid_blocks = 0;
  if (grid_blocks == 0) {
    if (n_in != 33 || ws_size < WS_END) { fprintf(stderr, "kernel_launch: need 33 inputs and %zu bytes of ws (got %d, %zu)\n", (size_t)WS_END, n_in, ws_size); grid_blocks = -1; return; }
    int dev = 0, cus = 0, per_cu = 0;
    (void)hipGetDevice(&dev);
    (void)hipDeviceGetAttribute(&cus, hipDeviceAttributeMultiprocessorCount, dev);
    (void)hipFuncSetAttribute((const void*)mega, hipFuncAttributeMaxDynamicSharedMemorySize, LDS_BYTES);
    (void)hipOccupancyMaxActiveBlocksPerMultiprocessor(&per_cu, (const void*)mega, 256, LDS_BYTES);
    if (per_cu < 1) per_cu = 1;
    if (per_cu > 2) per_cu = 2;
    grid_blocks = cus * per_cu;
    fprintf(stderr, "kernel_launch: cus %d per_cu %d grid %d\n", cus, per_cu, grid_blocks);
  }
  if (grid_blocks < 0) return;
  Params p;
  memset(&p, 0, sizeof(p));
  for (int i = 0; i < 33; i++) p.in[i] = (const float*)d_in[i];
  p.out = (float*)d_out;
  p.ws = (char*)d_ws;
#if MULTI_LAUNCH
  for (int ph = 0; ph < NPHASES; ph++) {
    hipLaunchKernelGGL(mega, dim3(grid_blocks), dim3(256), LDS_BYTES, stream, p, ph, ph + 1);
  }
#else
  int ph0 = 0, ph1 = NPHASES;
  (void)hipMemsetAsync((char*)d_ws + OFF_XBAR, 0, XCD_BAR_WORDS * 4, stream);
  void* args[] = {&p, &ph0, &ph1};
  hipError_t e = hipLaunchCooperativeKernel((const void*)mega, dim3(grid_blocks), dim3(256), args, LDS_BYTES, stream);
  if (e != hipSuccess) fprintf(stderr, "cooperative launch failed: %s (grid %d)\n", hipGetErrorString(e), grid_blocks);
#endif
}
```

```cpp
#include <hip/hip_runtime.h>
#include <hip/hip_cooperative_groups.h>
#include <stdint.h>
#include <math.h>
#include <stdio.h>
#include <string.h>
namespace cg = cooperative_groups;

#ifndef MULTI_LAUNCH
#define MULTI_LAUNCH 0
#endif

typedef unsigned short u16;
typedef __attribute__((ext_vector_type(8))) short bf16x8;
typedef __attribute__((ext_vector_type(4))) short s16x4;
typedef __attribute__((ext_vector_type(16))) float f32x16;
typedef __attribute__((ext_vector_type(4))) unsigned u32x4;
typedef __attribute__((ext_vector_type(2))) unsigned u32x2;

#define DI __device__ __forceinline__
#define MFMA32(a, b, c) __builtin_amdgcn_mfma_f32_32x32x16_bf16((a), (b), (c), 0, 0, 0)

constexpr int T_ = 65536;
constexpr int L_ = 8192;
constexpr int D_ = 1024;
constexpr int FF_ = 2816;
constexpr float ALPHA_ = 1.41421356237309515f;
constexpr float LN_EPS_ = 1e-5f;
constexpr float LOG2E_ = 1.44269504088896341f;
constexpr int LDS_BYTES = 73728;

constexpr size_t SZ_WGU = (size_t)5632 * 1024 * 2;
constexpr size_t SZ_WD = (size_t)1024 * 2816 * 2;
constexpr size_t SZ_WIN = (size_t)2560 * 1024 * 2;
constexpr size_t SZ_WO = (size_t)1024 * 1024 * 2;
constexpr size_t SZ_WGLU = (size_t)256 * 256 * 2;
constexpr size_t SZ_WPG = (size_t)1024 * 1024 * 2;
constexpr size_t SZ_WPP = (size_t)1024 * 256 * 2;
constexpr size_t OFF_WGU1 = 0;
constexpr size_t OFF_WD1 = OFF_WGU1 + 2 * SZ_WGU;
constexpr size_t OFF_WGU2 = OFF_WD1 + 2 * SZ_WD;
constexpr size_t OFF_WD2 = OFF_WGU2 + 2 * SZ_WGU;
constexpr size_t OFF_WIN = OFF_WD2 + 2 * SZ_WD;
constexpr size_t OFF_WO = OFF_WIN + 2 * SZ_WIN;
constexpr size_t OFF_WGLU = OFF_WO + 2 * SZ_WO;
constexpr size_t OFF_WPG = OFF_WGLU + 2 * SZ_WGLU;
constexpr size_t OFF_WPP = OFF_WPG + 2 * SZ_WPG;
constexpr size_t OFF_COEFA = OFF_WPP + 2 * SZ_WPP;
constexpr size_t OFF_COEFB = OFF_COEFA + 2 * 16 * 64 * 16;
constexpr size_t OFF_LAM = OFF_COEFB + 2 * 16 * 64 * 16 * 8;
constexpr size_t OFF_BIAS = OFF_LAM + 256;
constexpr size_t OFF_XBAR = OFF_BIAS + 8 * 129 * 4 + 32;
constexpr size_t OFF_XB = OFF_XBAR + 16384;
constexpr size_t OFF_PB = OFF_XB + (size_t)T_ * 1024 * 2;
constexpr size_t OFF_H = OFF_PB + (size_t)2 * T_ * 256 * 2;
constexpr size_t SZ_H = (size_t)384 << 20;
constexpr size_t OFF_CC = OFF_H + SZ_H;
constexpr size_t OFF_CANDK = OFF_CC + (size_t)T_ * 1024 * 2;
constexpr int CAP_ = 2048;
constexpr size_t OFF_CANDI = OFF_CANDK + (size_t)512 * 32 * CAP_ * 4;
constexpr size_t WS_END = OFF_CANDI + (size_t)512 * 32 * CAP_ * 2;
constexpr size_t MB_ = (size_t)1 << 20;
constexpr size_t M_QD = 0, M_KD = 64 * MB_, M_VT = 128 * MB_, M_U = 192 * MB_, M_QS = 256 * MB_, M_QI = 288 * MB_, M_YG = 320 * MB_,
                 M_KS = 352 * MB_, M_VS = 360 * MB_, M_KI = 368 * MB_, M_WI = 372 * MB_, M_SEND = 374 * MB_;

struct Params {
  const float* in[33];
  float* out;
  char* ws;
};

DI int tidx() { int t = threadIdx.x; asm volatile("" : "+v"(t)); return t; }
#define GAS __attribute__((address_space(1)))
DI size_t opaque0() { size_t z = 0; asm volatile("" : "+s"(z)); return z; }
DI char* WS(const Params& P) { return P.ws + opaque0(); }
DI float* OUTP(const Params& P) { return P.out + opaque0(); }
DI const float* INP(const Params& P, int i) { return P.in[i]; }
typedef __bf16 bf16v2_ __attribute__((ext_vector_type(2)));
typedef float f32v2_ __attribute__((ext_vector_type(2)));
DI u16 f2bf(float x) { const __bf16 h = (__bf16)x; return __builtin_bit_cast(u16, h); }
DI float bf2f(u16 v) { return __uint_as_float(((unsigned)v) << 16); }
DI unsigned pack2(float a, float b) { f32v2_ v; v.x = a; v.y = b; const bf16v2_ h = __builtin_convertvector(v, bf16v2_); return __builtin_bit_cast(unsigned, h); }
DI int crow(int i, int hh) { return (i & 3) + 8 * (i >> 2) + 4 * hh; }
DI float sigmoidf_(float x) { return __builtin_amdgcn_rcpf(1.f + __expf(-x)); }
DI float wave_sum(float v) { for (int o = 32; o > 0; o >>= 1) v += __shfl_xor(v, o); return v; }
DI float wave_max(float v) { for (int o = 32; o > 0; o >>= 1) v = fmaxf(v, __shfl_xor(v, o)); return v; }
DI f32x16 zero16() { f32x16 z; for (int i = 0; i < 16; i++) z[i] = 0.f; return z; }
DI bf16x8 pack8(const f32x16& x, int s) {
  union { unsigned u[4]; bf16x8 v; } t;
  t.u[0] = pack2(x[8 * s + 0], x[8 * s + 1]); t.u[1] = pack2(x[8 * s + 2], x[8 * s + 3]);
  t.u[2] = pack2(x[8 * s + 4], x[8 * s + 5]); t.u[3] = pack2(x[8 * s + 6], x[8 * s + 7]);
  return t.v;
}

constexpr int GS_ = 72;
constexpr int GT_ = 128 * GS_;

constexpr int GST_ = 32768;
DI void gemm_stage(const u16* __restrict__ A, int lda, const u16* __restrict__ B, int ldb, int kt, char* sbuf) {
  const int tid = tidx(), lane = tid & 63, wave = __builtin_amdgcn_readfirstlane(tid >> 6);
  const int pp = lane >> 4, pos = lane & 15;
#pragma unroll
  for (int i = 0; i < 4; i++) {
    const int blk = i * 4 + wave;
    const int p = blk * 4 + pp;
    const int row = 2 * p + (pos >> 3), c8 = (pos & 7) ^ (p & 7);
    const u16* ga = A + (size_t)row * lda + kt * 64 + c8 * 8;
    const u16* gb = B + (size_t)row * ldb + kt * 64 + c8 * 8;
    __builtin_amdgcn_global_load_lds((const GAS void*)ga, (__attribute__((address_space(3))) void*)(sbuf + blk * 1024), 16, 0, 0);
    __builtin_amdgcn_global_load_lds((const GAS void*)gb, (__attribute__((address_space(3))) void*)(sbuf + 16384 + blk * 1024), 16, 0, 0);
  }
}
DI void gemm_main(f32x16 (&acc)[2][2], const u16* __restrict__ A, int lda, const u16* __restrict__ B, int ldb, int K, u16* sm) {
  const int tid = tidx(), lane = tid & 63, wave = tid >> 6;
  const int wm = wave >> 1, wn = wave & 1, r = lane & 31, hh = lane >> 5;
  char* sb = (char*)sm;
  const int rowa = wm * 64 + r, rowb = wn * 64 + r;
  const int baseA = (rowa >> 1) * 256 + ((rowa & 1) << 7), xa = (rowa >> 1) & 7;
  const int baseB = 16384 + (rowb >> 1) * 256 + ((rowb & 1) << 7), xb = (rowb >> 1) & 7;
  const int nk = K >> 6;
  asm volatile("s_waitcnt vmcnt(0)" ::: "memory");
  __syncthreads();
#pragma unroll 1
  for (int kt = 0; kt < nk; kt++) {
    if (kt + 1 < nk) gemm_stage(A, lda, B, ldb, kt + 1, sb + ((kt + 1) & 1) * GST_);
    const char* st = sb + (kt & 1) * GST_;
#pragma unroll
    for (int ks = 0; ks < 4; ks++) {
      const int ca = ((ks * 2 + hh) ^ xa) << 4, cb = ((ks * 2 + hh) ^ xb) << 4;
      const bf16x8 fa0 = *(const bf16x8*)(st + baseA + ca);
      const bf16x8 fa1 = *(const bf16x8*)(st + baseA + 4096 + ca);
      const bf16x8 fb0 = *(const bf16x8*)(st + baseB + cb);
      const bf16x8 fb1 = *(const bf16x8*)(st + baseB + 4096 + cb);
      acc[0][0] = MFMA32(fa0, fb0, acc[0][0]); acc[0][1] = MFMA32(fa0, fb1, acc[0][1]);
      acc[1][0] = MFMA32(fa1, fb0, acc[1][0]); acc[1][1] = MFMA32(fa1, fb1, acc[1][1]);
    }
    asm volatile("s_waitcnt vmcnt(0)" ::: "memory");
    __syncthreads();
  }
}

DI bool tile_at(int it, int bid, int nb, int TM, int TN, int& tm, int& tn) {
  if ((nb & 7) == 0 && (TM & 63) == 0) {
    const int xcd = bid & 7, lw = bid >> 3, nlw = nb >> 3;
    const int lt = lw + it * nlw, per = (TM >> 3) * TN;
    if (lt >= per) return false;
    const int g = lt / (4 * TN), rem = lt - g * 4 * TN;
    tn = rem >> 2; tm = xcd * (TM >> 3) + g * 4 + (rem & 3);
    return true;
  } else {
    const int t = bid + it * nb;
    if (t >= TM * TN) return false;
    tn = t / TM; tm = t - tn * TM;
    return true;
  }
}

template <class AF, class BF, class INI, class EPI>
DI void gemm_phase_init(int TM, int TN, int K, int lda, int ldb, AF a_of, BF b_of, INI ini, EPI epi, int bid, int nb, u16* sm) {
  int tm, tn;
  bool have = tile_at(0, bid, nb, TM, TN, tm, tn);
  __syncthreads();
  if (have) gemm_stage(a_of(tm), lda, b_of(tn), ldb, 0, (char*)sm);
  for (int it = 0; have; it++) {
    f32x16 acc[2][2];
    ini(acc, tm, tn);
    gemm_main(acc, a_of(tm), lda, b_of(tn), ldb, K, sm);
    int tm2 = 0, tn2 = 0;
    const bool have2 = tile_at(it + 1, bid, nb, TM, TN, tm2, tn2);
    if (have2) gemm_stage(a_of(tm2), lda, b_of(tn2), ldb, 0, (char*)sm);
    epi(acc, tm, tn);
    have = have2; tm = tm2; tn = tn2;
  }
  asm volatile("s_waitcnt vmcnt(0)" ::: "memory");
}
template <class AF, class BF, class EPI>
DI void gemm_phase(int TM, int TN, int K, int lda, int ldb, AF a_of, BF b_of, EPI epi, int bid, int nb, u16* sm) {
  gemm_phase_init(TM, TN, K, lda, ldb, a_of, b_of,
    [&](f32x16 (&acc)[2][2], int, int) { acc[0][0] = zero16(); acc[0][1] = zero16(); acc[1][0] = zero16(); acc[1][1] = zero16(); },
    epi, bid, nb, sm);
}

DI void transpose_job(const float* __restrict__ src, int K, int N, u16* __restrict__ dst, int mode, int bid, int nb, float* tile) {
  const int tid = tidx();
  const int tk = K >> 6, tn = (N + 63) >> 6;
  for (int t = bid; t < tk * tn; t += nb) {
    const int k0 = (t % tk) * 64, n0 = (t / tk) * 64;
    __syncthreads();
#pragma unroll 4
    for (int i = 0; i < 16; i++) {
      const int k = i * 4 + (tid >> 6), n = tid & 63;
      tile[k * 65 + n] = (n0 + n < N) ? src[(size_t)(k0 + k) * N + n0 + n] : 0.f;
    }
    __syncthreads();
#pragma unroll 4
    for (int i = 0; i < 16; i++) {
      const int n = i * 4 + (tid >> 6), k = tid & 63;
      const int ng = n0 + n;
      if (ng < N) {
        int row = ng;
        if (mode == 1) row = (ng >> 5) * 64 + (ng & 31);
        else if (mode == 2) row = (ng >> 5) * 64 + 32 + (ng & 31);
        dst[(size_t)row * K + k0 + k] = f2bf(tile[k * 65 + n]);
      }
    }
  }
}

DI void phase_prep(const Params& P, int bid, int nb, char* smem) {
  float* tile = (float*)smem;
  char* ws = WS(P);
  for (int l = 0; l < 2; l++) {
    transpose_job(INP(P, 3) + (size_t)l * 1024 * FF_, 1024, FF_, (u16*)(ws + OFF_WGU1 + l * SZ_WGU), 1, bid, nb, tile);
    transpose_job(INP(P, 4) + (size_t)l * 1024 * FF_, 1024, FF_, (u16*)(ws + OFF_WGU1 + l * SZ_WGU), 2, bid, nb, tile);
    transpose_job(INP(P, 5) + (size_t)l * FF_ * 1024, FF_, 1024, (u16*)(ws + OFF_WD1 + l * SZ_WD), 0, bid, nb, tile);
    transpose_job(INP(P, 26) + (size_t)l * 1024 * FF_, 1024, FF_, (u16*)(ws + OFF_WGU2 + l * SZ_WGU), 1, bid, nb, tile);
    transpose_job(INP(P, 27) + (size_t)l * 1024 * FF_, 1024, FF_, (u16*)(ws + OFF_WGU2 + l * SZ_WGU), 2, bid, nb, tile);
    transpose_job(INP(P, 28) + (size_t)l * FF_ * 1024, FF_, 1024, (u16*)(ws + OFF_WD2 + l * SZ_WD), 0, bid, nb, tile);
    transpose_job(INP(P, 8) + (size_t)l * 1024 * 2472, 1024, 2472, (u16*)(ws + OFF_WIN + l * SZ_WIN), 0, bid, nb, tile);
    transpose_job(INP(P, 9) + (size_t)l * 1024 * 1024, 1024, 1024, (u16*)(ws + OFF_WO + l * SZ_WO), 0, bid, nb, tile);
    transpose_job(INP(P, 23) + (size_t)l * 256 * 256, 256, 256, (u16*)(ws + OFF_WGLU + l * SZ_WGLU), 0, bid, nb, tile);
    transpose_job(INP(P, 30) + (size_t)l * 1024 * 1024, 1024, 1024, (u16*)(ws + OFF_WPG + l * SZ_WPG), 0, bid, nb, tile);
    transpose_job(INP(P, 29) + (size_t)l * 256 * 1024, 256, 1024, (u16*)(ws + OFF_WPP + l * SZ_WPP), 0, bid, nb, tile);
    u16* win = (u16*)(ws + OFF_WIN + l * SZ_WIN);
    for (int i = bid * 256 + tidx(); i < 88 * 1024; i += nb * 256) win[(size_t)2472 * 1024 + i] = 0;
  }
  const size_t gt = (size_t)bid * 256 + tidx(), gs = (size_t)nb * 256;
  {
    const float4* x4 = (const float4*)INP(P, 0);
    uint2* xb = (uint2*)(ws + OFF_XB);
    for (size_t i = gt; i < (size_t)T_ * 1024 / 4; i += gs) { float4 v = x4[i]; xb[i] = make_uint2(pack2(v.x, v.y), pack2(v.z, v.w)); }
    const float4* p4 = (const float4*)INP(P, 1);
    uint2* pb = (uint2*)(ws + OFF_PB);
    for (size_t i = gt; i < (size_t)2 * T_ * 256 / 4; i += gs) { float4 v = p4[i]; pb[i] = make_uint2(pack2(v.x, v.y), pack2(v.z, v.w)); }
  }
  if (gt < 2 * 16 * 64) {
    const int l = (int)gt >> 10, g = ((int)gt >> 6) & 15, p = (int)gt & 63;
    const int gi = (l * 16 + g) * 64 + p;
    const double lr = INP(P, 15)[gi], li = INP(P, 16)[gi];
    const double dt = exp((double)INP(P, 17)[l * 16 + g]);
    const double mag = exp(lr * dt);
    const double ar = mag * cos(li * dt), ai = mag * sin(li * dt);
    const double mag5 = exp(512.0 * lr * dt);
    const double a5r = mag5 * cos(512.0 * li * dt), a5i = mag5 * sin(512.0 * li * dt);
    ((float4*)(ws + OFF_COEFA))[gi] = make_float4((float)ar, (float)ai, (float)a5r, (float)a5i);
    const double den = lr * lr + li * li, nr = ar - 1.0, ni = ai;
    const double fr = (nr * lr + ni * li) / den, fi = (ni * lr - nr * li) / den;
    float2* cb = (float2*)(ws + OFF_COEFB) + (size_t)gi * 16;
    for (int c = 0; c < 16; c++) {
      const double br = INP(P, 18)[(size_t)gi * 16 + c], bi = INP(P, 19)[(size_t)gi * 16 + c];
      cb[c] = make_float2((float)(fr * br - fi * bi), (float)(fr * bi + fi * br));
    }
  }
  if (gt < 8 * 129) {
    const int hd = (int)gt / 129, n = (int)gt - hd * 129;
    int bk = n;
    if (n >= 16) { bk = 16 + (int)(log((double)n / 16.0) / log(8.0) * 16.0); bk = bk < 31 ? bk : 31; }
    ((float*)(ws + OFF_BIAS))[gt] = INP(P, 2)[bk * 8 + hd];
  }
  if (gt < 2) {
    const int l = (int)gt;
    float s1 = 0.f, s2 = 0.f;
    for (int i = 0; i < 64; i++) { s1 += INP(P, 10)[l * 64 + i] * INP(P, 11)[l * 64 + i]; s2 += INP(P, 12)[l * 64 + i] * INP(P, 13)[l * 64 + i]; }
    const float lam_init = 0.8f - 0.6f * expf(-0.3f * (float)l);
    ((float*)(ws + OFF_LAM))[l] = expf(s1) - expf(s2) + lam_init;
  }
}

DI void phase_ffn_up(const u16* __restrict__ Xb, const u16* __restrict__ Wgu, u16* __restrict__ H, int bid, int nb, u16* sm) {
  const int lane = tidx() & 63, wave = tidx() >> 6, wm = wave >> 1, wn = wave & 1, r = lane & 31, hh = lane >> 5;
  gemm_phase(512, 44, 1024, 1024, 1024,
    [&](int tm) { return Xb + (size_t)tm * 128 * 1024; }, [&](int tn) { return Wgu + (size_t)tn * 128 * 1024; },
    [&](f32x16 (&acc)[2][2], int tm, int tn) {
      const int j = tn * 64 + wn * 32 + r;
#pragma unroll
      for (int mi = 0; mi < 2; mi++)
#pragma unroll
        for (int i = 0; i < 16; i++) {
          const int row = tm * 128 + wm * 64 + mi * 32 + crow(i, hh);
          const float g = acc[mi][0][i], u = acc[mi][1][i];
          H[(size_t)row * FF_ + j] = f2bf(g * sigmoidf_(g) * u);
        }
    }, bid, nb, sm);
}

DI void phase_ffn_down(const u16* __restrict__ H, const u16* __restrict__ Wd, const float* xin, const u16* __restrict__ xinb, float* xout, const u16* __restrict__ ple, int bid, int nb, u16* sm) {
  const int lane = tidx() & 63, wave = tidx() >> 6, wm = wave >> 1, wn = wave & 1, r = lane & 31, hh = lane >> 5;
  gemm_phase_init(512, 8, FF_, FF_, FF_,
    [&](int tm) { return H + (size_t)tm * 128 * FF_; }, [&](int tn) { return Wd + (size_t)tn * 128 * FF_; },
    [&](f32x16 (&acc)[2][2], int tm, int tn) {
#pragma unroll
      for (int mi = 0; mi < 2; mi++)
#pragma unroll
        for (int ni = 0; ni < 2; ni++)
#pragma unroll
          for (int i = 0; i < 16; i++) {
            const size_t o = (size_t)(tm * 128 + wm * 64 + mi * 32 + crow(i, hh)) * 1024 + tn * 128 + wn * 64 + ni * 32 + r;
            float v = 2.f * ALPHA_ * (xin ? xin[o] : bf2f(xinb[o]));
            if (ple) v += 2.f * bf2f(ple[o]);
            acc[mi][ni][i] = v;
          }
    },
    [&](f32x16 (&acc)[2][2], int tm, int tn) {
#pragma unroll
      for (int mi = 0; mi < 2; mi++)
#pragma unroll
        for (int ni = 0; ni < 2; ni++)
#pragma unroll
          for (int i = 0; i < 16; i++) {
            const size_t o = (size_t)(tm * 128 + wm * 64 + mi * 32 + crow(i, hh)) * 1024 + tn * 128 + wn * 64 + ni * 32 + r;
            xout[o] = 0.5f * acc[mi][ni][i];
          }
    }, bid, nb, sm);
}

DI void phase_w_o(const u16* __restrict__ CC, const u16* __restrict__ Wo, float* x, const u16* __restrict__ xb, int bid, int nb, u16* sm) {
  const int lane = tidx() & 63, wave = tidx() >> 6, wm = wave >> 1, wn = wave & 1, r = lane & 31, hh = lane >> 5;
  gemm_phase_init(512, 8, 1024, 1024, 1024,
    [&](int tm) { return CC + (size_t)tm * 128 * 1024; }, [&](int tn) { return Wo + (size_t)tn * 128 * 1024; },
    [&](f32x16 (&acc)[2][2], int tm, int tn) {
#pragma unroll
      for (int mi = 0; mi < 2; mi++)
#pragma unroll
        for (int ni = 0; ni < 2; ni++)
#pragma unroll
          for (int i = 0; i < 16; i++) {
            const size_t o = (size_t)(tm * 128 + wm * 64 + mi * 32 + crow(i, hh)) * 1024 + tn * 128 + wn * 64 + ni * 32 + r;
            acc[mi][ni][i] = ALPHA_ * bf2f(xb[o]);
          }
    },
    [&](f32x16 (&acc)[2][2], int tm, int tn) {
#pragma unroll
      for (int mi = 0; mi < 2; mi++)
#pragma unroll
        for (int ni = 0; ni < 2; ni++)
#pragma unroll
          for (int i = 0; i < 16; i++) {
            const size_t o = (size_t)(tm * 128 + wm * 64 + mi * 32 + crow(i, hh)) * 1024 + tn * 128 + wn * 64 + ni * 32 + r;
            x[o] = acc[mi][ni][i];
          }
    }, bid, nb, sm);
}

DI void phase_glu(const u16* __restrict__ Yg, const u16* __restrict__ Wglu, u16* __restrict__ CC, int bid, int nb, u16* sm) {
  const int lane = tidx() & 63, wave = tidx() >> 6, wm = wave >> 1, wn = wave & 1, r = lane & 31, hh = lane >> 5;
  gemm_phase(512, 2, 256, 256, 256,
    [&](int tm) { return Yg + (size_t)tm * 128 * 256; }, [&](int tn) { return Wglu + (size_t)tn * 128 * 256; },
    [&](f32x16 (&acc)[2][2], int tm, int tn) {
#pragma unroll
      for (int mi = 0; mi < 2; mi++)
#pragma unroll
        for (int ni = 0; ni < 2; ni++)
#pragma unroll
          for (int i = 0; i < 16; i++) {
            const int row = tm * 128 + wm * 64 + mi * 32 + crow(i, hh), col = tn * 128 + wn * 64 + ni * 32 + r;
            const float y = bf2f(Yg[(size_t)row * 256 + col]);
            CC[(size_t)row * 1024 + 512 + col] = f2bf(y * sigmoidf_(acc[mi][ni][i]));
          }
    }, bid, nb, sm);
}

DI void phase_ple(const u16* __restrict__ Xb, const u16* __restrict__ Wpg, const u16* __restrict__ Pb, const u16* __restrict__ Wpp, u16* ple, int bid, int nb, u16* sm) {
  const int lane = tidx() & 63, wave = tidx() >> 6, wm = wave >> 1, wn = wave & 1, r = lane & 31, hh = lane >> 5;
  gemm_phase(512, 8, 1024, 1024, 1024,
    [&](int tm) { return Xb + (size_t)tm * 128 * 1024; }, [&](int tn) { return Wpg + (size_t)tn * 128 * 1024; },
    [&](f32x16 (&acc)[2][2], int tm, int tn) {
#pragma unroll
      for (int mi = 0; mi < 2; mi++)
#pragma unroll
        for (int ni = 0; ni < 2; ni++)
#pragma unroll
          for (int i = 0; i < 16; i++) {
            const size_t o = (size_t)(tm * 128 + wm * 64 + mi * 32 + crow(i, hh)) * 1024 + tn * 128 + wn * 64 + ni * 32 + r;
            ple[o] = f2bf(sigmoidf_(acc[mi][ni][i]));
          }
    }, bid, nb, sm);
  gemm_phase(512, 8, 256, 256, 256,
    [&](int tm) { return Pb + (size_t)tm * 128 * 256; }, [&](int tn) { return Wpp + (size_t)tn * 128 * 256; },
    [&](f32x16 (&acc)[2][2], int tm, int tn) {
#pragma unroll
      for (int mi = 0; mi < 2; mi++)
#pragma unroll
        for (int ni = 0; ni < 2; ni++)
#pragma unroll
          for (int i = 0; i < 16; i++) {
            const size_t o = (size_t)(tm * 128 + wm * 64 + mi * 32 + crow(i, hh)) * 1024 + tn * 128 + wn * 64 + ni * 32 + r;
            ple[o] = f2bf(acc[mi][ni][i] * bf2f(ple[o]));
          }
    }, bid, nb, sm);
}

DI void phase_w_in(const u16* __restrict__ Xb, const u16* __restrict__ Win, char* mb, int bid, int nb, u16* sm) {
  const int lane = tidx() & 63, wave = tidx() >> 6, wm = wave >> 1, wn = wave & 1, r = lane & 31, hh = lane >> 5;
  u16* Qd = (u16*)(mb + M_QD); u16* Kd = (u16*)(mb + M_KD); u16* Vt = (u16*)(mb + M_VT); float* U = (float*)(mb + M_U);
  u16* Qs = (u16*)(mb + M_QS); u16* Qi = (u16*)(mb + M_QI); u16* Ks = (u16*)(mb + M_KS); u16* Vs = (u16*)(mb + M_VS);
  u16* Ki = (u16*)(mb + M_KI); float* Wi = (float*)(mb + M_WI);
  gemm_phase(512, 20, 1024, 1024, 1024,
    [&](int tm) { return Xb + (size_t)tm * 128 * 1024; }, [&](int tn) { return Win + (size_t)tn * 128 * 1024; },
    [&](f32x16 (&acc)[2][2], int tm, int tn) {
#pragma unroll
    for (int ni = 0; ni < 2; ni++) {
      const int c0 = tn * 128 + wn * 64 + ni * 32;
      const int c = c0 + r;
#pragma unroll
      for (int mi = 0; mi < 2; mi++) {
        const int rowb = tm * 128 + wm * 64 + mi * 32;
        if (c0 >= 1024 && c0 < 1536) {
          const int cc = c - 1024, head = cc >> 7, dv = cc & 127;
          const int b = rowb >> 13, t0 = rowb & 8191;
#pragma unroll
          for (int g4 = 0; g4 < 4; g4++) {
            uint2 v = make_uint2(pack2(acc[mi][ni][4 * g4], acc[mi][ni][4 * g4 + 1]), pack2(acc[mi][ni][4 * g4 + 2], acc[mi][ni][4 * g4 + 3]));
            const int tt = t0 + 8 * g4 + 4 * hh;
            *(uint2*)(Vt + ((size_t)(((b * 4 + head) * 128 + (tt >> 6)) * 128 + dv)) * 64 + (tt & 63)) = v;
          }
        } else {
#pragma unroll
          for (int i = 0; i < 16; i++) {
            const size_t row = rowb + crow(i, hh);
            const float v = acc[mi][ni][i];
            if (c0 < 512) Qd[row * 512 + c] = f2bf(v);
            else if (c0 < 1024) {
              const int cc = c - 512;
              Kd[((size_t)((((int)(row >> 13) * 4 + (cc >> 7)) * 2 + ((cc >> 6) & 1))) * L_ + (row & 8191)) * 64 + (cc & 63)] = f2bf(v);
            }
            else if (c0 < 1792) U[row * 256 + (c - 1536)] = v;
            else if (c0 < 2048) Qs[row * 256 + (c - 1792)] = f2bf(v);
            else if (c0 < 2112) Ks[row * 64 + (c - 2048)] = f2bf(v);
            else if (c0 < 2176) Vs[row * 64 + (c - 2112)] = f2bf(v);
            else if (c0 < 2432) Qi[row * 256 + (c - 2176)] = f2bf(v);
            else if (c0 < 2464) Ki[row * 32 + (c - 2432)] = f2bf(v);
            else if (c0 == 2464) { if (r < 8) Wi[row * 8 + r] = v * 0.0625f; }
          }
        }
      }
    }
  }, bid, nb, sm);
}

DI void phase_ln(float* x, u16* __restrict__ xb, const float* __restrict__ g, const float* __restrict__ bta, bool write_f32, int bid, int nb) {
  const int lane = tidx() & 63, wave = tidx() >> 6;
  float4 gg[4], bb[4];
#pragma unroll
  for (int i = 0; i < 4; i++) { gg[i] = *(const float4*)(g + i * 256 + lane * 4); bb[i] = *(const float4*)(bta + i * 256 + lane * 4); }
  constexpr int RB = 4;
  for (int row0 = (bid * 4 + wave) * RB; row0 < T_; row0 += nb * 4 * RB) {
    float4 v[RB][4];
#pragma unroll
    for (int rr = 0; rr < RB; rr++)
#pragma unroll
      for (int i = 0; i < 4; i++) v[rr][i] = *(const float4*)(x + (size_t)(row0 + rr) * 1024 + i * 256 + lane * 4);
    float s[RB], q[RB];
#pragma unroll
    for (int rr = 0; rr < RB; rr++) {
      s[rr] = 0.f;
#pragma unroll
      for (int i = 0; i < 4; i++) s[rr] += v[rr][i].x + v[rr][i].y + v[rr][i].z + v[rr][i].w;
    }
#pragma unroll
    for (int o = 32; o > 0; o >>= 1)
#pragma unroll
      for (int rr = 0; rr < RB; rr++) s[rr] += __shfl_xor(s[rr], o);
#pragma unroll
    for (int rr = 0; rr < RB; rr++) {
      const float mu = s[rr] * (1.f / 1024.f);
      q[rr] = 0.f;
#pragma unroll
      for (int i = 0; i < 4; i++) {
        v[rr][i].x -= mu; v[rr][i].y -= mu; v[rr][i].z -= mu; v[rr][i].w -= mu;
        q[rr] += v[rr][i].x * v[rr][i].x + v[rr][i].y * v[rr][i].y + v[rr][i].z * v[rr][i].z + v[rr][i].w * v[rr][i].w;
      }
    }
#pragma unroll
    for (int o = 32; o > 0; o >>= 1)
#pragma unroll
      for (int rr = 0; rr < RB; rr++) q[rr] += __shfl_xor(q[rr], o);
#pragma unroll
    for (int rr = 0; rr < RB; rr++) {
      const float rs = rsqrtf(q[rr] * (1.f / 1024.f) + LN_EPS_);
#pragma unroll
      for (int i = 0; i < 4; i++) {
        float4 o;
        o.x = v[rr][i].x * rs * gg[i].x + bb[i].x; o.y = v[rr][i].y * rs * gg[i].y + bb[i].y;
        o.z = v[rr][i].z * rs * gg[i].z + bb[i].z; o.w = v[rr][i].w * rs * gg[i].w + bb[i].w;
        if (write_f32) *(float4*)(x + (size_t)(row0 + rr) * 1024 + i * 256 + lane * 4) = o;
        *(uint2*)(xb + (size_t)(row0 + rr) * 1024 + i * 256 + lane * 4) = make_uint2(pack2(o.x, o.y), pack2(o.z, o.w));
      }
    }
  }
}

DI float gelu_tanh(float x) { const float u = 0.7978845608028654f * (x + 0.044715f * x * x * x); return 0.5f * x * (1.f + tanhf(u)); }

typedef __attribute__((ext_vector_type(4))) float f32x4;
template <bool OUT>
DI void ssm_scan(const Params& P, int layer, int widx, char* mb, char* smem) {
  const int lane = tidx() & 63, wave = tidx() >> 6;
  const int b = widx >> 8, g = (widx >> 4) & 15, ch = widx & 15;
  const int gi = (layer * 16 + g) * 64 + lane;
  const float4 ca = ((const float4*)(WS(P) + OFF_COEFA))[gi];
  const float2* cbp = (const float2*)(WS(P) + OFF_COEFB) + (size_t)gi * 16;
  float bre[16], bim[16];
#pragma unroll
  for (int c = 0; c < 16; c++) { float2 t = cbp[c]; bre[c] = t.x; bim[c] = t.y; }
  const float* U = (const float*)(mb + M_U);
  float2* Send = (float2*)(mb + M_SEND);
  const size_t sbase = (size_t)((b * 16 + g) * 16) * 64 + lane;
  float xr = 0.f, xi = 0.f;
  float am[32];
  float4 dsk4 = make_float4(0.f, 0.f, 0.f, 0.f);
  float* Xs = (float*)smem + wave * (128 * 17);
  const int lm = lane & 15, lq = lane >> 4;
  if (OUT) {
    for (int j = 0; j < ch; j++) {
      const float2 e = Send[sbase + (size_t)j * 64];
      const float nr = ca.z * xr - ca.w * xi + e.x, ni = ca.z * xi + ca.w * xr + e.y;
      xr = nr; xi = ni;
    }
    const float* cre = INP(P, 20) + ((size_t)(layer * 16 + g) * 16 + lm) * 64;
    const float* cim = INP(P, 21) + ((size_t)(layer * 16 + g) * 16 + lm) * 64;
#pragma unroll
    for (int kb = 0; kb < 32; kb++) {
      const int kk = 4 * kb + lq;
      am[kb] = (kb < 16) ? cre[kk] : -cim[kk - 64];
    }
    dsk4 = *(const float4*)(INP(P, 22) + layer * 256 + g * 16 + 4 * lq);
  }
  u16* Yg = (u16*)(mb + M_YG);
  const size_t tok0 = (size_t)b * L_ + ch * 512;
  const float* ub = U + (tok0 + (lane >> 2)) * 256 + g * 16 + (lane & 3) * 4;
  float4 cur = *(const float4*)ub;
#pragma unroll 1
  for (int blk = 0; blk < 32; blk++) {
    const float4 nxt = *(const float4*)(ub + (size_t)min(blk + 1, 31) * 16 * 256);
#pragma unroll
    for (int s16 = 0; s16 < 16; s16++) {
      float uu[16];
#pragma unroll
      for (int c = 0; c < 16; c++) {
        const float comp = ((c & 3) == 0) ? cur.x : ((c & 3) == 1) ? cur.y : ((c & 3) == 2) ? cur.z : cur.w;
        uu[c] = __int_as_float(__builtin_amdgcn_readlane(__float_as_int(comp), 4 * s16 + (c >> 2)));
      }
      float br4[4] = {0.f, 0.f, 0.f, 0.f}, bi4[4] = {0.f, 0.f, 0.f, 0.f};
#pragma unroll
      for (int c = 0; c < 16; c++) { br4[c & 3] += bre[c] * uu[c]; bi4[c & 3] += bim[c] * uu[c]; }
      const float br = (br4[0] + br4[1]) + (br4[2] + br4[3]), bi = (bi4[0] + bi4[1]) + (bi4[2] + bi4[3]);
      const float nr = ca.x * xr - ca.y * xi + br, ni = ca.x * xi + ca.y * xr + bi;
      xr = nr; xi = ni;
      if (OUT) { Xs[lane * 17 + s16] = xr; Xs[(64 + lane) * 17 + s16] = xi; }
    }
    if (OUT) {
      __builtin_amdgcn_wave_barrier();
      f32x4 acc = {0.f, 0.f, 0.f, 0.f}, acc2 = {0.f, 0.f, 0.f, 0.f};
#pragma unroll
      for (int kb = 0; kb < 32; kb += 2) {
        const float bv0 = Xs[(4 * kb + lq) * 17 + lm], bv1 = Xs[(4 * kb + 4 + lq) * 17 + lm];
        acc = __builtin_amdgcn_mfma_f32_16x16x4f32(am[kb], bv0, acc, 0, 0, 0);
        acc2 = __builtin_amdgcn_mfma_f32_16x16x4f32(am[kb + 1], bv1, acc2, 0, 0, 0);
      }
      acc += acc2;
      __builtin_amdgcn_wave_barrier();
      const size_t tok = tok0 + blk * 16 + lm;
      const float4 u4 = *(const float4*)(U + tok * 256 + g * 16 + 4 * lq);
      const float y0 = gelu_tanh(acc[0] + dsk4.x * u4.x), y1 = gelu_tanh(acc[1] + dsk4.y * u4.y);
      const float y2 = gelu_tanh(acc[2] + dsk4.z * u4.z), y3 = gelu_tanh(acc[3] + dsk4.w * u4.w);
      *(uint2*)(Yg + tok * 256 + g * 16 + 4 * lq) = make_uint2(pack2(y0, y1), pack2(y2, y3));
    }
    cur = nxt;
  }
  if (!OUT) Send[sbase + (size_t)ch * 64] = make_float2(xr, xi);
}

constexpr int KS_ = 72, VS_ = 68;
DI void da_item(const Params& P, int layer, int b, int h, int qt, char* mb, char* smem) {
  const int tid = tidx(), lane = tid & 63, wave = tid >> 6, r = lane & 31, hh = lane >> 5;
  u16* sK0 = (u16*)smem;
  u16* sV0 = sK0 + 2 * 64 * KS_;
  float* sbias = (float*)(sV0 + 2 * 128 * VS_);
  u16* sQw = (u16*)(smem + 54272) + (tidx() >> 6) * 32 * KS_;
  const u16* Qd = (const u16*)(mb + M_QD); const u16* Kd = (const u16*)(mb + M_KD); const u16* Vt = (const u16*)(mb + M_VT);
  u16* CC = (u16*)(WS(P) + OFF_CC);
  const int q0 = qt * 128, qw = q0 + wave * 32, qp = qw + r;
  const size_t tokq = (size_t)b * L_ + qp;
  __syncthreads();
  if (tid < 129) sbias[tid] = ((const float*)(WS(P) + OFF_BIAS))[h * 129 + tid] * LOG2E_;
  __syncthreads();
  const float bfar = sbias[128];
  const float SC = 0.125f * LOG2E_;
  const int nkt = (q0 + 128) >> 6;
  const float lam = ((const float*)(WS(P) + OFF_LAM))[layer];
  const int krow_l = tid >> 3, kch = (tid & 7) * 8;
#pragma unroll 1
  for (int c = 0; c < 2; c++) {
#pragma unroll
    for (int ks = 0; ks < 4; ks++) *(bf16x8*)(sQw + r * KS_ + ks * 16 + hh * 8) = *(const bf16x8*)(Qd + tokq * 512 + h * 128 + c * 64 + ks * 16 + hh * 8);
    f32x16 o[4] = {zero16(), zero16(), zero16(), zero16()};
    float m = -INFINITY, l = 0.f;
    const u16* Kbase = Kd + ((size_t)(((b * 4 + h) * 2 + c)) * L_ + krow_l) * 64 + kch;
    const u16* Vbase = Vt + ((size_t)((b * 4 + h) * 128) * 128 + krow_l) * 64 + kch;
    u32x4 rk[2], rv[4];
#pragma unroll
    for (int i = 0; i < 2; i++) rk[i] = *(const u32x4*)(Kbase + (size_t)(i * 32) * 64);
#pragma unroll
    for (int i = 0; i < 4; i++) rv[i] = *(const u32x4*)(Vbase + (size_t)(i * 32) * 64);
#define DA_STAGE(BUF) { u16* sKw = sK0 + (BUF) * 64 * KS_; u16* sVw = sV0 + (BUF) * 128 * VS_; \
      _Pragma("unroll") for (int i = 0; i < 2; i++) *(u32x4*)(sKw + (krow_l + i * 32) * KS_ + kch) = rk[i]; \
      _Pragma("unroll") for (int i = 0; i < 4; i++) { u32x2* d = (u32x2*)(sVw + (krow_l + i * 32) * VS_ + kch); \
        u32x2 lo2, hi2; lo2.x = rv[i].x; lo2.y = rv[i].y; hi2.x = rv[i].z; hi2.y = rv[i].w; d[0] = lo2; d[1] = hi2; } }
#define DA_FETCH(T) { const int ktn_ = min((T), nkt - 1); \
      _Pragma("unroll") for (int i = 0; i < 2; i++) rk[i] = *(const u32x4*)(Kbase + (size_t)(ktn_ * 64 + i * 32) * 64); \
      _Pragma("unroll") for (int i = 0; i < 4; i++) rv[i] = *(const u32x4*)(Vbase + (size_t)ktn_ * 8192 + (size_t)(i * 32) * 64); }
    __syncthreads();
    DA_STAGE(0)
    DA_FETCH(1)
    __syncthreads();
#pragma unroll 1
    for (int kt = 0; kt < nkt; kt++) {
      const u16* sK = sK0 + (kt & 1) * 64 * KS_;
      const u16* sV = sV0 + (kt & 1) * 128 * VS_;
      if (kt + 1 < nkt) { DA_STAGE((kt + 1) & 1) }
      DA_FETCH(kt + 2)
      if (kt * 64 <= qw + 31) {
        f32x16 s[2];
#pragma unroll
        for (int kb = 0; kb < 2; kb++) {
          s[kb] = zero16();
#pragma unroll
          for (int ks = 0; ks < 4; ks++) {
            const bf16x8 kf = *(const bf16x8*)(sK + (kb * 32 + r) * KS_ + ks * 16 + hh * 8);
            const bf16x8 qf = *(const bf16x8*)(sQw + r * KS_ + ks * 16 + hh * 8);
            s[kb] = MFMA32(kf, qf, s[kb]);
          }
        }
        const bool nearb = (kt * 64 + 63 + 128 > qw);
        float mx = -INFINITY;
        if (nearb) {
#pragma unroll
          for (int kb = 0; kb < 2; kb++)
#pragma unroll
            for (int i = 0; i < 16; i++) {
              const int dist = qp - (kt * 64 + kb * 32 + crow(i, hh));
              const float bv = sbias[min(max(dist, 0), 128)];
              float t = s[kb][i] * SC + bv;
              t = (dist >= 0) ? t : -INFINITY;
              s[kb][i] = t; mx = fmaxf(mx, t);
              if ((i & 7) == 7) __builtin_amdgcn_sched_barrier(0);
            }
        } else {
#pragma unroll
          for (int kb = 0; kb < 2; kb++)
#pragma unroll
            for (int i = 0; i < 16; i++) { const float t = s[kb][i] * SC + bfar; s[kb][i] = t; mx = fmaxf(mx, t); }
        }
        mx = fmaxf(mx, __shfl_xor(mx, 32));
        const float mn = fmaxf(m, mx);
        const float corr = __builtin_amdgcn_exp2f(m - mn);
        m = mn;
        float ls = 0.f;
#pragma unroll
        for (int kb = 0; kb < 2; kb++)
#pragma unroll
          for (int i = 0; i < 16; i++) { const float p = __builtin_amdgcn_exp2f(s[kb][i] - mn); s[kb][i] = p; ls += p; }
        l = l * corr + ls;
        if (__ballot(corr != 1.f) != 0ull) {
#pragma unroll
          for (int dt = 0; dt < 4; dt++)
#pragma unroll
            for (int i = 0; i < 16; i++) o[dt][i] *= corr;
        }
#pragma unroll
        for (int kb = 0; kb < 2; kb++)
#pragma unroll
          for (int s2 = 0; s2 < 2; s2++) {
            const bf16x8 pf = pack8(s[kb], s2);
#pragma unroll
            for (int dt = 0; dt < 4; dt++) {
              const u16* vp = sV + (dt * 32 + r) * VS_ + kb * 32 + s2 * 16 + 4 * hh;
              const s16x4 lo = *(const s16x4*)vp, hi = *(const s16x4*)(vp + 8);
              const bf16x8 vf = __builtin_shufflevector(lo, hi, 0, 1, 2, 3, 4, 5, 6, 7);
              o[dt] = MFMA32(vf, pf, o[dt]);
            }
            __builtin_amdgcn_sched_barrier(0);
          }
      }
      __syncthreads();
    }
#undef DA_STAGE
#undef DA_FETCH
    const float lt = l + __shfl_xor(l, 32);
    const float inv = 1.f / lt;
    size_t tq = tokq;
    asm volatile("" : "+v"(tq));
    u16* obase = CC + tq * 1024 + h * 128 + 4 * hh;
    if (c == 0) {
#pragma unroll
      for (int dt = 0; dt < 4; dt++)
#pragma unroll
        for (int g4 = 0; g4 < 4; g4++) {
          *(uint2*)(obase + dt * 32 + 8 * g4) = make_uint2(pack2(o[dt][4 * g4] * inv, o[dt][4 * g4 + 1] * inv), pack2(o[dt][4 * g4 + 2] * inv, o[dt][4 * g4 + 3] * inv));
        }
    } else {
      float ss = 0.f;
#pragma unroll
      for (int dt = 0; dt < 4; dt++)
#pragma unroll
        for (int g4 = 0; g4 < 4; g4++) {
          const uint2 pv = *(const uint2*)(obase + dt * 32 + 8 * g4);
          const float a4[4] = {bf2f((u16)(pv.x & 0xffff)), bf2f((u16)(pv.x >> 16)), bf2f((u16)(pv.y & 0xffff)), bf2f((u16)(pv.y >> 16))};
#pragma unroll
          for (int e = 0; e < 4; e++) { const float v = a4[e] - lam * o[dt][4 * g4 + e] * inv; o[dt][4 * g4 + e] = v; ss = __builtin_fmaf(v, v, ss); }
        }
      ss += __shfl_xor(ss, 32);
      const float lam_init = 0.8f - 0.6f * __expf(-0.3f * (float)layer);
      const float rn = rsqrtf(ss * (1.f / 128.f) + LN_EPS_) * (1.f - lam_init);
      int hh2 = hh;
      asm volatile("" : "+v"(hh2));
      const float* sg = INP(P, 14) + layer * 128 + 4 * hh2;
#pragma unroll
      for (int dt = 0; dt < 4; dt++)
#pragma unroll
        for (int g4 = 0; g4 < 4; g4++) {
          const int dv = dt * 32 + 8 * g4 + 4 * hh;
          const float4 gv = *(const float4*)(sg + dt * 32 + 8 * g4);
          uint2 w = make_uint2(pack2(o[dt][4 * g4] * rn * gv.x, o[dt][4 * g4 + 1] * rn * gv.y),
                               pack2(o[dt][4 * g4 + 2] * rn * gv.z, o[dt][4 * g4 + 3] * rn * gv.w));
          *(uint2*)(obase + dv - 4 * hh) = w;
        }
    }
  }
}

DI unsigned sortkey(float f) { const unsigned u = __float_as_uint(f + 0.f); return u ^ (((unsigned)((int)u >> 31)) | 0x80000000u); }

DI void dsa_item(const Params& P, int layer, int b, int qt, char* mb, char* smem) {
  const int tid = tidx(), lane = tid & 63, wave = tid >> 6, r = lane & 31, hh = lane >> 5;
  unsigned* hist = (unsigned*)smem;
  float* sP = (float*)smem;
  float* sQ = (float*)(smem + 16384);
  u16* sidx = (u16*)(smem + 32896);
  unsigned* meta = (unsigned*)(smem + 49280);
  float* sbias = (float*)(smem + 50304);
  const u16* Qi = (const u16*)(mb + M_QI); const u16* Ki = (const u16*)(mb + M_KI); const float* Wi = (const float*)(mb + M_WI);
  const u16* Qs = (const u16*)(mb + M_QS); const u16* Ks = (const u16*)(mb + M_KS); const u16* Vs = (const u16*)(mb + M_VS);
  u16* CC = (u16*)(WS(P) + OFF_CC);
  const int q0 = qt * 32;
  const int qp = q0 + r;
  const size_t tokb = (size_t)b * L_;
  const int nk32 = qt + 1;
  const bool radix = (q0 >= 256);
  __syncthreads();
  for (int i = tid; i < 4 * 129; i += 256) sbias[i] = ((const float*)(WS(P) + OFF_BIAS))[4 * 129 + i];
  meta[tid] = (tid >= 32 && tid < 64) ? 256u : 0u;
  char* sQi = smem + 52384;
  float* sWi = (float*)(smem + 69280);
  constexpr int CAPL_ = 64;
  unsigned* lK = (unsigned*)smem;
  u16* lI = (u16*)(smem + 32 * CAPL_ * 4);
  {
    const int row = tid >> 3, ch = tid & 7;
    const uint4* src = (const uint4*)(Qi + (tokb + q0 + row) * 256 + ch * 32);
    uint4* dst = (uint4*)(sQi + row * 528 + ch * 64);
    dst[0] = src[0]; dst[1] = src[1]; dst[2] = src[2]; dst[3] = src[3];
    sWi[tid] = Wi[(tokb + q0) * 8 + tid];
  }
  int pass = radix ? 0 : 4;
  bool fast = false;
#pragma unroll 1
  while (true) {
    __syncthreads();
    if (pass < 4) { for (int i = tid; i < 32 * 257; i += 256) hist[i] = 0u; }
    __syncthreads();
    const unsigned pref = meta[r];
    const unsigned krem = meta[32 + r];
    auto elems = [&](const f32x16& sc, const int kt, const int lim) __attribute__((always_inline)) {
      if (pass == 0) {
#pragma unroll
        for (int i = 0; i < 16; i++) {
          const int kp = kt * 32 + crow(i, hh);
          const unsigned key = sortkey(sc[i]);
          const unsigned bin = (kp <= lim) ? (key >> 24) : 256u;
          atomicAdd(&hist[r * 257 + bin], 1u);
        }
      } else if (pass < 4) {
        const int sh = 24 - 8 * pass;
#pragma unroll
        for (int i = 0; i < 16; i++) {
          const int kp = kt * 32 + crow(i, hh);
          const unsigned key = sortkey(sc[i]);
          if ((key >> (sh + 8)) == pref && kp <= lim) atomicAdd(&hist[r * 257 + ((key >> sh) & 255u)], 1u);
        }
      } else if (pass == 5) {
        unsigned mc = 0u, ms = 0u;
        unsigned keys[16];
#pragma unroll
        for (int i = 0; i < 16; i++) {
          const int kp = kt * 32 + crow(i, hh);
          keys[i] = sortkey(sc[i]);
          const unsigned bt = keys[i] >> 16;
          const bool valid = (kp <= lim);
          ms |= (valid && bt > pref) ? (1u << i) : 0u;
          mc |= (valid && bt == pref) ? (1u << i) : 0u;
        }
        unsigned base_c = 0u, base_s = 0u;
        if (mc) base_c = atomicAdd(&meta[128 + r], (unsigned)__popc(mc));
        if (ms) base_s = atomicAdd(&meta[64 + r], (unsigned)__popc(ms));
#pragma unroll
        for (int i = 0; i < 16; i++) {
          const int kp = kt * 32 + crow(i, hh);
          if ((mc >> i) & 1u) {
            const unsigned cp = base_c + (unsigned)__popc(mc & ((1u << i) - 1u));
            if (cp < (unsigned)CAPL_) { lK[r * CAPL_ + cp] = keys[i]; lI[r * CAPL_ + cp] = (u16)kp; }
          }
          if ((ms >> i) & 1u) {
            const unsigned pos = base_s + (unsigned)__popc(ms & ((1u << i) - 1u));
            if (pos < 256u) sidx[r * 256 + pos] = (u16)kp;
          }
        }
      } else {
#pragma unroll
        for (int i = 0; i < 16; i++) {
          const int kp = kt * 32 + crow(i, hh);
          const unsigned key = sortkey(sc[i]);
          bool sel = (kp <= lim);
          if (radix) {
            sel = sel && (key >= pref);
            if (sel && key == pref) sel = atomicAdd(&meta[96 + r], 1u) < krem;
          }
          if (sel) { const unsigned pos = atomicAdd(&meta[64 + r], 1u); if (pos < 256u) sidx[r * 256 + pos] = (u16)kp; }
        }
      }
    };
    const int klast = nk32 - 1;
    bf16x8 nA0 = {0, 0, 0, 0, 0, 0, 0, 0}, nA1 = nA0, nB0 = nA0, nB1 = nA0;
    if (wave < nk32) {
      const int ka = wave, kb2 = min(wave + 4, klast);
      nA0 = *(const bf16x8*)(Ki + (tokb + ka * 32 + r) * 32 + hh * 8);
      nA1 = *(const bf16x8*)(Ki + (tokb + ka * 32 + r) * 32 + 16 + hh * 8);
      nB0 = *(const bf16x8*)(Ki + (tokb + kb2 * 32 + r) * 32 + hh * 8);
      nB1 = *(const bf16x8*)(Ki + (tokb + kb2 * 32 + r) * 32 + 16 + hh * 8);
    }
#pragma unroll 1
    for (int kt = wave; kt < nk32; kt += 8) {
      const bf16x8 kA0 = nA0, kA1 = nA1, kB0 = nB0, kB1 = nB1;
      {
        const int ka = min(kt + 8, klast), kb2 = min(kt + 12, klast);
        nA0 = *(const bf16x8*)(Ki + (tokb + ka * 32 + r) * 32 + hh * 8);
        nA1 = *(const bf16x8*)(Ki + (tokb + ka * 32 + r) * 32 + 16 + hh * 8);
        nB0 = *(const bf16x8*)(Ki + (tokb + kb2 * 32 + r) * 32 + hh * 8);
        nB1 = *(const bf16x8*)(Ki + (tokb + kb2 * 32 + r) * 32 + 16 + hh * 8);
      }
      f32x16 scA = zero16(), scB = zero16();
#pragma unroll 2
      for (int hd = 0; hd < 8; hd++) {
        const bf16x8 q0f = *(const bf16x8*)(sQi + r * 528 + hd * 64 + hh * 16);
        const bf16x8 q1f = *(const bf16x8*)(sQi + r * 528 + hd * 64 + 32 + hh * 16);
        const float w = sWi[r * 8 + hd];
        f32x16 sa = MFMA32(kA0, q0f, zero16());
        f32x16 sb = MFMA32(kB0, q0f, zero16());
        sa = MFMA32(kA1, q1f, sa);
        sb = MFMA32(kB1, q1f, sb);
#pragma unroll
        for (int i = 0; i < 16; i++) {
          scA[i] += __int_as_float(max(__float_as_int(sa[i]), 0)) * w;
          scB[i] += __int_as_float(max(__float_as_int(sb[i]), 0)) * w;
        }
      }
      elems(scA, kt, (kt == qt) ? qp : 0x7fffffff);
      if (kt + 4 < nk32) elems(scB, kt + 4, (kt + 4 == qt) ? qp : 0x7fffffff);
    }
    __syncthreads();
    if (pass < 4) {
      for (int j = 0; j < 8; j++) {
        const int qq = wave * 8 + j;
        const unsigned k = meta[32 + qq];
        unsigned c4[4]; unsigned tot = 0;
#pragma unroll
        for (int e = 0; e < 4; e++) { c4[e] = hist[qq * 257 + 255 - 4 * lane - e]; tot += c4[e]; }
        unsigned incl = tot;
        for (int o = 1; o < 64; o <<= 1) { const unsigned t = __shfl_up(incl, o); if (lane >= o) incl += t; }
        unsigned run = incl - tot;
#pragma unroll
        for (int e = 0; e < 4; e++) {
          if (run < k && run + c4[e] >= k) {
            meta[qq] = (meta[qq] << 8) | (unsigned)(255 - 4 * lane - e); meta[32 + qq] = k - run;
            if (pass == 1 && c4[e] > (unsigned)CAPL_) meta[192] = 1u;
          }
          run += c4[e];
        }
      }
    }
    if (pass >= 4) break;
    if (pass == 1) { __syncthreads(); fast = (meta[192] == 0u); pass = fast ? 5 : 2; } else pass++;
  }
  __syncthreads();
  if (fast) {
#pragma unroll 1
    for (int j = 0; j < 8; j++) {
      const int qq = wave * 8 + j;
      const int c = min((int)meta[128 + qq], CAPL_);
      const unsigned k = meta[32 + qq];
      const bool in = lane < c;
      const unsigned mykey = in ? lK[qq * CAPL_ + lane] : 0u;
      const unsigned myidx = in ? (unsigned)lI[qq * CAPL_ + lane] : 0u;
      unsigned rank = 0u;
      for (int t = 0; t < c; t++) {
        const unsigned ok = __shfl(mykey, t);
        rank += (ok > mykey || (ok == mykey && t < lane)) ? 1u : 0u;
      }
      const bool sel = in && (rank < k);
      const unsigned long long m = __ballot(sel);
      const unsigned base = meta[64 + qq];
      if (sel) {
        const unsigned pos = base + (unsigned)__popcll(m & ((1ull << lane) - 1ull));
        if (pos < 256u) sidx[qq * 256 + pos] = (u16)myidx;
      }
      __builtin_amdgcn_wave_barrier();
      if (lane == 0) meta[64 + qq] = base + (unsigned)__popcll(m);
    }
    __syncthreads();
  }
  float* myP = sP + wave * 1024;
  (void)sQ;
  bf16x8 qn[4];
#pragma unroll
  for (int ks = 0; ks < 4; ks++) {
    bf16x8 z = {0, 0, 0, 0, 0, 0, 0, 0};
    if (r < 4) z = *(const bf16x8*)(Qs + (tokb + q0 + wave * 8) * 256 + r * 64 + ks * 16 + hh * 8);
    qn[ks] = z;
  }
#pragma unroll 1
  for (int j = 0; j < 8; j++) {
    const int qq = wave * 8 + j;
    const int qpos = q0 + qq;
    const size_t tok = tokb + qpos;
    const int n = min((int)meta[64 + qq], 256);
    __syncthreads();
    bf16x8 qf[4];
#pragma unroll
    for (int ks = 0; ks < 4; ks++) qf[ks] = qn[ks];
    {
      const size_t tokn = tokb + q0 + wave * 8 + min(j + 1, 7);
#pragma unroll
      for (int ks = 0; ks < 4; ks++) {
        bf16x8 z = {0, 0, 0, 0, 0, 0, 0, 0};
        if (r < 4) z = *(const bf16x8*)(Qs + tokn * 256 + r * 64 + ks * 16 + hh * 8);
        qn[ks] = z;
      }
    }
#pragma unroll 4
    for (int kb = 0; kb < 8; kb++) {
      const int jj = kb * 32 + r;
      const int kidx = (jj < n) ? (int)sidx[qq * 256 + jj] : 0;
      const u16* kp = Ks + (tokb + kidx) * 64 + hh * 8;
      bf16x8 kf[4];
#pragma unroll
      for (int ks = 0; ks < 4; ks++) kf[ks] = *(const bf16x8*)(kp + ks * 16);
      f32x16 sacc = zero16();
#pragma unroll
      for (int ks = 0; ks < 4; ks++) sacc = MFMA32(kf[ks], qf[ks], sacc);
      if (r < 4) {
#pragma unroll
        for (int i = 0; i < 16; i++) myP[(kb * 32 + crow(i, hh)) * 4 + r] = sacc[i];
      }
    }
    __syncthreads();
    float sc[4][4];
#pragma unroll
    for (int rd = 0; rd < 4; rd++) {
      const int jj = rd * 64 + lane;
      const bool valid = jj < n;
      const int kidx = valid ? (int)sidx[qq * 256 + jj] : 0;
      const int dist = min(max(qpos - kidx, 0), 128);
      const float4 d = *(const float4*)(myP + jj * 4);
      sc[rd][0] = valid ? d.x * 0.125f + sbias[0 * 129 + dist] : -INFINITY;
      sc[rd][1] = valid ? d.y * 0.125f + sbias[1 * 129 + dist] : -INFINITY;
      sc[rd][2] = valid ? d.z * 0.125f + sbias[2 * 129 + dist] : -INFINITY;
      sc[rd][3] = valid ? d.w * 0.125f + sbias[3 * 129 + dist] : -INFINITY;
    }
#pragma unroll
    for (int hd = 0; hd < 4; hd++) {
      float mx = fmaxf(fmaxf(sc[0][hd], sc[1][hd]), fmaxf(sc[2][hd], sc[3][hd]));
      mx = wave_max(mx);
      float sm = 0.f;
#pragma unroll
      for (int rd = 0; rd < 4; rd++) { sc[rd][hd] = __expf(sc[rd][hd] - mx); sm += sc[rd][hd]; }
      sm = wave_sum(sm);
      const float inv = 1.f / sm;
#pragma unroll
      for (int rd = 0; rd < 4; rd++) sc[rd][hd] *= inv;
    }
#pragma unroll
    for (int rd = 0; rd < 4; rd++) *(float4*)(myP + (rd * 64 + lane) * 4) = make_float4(sc[rd][0], sc[rd][1], sc[rd][2], sc[rd][3]);
    __syncthreads();
    const int g = lane >> 3, c8 = lane & 7;
    float acc[32];
#pragma unroll
    for (int i = 0; i < 32; i++) acc[i] = 0.f;
#pragma unroll 16
    for (int it = 0; it < 32; it++) {
      const int jj = it * 8 + g;
      const int kidx = (jj < n) ? (int)sidx[qq * 256 + jj] : 0;
      const float4 pj = *(const float4*)(myP + jj * 4);
      const u32x4 vv = *(const u32x4*)(Vs + (tokb + kidx) * 64 + c8 * 8);
      const float vf[8] = {bf2f((u16)(vv.x & 0xffff)), bf2f((u16)(vv.x >> 16)), bf2f((u16)(vv.y & 0xffff)), bf2f((u16)(vv.y >> 16)),
                           bf2f((u16)(vv.z & 0xffff)), bf2f((u16)(vv.z >> 16)), bf2f((u16)(vv.w & 0xffff)), bf2f((u16)(vv.w >> 16))};
#pragma unroll
      for (int e = 0; e < 8; e++) {
        acc[0 * 8 + e] += pj.x * vf[e]; acc[1 * 8 + e] += pj.y * vf[e];
        acc[2 * 8 + e] += pj.z * vf[e]; acc[3 * 8 + e] += pj.w * vf[e];
      }
    }
    const bool b5 = lane & 32, b4 = lane & 16, b3 = lane & 8;
    float w16[16], w8[8], w4[4];
#pragma unroll
    for (int i = 0; i < 16; i++) { const float snd = b5 ? acc[i] : acc[i + 16]; const float rcv = __shfl_xor(snd, 32); w16[i] = (b5 ? acc[i + 16] : acc[i]) + rcv; }
#pragma unroll
    for (int i = 0; i < 8; i++) { const float snd = b4 ? w16[i] : w16[i + 8]; const float rcv = __shfl_xor(snd, 16); w8[i] = (b4 ? w16[i + 8] : w16[i]) + rcv; }
#pragma unroll
    for (int i = 0; i < 4; i++) { const float snd = b3 ? w8[i] : w8[i + 4]; const float rcv = __shfl_xor(snd, 8); w4[i] = (b3 ? w8[i + 4] : w8[i]) + rcv; }
    const int hd = (b5 ? 2 : 0) + (b4 ? 1 : 0);
    *(uint2*)(CC + tok * 1024 + 768 + hd * 64 + c8 * 8 + (b3 ? 4 : 0)) = make_uint2(pack2(w4[0], w4[1]), pack2(w4[2], w4[3]));
  }
}

DI void phase_mix1(const Params& P, int layer, int bid, int nb, char* smem) {
  char* mb = WS(P) + OFF_H;
  for (int w = bid * 4 + (tidx() >> 6); w < 2048; w += nb * 4) ssm_scan<false>(P, layer, w, mb, smem);
  for (int j = 0;; j++) {
    const int idx = (j & 1) ? (j * nb + (nb - 1 - bid)) : (j * nb + bid);
    if (j * nb >= 2048) break;
    if (idx >= 2048) continue;
    const int qt = 255 - (idx >> 3), b = idx & 7;
    dsa_item(P, layer, b, qt, mb, smem);
  }
  for (int j = 0;; j++) {
    const int idx = (j & 1) ? (j * nb + (nb - 1 - bid)) : (j * nb + bid);
    if (j * nb >= 2048) break;
    if (idx >= 2048) continue;
    const int qt = 63 - (idx >> 5), bh = idx & 31;
    da_item(P, layer, bh >> 2, bh & 3, qt, mb, smem);
  }
}

DI void phase_mix2(const Params& P, int layer, int bid, int nb, char* smem) {
  char* mb = WS(P) + OFF_H;
  for (int w = bid * 4 + (tidx() >> 6); w < 2048; w += nb * 4) ssm_scan<true>(P, layer, w, mb, smem);
}

DI void run_phase(const Params& P, int ph, int bid, int nb, char* smem) {
  char* ws = WS(P);
  u16* sm = (u16*)smem;
  if (ph == 0) { phase_prep(P, bid, nb, smem); return; }
  const int l = (ph - 1) / 12, s = (ph - 1) % 12;
  u16* Xb = (u16*)(ws + OFF_XB);
  u16* H = (u16*)(ws + OFF_H);
  u16* CC = (u16*)(ws + OFF_CC);
  float* X = OUTP(P);
  switch (s) {
    case 0: phase_ffn_up(Xb, (const u16*)(ws + OFF_WGU1 + l * SZ_WGU), H, bid, nb, sm); break;
    case 1: phase_ffn_down(H, (const u16*)(ws + OFF_WD1 + l * SZ_WD), (l == 0) ? INP(P, 0) : (const float*)nullptr, Xb, X, nullptr, bid, nb, sm); break;
    case 2: phase_ln(X, Xb, INP(P, 6) + l * 1024, INP(P, 7) + l * 1024, false, bid, nb); break;
    case 3: phase_w_in(Xb, (const u16*)(ws + OFF_WIN + l * SZ_WIN), ws + OFF_H, bid, nb, sm); break;
    case 4: phase_mix1(P, l, bid, nb, smem); break;
    case 5: phase_mix2(P, l, bid, nb, smem); break;
    case 6: phase_glu((const u16*)(ws + OFF_H + M_YG), (const u16*)(ws + OFF_WGLU + l * SZ_WGLU), CC, bid, nb, sm); break;
    case 7: phase_w_o(CC, (const u16*)(ws + OFF_WO + l * SZ_WO), X, Xb, bid, nb, sm); break;
    case 8: phase_ln(X, Xb, INP(P, 24) + l * 1024, INP(P, 25) + l * 1024, false, bid, nb); break;
    case 9:
      phase_ffn_up(Xb, (const u16*)(ws + OFF_WGU2 + l * SZ_WGU), H, bid, nb, sm);
      phase_ple(Xb, (const u16*)(ws + OFF_WPG + l * SZ_WPG), (const u16*)(ws + OFF_PB) + (size_t)l * T_ * 256, (const u16*)(ws + OFF_WPP + l * SZ_WPP), CC, bid, nb, sm);
      break;
    case 10: phase_ffn_down(H, (const u16*)(ws + OFF_WD2 + l * SZ_WD), (const float*)nullptr, Xb, X, CC, bid, nb, sm); break;
    case 11: phase_ln(X, Xb, INP(P, 31) + l * 1024, INP(P, 32) + l * 1024, l == 1, bid, nb); break;
  }
}

#define XB_TMO      128
#define XB_XCNT(j)  (256  + 64 * (j))
#define XB_XSUB(j)  (1280 + 64 * (j))
#define XB_XGEN(j)  (2304 + 64 * (j))
#define XB_TOP      3328
#define XB_TOPGEN   3392
#define XCD_BAR_WORDS 3456
#define XB_SPIN_CAP (1u << 22)
#define LAS __attribute__((address_space(3)))

__device__ __forceinline__ unsigned xb_ld(unsigned* p)              { return __hip_atomic_load(p, __ATOMIC_RELAXED, __HIP_MEMORY_SCOPE_AGENT); }
__device__ __forceinline__ unsigned xb_add(unsigned* p, unsigned v) { return __hip_atomic_fetch_add(p, v, __ATOMIC_RELAXED, __HIP_MEMORY_SCOPE_AGENT); }
__device__ __forceinline__ unsigned xb_xcc_id() { return (unsigned)__builtin_amdgcn_s_getreg((3 << 11) | 20) & 0xFu; }
#define XB_SPIN(cond, bar) do { unsigned _sp = 0; while (cond) { __builtin_amdgcn_s_sleep(1); \
    if ((++_sp & 255u) == 0u) { if (xb_ld(&(bar)[XB_TMO])) break; if (_sp > XB_SPIN_CAP) { atomicAdd(&(bar)[XB_TMO], 1u); break; } } } } while (0)

struct XcdBarrier {
    unsigned* bar; unsigned x;
    volatile LAS unsigned* st;
};

__device__ __forceinline__ XcdBarrier xcd_barrier_post(unsigned* bar, volatile LAS unsigned* st) {
    XcdBarrier b; b.bar = bar; b.x = xb_xcc_id(); b.st = st;
    if (threadIdx.x == 0) (void)xb_add(&bar[XB_XCNT(b.x)], 1u);
    return b;
}
__device__ __forceinline__ void xcd_barrier_complete(unsigned* bar, unsigned x, unsigned& nloc, unsigned& nx) {
    const unsigned G = gridDim.x * gridDim.y * gridDim.z;
    unsigned sum, cnt, mine, sp = 0u;
    for (;;) {
        sum = 0u; cnt = 0u; mine = 0u;
#pragma unroll
        for (unsigned j = 0; j < 16; ++j) { const unsigned c = xb_ld(&bar[XB_XCNT(j)]); sum += c; cnt += (c > 0u) ? 1u : 0u; mine = (j == x) ? c : mine; }
        if (sum == G) break;
        __builtin_amdgcn_s_sleep(1);
        if ((++sp & 255u) == 0u) { if (xb_ld(&bar[XB_TMO])) break; if (sp > XB_SPIN_CAP) { atomicAdd(&bar[XB_TMO], 1u); break; } }
    }
    nloc = mine > 0u ? mine : 1u; nx = cnt > 0u ? cnt : 1u;
}

__device__ __forceinline__ void xcd_barrier(const XcdBarrier& b) {
    asm volatile("s_waitcnt vmcnt(0)" ::: "memory");
    __syncthreads();
    if (threadIdx.x == 0) {
        unsigned* bar = b.bar;
        __builtin_amdgcn_s_waitcnt(0);
        unsigned nloc = b.st[0], nx = b.st[1];
        if (nloc == 0u) { xcd_barrier_complete(bar, b.x, nloc, nx); b.st[0] = nloc; b.st[1] = nx; }
        const unsigned old = xb_add(&bar[XB_XSUB(b.x)], 1u);
        const unsigned gen = old / nloc;
        if (old + 1u == (gen + 1u) * nloc) {
            __builtin_amdgcn_fence(__ATOMIC_RELEASE, "agent");
            asm volatile("s_waitcnt vmcnt(0)" ::: "memory");
            const unsigned og = xb_add(&bar[XB_TOP], 1u);
            const unsigned tg = og / nx;
            if (og + 1u == (tg + 1u) * nx) xb_add(&bar[XB_TOPGEN], 1u);
            else XB_SPIN(xb_ld(&bar[XB_TOPGEN]) == tg, bar);
            __builtin_amdgcn_fence(__ATOMIC_ACQUIRE, "agent");
            xb_add(&bar[XB_XGEN(b.x)], 1u);
            asm volatile("s_waitcnt vmcnt(0)" ::: "memory");
        } else {
            XB_SPIN(xb_ld(&bar[XB_XGEN(b.x)]) == gen, bar);
            __builtin_amdgcn_fence(__ATOMIC_ACQUIRE, "agent");
            asm volatile("s_waitcnt vmcnt(0)" ::: "memory");
        }
    }
    __syncthreads();
}


constexpr int NPHASES = 25;

__global__ void __launch_bounds__(256, 2) mega(Params P, int ph0, int ph1) {
  extern __shared__ __attribute__((aligned(16))) char smem[];
  cg::grid_group grid = cg::this_grid();
  const int bid = blockIdx.x, nb = gridDim.x;
  volatile LAS unsigned* xst = (volatile LAS unsigned*)(smem + 73712);
  if (threadIdx.x == 0) { xst[0] = 0u; xst[1] = 0u; xst[2] = 0u; xst[3] = 0u; }
  __syncthreads();
  const XcdBarrier xbar = xcd_barrier_post((unsigned*)(P.ws + OFF_XBAR), xst);
#ifndef DUP_MASK
#define DUP_MASK 0
#endif
#define PHASE(k) if (ph0 <= (k) && (k) < ph1) { \
    if ((k) > 0 && ((DUP_MASK >> (((k) - 1) % 12)) & 1)) { run_phase(P, (k), bid, nb, smem); grid.sync(); } \
    run_phase(P, (k), bid, nb, smem); if ((k) + 1 < ph1) { if (ph0 < 0) grid.sync(); else xcd_barrier(xbar); } }
  PHASE(0) PHASE(1) PHASE(2) PHASE(3) PHASE(4) PHASE(5) PHASE(6) PHASE(7) PHASE(8) PHASE(9) PHASE(10) PHASE(11) PHASE(12)
  PHASE(13) PHASE(14) PHASE(15) PHASE(16) PHASE(17) PHASE(18) PHASE(19) PHASE(20) PHASE(21) PHASE(22) PHASE(23) PHASE(24)
#undef PHASE
}

extern "C" void kernel_launch(void* const* d_in, const int* in_sizes, int n_in, void* d_out, int out_size, void* d_ws, size_t ws_size, hipStream_t stream) {
  static int grid_blocks = 0;
  if (grid_blocks == 0) {
    if (n_in != 33 || ws_size < WS_END) { fprintf(stderr, "kernel_launch: need 33 inputs and %zu bytes of ws (got %d, %zu)\n", (size_t)WS_END, n_in, ws_size); grid_blocks = -1; return; }
    int dev = 0, cus = 0, per_cu = 0;
    (void)hipGetDevice(&dev);
    (void)hipDeviceGetAttribute(&cus, hipDeviceAttributeMultiprocessorCount, dev);
    (void)hipFuncSetAttribute((const void*)mega, hipFuncAttributeMaxDynamicSharedMemorySize, LDS_BYTES);
    (void)hipOccupancyMaxActiveBlocksPerMultiprocessor(&per_cu, (const void*)mega, 256, LDS_BYTES);
    if (per_cu < 1) per_cu = 1;
    if (per_cu > 2) per_cu = 2;
    grid_blocks = cus * per_cu;
    fprintf(stderr, "kernel_launch: cus %d per_cu %d grid %d\n", cus, per_cu, grid_blocks);
  }
  if (grid_blocks < 0) return;
  Params p;
  memset(&p, 0, sizeof(p));
  for (int i = 0; i < 33; i++) p.in[i] = (const float*)d_in[i];
  p.out = (float*)d_out;
  p.ws = (char*)d_ws;
#if MULTI_LAUNCH
  for (int ph = 0; ph < NPHASES; ph++) {
    hipLaunchKernelGGL(mega, dim3(grid_blocks), dim3(256), LDS_BYTES, stream, p, ph, ph + 1);
  }
#else
  int ph0 = 0, ph1 = NPHASES;
  (void)hipMemsetAsync((char*)d_ws + OFF_XBAR, 0, XCD_BAR_WORDS * 4, stream);
  void* args[] = {&p, &ph0, &ph1};
  hipError_t e = hipLaunchCooperativeKernel((const void*)mega, dim3(grid_blocks), dim3(256), args, LDS_BYTES, stream);
  if (e != hipSuccess) fprintf(stderr, "cooperative launch failed: %s (grid %d)\n", hipGetErrorString(e), grid_blocks);
#endif
}
```

```cpp
#include <hip/hip_runtime.h>
#include <hip/hip_cooperative_groups.h>
#include <stdint.h>
#include <math.h>
#include <stdio.h>
#include <string.h>
namespace cg = cooperative_groups;

#ifndef MULTI_LAUNCH
#define MULTI_LAUNCH 0
#endif

typedef unsigned short u16;
typedef __attribute__((ext_vector_type(8))) short bf16x8;
typedef __attribute__((ext_vector_type(4))) short s16x4;
typedef __attribute__((ext_vector_type(16))) float f32x16;
typedef __attribute__((ext_vector_type(4))) unsigned u32x4;
typedef __attribute__((ext_vector_type(2))) unsigned u32x2;

#define DI __device__ __forceinline__
#define MFMA32(a, b, c) __builtin_amdgcn_mfma_f32_32x32x16_bf16((a), (b), (c), 0, 0, 0)

constexpr int T_ = 65536;
constexpr int L_ = 8192;
constexpr int D_ = 1024;
constexpr int FF_ = 2816;
constexpr float ALPHA_ = 1.41421356237309515f;
constexpr float LN_EPS_ = 1e-5f;
constexpr float LOG2E_ = 1.44269504088896341f;
constexpr int LDS_BYTES = 73728;

constexpr size_t SZ_WGU = (size_t)5632 * 1024 * 2;
constexpr size_t SZ_WD = (size_t)1024 * 2816 * 2;
constexpr size_t SZ_WIN = (size_t)2560 * 1024 * 2;
constexpr size_t SZ_WO = (size_t)1024 * 1024 * 2;
constexpr size_t SZ_WGLU = (size_t)256 * 256 * 2;
constexpr size_t SZ_WPG = (size_t)1024 * 1024 * 2;
constexpr size_t SZ_WPP = (size_t)1024 * 256 * 2;
constexpr size_t OFF_WGU1 = 0;
constexpr size_t OFF_WD1 = OFF_WGU1 + 2 * SZ_WGU;
constexpr size_t OFF_WGU2 = OFF_WD1 + 2 * SZ_WD;
constexpr size_t OFF_WD2 = OFF_WGU2 + 2 * SZ_WGU;
constexpr size_t OFF_WIN = OFF_WD2 + 2 * SZ_WD;
constexpr size_t OFF_WO = OFF_WIN + 2 * SZ_WIN;
constexpr size_t OFF_WGLU = OFF_WO + 2 * SZ_WO;
constexpr size_t OFF_WPG = OFF_WGLU + 2 * SZ_WGLU;
constexpr size_t OFF_WPP = OFF_WPG + 2 * SZ_WPG;
constexpr size_t OFF_COEFA = OFF_WPP + 2 * SZ_WPP;
constexpr size_t OFF_COEFB = OFF_COEFA + 2 * 16 * 64 * 16;
constexpr size_t OFF_LAM = OFF_COEFB + 2 * 16 * 64 * 16 * 8;
constexpr size_t OFF_BIAS = OFF_LAM + 256;
constexpr size_t OFF_XBAR = OFF_BIAS + 8 * 129 * 4 + 32;
constexpr size_t OFF_XB = OFF_XBAR + 16384;
constexpr size_t OFF_PB = OFF_XB + (size_t)T_ * 1024 * 2;
constexpr size_t OFF_H = OFF_PB + (size_t)2 * T_ * 256 * 2;
constexpr size_t SZ_H = (size_t)384 << 20;
constexpr size_t OFF_CC = OFF_H + SZ_H;
constexpr size_t OFF_CANDK = OFF_CC + (size_t)T_ * 1024 * 2;
constexpr int CAP_ = 2048;
constexpr size_t OFF_CANDI = OFF_CANDK + (size_t)512 * 32 * CAP_ * 4;
constexpr size_t WS_END = OFF_CANDI + (size_t)512 * 32 * CAP_ * 2;
constexpr size_t MB_ = (size_t)1 << 20;
constexpr size_t M_QD = 0, M_KD = 64 * MB_, M_VT = 128 * MB_, M_U = 192 * MB_, M_QS = 256 * MB_, M_QI = 288 * MB_, M_YG = 320 * MB_,
                 M_KS = 352 * MB_, M_VS = 360 * MB_, M_KI = 368 * MB_, M_WI = 372 * MB_, M_SEND = 374 * MB_;

struct Params {
  const float* in[33];
  float* out;
  char* ws;
};

DI int tidx() { int t = threadIdx.x; asm volatile("" : "+v"(t)); return t; }
#define GAS __attribute__((address_space(1)))
DI size_t opaque0() { size_t z = 0; asm volatile("" : "+s"(z)); return z; }
DI char* WS(const Params& P) { return P.ws + opaque0(); }
DI float* OUTP(const Params& P) { return P.out + opaque0(); }
DI const float* INP(const Params& P, int i) { return P.in[i]; }
typedef __bf16 bf16v2_ __attribute__((ext_vector_type(2)));
typedef float f32v2_ __attribute__((ext_vector_type(2)));
DI u16 f2bf(float x) { const __bf16 h = (__bf16)x; return __builtin_bit_cast(u16, h); }
DI float bf2f(u16 v) { return __uint_as_float(((unsigned)v) << 16); }
DI unsigned pack2(float a, float b) { f32v2_ v; v.x = a; v.y = b; const bf16v2_ h = __builtin_convertvector(v, bf16v2_); return __builtin_bit_cast(unsigned, h); }
DI int crow(int i, int hh) { return (i & 3) + 8 * (i >> 2) + 4 * hh; }
DI float sigmoidf_(float x) { return __builtin_amdgcn_rcpf(1.f + __expf(-x)); }
DI float wave_sum(float v) { for (int o = 32; o > 0; o >>= 1) v += __shfl_xor(v, o); return v; }
DI float wave_max(float v) { for (int o = 32; o > 0; o >>= 1) v = fmaxf(v, __shfl_xor(v, o)); return v; }
DI f32x16 zero16() { f32x16 z; for (int i = 0; i < 16; i++) z[i] = 0.f; return z; }
DI bf16x8 pack8(const f32x16& x, int s) {
  union { unsigned u[4]; bf16x8 v; } t;
  t.u[0] = pack2(x[8 * s + 0], x[8 * s + 1]); t.u[1] = pack2(x[8 * s + 2], x[8 * s + 3]);
  t.u[2] = pack2(x[8 * s + 4], x[8 * s + 5]); t.u[3] = pack2(x[8 * s + 6], x[8 * s + 7]);
  return t.v;
}

constexpr int GS_ = 72;
constexpr int GT_ = 128 * GS_;

constexpr int GST_ = 32768;
DI void gemm_stage(const u16* __restrict__ A, int lda, const u16* __restrict__ B, int ldb, int kt, char* sbuf) {
  const int tid = tidx(), lane = tid & 63, wave = __builtin_amdgcn_readfirstlane(tid >> 6);
  const int pp = lane >> 4, pos = lane & 15;
#pragma unroll
  for (int i = 0; i < 4; i++) {
    const int blk = i * 4 + wave;
    const int p = blk * 4 + pp;
    const int row = 2 * p + (pos >> 3), c8 = (pos & 7) ^ (p & 7);
    const u16* ga = A + (size_t)row * lda + kt * 64 + c8 * 8;
    const u16* gb = B + (size_t)row * ldb + kt * 64 + c8 * 8;
    __builtin_amdgcn_global_load_lds((const GAS void*)ga, (__attribute__((address_space(3))) void*)(sbuf + blk * 1024), 16, 0, 0);
    __builtin_amdgcn_global_load_lds((const GAS void*)gb, (__attribute__((address_space(3))) void*)(sbuf + 16384 + blk * 1024), 16, 0, 0);
  }
}
DI void gemm_main(f32x16 (&acc)[2][2], const u16* __restrict__ A, int lda, const u16* __restrict__ B, int ldb, int K, u16* sm) {
  const int tid = tidx(), lane = tid & 63, wave = tid >> 6;
  const int wm = wave >> 1, wn = wave & 1, r = lane & 31, hh = lane >> 5;
  char* sb = (char*)sm;
  const int rowa = wm * 64 + r, rowb = wn * 64 + r;
  const int baseA = (rowa >> 1) * 256 + ((rowa & 1) << 7), xa = (rowa >> 1) & 7;
  const int baseB = 16384 + (rowb >> 1) * 256 + ((rowb & 1) << 7), xb = (rowb >> 1) & 7;
  const int nk = K >> 6;
  asm volatile("s_waitcnt vmcnt(0)" ::: "memory");
  __syncthreads();
#pragma unroll 1
  for (int kt = 0; kt < nk; kt++) {
    if (kt + 1 < nk) gemm_stage(A, lda, B, ldb, kt + 1, sb + ((kt + 1) & 1) * GST_);
    const char* st = sb + (kt & 1) * GST_;
#pragma unroll
    for (int ks = 0; ks < 4; ks++) {
      const int ca = ((ks * 2 + hh) ^ xa) << 4, cb = ((ks * 2 + hh) ^ xb) << 4;
      const bf16x8 fa0 = *(const bf16x8*)(st + baseA + ca);
      const bf16x8 fa1 = *(const bf16x8*)(st + baseA + 4096 + ca);
      const bf16x8 fb0 = *(const bf16x8*)(st + baseB + cb);
      const bf16x8 fb1 = *(const bf16x8*)(st + baseB + 4096 + cb);
      acc[0][0] = MFMA32(fa0, fb0, acc[0][0]); acc[0][1] = MFMA32(fa0, fb1, acc[0][1]);
      acc[1][0] = MFMA32(fa1, fb0, acc[1][0]); acc[1][1] = MFMA32(fa1, fb1, acc[1][1]);
    }
    asm volatile("s_waitcnt vmcnt(0)" ::: "memory");
    __syncthreads();
  }
}

DI bool tile_at(int it, int bid, int nb, int TM, int TN, int& tm, int& tn) {
  if ((nb & 7) == 0 && (TM & 63) == 0) {
    const int xcd = bid & 7, lw = bid >> 3, nlw = nb >> 3;
    const int lt = lw + it * nlw, per = (TM >> 3) * TN;
    if (lt >= per) return false;
    const int g = lt / (4 * TN), rem = lt - g * 4 * TN;
    tn = rem >> 2; tm = xcd * (TM >> 3) + g * 4 + (rem & 3);
    return true;
  } else {
    const int t = bid + it * nb;
    if (t >= TM * TN) return false;
    tn = t / TM; tm = t - tn * TM;
    return true;
  }
}

template <class AF, class BF, class INI, class EPI>
DI void gemm_phase_init(int TM, int TN, int K, int lda, int ldb, AF a_of, BF b_of, INI ini, EPI epi, int bid, int nb, u16* sm) {
  int tm, tn;
  bool have = tile_at(0, bid, nb, TM, TN, tm, tn);
  __syncthreads();
  if (have) gemm_stage(a_of(tm), lda, b_of(tn), ldb, 0, (char*)sm);
  for (int it = 0; have; it++) {
    f32x16 acc[2][2];
    ini(acc, tm, tn);
    gemm_main(acc, a_of(tm), lda, b_of(tn), ldb, K, sm);
    int tm2 = 0, tn2 = 0;
    const bool have2 = tile_at(it + 1, bid, nb, TM, TN, tm2, tn2);
    if (have2) gemm_stage(a_of(tm2), lda, b_of(tn2), ldb, 0, (char*)sm);
    epi(acc, tm, tn);
    have = have2; tm = tm2; tn = tn2;
  }
  asm volatile("s_waitcnt vmcnt(0)" ::: "memory");
}
template <class AF, class BF, class EPI>
DI void gemm_phase(int TM, int TN, int K, int lda, int ldb, AF a_of, BF b_of, EPI epi, int bid, int nb, u16* sm) {
  gemm_phase_init(TM, TN, K, lda, ldb, a_of, b_of,
    [&](f32x16 (&acc)[2][2], int, int) { acc[0][0] = zero16(); acc[0][1] = zero16(); acc[1][0] = zero16(); acc[1][1] = zero16(); },
    epi, bid, nb, sm);
}

DI void transpose_job(const float* __restrict__ src, int K, int N, u16* __restrict__ dst, int mode, int bid, int nb, float* tile) {
  const int tid = tidx();
  const int tk = K >> 6, tn = (N + 63) >> 6;
  for (int t = bid; t < tk * tn; t += nb) {
    const int k0 = (t % tk) * 64, n0 = (t / tk) * 64;
    __syncthreads();
#pragma unroll 4
    for (int i = 0; i < 16; i++) {
      const int k = i * 4 + (tid >> 6), n = tid & 63;
      tile[k * 65 + n] = (n0 + n < N) ? src[(size_t)(k0 + k) * N + n0 + n] : 0.f;
    }
    __syncthreads();
#pragma unroll 4
    for (int i = 0; i < 16; i++) {
      const int n = i * 4 + (tid >> 6), k = tid & 63;
      const int ng = n0 + n;
      if (ng < N) {
        int row = ng;
        if (mode == 1) row = (ng >> 5) * 64 + (ng & 31);
        else if (mode == 2) row = (ng >> 5) * 64 + 32 + (ng & 31);
        dst[(size_t)row * K + k0 + k] = f2bf(tile[k * 65 + n]);
      }
    }
  }
}

DI void phase_prep(const Params& P, int bid, int nb, char* smem) {
  float* tile = (float*)smem;
  char* ws = WS(P);
  for (int l = 0; l < 2; l++) {
    transpose_job(INP(P, 3) + (size_t)l * 1024 * FF_, 1024, FF_, (u16*)(ws + OFF_WGU1 + l * SZ_WGU), 1, bid, nb, tile);
    transpose_job(INP(P, 4) + (size_t)l * 1024 * FF_, 1024, FF_, (u16*)(ws + OFF_WGU1 + l * SZ_WGU), 2, bid, nb, tile);
    transpose_job(INP(P, 5) + (size_t)l * FF_ * 1024, FF_, 1024, (u16*)(ws + OFF_WD1 + l * SZ_WD), 0, bid, nb, tile);
    transpose_job(INP(P, 26) + (size_t)l * 1024 * FF_, 1024, FF_, (u16*)(ws + OFF_WGU2 + l * SZ_WGU), 1, bid, nb, tile);
    transpose_job(INP(P, 27) + (size_t)l * 1024 * FF_, 1024, FF_, (u16*)(ws + OFF_WGU2 + l * SZ_WGU), 2, bid, nb, tile);
    transpose_job(INP(P, 28) + (size_t)l * FF_ * 1024, FF_, 1024, (u16*)(ws + OFF_WD2 + l * SZ_WD), 0, bid, nb, tile);
    transpose_job(INP(P, 8) + (size_t)l * 1024 * 2472, 1024, 2472, (u16*)(ws + OFF_WIN + l * SZ_WIN), 0, bid, nb, tile);
    transpose_job(INP(P, 9) + (size_t)l * 1024 * 1024, 1024, 1024, (u16*)(ws + OFF_WO + l * SZ_WO), 0, bid, nb, tile);
    transpose_job(INP(P, 23) + (size_t)l * 256 * 256, 256, 256, (u16*)(ws + OFF_WGLU + l * SZ_WGLU), 0, bid, nb, tile);
    transpose_job(INP(P, 30) + (size_t)l * 1024 * 1024, 1024, 1024, (u16*)(ws + OFF_WPG + l * SZ_WPG), 0, bid, nb, tile);
    transpose_job(INP(P, 29) + (size_t)l * 256 * 1024, 256, 1024, (u16*)(ws + OFF_WPP + l * SZ_WPP), 0, bid, nb, tile);
    u16* win = (u16*)(ws + OFF_WIN + l * SZ_WIN);
    for (int i = bid * 256 + tidx(); i < 88 * 1024; i += nb * 256) win[(size_t)2472 * 1024 + i] = 0;
  }
  const size_t gt = (size_t)bid * 256 + tidx(), gs = (size_t)nb * 256;
  {
    const float4* x4 = (const float4*)INP(P, 0);
    uint2* xb = (uint2*)(ws + OFF_XB);
    for (size_t i = gt; i < (size_t)T_ * 1024 / 4; i += gs * 8) {
      float4 v[8];
#pragma unroll
      for (int u = 0; u < 8; u++) v[u] = (i + u * gs < (size_t)T_ * 1024 / 4) ? x4[i + u * gs] : make_float4(0.f, 0.f, 0.f, 0.f);
#pragma unroll
      for (int u = 0; u < 8; u++) if (i + u * gs < (size_t)T_ * 1024 / 4) xb[i + u * gs] = make_uint2(pack2(v[u].x, v[u].y), pack2(v[u].z, v[u].w));
    }
    const float4* p4 = (const float4*)INP(P, 1);
    uint2* pb = (uint2*)(ws + OFF_PB);
    for (size_t i = gt; i < (size_t)2 * T_ * 256 / 4; i += gs * 8) {
      float4 v[8];
#pragma unroll
      for (int u = 0; u < 8; u++) v[u] = (i + u * gs < (size_t)2 * T_ * 256 / 4) ? p4[i + u * gs] : make_float4(0.f, 0.f, 0.f, 0.f);
#pragma unroll
      for (int u = 0; u < 8; u++) if (i + u * gs < (size_t)2 * T_ * 256 / 4) pb[i + u * gs] = make_uint2(pack2(v[u].x, v[u].y), pack2(v[u].z, v[u].w));
    }
  }
  if (gt < 2 * 16 * 64) {
    const int l = (int)gt >> 10, g = ((int)gt >> 6) & 15, p = (int)gt & 63;
    const int gi = (l * 16 + g) * 64 + p;
    const double lr = INP(P, 15)[gi], li = INP(P, 16)[gi];
    const double dt = exp((double)INP(P, 17)[l * 16 + g]);
    const double mag = exp(lr * dt);
    const double ar = mag * cos(li * dt), ai = mag * sin(li * dt);
    const double mag5 = exp(512.0 * lr * dt);
    const double a5r = mag5 * cos(512.0 * li * dt), a5i = mag5 * sin(512.0 * li * dt);
    ((float4*)(ws + OFF_COEFA))[gi] = make_float4((float)ar, (float)ai, (float)a5r, (float)a5i);
    const double den = lr * lr + li * li, nr = ar - 1.0, ni = ai;
    const double fr = (nr * lr + ni * li) / den, fi = (ni * lr - nr * li) / den;
    float2* cb = (float2*)(ws + OFF_COEFB) + (size_t)gi * 16;
    for (int c = 0; c < 16; c++) {
      const double br = INP(P, 18)[(size_t)gi * 16 + c], bi = INP(P, 19)[(size_t)gi * 16 + c];
      cb[c] = make_float2((float)(fr * br - fi * bi), (float)(fr * bi + fi * br));
    }
  }
  if (gt < 8 * 129) {
    const int hd = (int)gt / 129, n = (int)gt - hd * 129;
    int bk = n;
    if (n >= 16) { bk = 16 + (int)(log((double)n / 16.0) / log(8.0) * 16.0); bk = bk < 31 ? bk : 31; }
    ((float*)(ws + OFF_BIAS))[gt] = INP(P, 2)[bk * 8 + hd];
  }
  if (gt < 2) {
    const int l = (int)gt;
    float s1 = 0.f, s2 = 0.f;
    for (int i = 0; i < 64; i++) { s1 += INP(P, 10)[l * 64 + i] * INP(P, 11)[l * 64 + i]; s2 += INP(P, 12)[l * 64 + i] * INP(P, 13)[l * 64 + i]; }
    const float lam_init = 0.8f - 0.6f * expf(-0.3f * (float)l);
    ((float*)(ws + OFF_LAM))[l] = expf(s1) - expf(s2) + lam_init;
  }
}

DI void phase_ffn_up(const u16* __restrict__ Xb, const u16* __restrict__ Wgu, u16* __restrict__ H, int bid, int nb, u16* sm) {
  const int lane = tidx() & 63, wave = tidx() >> 6, wm = wave >> 1, wn = wave & 1, r = lane & 31, hh = lane >> 5;
  gemm_phase(512, 44, 1024, 1024, 1024,
    [&](int tm) { return Xb + (size_t)tm * 128 * 1024; }, [&](int tn) { return Wgu + (size_t)tn * 128 * 1024; },
    [&](f32x16 (&acc)[2][2], int tm, int tn) {
      const int j = tn * 64 + wn * 32 + r;
#pragma unroll
      for (int mi = 0; mi < 2; mi++)
#pragma unroll
        for (int i = 0; i < 16; i++) {
          const int row = tm * 128 + wm * 64 + mi * 32 + crow(i, hh);
          const float g = acc[mi][0][i], u = acc[mi][1][i];
          H[(size_t)row * FF_ + j] = f2bf(g * sigmoidf_(g) * u);
        }
    }, bid, nb, sm);
}

DI void phase_ffn_down(const u16* __restrict__ H, const u16* __restrict__ Wd, const float* xin, const u16* __restrict__ xinb, float* xout, const u16* __restrict__ ple, int bid, int nb, u16* sm) {
  const int lane = tidx() & 63, wave = tidx() >> 6, wm = wave >> 1, wn = wave & 1, r = lane & 31, hh = lane >> 5;
  gemm_phase_init(512, 8, FF_, FF_, FF_,
    [&](int tm) { return H + (size_t)tm * 128 * FF_; }, [&](int tn) { return Wd + (size_t)tn * 128 * FF_; },
    [&](f32x16 (&acc)[2][2], int tm, int tn) {
#pragma unroll
      for (int mi = 0; mi < 2; mi++)
#pragma unroll
        for (int ni = 0; ni < 2; ni++)
#pragma unroll
          for (int i = 0; i < 16; i++) {
            const size_t o = (size_t)(tm * 128 + wm * 64 + mi * 32 + crow(i, hh)) * 1024 + tn * 128 + wn * 64 + ni * 32 + r;
            float v = 2.f * ALPHA_ * (xin ? xin[o] : bf2f(xinb[o]));
            if (ple) v += 2.f * bf2f(ple[o]);
            acc[mi][ni][i] = v;
          }
    },
    [&](f32x16 (&acc)[2][2], int tm, int tn) {
#pragma unroll
      for (int mi = 0; mi < 2; mi++)
#pragma unroll
        for (int ni = 0; ni < 2; ni++)
#pragma unroll
          for (int i = 0; i < 16; i++) {
            const size_t o = (size_t)(tm * 128 + wm * 64 + mi * 32 + crow(i, hh)) * 1024 + tn * 128 + wn * 64 + ni * 32 + r;
            xout[o] = 0.5f * acc[mi][ni][i];
          }
    }, bid, nb, sm);
}

DI void phase_w_o(const u16* __restrict__ CC, const u16* __restrict__ Wo, float* x, const u16* __restrict__ xb, int bid, int nb, u16* sm) {
  const int lane = tidx() & 63, wave = tidx() >> 6, wm = wave >> 1, wn = wave & 1, r = lane & 31, hh = lane >> 5;
  gemm_phase_init(512, 8, 1024, 1024, 1024,
    [&](int tm) { return CC + (size_t)tm * 128 * 1024; }, [&](int tn) { return Wo + (size_t)tn * 128 * 1024; },
    [&](f32x16 (&acc)[2][2], int tm, int tn) {
#pragma unroll
      for (int mi = 0; mi < 2; mi++)
#pragma unroll
        for (int ni = 0; ni < 2; ni++)
#pragma unroll
          for (int i = 0; i < 16; i++) {
            const size_t o = (size_t)(tm * 128 + wm * 64 + mi * 32 + crow(i, hh)) * 1024 + tn * 128 + wn * 64 + ni * 32 + r;
            acc[mi][ni][i] = ALPHA_ * bf2f(xb[o]);
          }
    },
    [&](f32x16 (&acc)[2][2], int tm, int tn) {
#pragma unroll
      for (int mi = 0; mi < 2; mi++)
#pragma unroll
        for (int ni = 0; ni < 2; ni++)
#pragma unroll
          for (int i = 0; i < 16; i++) {
            const size_t o = (size_t)(tm * 128 + wm * 64 + mi * 32 + crow(i, hh)) * 1024 + tn * 128 + wn * 64 + ni * 32 + r;
            x[o] = acc[mi][ni][i];
          }
    }, bid, nb, sm);
}

DI void phase_glu(const u16* __restrict__ Yg, const u16* __restrict__ Wglu, u16* __restrict__ CC, int bid, int nb, u16* sm) {
  const int lane = tidx() & 63, wave = tidx() >> 6, wm = wave >> 1, wn = wave & 1, r = lane & 31, hh = lane >> 5;
  gemm_phase(512, 2, 256, 256, 256,
    [&](int tm) { return Yg + (size_t)tm * 128 * 256; }, [&](int tn) { return Wglu + (size_t)tn * 128 * 256; },
    [&](f32x16 (&acc)[2][2], int tm, int tn) {
#pragma unroll
      for (int mi = 0; mi < 2; mi++)
#pragma unroll
        for (int ni = 0; ni < 2; ni++)
#pragma unroll
          for (int i = 0; i < 16; i++) {
            const int row = tm * 128 + wm * 64 + mi * 32 + crow(i, hh), col = tn * 128 + wn * 64 + ni * 32 + r;
            const float y = bf2f(Yg[(size_t)row * 256 + col]);
            CC[(size_t)row * 1024 + 512 + col] = f2bf(y * sigmoidf_(acc[mi][ni][i]));
          }
    }, bid, nb, sm);
}

DI void phase_ple(const u16* __restrict__ Xb, const u16* __restrict__ Wpg, const u16* __restrict__ Pb, const u16* __restrict__ Wpp, u16* ple, int bid, int nb, u16* sm) {
  const int lane = tidx() & 63, wave = tidx() >> 6, wm = wave >> 1, wn = wave & 1, r = lane & 31, hh = lane >> 5;
  gemm_phase(512, 8, 1024, 1024, 1024,
    [&](int tm) { return Xb + (size_t)tm * 128 * 1024; }, [&](int tn) { return Wpg + (size_t)tn * 128 * 1024; },
    [&](f32x16 (&acc)[2][2], int tm, int tn) {
#pragma unroll
      for (int mi = 0; mi < 2; mi++)
#pragma unroll
        for (int ni = 0; ni < 2; ni++)
#pragma unroll
          for (int i = 0; i < 16; i++) {
            const size_t o = (size_t)(tm * 128 + wm * 64 + mi * 32 + crow(i, hh)) * 1024 + tn * 128 + wn * 64 + ni * 32 + r;
            ple[o] = f2bf(sigmoidf_(acc[mi][ni][i]));
          }
    }, bid, nb, sm);
  gemm_phase(512, 8, 256, 256, 256,
    [&](int tm) { return Pb + (size_t)tm * 128 * 256; }, [&](int tn) { return Wpp + (size_t)tn * 128 * 256; },
    [&](f32x16 (&acc)[2][2], int tm, int tn) {
#pragma unroll
      for (int mi = 0; mi < 2; mi++)
#pragma unroll
        for (int ni = 0; ni < 2; ni++)
#pragma unroll
          for (int i = 0; i < 16; i++) {
            const size_t o = (size_t)(tm * 128 + wm * 64 + mi * 32 + crow(i, hh)) * 1024 + tn * 128 + wn * 64 + ni * 32 + r;
            ple[o] = f2bf(acc[mi][ni][i] * bf2f(ple[o]));
          }
    }, bid, nb, sm);
}

DI void phase_w_in(const u16* __restrict__ Xb, const u16* __restrict__ Win, char* mb, int bid, int nb, u16* sm) {
  const int lane = tidx() & 63, wave = tidx() >> 6, wm = wave >> 1, wn = wave & 1, r = lane & 31, hh = lane >> 5;
  u16* Qd = (u16*)(mb + M_QD); u16* Kd = (u16*)(mb + M_KD); u16* Vt = (u16*)(mb + M_VT); float* U = (float*)(mb + M_U);
  u16* Qs = (u16*)(mb + M_QS); u16* Qi = (u16*)(mb + M_QI); u16* Ks = (u16*)(mb + M_KS); u16* Vs = (u16*)(mb + M_VS);
  u16* Ki = (u16*)(mb + M_KI); float* Wi = (float*)(mb + M_WI);
  gemm_phase(512, 20, 1024, 1024, 1024,
    [&](int tm) { return Xb + (size_t)tm * 128 * 1024; }, [&](int tn) { return Win + (size_t)tn * 128 * 1024; },
    [&](f32x16 (&acc)[2][2], int tm, int tn) {
#pragma unroll
    for (int ni = 0; ni < 2; ni++) {
      const int c0 = tn * 128 + wn * 64 + ni * 32;
      const int c = c0 + r;
#pragma unroll
      for (int mi = 0; mi < 2; mi++) {
        const int rowb = tm * 128 + wm * 64 + mi * 32;
        if (c0 >= 1024 && c0 < 1536) {
          const int cc = c - 1024, head = cc >> 7, dv = cc & 127;
          const int b = rowb >> 13, t0 = rowb & 8191;
#pragma unroll
          for (int g4 = 0; g4 < 4; g4++) {
            uint2 v = make_uint2(pack2(acc[mi][ni][4 * g4], acc[mi][ni][4 * g4 + 1]), pack2(acc[mi][ni][4 * g4 + 2], acc[mi][ni][4 * g4 + 3]));
            const int tt = t0 + 8 * g4 + 4 * hh;
            *(uint2*)(Vt + ((size_t)(((b * 4 + head) * 128 + (tt >> 6)) * 128 + dv)) * 64 + (tt & 63)) = v;
          }
        } else {
#pragma unroll
          for (int i = 0; i < 16; i++) {
            const size_t row = rowb + crow(i, hh);
            const float v = acc[mi][ni][i];
            if (c0 < 512) Qd[row * 512 + c] = f2bf(v);
            else if (c0 < 1024) {
              const int cc = c - 512;
              Kd[((size_t)((((int)(row >> 13) * 4 + (cc >> 7)) * 2 + ((cc >> 6) & 1))) * L_ + (row & 8191)) * 64 + (cc & 63)] = f2bf(v);
            }
            else if (c0 < 1792) U[row * 256 + (c - 1536)] = v;
            else if (c0 < 2048) Qs[row * 256 + (c - 1792)] = f2bf(v);
            else if (c0 < 2112) Ks[row * 64 + (c - 2048)] = f2bf(v);
            else if (c0 < 2176) Vs[row * 64 + (c - 2112)] = f2bf(v);
            else if (c0 < 2432) Qi[row * 256 + (c - 2176)] = f2bf(v);
            else if (c0 < 2464) Ki[row * 32 + (c - 2432)] = f2bf(v);
            else if (c0 == 2464) { if (r < 8) Wi[row * 8 + r] = v * 0.0625f; }
          }
        }
      }
    }
  }, bid, nb, sm);
}

DI void phase_ln(float* x, u16* __restrict__ xb, const float* __restrict__ g, const float* __restrict__ bta, bool write_f32, int bid, int nb) {
  const int lane = tidx() & 63, wave = tidx() >> 6;
  float4 gg[4], bb[4];
#pragma unroll
  for (int i = 0; i < 4; i++) { gg[i] = *(const float4*)(g + i * 256 + lane * 4); bb[i] = *(const float4*)(bta + i * 256 + lane * 4); }
  constexpr int RB = 4;
  for (int row0 = (bid * 4 + wave) * RB; row0 < T_; row0 += nb * 4 * RB) {
    float4 v[RB][4];
#pragma unroll
    for (int rr = 0; rr < RB; rr++)
#pragma unroll
      for (int i = 0; i < 4; i++) v[rr][i] = *(const float4*)(x + (size_t)(row0 + rr) * 1024 + i * 256 + lane * 4);
    float s[RB], q[RB];
#pragma unroll
    for (int rr = 0; rr < RB; rr++) {
      s[rr] = 0.f;
#pragma unroll
      for (int i = 0; i < 4; i++) s[rr] += v[rr][i].x + v[rr][i].y + v[rr][i].z + v[rr][i].w;
    }
#pragma unroll
    for (int o = 32; o > 0; o >>= 1)
#pragma unroll
      for (int rr = 0; rr < RB; rr++) s[rr] += __shfl_xor(s[rr], o);
#pragma unroll
    for (int rr = 0; rr < RB; rr++) {
      const float mu = s[rr] * (1.f / 1024.f);
      q[rr] = 0.f;
#pragma unroll
      for (int i = 0; i < 4; i++) {
        v[rr][i].x -= mu; v[rr][i].y -= mu; v[rr][i].z -= mu; v[rr][i].w -= mu;
        q[rr] += v[rr][i].x * v[rr][i].x + v[rr][i].y * v[rr][i].y + v[rr][i].z * v[rr][i].z + v[rr][i].w * v[rr][i].w;
      }
    }
#pragma unroll
    for (int o = 32; o > 0; o >>= 1)
#pragma unroll
      for (int rr = 0; rr < RB; rr++) q[rr] += __shfl_xor(q[rr], o);
#pragma unroll
    for (int rr = 0; rr < RB; rr++) {
      const float rs = rsqrtf(q[rr] * (1.f / 1024.f) + LN_EPS_);
#pragma unroll
      for (int i = 0; i < 4; i++) {
        float4 o;
        o.x = v[rr][i].x * rs * gg[i].x + bb[i].x; o.y = v[rr][i].y * rs * gg[i].y + bb[i].y;
        o.z = v[rr][i].z * rs * gg[i].z + bb[i].z; o.w = v[rr][i].w * rs * gg[i].w + bb[i].w;
        if (write_f32) *(float4*)(x + (size_t)(row0 + rr) * 1024 + i * 256 + lane * 4) = o;
        *(uint2*)(xb + (size_t)(row0 + rr) * 1024 + i * 256 + lane * 4) = make_uint2(pack2(o.x, o.y), pack2(o.z, o.w));
      }
    }
  }
}

DI float gelu_tanh(float x) { const float u = 0.7978845608028654f * (x + 0.044715f * x * x * x); return 0.5f * x * (1.f + tanhf(u)); }

typedef __attribute__((ext_vector_type(4))) float f32x4;
template <bool OUT>
DI void ssm_scan(const Params& P, int layer, int widx, char* mb, char* smem) {
  const int lane = tidx() & 63, wave = tidx() >> 6;
  const int b = widx >> 8, g = (widx >> 4) & 15, ch = widx & 15;
  const int gi = (layer * 16 + g) * 64 + lane;
  const float4 ca = ((const float4*)(WS(P) + OFF_COEFA))[gi];
  const float2* cbp = (const float2*)(WS(P) + OFF_COEFB) + (size_t)gi * 16;
  float bre[16], bim[16];
#pragma unroll
  for (int c = 0; c < 16; c++) { float2 t = cbp[c]; bre[c] = t.x; bim[c] = t.y; }
  const float* U = (const float*)(mb + M_U);
  float2* Send = (float2*)(mb + M_SEND);
  const size_t sbase = (size_t)((b * 16 + g) * 16) * 64 + lane;
  float xr = 0.f, xi = 0.f;
  float am[32];
  float4 dsk4 = make_float4(0.f, 0.f, 0.f, 0.f);
  float* Xs = (float*)smem + wave * (128 * 17);
  const int lm = lane & 15, lq = lane >> 4;
  if (OUT) {
    for (int j = 0; j < ch; j++) {
      const float2 e = Send[sbase + (size_t)j * 64];
      const float nr = ca.z * xr - ca.w * xi + e.x, ni = ca.z * xi + ca.w * xr + e.y;
      xr = nr; xi = ni;
    }
    const float* cre = INP(P, 20) + ((size_t)(layer * 16 + g) * 16 + lm) * 64;
    const float* cim = INP(P, 21) + ((size_t)(layer * 16 + g) * 16 + lm) * 64;
#pragma unroll
    for (int kb = 0; kb < 32; kb++) {
      const int kk = 4 * kb + lq;
      am[kb] = (kb < 16) ? cre[kk] : -cim[kk - 64];
    }
    dsk4 = *(const float4*)(INP(P, 22) + layer * 256 + g * 16 + 4 * lq);
  }
  u16* Yg = (u16*)(mb + M_YG);
  const size_t tok0 = (size_t)b * L_ + ch * 512;
  const float* ub = U + (tok0 + (lane >> 2)) * 256 + g * 16 + (lane & 3) * 4;
  float4 cur = *(const float4*)ub;
#pragma unroll 1
  for (int blk = 0; blk < 32; blk++) {
    const float4 nxt = *(const float4*)(ub + (size_t)min(blk + 1, 31) * 16 * 256);
#pragma unroll
    for (int s16 = 0; s16 < 16; s16++) {
      float uu[16];
#pragma unroll
      for (int c = 0; c < 16; c++) {
        const float comp = ((c & 3) == 0) ? cur.x : ((c & 3) == 1) ? cur.y : ((c & 3) == 2) ? cur.z : cur.w;
        uu[c] = __int_as_float(__builtin_amdgcn_readlane(__float_as_int(comp), 4 * s16 + (c >> 2)));
      }
      float br4[4] = {0.f, 0.f, 0.f, 0.f}, bi4[4] = {0.f, 0.f, 0.f, 0.f};
#pragma unroll
      for (int c = 0; c < 16; c++) { br4[c & 3] += bre[c] * uu[c]; bi4[c & 3] += bim[c] * uu[c]; }
      const float br = (br4[0] + br4[1]) + (br4[2] + br4[3]), bi = (bi4[0] + bi4[1]) + (bi4[2] + bi4[3]);
      const float nr = ca.x * xr - ca.y * xi + br, ni = ca.x * xi + ca.y * xr + bi;
      xr = nr; xi = ni;
      if (OUT) { Xs[lane * 17 + s16] = xr; Xs[(64 + lane) * 17 + s16] = xi; }
    }
    if (OUT) {
      __builtin_amdgcn_wave_barrier();
      f32x4 acc = {0.f, 0.f, 0.f, 0.f}, acc2 = {0.f, 0.f, 0.f, 0.f};
#pragma unroll
      for (int kb = 0; kb < 32; kb += 2) {
        const float bv0 = Xs[(4 * kb + lq) * 17 + lm], bv1 = Xs[(4 * kb + 4 + lq) * 17 + lm];
        acc = __builtin_amdgcn_mfma_f32_16x16x4f32(am[kb], bv0, acc, 0, 0, 0);
        acc2 = __builtin_amdgcn_mfma_f32_16x16x4f32(am[kb + 1], bv1, acc2, 0, 0, 0);
      }
      acc += acc2;
      __builtin_amdgcn_wave_barrier();
      const size_t tok = tok0 + blk * 16 + lm;
      const float4 u4 = *(const float4*)(U + tok * 256 + g * 16 + 4 * lq);
      const float y0 = gelu_tanh(acc[0] + dsk4.x * u4.x), y1 = gelu_tanh(acc[1] + dsk4.y * u4.y);
      const float y2 = gelu_tanh(acc[2] + dsk4.z * u4.z), y3 = gelu_tanh(acc[3] + dsk4.w * u4.w);
      *(uint2*)(Yg + tok * 256 + g * 16 + 4 * lq) = make_uint2(pack2(y0, y1), pack2(y2, y3));
    }
    cur = nxt;
  }
  if (!OUT) Send[sbase + (size_t)ch * 64] = make_float2(xr, xi);
}

constexpr int KS_ = 72, VS_ = 68;
DI void da_item(const Params& P, int layer, int b, int h, int qt, char* mb, char* smem) {
  const int tid = tidx(), lane = tid & 63, wave = tid >> 6, r = lane & 31, hh = lane >> 5;
  u16* sK0 = (u16*)smem;
  u16* sV0 = sK0 + 2 * 64 * KS_;
  float* sbias = (float*)(sV0 + 2 * 128 * VS_);
  u16* sQw = (u16*)(smem + 54272) + (tidx() >> 6) * 32 * KS_;
  const u16* Qd = (const u16*)(mb + M_QD); const u16* Kd = (const u16*)(mb + M_KD); const u16* Vt = (const u16*)(mb + M_VT);
  u16* CC = (u16*)(WS(P) + OFF_CC);
  const int q0 = qt * 128, qw = q0 + wave * 32, qp = qw + r;
  const size_t tokq = (size_t)b * L_ + qp;
  __syncthreads();
  if (tid < 129) sbias[tid] = ((const float*)(WS(P) + OFF_BIAS))[h * 129 + tid] * LOG2E_;
  __syncthreads();
  const float bfar = sbias[128];
  const float SC = 0.125f * LOG2E_;
  const int nkt = (q0 + 128) >> 6;
  const float lam = ((const float*)(WS(P) + OFF_LAM))[layer];
  const int krow_l = tid >> 3, kch = (tid & 7) * 8;
#pragma unroll 1
  for (int c = 0; c < 2; c++) {
#pragma unroll
    for (int ks = 0; ks < 4; ks++) *(bf16x8*)(sQw + r * KS_ + ks * 16 + hh * 8) = *(const bf16x8*)(Qd + tokq * 512 + h * 128 + c * 64 + ks * 16 + hh * 8);
    f32x16 o[4] = {zero16(), zero16(), zero16(), zero16()};
    float m = -INFINITY, l = 0.f;
    const u16* Kbase = Kd + ((size_t)(((b * 4 + h) * 2 + c)) * L_ + krow_l) * 64 + kch;
    const u16* Vbase = Vt + ((size_t)((b * 4 + h) * 128) * 128 + krow_l) * 64 + kch;
    u32x4 rk[2], rv[4];
#pragma unroll
    for (int i = 0; i < 2; i++) rk[i] = *(const u32x4*)(Kbase + (size_t)(i * 32) * 64);
#pragma unroll
    for (int i = 0; i < 4; i++) rv[i] = *(const u32x4*)(Vbase + (size_t)(i * 32) * 64);
#define DA_STAGE(BUF) { u16* sKw = sK0 + (BUF) * 64 * KS_; u16* sVw = sV0 + (BUF) * 128 * VS_; \
      _Pragma("unroll") for (int i = 0; i < 2; i++) *(u32x4*)(sKw + (krow_l + i * 32) * KS_ + kch) = rk[i]; \
      _Pragma("unroll") for (int i = 0; i < 4; i++) { u32x2* d = (u32x2*)(sVw + (krow_l + i * 32) * VS_ + kch); \
        u32x2 lo2, hi2; lo2.x = rv[i].x; lo2.y = rv[i].y; hi2.x = rv[i].z; hi2.y = rv[i].w; d[0] = lo2; d[1] = hi2; } }
#define DA_FETCH(T) { const int ktn_ = min((T), nkt - 1); \
      _Pragma("unroll") for (int i = 0; i < 2; i++) rk[i] = *(const u32x4*)(Kbase + (size_t)(ktn_ * 64 + i * 32) * 64); \
      _Pragma("unroll") for (int i = 0; i < 4; i++) rv[i] = *(const u32x4*)(Vbase + (size_t)ktn_ * 8192 + (size_t)(i * 32) * 64); }
    __syncthreads();
    DA_STAGE(0)
    DA_FETCH(1)
    __syncthreads();
#pragma unroll 1
    for (int kt = 0; kt < nkt; kt++) {
      const u16* sK = sK0 + (kt & 1) * 64 * KS_;
      const u16* sV = sV0 + (kt & 1) * 128 * VS_;
      if (kt + 1 < nkt) { DA_STAGE((kt + 1) & 1) }
      DA_FETCH(kt + 2)
      if (kt * 64 <= qw + 31) {
        f32x16 s[2];
#pragma unroll
        for (int kb = 0; kb < 2; kb++) {
          s[kb] = zero16();
#pragma unroll
          for (int ks = 0; ks < 4; ks++) {
            const bf16x8 kf = *(const bf16x8*)(sK + (kb * 32 + r) * KS_ + ks * 16 + hh * 8);
            const bf16x8 qf = *(const bf16x8*)(sQw + r * KS_ + ks * 16 + hh * 8);
            s[kb] = MFMA32(kf, qf, s[kb]);
          }
        }
        const bool nearb = (kt * 64 + 63 + 128 > qw);
        float mx = -INFINITY;
        if (nearb) {
#pragma unroll
          for (int kb = 0; kb < 2; kb++)
#pragma unroll
            for (int i = 0; i < 16; i++) {
              const int dist = qp - (kt * 64 + kb * 32 + crow(i, hh));
              const float bv = sbias[min(max(dist, 0), 128)];
              float t = s[kb][i] * SC + bv;
              t = (dist >= 0) ? t : -INFINITY;
              s[kb][i] = t; mx = fmaxf(mx, t);
              if ((i & 7) == 7) __builtin_amdgcn_sched_barrier(0);
            }
        } else {
#pragma unroll
          for (int kb = 0; kb < 2; kb++)
#pragma unroll
            for (int i = 0; i < 16; i++) { const float t = s[kb][i] * SC + bfar; s[kb][i] = t; mx = fmaxf(mx, t); }
        }
        mx = fmaxf(mx, __shfl_xor(mx, 32));
        const float mn = fmaxf(m, mx);
        const float corr = __builtin_amdgcn_exp2f(m - mn);
        m = mn;
        float ls = 0.f;
#pragma unroll
        for (int kb = 0; kb < 2; kb++)
#pragma unroll
          for (int i = 0; i < 16; i++) { const float p = __builtin_amdgcn_exp2f(s[kb][i] - mn); s[kb][i] = p; ls += p; }
        l = l * corr + ls;
        if (__ballot(corr != 1.f) != 0ull) {
#pragma unroll
          for (int dt = 0; dt < 4; dt++)
#pragma unroll
            for (int i = 0; i < 16; i++) o[dt][i] *= corr;
        }
#pragma unroll
        for (int kb = 0; kb < 2; kb++)
#pragma unroll
          for (int s2 = 0; s2 < 2; s2++) {
            const bf16x8 pf = pack8(s[kb], s2);
#pragma unroll
            for (int dt = 0; dt < 4; dt++) {
              const u16* vp = sV + (dt * 32 + r) * VS_ + kb * 32 + s2 * 16 + 4 * hh;
              const s16x4 lo = *(const s16x4*)vp, hi = *(const s16x4*)(vp + 8);
              const bf16x8 vf = __builtin_shufflevector(lo, hi, 0, 1, 2, 3, 4, 5, 6, 7);
              o[dt] = MFMA32(vf, pf, o[dt]);
            }
            __builtin_amdgcn_sched_barrier(0);
          }
      }
      __syncthreads();
    }
#undef DA_STAGE
#undef DA_FETCH
    const float lt = l + __shfl_xor(l, 32);
    const float inv = 1.f / lt;
    size_t tq = tokq;
    asm volatile("" : "+v"(tq));
    u16* obase = CC + tq * 1024 + h * 128 + 4 * hh;
    if (c == 0) {
#pragma unroll
      for (int dt = 0; dt < 4; dt++)
#pragma unroll
        for (int g4 = 0; g4 < 4; g4++) {
          *(uint2*)(obase + dt * 32 + 8 * g4) = make_uint2(pack2(o[dt][4 * g4] * inv, o[dt][4 * g4 + 1] * inv), pack2(o[dt][4 * g4 + 2] * inv, o[dt][4 * g4 + 3] * inv));
        }
    } else {
      float ss = 0.f;
#pragma unroll
      for (int dt = 0; dt < 4; dt++)
#pragma unroll
        for (int g4 = 0; g4 < 4; g4++) {
          const uint2 pv = *(const uint2*)(obase + dt * 32 + 8 * g4);
          const float a4[4] = {bf2f((u16)(pv.x & 0xffff)), bf2f((u16)(pv.x >> 16)), bf2f((u16)(pv.y & 0xffff)), bf2f((u16)(pv.y >> 16))};
#pragma unroll
          for (int e = 0; e < 4; e++) { const float v = a4[e] - lam * o[dt][4 * g4 + e] * inv; o[dt][4 * g4 + e] = v; ss = __builtin_fmaf(v, v, ss); }
        }
      ss += __shfl_xor(ss, 32);
      const float lam_init = 0.8f - 0.6f * __expf(-0.3f * (float)layer);
      const float rn = rsqrtf(ss * (1.f / 128.f) + LN_EPS_) * (1.f - lam_init);
      int hh2 = hh;
      asm volatile("" : "+v"(hh2));
      const float* sg = INP(P, 14) + layer * 128 + 4 * hh2;
#pragma unroll
      for (int dt = 0; dt < 4; dt++)
#pragma unroll
        for (int g4 = 0; g4 < 4; g4++) {
          const int dv = dt * 32 + 8 * g4 + 4 * hh;
          const float4 gv = *(const float4*)(sg + dt * 32 + 8 * g4);
          uint2 w = make_uint2(pack2(o[dt][4 * g4] * rn * gv.x, o[dt][4 * g4 + 1] * rn * gv.y),
                               pack2(o[dt][4 * g4 + 2] * rn * gv.z, o[dt][4 * g4 + 3] * rn * gv.w));
          *(uint2*)(obase + dv - 4 * hh) = w;
        }
    }
  }
}

DI unsigned sortkey(float f) { const unsigned u = __float_as_uint(f + 0.f); return u ^ (((unsigned)((int)u >> 31)) | 0x80000000u); }

DI void dsa_item(const Params& P, int layer, int b, int qt, char* mb, char* smem) {
  const int tid = tidx(), lane = tid & 63, wave = tid >> 6, r = lane & 31, hh = lane >> 5;
  unsigned* hist = (unsigned*)smem;
  float* sP = (float*)smem;
  float* sQ = (float*)(smem + 16384);
  u16* sidx = (u16*)(smem + 32896);
  unsigned* meta = (unsigned*)(smem + 49280);
  float* sbias = (float*)(smem + 50304);
  const u16* Qi = (const u16*)(mb + M_QI); const u16* Ki = (const u16*)(mb + M_KI); const float* Wi = (const float*)(mb + M_WI);
  const u16* Qs = (const u16*)(mb + M_QS); const u16* Ks = (const u16*)(mb + M_KS); const u16* Vs = (const u16*)(mb + M_VS);
  u16* CC = (u16*)(WS(P) + OFF_CC);
  const int q0 = qt * 32;
  const int qp = q0 + r;
  const size_t tokb = (size_t)b * L_;
  const int nk32 = qt + 1;
  const bool radix = (q0 >= 256);
  __syncthreads();
  for (int i = tid; i < 4 * 129; i += 256) sbias[i] = ((const float*)(WS(P) + OFF_BIAS))[4 * 129 + i];
  meta[tid] = (tid >= 32 && tid < 64) ? 256u : 0u;
  char* sQi = smem + 52384;
  float* sWi = (float*)(smem + 69280);
  constexpr int CAPL_ = 64;
  unsigned* lK = (unsigned*)smem;
  u16* lI = (u16*)(smem + 32 * CAPL_ * 4);
  {
    const int row = tid >> 3, ch = tid & 7;
    const uint4* src = (const uint4*)(Qi + (tokb + q0 + row) * 256 + ch * 32);
    uint4* dst = (uint4*)(sQi + row * 528 + ch * 64);
    dst[0] = src[0]; dst[1] = src[1]; dst[2] = src[2]; dst[3] = src[3];
    sWi[tid] = Wi[(tokb + q0) * 8 + tid];
  }
  int pass = radix ? 0 : 4;
  bool fast = false;
#pragma unroll 1
  while (true) {
    __syncthreads();
    if (pass < 4) { for (int i = tid; i < 32 * 257; i += 256) hist[i] = 0u; }
    __syncthreads();
    const unsigned pref = meta[r];
    const unsigned krem = meta[32 + r];
    auto elems = [&](const f32x16& sc, const int kt, const int lim) __attribute__((always_inline)) {
      if (pass == 0) {
#pragma unroll
        for (int i = 0; i < 16; i++) {
          const int kp = kt * 32 + crow(i, hh);
          const unsigned key = sortkey(sc[i]);
          const unsigned bin = (kp <= lim) ? (key >> 24) : 256u;
          atomicAdd(&hist[r * 257 + bin], 1u);
        }
      } else if (pass < 4) {
        const int sh = 24 - 8 * pass;
#pragma unroll
        for (int i = 0; i < 16; i++) {
          const int kp = kt * 32 + crow(i, hh);
          const unsigned key = sortkey(sc[i]);
          if ((key >> (sh + 8)) == pref && kp <= lim) atomicAdd(&hist[r * 257 + ((key >> sh) & 255u)], 1u);
        }
      } else if (pass == 5) {
        unsigned mc = 0u, ms = 0u;
        unsigned keys[16];
#pragma unroll
        for (int i = 0; i < 16; i++) {
          const int kp = kt * 32 + crow(i, hh);
          keys[i] = sortkey(sc[i]);
          const unsigned bt = keys[i] >> 16;
          const bool valid = (kp <= lim);
          ms |= (valid && bt > pref) ? (1u << i) : 0u;
          mc |= (valid && bt == pref) ? (1u << i) : 0u;
        }
        unsigned base_c = 0u, base_s = 0u;
        if (mc) base_c = atomicAdd(&meta[128 + r], (unsigned)__popc(mc));
        if (ms) base_s = atomicAdd(&meta[64 + r], (unsigned)__popc(ms));
#pragma unroll
        for (int i = 0; i < 16; i++) {
          const int kp = kt * 32 + crow(i, hh);
          if ((mc >> i) & 1u) {
            const unsigned cp = base_c + (unsigned)__popc(mc & ((1u << i) - 1u));
            if (cp < (unsigned)CAPL_) { lK[r * CAPL_ + cp] = keys[i]; lI[r * CAPL_ + cp] = (u16)kp; }
          }
          if ((ms >> i) & 1u) {
            const unsigned pos = base_s + (unsigned)__popc(ms & ((1u << i) - 1u));
            if (pos < 256u) sidx[r * 256 + pos] = (u16)kp;
          }
        }
      } else {
#pragma unroll
        for (int i = 0; i < 16; i++) {
          const int kp = kt * 32 + crow(i, hh);
          const unsigned key = sortkey(sc[i]);
          bool sel = (kp <= lim);
          if (radix) {
            sel = sel && (key >= pref);
            if (sel && key == pref) sel = atomicAdd(&meta[96 + r], 1u) < krem;
          }
          if (sel) { const unsigned pos = atomicAdd(&meta[64 + r], 1u); if (pos < 256u) sidx[r * 256 + pos] = (u16)kp; }
        }
      }
    };
    const int klast = nk32 - 1;
    bf16x8 nA0 = {0, 0, 0, 0, 0, 0, 0, 0}, nA1 = nA0, nB0 = nA0, nB1 = nA0;
    if (wave < nk32) {
      const int ka = wave, kb2 = min(wave + 4, klast);
      nA0 = *(const bf16x8*)(Ki + (tokb + ka * 32 + r) * 32 + hh * 8);
      nA1 = *(const bf16x8*)(Ki + (tokb + ka * 32 + r) * 32 + 16 + hh * 8);
      nB0 = *(const bf16x8*)(Ki + (tokb + kb2 * 32 + r) * 32 + hh * 8);
      nB1 = *(const bf16x8*)(Ki + (tokb + kb2 * 32 + r) * 32 + 16 + hh * 8);
    }
#pragma unroll 1
    for (int kt = wave; kt < nk32; kt += 8) {
      const bf16x8 kA0 = nA0, kA1 = nA1, kB0 = nB0, kB1 = nB1;
      {
        const int ka = min(kt + 8, klast), kb2 = min(kt + 12, klast);
        nA0 = *(const bf16x8*)(Ki + (tokb + ka * 32 + r) * 32 + hh * 8);
        nA1 = *(const bf16x8*)(Ki + (tokb + ka * 32 + r) * 32 + 16 + hh * 8);
        nB0 = *(const bf16x8*)(Ki + (tokb + kb2 * 32 + r) * 32 + hh * 8);
        nB1 = *(const bf16x8*)(Ki + (tokb + kb2 * 32 + r) * 32 + 16 + hh * 8);
      }
      f32x16 scA = zero16(), scB = zero16();
#pragma unroll 2
      for (int hd = 0; hd < 8; hd++) {
        const bf16x8 q0f = *(const bf16x8*)(sQi + r * 528 + hd * 64 + hh * 16);
        const bf16x8 q1f = *(const bf16x8*)(sQi + r * 528 + hd * 64 + 32 + hh * 16);
        const float w = sWi[r * 8 + hd];
        f32x16 sa = MFMA32(kA0, q0f, zero16());
        f32x16 sb = MFMA32(kB0, q0f, zero16());
        sa = MFMA32(kA1, q1f, sa);
        sb = MFMA32(kB1, q1f, sb);
#pragma unroll
        for (int i = 0; i < 16; i++) {
          scA[i] += __int_as_float(max(__float_as_int(sa[i]), 0)) * w;
          scB[i] += __int_as_float(max(__float_as_int(sb[i]), 0)) * w;
        }
      }
      elems(scA, kt, (kt == qt) ? qp : 0x7fffffff);
      if (kt + 4 < nk32) elems(scB, kt + 4, (kt + 4 == qt) ? qp : 0x7fffffff);
    }
    __syncthreads();
    if (pass < 4) {
      for (int j = 0; j < 8; j++) {
        const int qq = wave * 8 + j;
        const unsigned k = meta[32 + qq];
        unsigned c4[4]; unsigned tot = 0;
#pragma unroll
        for (int e = 0; e < 4; e++) { c4[e] = hist[qq * 257 + 255 - 4 * lane - e]; tot += c4[e]; }
        unsigned incl = tot;
        for (int o = 1; o < 64; o <<= 1) { const unsigned t = __shfl_up(incl, o); if (lane >= o) incl += t; }
        unsigned run = incl - tot;
#pragma unroll
        for (int e = 0; e < 4; e++) {
          if (run < k && run + c4[e] >= k) {
            meta[qq] = (meta[qq] << 8) | (unsigned)(255 - 4 * lane - e); meta[32 + qq] = k - run;
            if (pass == 1 && c4[e] > (unsigned)CAPL_) meta[192] = 1u;
          }
          run += c4[e];
        }
      }
    }
    if (pass >= 4) break;
    if (pass == 1) { __syncthreads(); fast = (meta[192] == 0u); pass = fast ? 5 : 2; } else pass++;
  }
  __syncthreads();
  if (fast) {
#pragma unroll 1
    for (int j = 0; j < 8; j++) {
      const int qq = wave * 8 + j;
      const int c = min((int)meta[128 + qq], CAPL_);
      const unsigned k = meta[32 + qq];
      const bool in = lane < c;
      const unsigned mykey = in ? lK[qq * CAPL_ + lane] : 0u;
      const unsigned myidx = in ? (unsigned)lI[qq * CAPL_ + lane] : 0u;
      unsigned rank = 0u;
      for (int t = 0; t < c; t++) {
        const unsigned ok = __shfl(mykey, t);
        rank += (ok > mykey || (ok == mykey && t < lane)) ? 1u : 0u;
      }
      const bool sel = in && (rank < k);
      const unsigned long long m = __ballot(sel);
      const unsigned base = meta[64 + qq];
      if (sel) {
        const unsigned pos = base + (unsigned)__popcll(m & ((1ull << lane) - 1ull));
        if (pos < 256u) sidx[qq * 256 + pos] = (u16)myidx;
      }
      __builtin_amdgcn_wave_barrier();
      if (lane == 0) meta[64 + qq] = base + (unsigned)__popcll(m);
    }
    __syncthreads();
  }
  float* myP = sP + wave * 1024;
  (void)sQ;
  bf16x8 qn[4];
#pragma unroll
  for (int ks = 0; ks < 4; ks++) {
    bf16x8 z = {0, 0, 0, 0, 0, 0, 0, 0};
    if (r < 4) z = *(const bf16x8*)(Qs + (tokb + q0 + wave * 8) * 256 + r * 64 + ks * 16 + hh * 8);
    qn[ks] = z;
  }
#pragma unroll 1
  for (int j = 0; j < 8; j++) {
    const int qq = wave * 8 + j;
    const int qpos = q0 + qq;
    const size_t tok = tokb + qpos;
    const int n = min((int)meta[64 + qq], 256);
    __syncthreads();
    bf16x8 qf[4];
#pragma unroll
    for (int ks = 0; ks < 4; ks++) qf[ks] = qn[ks];
    {
      const size_t tokn = tokb + q0 + wave * 8 + min(j + 1, 7);
#pragma unroll
      for (int ks = 0; ks < 4; ks++) {
        bf16x8 z = {0, 0, 0, 0, 0, 0, 0, 0};
        if (r < 4) z = *(const bf16x8*)(Qs + tokn * 256 + r * 64 + ks * 16 + hh * 8);
        qn[ks] = z;
      }
    }
#pragma unroll 4
    for (int kb = 0; kb < 8; kb++) {
      const int jj = kb * 32 + r;
      const int kidx = (jj < n) ? (int)sidx[qq * 256 + jj] : 0;
      const u16* kp = Ks + (tokb + kidx) * 64 + hh * 8;
      bf16x8 kf[4];
#pragma unroll
      for (int ks = 0; ks < 4; ks++) kf[ks] = *(const bf16x8*)(kp + ks * 16);
      f32x16 sacc = zero16();
#pragma unroll
      for (int ks = 0; ks < 4; ks++) sacc = MFMA32(kf[ks], qf[ks], sacc);
      if (r < 4) {
#pragma unroll
        for (int i = 0; i < 16; i++) myP[(kb * 32 + crow(i, hh)) * 4 + r] = sacc[i];
      }
    }
    __syncthreads();
    float sc[4][4];
#pragma unroll
    for (int rd = 0; rd < 4; rd++) {
      const int jj = rd * 64 + lane;
      const bool valid = jj < n;
      const int kidx = valid ? (int)sidx[qq * 256 + jj] : 0;
      const int dist = min(max(qpos - kidx, 0), 128);
      const float4 d = *(const float4*)(myP + jj * 4);
      sc[rd][0] = valid ? d.x * 0.125f + sbias[0 * 129 + dist] : -INFINITY;
      sc[rd][1] = valid ? d.y * 0.125f + sbias[1 * 129 + dist] : -INFINITY;
      sc[rd][2] = valid ? d.z * 0.125f + sbias[2 * 129 + dist] : -INFINITY;
      sc[rd][3] = valid ? d.w * 0.125f + sbias[3 * 129 + dist] : -INFINITY;
    }
#pragma unroll
    for (int hd = 0; hd < 4; hd++) {
      float mx = fmaxf(fmaxf(sc[0][hd], sc[1][hd]), fmaxf(sc[2][hd], sc[3][hd]));
      mx = wave_max(mx);
      float sm = 0.f;
#pragma unroll
      for (int rd = 0; rd < 4; rd++) { sc[rd][hd] = __expf(sc[rd][hd] - mx); sm += sc[rd][hd]; }
      sm = wave_sum(sm);
      const float inv = 1.f / sm;
#pragma unroll
      for (int rd = 0; rd < 4; rd++) sc[rd][hd] *= inv;
    }
#pragma unroll
    for (int rd = 0; rd < 4; rd++) *(float4*)(myP + (rd * 64 + lane) * 4) = make_float4(sc[rd][0], sc[rd][1], sc[rd][2], sc[rd][3]);
    __syncthreads();
    const int g = lane >> 3, c8 = lane & 7;
    float acc[32];
#pragma unroll
    for (int i = 0; i < 32; i++) acc[i] = 0.f;
#pragma unroll 16
    for (int it = 0; it < 32; it++) {
      const int jj = it * 8 + g;
      const int kidx = (jj < n) ? (int)sidx[qq * 256 + jj] : 0;
      const float4 pj = *(const float4*)(myP + jj * 4);
      const u32x4 vv = *(const u32x4*)(Vs + (tokb + kidx) * 64 + c8 * 8);
      const float vf[8] = {bf2f((u16)(vv.x & 0xffff)), bf2f((u16)(vv.x >> 16)), bf2f((u16)(vv.y & 0xffff)), bf2f((u16)(vv.y >> 16)),
                           bf2f((u16)(vv.z & 0xffff)), bf2f((u16)(vv.z >> 16)), bf2f((u16)(vv.w & 0xffff)), bf2f((u16)(vv.w >> 16))};
#pragma unroll
      for (int e = 0; e < 8; e++) {
        acc[0 * 8 + e] += pj.x * vf[e]; acc[1 * 8 + e] += pj.y * vf[e];
        acc[2 * 8 + e] += pj.z * vf[e]; acc[3 * 8 + e] += pj.w * vf[e];
      }
    }
    const bool b5 = lane & 32, b4 = lane & 16, b3 = lane & 8;
    float w16[16], w8[8], w4[4];
#pragma unroll
    for (int i = 0; i < 16; i++) { const float snd = b5 ? acc[i] : acc[i + 16]; const float rcv = __shfl_xor(snd, 32); w16[i] = (b5 ? acc[i + 16] : acc[i]) + rcv; }
#pragma unroll
    for (int i = 0; i < 8; i++) { const float snd = b4 ? w16[i] : w16[i + 8]; const float rcv = __shfl_xor(snd, 16); w8[i] = (b4 ? w16[i + 8] : w16[i]) + rcv; }
#pragma unroll
    for (int i = 0; i < 4; i++) { const float snd = b3 ? w8[i] : w8[i + 4]; const float rcv = __shfl_xor(snd, 8); w4[i] = (b3 ? w8[i + 4] : w8[i]) + rcv; }
    const int hd = (b5 ? 2 : 0) + (b4 ? 1 : 0);
    *(uint2*)(CC + tok * 1024 + 768 + hd * 64 + c8 * 8 + (b3 ? 4 : 0)) = make_uint2(pack2(w4[0], w4[1]), pack2(w4[2], w4[3]));
  }
}

DI void phase_mix1(const Params& P, int layer, int bid, int nb, char* smem) {
  char* mb = WS(P) + OFF_H;
  for (int w = bid * 4 + (tidx() >> 6); w < 2048; w += nb * 4) ssm_scan<false>(P, layer, w, mb, smem);
  for (int j = 0;; j++) {
    const int idx = (j & 1) ? (j * nb + (nb - 1 - bid)) : (j * nb + bid);
    if (j * nb >= 2048) break;
    if (idx >= 2048) continue;
    const int qt = 255 - (idx >> 3), b = idx & 7;
    dsa_item(P, layer, b, qt, mb, smem);
  }
  for (int j = 0;; j++) {
    const int idx = (j & 1) ? (j * nb + (nb - 1 - bid)) : (j * nb + bid);
    if (j * nb >= 2048) break;
    if (idx >= 2048) continue;
    const int qt = 63 - (idx >> 5), bh = idx & 31;
    da_item(P, layer, bh >> 2, bh & 3, qt, mb, smem);
  }
}

DI void phase_mix2(const Params& P, int layer, int bid, int nb, char* smem) {
  char* mb = WS(P) + OFF_H;
  for (int w = bid * 4 + (tidx() >> 6); w < 2048; w += nb * 4) ssm_scan<true>(P, layer, w, mb, smem);
}

DI void run_phase(const Params& P, int ph, int bid, int nb, char* smem) {
  char* ws = WS(P);
  u16* sm = (u16*)smem;
  if (ph == 0) { phase_prep(P, bid, nb, smem); return; }
  const int l = (ph - 1) / 12, s = (ph - 1) % 12;
  u16* Xb = (u16*)(ws + OFF_XB);
  u16* H = (u16*)(ws + OFF_H);
  u16* CC = (u16*)(ws + OFF_CC);
  float* X = OUTP(P);
  switch (s) {
    case 0: phase_ffn_up(Xb, (const u16*)(ws + OFF_WGU1 + l * SZ_WGU), H, bid, nb, sm); break;
    case 1: phase_ffn_down(H, (const u16*)(ws + OFF_WD1 + l * SZ_WD), (l == 0) ? INP(P, 0) : (const float*)nullptr, Xb, X, nullptr, bid, nb, sm); break;
    case 2: phase_ln(X, Xb, INP(P, 6) + l * 1024, INP(P, 7) + l * 1024, false, bid, nb); break;
    case 3: phase_w_in(Xb, (const u16*)(ws + OFF_WIN + l * SZ_WIN), ws + OFF_H, bid, nb, sm); break;
    case 4: phase_mix1(P, l, bid, nb, smem); break;
    case 5: phase_mix2(P, l, bid, nb, smem); break;
    case 6: phase_glu((const u16*)(ws + OFF_H + M_YG), (const u16*)(ws + OFF_WGLU + l * SZ_WGLU), CC, bid, nb, sm); break;
    case 7: phase_w_o(CC, (const u16*)(ws + OFF_WO + l * SZ_WO), X, Xb, bid, nb, sm); break;
    case 8: phase_ln(X, Xb, INP(P, 24) + l * 1024, INP(P, 25) + l * 1024, false, bid, nb); break;
    case 9:
      phase_ffn_up(Xb, (const u16*)(ws + OFF_WGU2 + l * SZ_WGU), H, bid, nb, sm);
      phase_ple(Xb, (const u16*)(ws + OFF_WPG + l * SZ_WPG), (const u16*)(ws + OFF_PB) + (size_t)l * T_ * 256, (const u16*)(ws + OFF_WPP + l * SZ_WPP), CC, bid, nb, sm);
      break;
    case 10: phase_ffn_down(H, (const u16*)(ws + OFF_WD2 + l * SZ_WD), (const float*)nullptr, Xb, X, CC, bid, nb, sm); break;
    case 11: phase_ln(X, Xb, INP(P, 31) + l * 1024, INP(P, 32) + l * 1024, l == 1, bid, nb); break;
  }
}

#define XB_TMO      128
#define XB_XCNT(j)  (256  + 64 * (j))
#define XB_XSUB(j)  (1280 + 64 * (j))
#define XB_XGEN(j)  (2304 + 64 * (j))
#define XB_TOP      3328
#define XB_TOPGEN   3392
#define XCD_BAR_WORDS 3456
#define XB_SPIN_CAP (1u << 22)
#define LAS __attribute__((address_space(3)))

__device__ __forceinline__ unsigned xb_ld(unsigned* p)              { return __hip_atomic_load(p, __ATOMIC_RELAXED, __HIP_MEMORY_SCOPE_AGENT); }
__device__ __forceinline__ unsigned xb_add(unsigned* p, unsigned v) { return __hip_atomic_fetch_add(p, v, __ATOMIC_RELAXED, __HIP_MEMORY_SCOPE_AGENT); }
__device__ __forceinline__ unsigned xb_xcc_id() { return (unsigned)__builtin_amdgcn_s_getreg((3 << 11) | 20) & 0xFu; }
#define XB_SPIN(cond, bar) do { unsigned _sp = 0; while (cond) { __builtin_amdgcn_s_sleep(1); \
    if ((++_sp & 255u) == 0u) { if (xb_ld(&(bar)[XB_TMO])) break; if (_sp > XB_SPIN_CAP) { atomicAdd(&(bar)[XB_TMO], 1u); break; } } } } while (0)

struct XcdBarrier {
    unsigned* bar; unsigned x;
    volatile LAS unsigned* st;
};

__device__ __forceinline__ XcdBarrier xcd_barrier_post(unsigned* bar, volatile LAS unsigned* st) {
    XcdBarrier b; b.bar = bar; b.x = xb_xcc_id(); b.st = st;
    if (threadIdx.x == 0) (void)xb_add(&bar[XB_XCNT(b.x)], 1u);
    return b;
}
__device__ __forceinline__ void xcd_barrier_complete(unsigned* bar, unsigned x, unsigned& nloc, unsigned& nx) {
    const unsigned G = gridDim.x * gridDim.y * gridDim.z;
    unsigned sum, cnt, mine, sp = 0u;
    for (;;) {
        sum = 0u; cnt = 0u; mine = 0u;
#pragma unroll
        for (unsigned j = 0; j < 16; ++j) { const unsigned c = xb_ld(&bar[XB_XCNT(j)]); sum += c; cnt += (c > 0u) ? 1u : 0u; mine = (j == x) ? c : mine; }
        if (sum == G) break;
        __builtin_amdgcn_s_sleep(1);
        if ((++sp & 255u) == 0u) { if (xb_ld(&bar[XB_TMO])) break; if (sp > XB_SPIN_CAP) { atomicAdd(&bar[XB_TMO], 1u); break; } }
    }
    nloc = mine > 0u ? mine : 1u; nx = cnt > 0u ? cnt : 1u;
}

__device__ __forceinline__ void xcd_barrier(const XcdBarrier& b) {
    asm volatile("s_waitcnt vmcnt(0)" ::: "memory");
    __syncthreads();
    if (threadIdx.x == 0) {
        unsigned* bar = b.bar;
        __builtin_amdgcn_s_waitcnt(0);
        unsigned nloc = b.st[0], nx = b.st[1];
        if (nloc == 0u) { xcd_barrier_complete(bar, b.x, nloc, nx); b.st[0] = nloc; b.st[1] = nx; }
        const unsigned old = xb_add(&bar[XB_XSUB(b.x)], 1u);
        const unsigned gen = old / nloc;
        if (old + 1u == (gen + 1u) * nloc) {
            __builtin_amdgcn_fence(__ATOMIC_RELEASE, "agent");
            asm volatile("s_waitcnt vmcnt(0)" ::: "memory");
            const unsigned og = xb_add(&bar[XB_TOP], 1u);
            const unsigned tg = og / nx;
            if (og + 1u == (tg + 1u) * nx) xb_add(&bar[XB_TOPGEN], 1u);
            else XB_SPIN(xb_ld(&bar[XB_TOPGEN]) == tg, bar);
            __builtin_amdgcn_fence(__ATOMIC_ACQUIRE, "agent");
            xb_add(&bar[XB_XGEN(b.x)], 1u);
            asm volatile("s_waitcnt vmcnt(0)" ::: "memory");
        } else {
            XB_SPIN(xb_ld(&bar[XB_XGEN(b.x)]) == gen, bar);
            __builtin_amdgcn_fence(__ATOMIC_ACQUIRE, "agent");
            asm volatile("s_waitcnt vmcnt(0)" ::: "memory");
        }
    }
    __syncthreads();
}


constexpr int NPHASES = 25;

__global__ void __launch_bounds__(256, 2) mega(Params P, int ph0, int ph1) {
  extern __shared__ __attribute__((aligned(16))) char smem[];
  cg::grid_group grid = cg::this_grid();
  const int bid = blockIdx.x, nb = gridDim.x;
  volatile LAS unsigned* xst = (volatile LAS unsigned*)(smem + 73712);
  if (threadIdx.x == 0) { xst[0] = 0u; xst[1] = 0u; xst[2] = 0u; xst[3] = 0u; }
  __syncthreads();
  const XcdBarrier xbar = xcd_barrier_post((unsigned*)(P.ws + OFF_XBAR), xst);
#ifndef DUP_MASK
#define DUP_MASK 0
#endif
#define PHASE(k) if (ph0 <= (k) && (k) < ph1) { \
    if ((k) > 0 && ((DUP_MASK >> (((k) - 1) % 12)) & 1)) { run_phase(P, (k), bid, nb, smem); grid.sync(); } \
    run_phase(P, (k), bid, nb, smem); if ((k) + 1 < ph1) { if (ph0 < 0) grid.sync(); else xcd_barrier(xbar); } }
  PHASE(0) PHASE(1) PHASE(2) PHASE(3) PHASE(4) PHASE(5) PHASE(6) PHASE(7) PHASE(8) PHASE(9) PHASE(10) PHASE(11) PHASE(12)
  PHASE(13) PHASE(14) PHASE(15) PHASE(16) PHASE(17) PHASE(18) PHASE(19) PHASE(20) PHASE(21) PHASE(22) PHASE(23) PHASE(24)
#undef PHASE
}

extern "C" void kernel_launch(void* const* d_in, const int* in_sizes, int n_in, void* d_out, int out_size, void* d_ws, size_t ws_size, hipStream_t stream) {
  static int grid_blocks = 0;
  if (grid_blocks == 0) {
    if (n_in != 33 || ws_size < WS_END) { fprintf(stderr, "kernel_launch: need 33 inputs and %zu bytes of ws (got %d, %zu)\n", (size_t)WS_END, n_in, ws_size); grid_blocks = -1; return; }
    int dev = 0, cus = 0, per_cu = 0;
    (void)hipGetDevice(&dev);
    (void)hipDeviceGetAttribute(&cus, hipDeviceAttributeMultiprocessorCount, dev);
    (void)hipFuncSetAttribute((const void*)mega, hipFuncAttributeMaxDynamicSharedMemorySize, LDS_BYTES);
    (void)hipOccupancyMaxActiveBlocksPerMultiprocessor(&per_cu, (const void*)mega, 256, LDS_BYTES);
    if (per_cu < 1) per_cu = 1;
    if (per_cu > 2) per_cu = 2;
    grid_blocks = cus * per_cu;
    fprintf(stderr, "kernel_launch: cus %d per_cu %d grid %d\n", cus, per_cu, grid_blocks);
  }
  if (grid_blocks < 0) return;
  Params p;
  memset(&p, 0, sizeof(p));
  for (int i = 0; i < 33; i++) p.in[i] = (const float*)d_in[i];
  p.out = (float*)d_out;
  p.ws = (char*)d_ws;
#if MULTI_LAUNCH
  for (int ph = 0; ph < NPHASES; ph++) {
    hipLaunchKernelGGL(mega, dim3(grid_blocks), dim3(256), LDS_BYTES, stream, p, ph, ph + 1);
  }
#else
  int ph0 = 0, ph1 = NPHASES;
  (void)hipMemsetAsync((char*)d_ws + OFF_XBAR, 0, XCD_BAR_WORDS * 4, stream);
  void* args[] = {&p, &ph0, &ph1};
  hipError_t e = hipLaunchCooperativeKernel((const void*)mega, dim3(grid_blocks), dim3(256), args, LDS_BYTES, stream);
  if (e != hipSuccess) fprintf(stderr, "cooperative launch failed: %s (grid %d)\n", hipGetErrorString(e), grid_blocks);
#endif
}
```

```cpp
#include <hip/hip_runtime.h>
#include <hip/hip_cooperative_groups.h>
#include <stdint.h>
#include <math.h>
#include <stdio.h>
#include <string.h>
namespace cg = cooperative_groups;

#ifndef MULTI_LAUNCH
#define MULTI_LAUNCH 0
#endif

typedef unsigned short u16;
typedef __attribute__((ext_vector_type(8))) short bf16x8;
typedef __attribute__((ext_vector_type(4))) short s16x4;
typedef __attribute__((ext_vector_type(16))) float f32x16;
typedef __attribute__((ext_vector_type(4))) unsigned u32x4;
typedef __attribute__((ext_vector_type(2))) unsigned u32x2;

#define DI __device__ __forceinline__
#define MFMA32(a, b, c) __builtin_amdgcn_mfma_f32_32x32x16_bf16((a), (b), (c), 0, 0, 0)

constexpr int T_ = 65536;
constexpr int L_ = 8192;
constexpr int D_ = 1024;
constexpr int FF_ = 2816;
constexpr float ALPHA_ = 1.41421356237309515f;
constexpr float LN_EPS_ = 1e-5f;
constexpr float LOG2E_ = 1.44269504088896341f;
constexpr int LDS_BYTES = 73728;

constexpr size_t SZ_WGU = (size_t)5632 * 1024 * 2;
constexpr size_t SZ_WD = (size_t)1024 * 2816 * 2;
constexpr size_t SZ_WIN = (size_t)2560 * 1024 * 2;
constexpr size_t SZ_WO = (size_t)1024 * 1024 * 2;
constexpr size_t SZ_WGLU = (size_t)256 * 256 * 2;
constexpr size_t SZ_WPG = (size_t)1024 * 1024 * 2;
constexpr size_t SZ_WPP = (size_t)1024 * 256 * 2;
constexpr size_t OFF_WGU1 = 0;
constexpr size_t OFF_WD1 = OFF_WGU1 + 2 * SZ_WGU;
constexpr size_t OFF_WGU2 = OFF_WD1 + 2 * SZ_WD;
constexpr size_t OFF_WD2 = OFF_WGU2 + 2 * SZ_WGU;
constexpr size_t OFF_WIN = OFF_WD2 + 2 * SZ_WD;
constexpr size_t OFF_WO = OFF_WIN + 2 * SZ_WIN;
constexpr size_t OFF_WGLU = OFF_WO + 2 * SZ_WO;
constexpr size_t OFF_WPG = OFF_WGLU + 2 * SZ_WGLU;
constexpr size_t OFF_WPP = OFF_WPG + 2 * SZ_WPG;
constexpr size_t OFF_COEFA = OFF_WPP + 2 * SZ_WPP;
constexpr size_t OFF_COEFB = OFF_COEFA + 2 * 16 * 64 * 16;
constexpr size_t OFF_LAM = OFF_COEFB + 2 * 16 * 64 * 16 * 8;
constexpr size_t OFF_BIAS = OFF_LAM + 256;
constexpr size_t OFF_XBAR = OFF_BIAS + 8 * 129 * 4 + 32;
constexpr size_t OFF_XB = OFF_XBAR + 16384;
constexpr size_t OFF_PB = OFF_XB + (size_t)T_ * 1024 * 2;
constexpr size_t OFF_H = OFF_PB + (size_t)2 * T_ * 256 * 2;
constexpr size_t SZ_H = (size_t)384 << 20;
constexpr size_t OFF_CC = OFF_H + SZ_H;
constexpr size_t OFF_CANDK = OFF_CC + (size_t)T_ * 1024 * 2;
constexpr int CAP_ = 2048;
constexpr size_t OFF_CANDI = OFF_CANDK + (size_t)512 * 32 * CAP_ * 4;
constexpr size_t WS_END = OFF_CANDI + (size_t)512 * 32 * CAP_ * 2;
constexpr size_t MB_ = (size_t)1 << 20;
constexpr size_t M_QD = 0, M_KD = 64 * MB_, M_VT = 128 * MB_, M_U = 192 * MB_, M_QS = 256 * MB_, M_QI = 288 * MB_, M_YG = 320 * MB_,
                 M_KS = 352 * MB_, M_VS = 360 * MB_, M_KI = 368 * MB_, M_WI = 372 * MB_, M_SEND = 374 * MB_;

struct Params {
  const float* in[33];
  float* out;
  char* ws;
};

DI int tidx() { int t = threadIdx.x; asm volatile("" : "+v"(t)); return t; }
#define GAS __attribute__((address_space(1)))
DI size_t opaque0() { size_t z = 0; asm volatile("" : "+s"(z)); return z; }
DI char* WS(const Params& P) { return P.ws + opaque0(); }
DI float* OUTP(const Params& P) { return P.out + opaque0(); }
DI const float* INP(const Params& P, int i) { return P.in[i]; }
typedef __bf16 bf16v2_ __attribute__((ext_vector_type(2)));
typedef float f32v2_ __attribute__((ext_vector_type(2)));
DI u16 f2bf(float x) { const __bf16 h = (__bf16)x; return __builtin_bit_cast(u16, h); }
DI float bf2f(u16 v) { return __uint_as_float(((unsigned)v) << 16); }
DI unsigned pack2(float a, float b) { f32v2_ v; v.x = a; v.y = b; const bf16v2_ h = __builtin_convertvector(v, bf16v2_); return __builtin_bit_cast(unsigned, h); }
DI int crow(int i, int hh) { return (i & 3) + 8 * (i >> 2) + 4 * hh; }
DI float sigmoidf_(float x) { return __builtin_amdgcn_rcpf(1.f + __expf(-x)); }
DI float wave_sum(float v) { for (int o = 32; o > 0; o >>= 1) v += __shfl_xor(v, o); return v; }
DI float wave_max(float v) { for (int o = 32; o > 0; o >>= 1) v = fmaxf(v, __shfl_xor(v, o)); return v; }
DI f32x16 zero16() { f32x16 z; for (int i = 0; i < 16; i++) z[i] = 0.f; return z; }
DI bf16x8 pack8(const f32x16& x, int s) {
  union { unsigned u[4]; bf16x8 v; } t;
  t.u[0] = pack2(x[8 * s + 0], x[8 * s + 1]); t.u[1] = pack2(x[8 * s + 2], x[8 * s + 3]);
  t.u[2] = pack2(x[8 * s + 4], x[8 * s + 5]); t.u[3] = pack2(x[8 * s + 6], x[8 * s + 7]);
  return t.v;
}

constexpr int GS_ = 72;
constexpr int GT_ = 128 * GS_;

constexpr int GST_ = 32768;
DI void gemm_stage(const u16* __restrict__ A, int lda, const u16* __restrict__ B, int ldb, int kt, char* sbuf) {
  const int tid = tidx(), lane = tid & 63, wave = __builtin_amdgcn_readfirstlane(tid >> 6);
  const int pp = lane >> 4, pos = lane & 15;
#pragma unroll
  for (int i = 0; i < 4; i++) {
    const int blk = i * 4 + wave;
    const int p = blk * 4 + pp;
    const int row = 2 * p + (pos >> 3), c8 = (pos & 7) ^ (p & 7);
    const u16* ga = A + (size_t)row * lda + kt * 64 + c8 * 8;
    const u16* gb = B + (size_t)row * ldb + kt * 64 + c8 * 8;
    __builtin_amdgcn_global_load_lds((const GAS void*)ga, (__attribute__((address_space(3))) void*)(sbuf + blk * 1024), 16, 0, 0);
    __builtin_amdgcn_global_load_lds((const GAS void*)gb, (__attribute__((address_space(3))) void*)(sbuf + 16384 + blk * 1024), 16, 0, 0);
  }
}
DI void gemm_main(f32x16 (&acc)[2][2], const u16* __restrict__ A, int lda, const u16* __restrict__ B, int ldb, int K, u16* sm) {
  const int tid = tidx(), lane = tid & 63, wave = tid >> 6;
  const int wm = wave >> 1, wn = wave & 1, r = lane & 31, hh = lane >> 5;
  char* sb = (char*)sm;
  const int rowa = wm * 64 + r, rowb = wn * 64 + r;
  const int baseA = (rowa >> 1) * 256 + ((rowa & 1) << 7), xa = (rowa >> 1) & 7;
  const int baseB = 16384 + (rowb >> 1) * 256 + ((rowb & 1) << 7), xb = (rowb >> 1) & 7;
  const int nk = K >> 6;
  asm volatile("s_waitcnt vmcnt(0)" ::: "memory");
  __syncthreads();
#pragma unroll 1
  for (int kt = 0; kt < nk; kt++) {
    if (kt + 1 < nk) gemm_stage(A, lda, B, ldb, kt + 1, sb + ((kt + 1) & 1) * GST_);
    const char* st = sb + (kt & 1) * GST_;
#pragma unroll
    for (int ks = 0; ks < 4; ks++) {
      const int ca = ((ks * 2 + hh) ^ xa) << 4, cb = ((ks * 2 + hh) ^ xb) << 4;
      const bf16x8 fa0 = *(const bf16x8*)(st + baseA + ca);
      const bf16x8 fa1 = *(const bf16x8*)(st + baseA + 4096 + ca);
      const bf16x8 fb0 = *(const bf16x8*)(st + baseB + cb);
      const bf16x8 fb1 = *(const bf16x8*)(st + baseB + 4096 + cb);
      acc[0][0] = MFMA32(fa0, fb0, acc[0][0]); acc[0][1] = MFMA32(fa0, fb1, acc[0][1]);
      acc[1][0] = MFMA32(fa1, fb0, acc[1][0]); acc[1][1] = MFMA32(fa1, fb1, acc[1][1]);
    }
    asm volatile("s_waitcnt vmcnt(0)" ::: "memory");
    __syncthreads();
  }
}

DI bool tile_at(int it, int bid, int nb, int TM, int TN, int& tm, int& tn) {
  if ((nb & 7) == 0 && (TM & 63) == 0) {
    const int xcd = bid & 7, lw = bid >> 3, nlw = nb >> 3;
    const int lt = lw + it * nlw, per = (TM >> 3) * TN;
    if (lt >= per) return false;
    const int g = lt / (4 * TN), rem = lt - g * 4 * TN;
    tn = rem >> 2; tm = xcd * (TM >> 3) + g * 4 + (rem & 3);
    return true;
  } else {
    const int t = bid + it * nb;
    if (t >= TM * TN) return false;
    tn = t / TM; tm = t - tn * TM;
    return true;
  }
}

template <class AF, class BF, class INI, class EPI>
DI void gemm_phase_init(int TM, int TN, int K, int lda, int ldb, AF a_of, BF b_of, INI ini, EPI epi, int bid, int nb, u16* sm) {
  int tm, tn;
  bool have = tile_at(0, bid, nb, TM, TN, tm, tn);
  __syncthreads();
  if (have) gemm_stage(a_of(tm), lda, b_of(tn), ldb, 0, (char*)sm);
  for (int it = 0; have; it++) {
    f32x16 acc[2][2];
    ini(acc, tm, tn);
    gemm_main(acc, a_of(tm), lda, b_of(tn), ldb, K, sm);
    int tm2 = 0, tn2 = 0;
    const bool have2 = tile_at(it + 1, bid, nb, TM, TN, tm2, tn2);
    if (have2) gemm_stage(a_of(tm2), lda, b_of(tn2), ldb, 0, (char*)sm);
    epi(acc, tm, tn);
    have = have2; tm = tm2; tn = tn2;
  }
  asm volatile("s_waitcnt vmcnt(0)" ::: "memory");
}
template <class AF, class BF, class EPI>
DI void gemm_phase(int TM, int TN, int K, int lda, int ldb, AF a_of, BF b_of, EPI epi, int bid, int nb, u16* sm) {
  gemm_phase_init(TM, TN, K, lda, ldb, a_of, b_of,
    [&](f32x16 (&acc)[2][2], int, int) { acc[0][0] = zero16(); acc[0][1] = zero16(); acc[1][0] = zero16(); acc[1][1] = zero16(); },
    epi, bid, nb, sm);
}

DI void transpose_job(const float* __restrict__ src, int K, int N, u16* __restrict__ dst, int mode, int bid, int nb, float* tile) {
  const int tid = tidx();
  const int tk = K >> 6, tn = (N + 63) >> 6;
  for (int t = bid; t < tk * tn; t += nb) {
    const int k0 = (t % tk) * 64, n0 = (t / tk) * 64;
    __syncthreads();
#pragma unroll 4
    for (int i = 0; i < 16; i++) {
      const int k = i * 4 + (tid >> 6), n = tid & 63;
      tile[k * 65 + n] = (n0 + n < N) ? src[(size_t)(k0 + k) * N + n0 + n] : 0.f;
    }
    __syncthreads();
#pragma unroll 4
    for (int i = 0; i < 16; i++) {
      const int n = i * 4 + (tid >> 6), k = tid & 63;
      const int ng = n0 + n;
      if (ng < N) {
        int row = ng;
        if (mode == 1) row = (ng >> 5) * 64 + (ng & 31);
        else if (mode == 2) row = (ng >> 5) * 64 + 32 + (ng & 31);
        dst[(size_t)row * K + k0 + k] = f2bf(tile[k * 65 + n]);
      }
    }
  }
}

DI void phase_prep(const Params& P, int bid, int nb, char* smem) {
  float* tile = (float*)smem;
  char* ws = WS(P);
  for (int l = 0; l < 2; l++) {
    transpose_job(INP(P, 3) + (size_t)l * 1024 * FF_, 1024, FF_, (u16*)(ws + OFF_WGU1 + l * SZ_WGU), 1, bid, nb, tile);
    transpose_job(INP(P, 4) + (size_t)l * 1024 * FF_, 1024, FF_, (u16*)(ws + OFF_WGU1 + l * SZ_WGU), 2, bid, nb, tile);
    transpose_job(INP(P, 5) + (size_t)l * FF_ * 1024, FF_, 1024, (u16*)(ws + OFF_WD1 + l * SZ_WD), 0, bid, nb, tile);
    transpose_job(INP(P, 26) + (size_t)l * 1024 * FF_, 1024, FF_, (u16*)(ws + OFF_WGU2 + l * SZ_WGU), 1, bid, nb, tile);
    transpose_job(INP(P, 27) + (size_t)l * 1024 * FF_, 1024, FF_, (u16*)(ws + OFF_WGU2 + l * SZ_WGU), 2, bid, nb, tile);
    transpose_job(INP(P, 28) + (size_t)l * FF_ * 1024, FF_, 1024, (u16*)(ws + OFF_WD2 + l * SZ_WD), 0, bid, nb, tile);
    transpose_job(INP(P, 8) + (size_t)l * 1024 * 2472, 1024, 2472, (u16*)(ws + OFF_WIN + l * SZ_WIN), 0, bid, nb, tile);
    transpose_job(INP(P, 9) + (size_t)l * 1024 * 1024, 1024, 1024, (u16*)(ws + OFF_WO + l * SZ_WO), 0, bid, nb, tile);
    transpose_job(INP(P, 23) + (size_t)l * 256 * 256, 256, 256, (u16*)(ws + OFF_WGLU + l * SZ_WGLU), 0, bid, nb, tile);
    transpose_job(INP(P, 30) + (size_t)l * 1024 * 1024, 1024, 1024, (u16*)(ws + OFF_WPG + l * SZ_WPG), 0, bid, nb, tile);
    transpose_job(INP(P, 29) + (size_t)l * 256 * 1024, 256, 1024, (u16*)(ws + OFF_WPP + l * SZ_WPP), 0, bid, nb, tile);
    u16* win = (u16*)(ws + OFF_WIN + l * SZ_WIN);
    for (int i = bid * 256 + tidx(); i < 88 * 1024; i += nb * 256) win[(size_t)2472 * 1024 + i] = 0;
  }
  const size_t gt = (size_t)bid * 256 + tidx(), gs = (size_t)nb * 256;
  {
    const float4* x4 = (const float4*)INP(P, 0);
    uint2* xb = (uint2*)(ws + OFF_XB);
    for (size_t i = gt; i < (size_t)T_ * 1024 / 4; i += gs * 8) {
      float4 v[8];
#pragma unroll
      for (int u = 0; u < 8; u++) v[u] = (i + u * gs < (size_t)T_ * 1024 / 4) ? x4[i + u * gs] : make_float4(0.f, 0.f, 0.f, 0.f);
#pragma unroll
      for (int u = 0; u < 8; u++) if (i + u * gs < (size_t)T_ * 1024 / 4) xb[i + u * gs] = make_uint2(pack2(v[u].x, v[u].y), pack2(v[u].z, v[u].w));
    }
    const float4* p4 = (const float4*)INP(P, 1);
    uint2* pb = (uint2*)(ws + OFF_PB);
    for (size_t i = gt; i < (size_t)2 * T_ * 256 / 4; i += gs * 8) {
      float4 v[8];
#pragma unroll
      for (int u = 0; u < 8; u++) v[u] = (i + u * gs < (size_t)2 * T_ * 256 / 4) ? p4[i + u * gs] : make_float4(0.f, 0.f, 0.f, 0.f);
#pragma unroll
      for (int u = 0; u < 8; u++) if (i + u * gs < (size_t)2 * T_ * 256 / 4) pb[i + u * gs] = make_uint2(pack2(v[u].x, v[u].y), pack2(v[u].z, v[u].w));
    }
  }
  if (gt < 2 * 16 * 64) {
    const int l = (int)gt >> 10, g = ((int)gt >> 6) & 15, p = (int)gt & 63;
    const int gi = (l * 16 + g) * 64 + p;
    const double lr = INP(P, 15)[gi], li = INP(P, 16)[gi];
    const double dt = exp((double)INP(P, 17)[l * 16 + g]);
    const double mag = exp(lr * dt);
    const double ar = mag * cos(li * dt), ai = mag * sin(li * dt);
    const double mag5 = exp(512.0 * lr * dt);
    const double a5r = mag5 * cos(512.0 * li * dt), a5i = mag5 * sin(512.0 * li * dt);
    ((float4*)(ws + OFF_COEFA))[gi] = make_float4((float)ar, (float)ai, (float)a5r, (float)a5i);
    const double den = lr * lr + li * li, nr = ar - 1.0, ni = ai;
    const double fr = (nr * lr + ni * li) / den, fi = (ni * lr - nr * li) / den;
    float2* cb = (float2*)(ws + OFF_COEFB) + (size_t)gi * 16;
    for (int c = 0; c < 16; c++) {
      const double br = INP(P, 18)[(size_t)gi * 16 + c], bi = INP(P, 19)[(size_t)gi * 16 + c];
      cb[c] = make_float2((float)(fr * br - fi * bi), (float)(fr * bi + fi * br));
    }
  }
  if (gt < 8 * 129) {
    const int hd = (int)gt / 129, n = (int)gt - hd * 129;
    int bk = n;
    if (n >= 16) { bk = 16 + (int)(log((double)n / 16.0) / log(8.0) * 16.0); bk = bk < 31 ? bk : 31; }
    ((float*)(ws + OFF_BIAS))[gt] = INP(P, 2)[bk * 8 + hd];
  }
  if (gt < 2) {
    const int l = (int)gt;
    float s1 = 0.f, s2 = 0.f;
    for (int i = 0; i < 64; i++) { s1 += INP(P, 10)[l * 64 + i] * INP(P, 11)[l * 64 + i]; s2 += INP(P, 12)[l * 64 + i] * INP(P, 13)[l * 64 + i]; }
    const float lam_init = 0.8f - 0.6f * expf(-0.3f * (float)l);
    ((float*)(ws + OFF_LAM))[l] = expf(s1) - expf(s2) + lam_init;
  }
}

DI void phase_ffn_up(const u16* __restrict__ Xb, const u16* __restrict__ Wgu, u16* __restrict__ H, int bid, int nb, u16* sm) {
  const int lane = tidx() & 63, wave = tidx() >> 6, wm = wave >> 1, wn = wave & 1, r = lane & 31, hh = lane >> 5;
  gemm_phase(512, 44, 1024, 1024, 1024,
    [&](int tm) { return Xb + (size_t)tm * 128 * 1024; }, [&](int tn) { return Wgu + (size_t)tn * 128 * 1024; },
    [&](f32x16 (&acc)[2][2], int tm, int tn) {
      const int j = tn * 64 + wn * 32 + r;
#pragma unroll
      for (int mi = 0; mi < 2; mi++)
#pragma unroll
        for (int i = 0; i < 16; i++) {
          const int row = tm * 128 + wm * 64 + mi * 32 + crow(i, hh);
          const float g = acc[mi][0][i], u = acc[mi][1][i];
          H[(size_t)row * FF_ + j] = f2bf(g * sigmoidf_(g) * u);
        }
    }, bid, nb, sm);
}

DI void phase_ffn_down(const u16* __restrict__ H, const u16* __restrict__ Wd, const float* xin, const u16* __restrict__ xinb, float* xout, const u16* __restrict__ ple, int bid, int nb, u16* sm) {
  const int lane = tidx() & 63, wave = tidx() >> 6, wm = wave >> 1, wn = wave & 1, r = lane & 31, hh = lane >> 5;
  gemm_phase_init(512, 8, FF_, FF_, FF_,
    [&](int tm) { return H + (size_t)tm * 128 * FF_; }, [&](int tn) { return Wd + (size_t)tn * 128 * FF_; },
    [&](f32x16 (&acc)[2][2], int tm, int tn) {
#pragma unroll
      for (int mi = 0; mi < 2; mi++)
#pragma unroll
        for (int ni = 0; ni < 2; ni++)
#pragma unroll
          for (int i = 0; i < 16; i++) {
            const size_t o = (size_t)(tm * 128 + wm * 64 + mi * 32 + crow(i, hh)) * 1024 + tn * 128 + wn * 64 + ni * 32 + r;
            float v = 2.f * ALPHA_ * (xin ? xin[o] : bf2f(xinb[o]));
            if (ple) v += 2.f * bf2f(ple[o]);
            acc[mi][ni][i] = v;
          }
    },
    [&](f32x16 (&acc)[2][2], int tm, int tn) {
#pragma unroll
      for (int mi = 0; mi < 2; mi++)
#pragma unroll
        for (int ni = 0; ni < 2; ni++)
#pragma unroll
          for (int i = 0; i < 16; i++) {
            const size_t o = (size_t)(tm * 128 + wm * 64 + mi * 32 + crow(i, hh)) * 1024 + tn * 128 + wn * 64 + ni * 32 + r;
            xout[o] = 0.5f * acc[mi][ni][i];
          }
    }, bid, nb, sm);
}

DI void phase_w_o(const u16* __restrict__ CC, const u16* __restrict__ Wo, float* x, const u16* __restrict__ xb, int bid, int nb, u16* sm) {
  const int lane = tidx() & 63, wave = tidx() >> 6, wm = wave >> 1, wn = wave & 1, r = lane & 31, hh = lane >> 5;
  gemm_phase_init(512, 8, 1024, 1024, 1024,
    [&](int tm) { return CC + (size_t)tm * 128 * 1024; }, [&](int tn) { return Wo + (size_t)tn * 128 * 1024; },
    [&](f32x16 (&acc)[2][2], int tm, int tn) {
#pragma unroll
      for (int mi = 0; mi < 2; mi++)
#pragma unroll
        for (int ni = 0; ni < 2; ni++)
#pragma unroll
          for (int i = 0; i < 16; i++) {
            const size_t o = (size_t)(tm * 128 + wm * 64 + mi * 32 + crow(i, hh)) * 1024 + tn * 128 + wn * 64 + ni * 32 + r;
            acc[mi][ni][i] = ALPHA_ * bf2f(xb[o]);
          }
    },
    [&](f32x16 (&acc)[2][2], int tm, int tn) {
#pragma unroll
      for (int mi = 0; mi < 2; mi++)
#pragma unroll
        for (int ni = 0; ni < 2; ni++)
#pragma unroll
          for (int i = 0; i < 16; i++) {
            const size_t o = (size_t)(tm * 128 + wm * 64 + mi * 32 + crow(i, hh)) * 1024 + tn * 128 + wn * 64 + ni * 32 + r;
            x[o] = acc[mi][ni][i];
          }
    }, bid, nb, sm);
}

DI void phase_glu(const u16* __restrict__ Yg, const u16* __restrict__ Wglu, u16* __restrict__ CC, int bid, int nb, u16* sm) {
  const int lane = tidx() & 63, wave = tidx() >> 6, wm = wave >> 1, wn = wave & 1, r = lane & 31, hh = lane >> 5;
  gemm_phase(512, 2, 256, 256, 256,
    [&](int tm) { return Yg + (size_t)tm * 128 * 256; }, [&](int tn) { return Wglu + (size_t)tn * 128 * 256; },
    [&](f32x16 (&acc)[2][2], int tm, int tn) {
#pragma unroll
      for (int mi = 0; mi < 2; mi++)
#pragma unroll
        for (int ni = 0; ni < 2; ni++)
#pragma unroll
          for (int i = 0; i < 16; i++) {
            const int row = tm * 128 + wm * 64 + mi * 32 + crow(i, hh), col = tn * 128 + wn * 64 + ni * 32 + r;
            const float y = bf2f(Yg[(size_t)row * 256 + col]);
            CC[(size_t)row * 1024 + 512 + col] = f2bf(y * sigmoidf_(acc[mi][ni][i]));
          }
    }, bid, nb, sm);
}

DI void phase_ple(const u16* __restrict__ Xb, const u16* __restrict__ Wpg, const u16* __restrict__ Pb, const u16* __restrict__ Wpp, u16* ple, int bid, int nb, u16* sm) {
  const int lane = tidx() & 63, wave = tidx() >> 6, wm = wave >> 1, wn = wave & 1, r = lane & 31, hh = lane >> 5;
  gemm_phase(512, 8, 1024, 1024, 1024,
    [&](int tm) { return Xb + (size_t)tm * 128 * 1024; }, [&](int tn) { return Wpg + (size_t)tn * 128 * 1024; },
    [&](f32x16 (&acc)[2][2], int tm, int tn) {
#pragma unroll
      for (int mi = 0; mi < 2; mi++)
#pragma unroll
        for (int ni = 0; ni < 2; ni++)
#pragma unroll
          for (int i = 0; i < 16; i++) {
            const size_t o = (size_t)(tm * 128 + wm * 64 + mi * 32 + crow(i, hh)) * 1024 + tn * 128 + wn * 64 + ni * 32 + r;
            ple[o] = f2bf(sigmoidf_(acc[mi][ni][i]));
          }
    }, bid, nb, sm);
  gemm_phase(512, 8, 256, 256, 256,
    [&](int tm) { return Pb + (size_t)tm * 128 * 256; }, [&](int tn) { return Wpp + (size_t)tn * 128 * 256; },
    [&](f32x16 (&acc)[2][2], int tm, int tn) {
#pragma unroll
      for (int mi = 0; mi < 2; mi++)
#pragma unroll
        for (int ni = 0; ni < 2; ni++)
#pragma unroll
          for (int i = 0; i < 16; i++) {
            const size_t o = (size_t)(tm * 128 + wm * 64 + mi * 32 + crow(i, hh)) * 1024 + tn * 128 + wn * 64 + ni * 32 + r;
            ple[o] = f2bf(acc[mi][ni][i] * bf2f(ple[o]));
          }
    }, bid, nb, sm);
}

DI void phase_w_in(const u16* __restrict__ Xb, const u16* __restrict__ Win, char* mb, int bid, int nb, u16* sm) {
  const int lane = tidx() & 63, wave = tidx() >> 6, wm = wave >> 1, wn = wave & 1, r = lane & 31, hh = lane >> 5;
  u16* Qd = (u16*)(mb + M_QD); u16* Kd = (u16*)(mb + M_KD); u16* Vt = (u16*)(mb + M_VT); float* U = (float*)(mb + M_U);
  u16* Qs = (u16*)(mb + M_QS); u16* Qi = (u16*)(mb + M_QI); u16* Ks = (u16*)(mb + M_KS); u16* Vs = (u16*)(mb + M_VS);
  u16* Ki = (u16*)(mb + M_KI); float* Wi = (float*)(mb + M_WI);
  gemm_phase(512, 20, 1024, 1024, 1024,
    [&](int tm) { return Xb + (size_t)tm * 128 * 1024; }, [&](int tn) { return Win + (size_t)tn * 128 * 1024; },
    [&](f32x16 (&acc)[2][2], int tm, int tn) {
#pragma unroll
    for (int ni = 0; ni < 2; ni++) {
      const int c0 = tn * 128 + wn * 64 + ni * 32;
      const int c = c0 + r;
#pragma unroll
      for (int mi = 0; mi < 2; mi++) {
        const int rowb = tm * 128 + wm * 64 + mi * 32;
        if (c0 >= 1024 && c0 < 1536) {
          const int cc = c - 1024, head = cc >> 7, dv = cc & 127;
          const int b = rowb >> 13, t0 = rowb & 8191;
#pragma unroll
          for (int g4 = 0; g4 < 4; g4++) {
            uint2 v = make_uint2(pack2(acc[mi][ni][4 * g4], acc[mi][ni][4 * g4 + 1]), pack2(acc[mi][ni][4 * g4 + 2], acc[mi][ni][4 * g4 + 3]));
            const int tt = t0 + 8 * g4 + 4 * hh;
            *(uint2*)(Vt + ((size_t)(((b * 4 + head) * 128 + (tt >> 6)) * 128 + dv)) * 64 + (tt & 63)) = v;
          }
        } else {
#pragma unroll
          for (int i = 0; i < 16; i++) {
            const size_t row = rowb + crow(i, hh);
            const float v = acc[mi][ni][i];
            if (c0 < 512) Qd[row * 512 + c] = f2bf(v);
            else if (c0 < 1024) {
              const int cc = c - 512;
              Kd[((size_t)((((int)(row >> 13) * 4 + (cc >> 7)) * 2 + ((cc >> 6) & 1))) * L_ + (row & 8191)) * 64 + (cc & 63)] = f2bf(v);
            }
            else if (c0 < 1792) U[row * 256 + (c - 1536)] = v;
            else if (c0 < 2048) Qs[row * 256 + (c - 1792)] = f2bf(v);
            else if (c0 < 2112) Ks[row * 64 + (c - 2048)] = f2bf(v);
            else if (c0 < 2176) Vs[row * 64 + (c - 2112)] = f2bf(v);
            else if (c0 < 2432) Qi[row * 256 + (c - 2176)] = f2bf(v);
            else if (c0 < 2464) Ki[row * 32 + (c - 2432)] = f2bf(v);
            else if (c0 == 2464) { if (r < 8) Wi[row * 8 + r] = v * 0.0625f; }
          }
        }
      }
    }
  }, bid, nb, sm);
}

DI void phase_ln(float* x, u16* __restrict__ xb, const float* __restrict__ g, const float* __restrict__ bta, bool write_f32, int bid, int nb) {
  const int lane = tidx() & 63, wave = tidx() >> 6;
  float4 gg[4], bb[4];
#pragma unroll
  for (int i = 0; i < 4; i++) { gg[i] = *(const float4*)(g + i * 256 + lane * 4); bb[i] = *(const float4*)(bta + i * 256 + lane * 4); }
  constexpr int RB = 4;
  for (int row0 = (bid * 4 + wave) * RB; row0 < T_; row0 += nb * 4 * RB) {
    float4 v[RB][4];
#pragma unroll
    for (int rr = 0; rr < RB; rr++)
#pragma unroll
      for (int i = 0; i < 4; i++) v[rr][i] = *(const float4*)(x + (size_t)(row0 + rr) * 1024 + i * 256 + lane * 4);
    float s[RB], q[RB];
#pragma unroll
    for (int rr = 0; rr < RB; rr++) {
      s[rr] = 0.f;
#pragma unroll
      for (int i = 0; i < 4; i++) s[rr] += v[rr][i].x + v[rr][i].y + v[rr][i].z + v[rr][i].w;
    }
#pragma unroll
    for (int o = 32; o > 0; o >>= 1)
#pragma unroll
      for (int rr = 0; rr < RB; rr++) s[rr] += __shfl_xor(s[rr], o);
#pragma unroll
    for (int rr = 0; rr < RB; rr++) {
      const float mu = s[rr] * (1.f / 1024.f);
      q[rr] = 0.f;
#pragma unroll
      for (int i = 0; i < 4; i++) {
        v[rr][i].x -= mu; v[rr][i].y -= mu; v[rr][i].z -= mu; v[rr][i].w -= mu;
        q[rr] += v[rr][i].x * v[rr][i].x + v[rr][i].y * v[rr][i].y + v[rr][i].z * v[rr][i].z + v[rr][i].w * v[rr][i].w;
      }
    }
#pragma unroll
    for (int o = 32; o > 0; o >>= 1)
#pragma unroll
      for (int rr = 0; rr < RB; rr++) q[rr] += __shfl_xor(q[rr], o);
#pragma unroll
    for (int rr = 0; rr < RB; rr++) {
      const float rs = rsqrtf(q[rr] * (1.f / 1024.f) + LN_EPS_);
#pragma unroll
      for (int i = 0; i < 4; i++) {
        float4 o;
        o.x = v[rr][i].x * rs * gg[i].x + bb[i].x; o.y = v[rr][i].y * rs * gg[i].y + bb[i].y;
        o.z = v[rr][i].z * rs * gg[i].z + bb[i].z; o.w = v[rr][i].w * rs * gg[i].w + bb[i].w;
        if (write_f32) *(float4*)(x + (size_t)(row0 + rr) * 1024 + i * 256 + lane * 4) = o;
        *(uint2*)(xb + (size_t)(row0 + rr) * 1024 + i * 256 + lane * 4) = make_uint2(pack2(o.x, o.y), pack2(o.z, o.w));
      }
    }
  }
}

DI float gelu_tanh(float x) { const float u = 0.7978845608028654f * (x + 0.044715f * x * x * x); return 0.5f * x * (1.f + tanhf(u)); }

typedef __attribute__((ext_vector_type(4))) float f32x4;
template <bool OUT>
DI void ssm_scan(const Params& P, int layer, int widx, char* mb, char* smem) {
  const int lane = tidx() & 63, wave = tidx() >> 6;
  const int b = widx >> 8, g = (widx >> 4) & 15, ch = widx & 15;
  const int gi = (layer * 16 + g) * 64 + lane;
  const float4 ca = ((const float4*)(WS(P) + OFF_COEFA))[gi];
  const float2* cbp = (const float2*)(WS(P) + OFF_COEFB) + (size_t)gi * 16;
  float bre[16], bim[16];
#pragma unroll
  for (int c = 0; c < 16; c++) { float2 t = cbp[c]; bre[c] = t.x; bim[c] = t.y; }
  const float* U = (const float*)(mb + M_U);
  float2* Send = (float2*)(mb + M_SEND);
  const size_t sbase = (size_t)((b * 16 + g) * 16) * 64 + lane;
  float xr = 0.f, xi = 0.f;
  float am[32];
  float4 dsk4 = make_float4(0.f, 0.f, 0.f, 0.f);
  float* Xs = (float*)smem + wave * (128 * 17);
  const int lm = lane & 15, lq = lane >> 4;
  if (OUT) {
    for (int j = 0; j < ch; j++) {
      const float2 e = Send[sbase + (size_t)j * 64];
      const float nr = ca.z * xr - ca.w * xi + e.x, ni = ca.z * xi + ca.w * xr + e.y;
      xr = nr; xi = ni;
    }
    const float* cre = INP(P, 20) + ((size_t)(layer * 16 + g) * 16 + lm) * 64;
    const float* cim = INP(P, 21) + ((size_t)(layer * 16 + g) * 16 + lm) * 64;
#pragma unroll
    for (int kb = 0; kb < 32; kb++) {
      const int kk = 4 * kb + lq;
      am[kb] = (kb < 16) ? cre[kk] : -cim[kk - 64];
    }
    dsk4 = *(const float4*)(INP(P, 22) + layer * 256 + g * 16 + 4 * lq);
  }
  u16* Yg = (u16*)(mb + M_YG);
  const size_t tok0 = (size_t)b * L_ + ch * 512;
  const float* ub = U + (tok0 + (lane >> 2)) * 256 + g * 16 + (lane & 3) * 4;
  float4 cur = *(const float4*)ub;
#pragma unroll 1
  for (int blk = 0; blk < 32; blk++) {
    const float4 nxt = *(const float4*)(ub + (size_t)min(blk + 1, 31) * 16 * 256);
#pragma unroll
    for (int s16 = 0; s16 < 16; s16++) {
      float uu[16];
#pragma unroll
      for (int c = 0; c < 16; c++) {
        const float comp = ((c & 3) == 0) ? cur.x : ((c & 3) == 1) ? cur.y : ((c & 3) == 2) ? cur.z : cur.w;
        uu[c] = __int_as_float(__builtin_amdgcn_readlane(__float_as_int(comp), 4 * s16 + (c >> 2)));
      }
      float br4[4] = {0.f, 0.f, 0.f, 0.f}, bi4[4] = {0.f, 0.f, 0.f, 0.f};
#pragma unroll
      for (int c = 0; c < 16; c++) { br4[c & 3] += bre[c] * uu[c]; bi4[c & 3] += bim[c] * uu[c]; }
      const float br = (br4[0] + br4[1]) + (br4[2] + br4[3]), bi = (bi4[0] + bi4[1]) + (bi4[2] + bi4[3]);
      const float nr = ca.x * xr - ca.y * xi + br, ni = ca.x * xi + ca.y * xr + bi;
      xr = nr; xi = ni;
      if (OUT) { Xs[lane * 17 + s16] = xr; Xs[(64 + lane) * 17 + s16] = xi; }
    }
    if (OUT) {
      __builtin_amdgcn_wave_barrier();
      f32x4 acc = {0.f, 0.f, 0.f, 0.f}, acc2 = {0.f, 0.f, 0.f, 0.f};
#pragma unroll
      for (int kb = 0; kb < 32; kb += 2) {
        const float bv0 = Xs[(4 * kb + lq) * 17 + lm], bv1 = Xs[(4 * kb + 4 + lq) * 17 + lm];
        acc = __builtin_amdgcn_mfma_f32_16x16x4f32(am[kb], bv0, acc, 0, 0, 0);
        acc2 = __builtin_amdgcn_mfma_f32_16x16x4f32(am[kb + 1], bv1, acc2, 0, 0, 0);
      }
      acc += acc2;
      __builtin_amdgcn_wave_barrier();
      const size_t tok = tok0 + blk * 16 + lm;
      const float4 u4 = *(const float4*)(U + tok * 256 + g * 16 + 4 * lq);
      const float y0 = gelu_tanh(acc[0] + dsk4.x * u4.x), y1 = gelu_tanh(acc[1] + dsk4.y * u4.y);
      const float y2 = gelu_tanh(acc[2] + dsk4.z * u4.z), y3 = gelu_tanh(acc[3] + dsk4.w * u4.w);
      *(uint2*)(Yg + tok * 256 + g * 16 + 4 * lq) = make_uint2(pack2(y0, y1), pack2(y2, y3));
    }
    cur = nxt;
  }
  if (!OUT) Send[sbase + (size_t)ch * 64] = make_float2(xr, xi);
}

constexpr int KS_ = 72, VS_ = 68;
DI void da_item(const Params& P, int layer, int b, int h, int qt, char* mb, char* smem) {
  const int tid = tidx(), lane = tid & 63, wave = tid >> 6, r = lane & 31, hh = lane >> 5;
  u16* sK0 = (u16*)smem;
  u16* sV0 = sK0 + 2 * 64 * KS_;
  float* sbias = (float*)(sV0 + 2 * 128 * VS_);
  u16* sQw = (u16*)(smem + 54272) + (tidx() >> 6) * 32 * KS_;
  const u16* Qd = (const u16*)(mb + M_QD); const u16* Kd = (const u16*)(mb + M_KD); const u16* Vt = (const u16*)(mb + M_VT);
  u16* CC = (u16*)(WS(P) + OFF_CC);
  const int q0 = qt * 128, qw = q0 + wave * 32, qp = qw + r;
  const size_t tokq = (size_t)b * L_ + qp;
  __syncthreads();
  if (tid < 129) sbias[tid] = ((const float*)(WS(P) + OFF_BIAS))[h * 129 + tid] * LOG2E_;
  __syncthreads();
  const float bfar = sbias[128];
  const float SC = 0.125f * LOG2E_;
  const int nkt = (q0 + 128) >> 6;
  const float lam = ((const float*)(WS(P) + OFF_LAM))[layer];
  const int krow_l = tid >> 3, kch = (tid & 7) * 8;
#pragma unroll 1
  for (int c = 0; c < 2; c++) {
#pragma unroll
    for (int ks = 0; ks < 4; ks++) *(bf16x8*)(sQw + r * KS_ + ks * 16 + hh * 8) = *(const bf16x8*)(Qd + tokq * 512 + h * 128 + c * 64 + ks * 16 + hh * 8);
    f32x16 o[4] = {zero16(), zero16(), zero16(), zero16()};
    float m = -INFINITY, l = 0.f;
    const u16* Kbase = Kd + ((size_t)(((b * 4 + h) * 2 + c)) * L_ + krow_l) * 64 + kch;
    const u16* Vbase = Vt + ((size_t)((b * 4 + h) * 128) * 128 + krow_l) * 64 + kch;
    u32x4 rk[2], rv[4];
#pragma unroll
    for (int i = 0; i < 2; i++) rk[i] = *(const u32x4*)(Kbase + (size_t)(i * 32) * 64);
#pragma unroll
    for (int i = 0; i < 4; i++) rv[i] = *(const u32x4*)(Vbase + (size_t)(i * 32) * 64);
#define DA_STAGE(BUF) { u16* sKw = sK0 + (BUF) * 64 * KS_; u16* sVw = sV0 + (BUF) * 128 * VS_; \
      _Pragma("unroll") for (int i = 0; i < 2; i++) *(u32x4*)(sKw + (krow_l + i * 32) * KS_ + kch) = rk[i]; \
      _Pragma("unroll") for (int i = 0; i < 4; i++) { u32x2* d = (u32x2*)(sVw + (krow_l + i * 32) * VS_ + kch); \
        u32x2 lo2, hi2; lo2.x = rv[i].x; lo2.y = rv[i].y; hi2.x = rv[i].z; hi2.y = rv[i].w; d[0] = lo2; d[1] = hi2; } }
#define DA_FETCH(T) { const int ktn_ = min((T), nkt - 1); \
      _Pragma("unroll") for (int i = 0; i < 2; i++) rk[i] = *(const u32x4*)(Kbase + (size_t)(ktn_ * 64 + i * 32) * 64); \
      _Pragma("unroll") for (int i = 0; i < 4; i++) rv[i] = *(const u32x4*)(Vbase + (size_t)ktn_ * 8192 + (size_t)(i * 32) * 64); }
    __syncthreads();
    DA_STAGE(0)
    DA_FETCH(1)
    __syncthreads();
#pragma unroll 1
    for (int kt = 0; kt < nkt; kt++) {
      const u16* sK = sK0 + (kt & 1) * 64 * KS_;
      const u16* sV = sV0 + (kt & 1) * 128 * VS_;
      if (kt + 1 < nkt) { DA_STAGE((kt + 1) & 1) }
      DA_FETCH(kt + 2)
      if (kt * 64 <= qw + 31) {
        f32x16 s[2];
#pragma unroll
        for (int kb = 0; kb < 2; kb++) {
          s[kb] = zero16();
#pragma unroll
          for (int ks = 0; ks < 4; ks++) {
            const bf16x8 kf = *(const bf16x8*)(sK + (kb * 32 + r) * KS_ + ks * 16 + hh * 8);
            const bf16x8 qf = *(const bf16x8*)(sQw + r * KS_ + ks * 16 + hh * 8);
            s[kb] = MFMA32(kf, qf, s[kb]);
          }
        }
        const bool nearb = (kt * 64 + 63 + 128 > qw);
        float mx = -INFINITY;
        if (nearb) {
#pragma unroll
          for (int kb = 0; kb < 2; kb++)
#pragma unroll
            for (int i = 0; i < 16; i++) {
              const int dist = qp - (kt * 64 + kb * 32 + crow(i, hh));
              const float bv = sbias[min(max(dist, 0), 128)];
              float t = s[kb][i] * SC + bv;
              t = (dist >= 0) ? t : -INFINITY;
              s[kb][i] = t; mx = fmaxf(mx, t);
              if ((i & 7) == 7) __builtin_amdgcn_sched_barrier(0);
            }
        } else {
#pragma unroll
          for (int kb = 0; kb < 2; kb++)
#pragma unroll
            for (int i = 0; i < 16; i++) { const float t = s[kb][i] * SC + bfar; s[kb][i] = t; mx = fmaxf(mx, t); }
        }
        mx = fmaxf(mx, __shfl_xor(mx, 32));
        const float mn = fmaxf(m, mx);
        const float corr = __builtin_amdgcn_exp2f(m - mn);
        m = mn;
        float ls = 0.f;
#pragma unroll
        for (int kb = 0; kb < 2; kb++)
#pragma unroll
          for (int i = 0; i < 16; i++) { const float p = __builtin_amdgcn_exp2f(s[kb][i] - mn); s[kb][i] = p; ls += p; }
        l = l * corr + ls;
        if (__ballot(corr != 1.f) != 0ull) {
#pragma unroll
          for (int dt = 0; dt < 4; dt++)
#pragma unroll
            for (int i = 0; i < 16; i++) o[dt][i] *= corr;
        }
#pragma unroll
        for (int kb = 0; kb < 2; kb++)
#pragma unroll
          for (int s2 = 0; s2 < 2; s2++) {
            const bf16x8 pf = pack8(s[kb], s2);
#pragma unroll
            for (int dt = 0; dt < 4; dt++) {
              const u16* vp = sV + (dt * 32 + r) * VS_ + kb * 32 + s2 * 16 + 4 * hh;
              const s16x4 lo = *(const s16x4*)vp, hi = *(const s16x4*)(vp + 8);
              const bf16x8 vf = __builtin_shufflevector(lo, hi, 0, 1, 2, 3, 4, 5, 6, 7);
              o[dt] = MFMA32(vf, pf, o[dt]);
            }
            __builtin_amdgcn_sched_barrier(0);
          }
      }
      __syncthreads();
    }
#undef DA_STAGE
#undef DA_FETCH
    const float lt = l + __shfl_xor(l, 32);
    const float inv = 1.f / lt;
    size_t tq = tokq;
    asm volatile("" : "+v"(tq));
    u16* obase = CC + tq * 1024 + h * 128 + 4 * hh;
    if (c == 0) {
#pragma unroll
      for (int dt = 0; dt < 4; dt++)
#pragma unroll
        for (int g4 = 0; g4 < 4; g4++) {
          *(uint2*)(obase + dt * 32 + 8 * g4) = make_uint2(pack2(o[dt][4 * g4] * inv, o[dt][4 * g4 + 1] * inv), pack2(o[dt][4 * g4 + 2] * inv, o[dt][4 * g4 + 3] * inv));
        }
    } else {
      float ss = 0.f;
#pragma unroll
      for (int dt = 0; dt < 4; dt++)
#pragma unroll
        for (int g4 = 0; g4 < 4; g4++) {
          const uint2 pv = *(const uint2*)(obase + dt * 32 + 8 * g4);
          const float a4[4] = {bf2f((u16)(pv.x & 0xffff)), bf2f((u16)(pv.x >> 16)), bf2f((u16)(pv.y & 0xffff)), bf2f((u16)(pv.y >> 16))};
#pragma unroll
          for (int e = 0; e < 4; e++) { const float v = a4[e] - lam * o[dt][4 * g4 + e] * inv; o[dt][4 * g4 + e] = v; ss = __builtin_fmaf(v, v, ss); }
        }
      ss += __shfl_xor(ss, 32);
      const float lam_init = 0.8f - 0.6f * __expf(-0.3f * (float)layer);
      const float rn = rsqrtf(ss * (1.f / 128.f) + LN_EPS_) * (1.f - lam_init);
      int hh2 = hh;
      asm volatile("" : "+v"(hh2));
      const float* sg = INP(P, 14) + layer * 128 + 4 * hh2;
#pragma unroll
      for (int dt = 0; dt < 4; dt++)
#pragma unroll
        for (int g4 = 0; g4 < 4; g4++) {
          const int dv = dt * 32 + 8 * g4 + 4 * hh;
          const float4 gv = *(const float4*)(sg + dt * 32 + 8 * g4);
          uint2 w = make_uint2(pack2(o[dt][4 * g4] * rn * gv.x, o[dt][4 * g4 + 1] * rn * gv.y),
                               pack2(o[dt][4 * g4 + 2] * rn * gv.z, o[dt][4 * g4 + 3] * rn * gv.w));
          *(uint2*)(obase + dv - 4 * hh) = w;
        }
    }
  }
}

DI unsigned sortkey(float f) { const unsigned u = __float_as_uint(f + 0.f); return u ^ (((unsigned)((int)u >> 31)) | 0x80000000u); }

DI void dsa_item(const Params& P, int layer, int b, int qt, char* mb, char* smem) {
  const int tid = tidx(), lane = tid & 63, wave = tid >> 6, r = lane & 31, hh = lane >> 5;
  unsigned* hist = (unsigned*)smem;
  float* sP = (float*)smem;
  float* sQ = (float*)(smem + 16384);
  u16* sidx = (u16*)(smem + 32896);
  unsigned* meta = (unsigned*)(smem + 49280);
  float* sbias = (float*)(smem + 50304);
  const u16* Qi = (const u16*)(mb + M_QI); const u16* Ki = (const u16*)(mb + M_KI); const float* Wi = (const float*)(mb + M_WI);
  const u16* Qs = (const u16*)(mb + M_QS); const u16* Ks = (const u16*)(mb + M_KS); const u16* Vs = (const u16*)(mb + M_VS);
  u16* CC = (u16*)(WS(P) + OFF_CC);
  const int q0 = qt * 32;
  const int qp = q0 + r;
  const size_t tokb = (size_t)b * L_;
  const int nk32 = qt + 1;
  const bool radix = (q0 >= 256);
  __syncthreads();
  for (int i = tid; i < 4 * 129; i += 256) sbias[i] = ((const float*)(WS(P) + OFF_BIAS))[4 * 129 + i];
  meta[tid] = (tid >= 32 && tid < 64) ? 256u : 0u;
  char* sQi = smem + 52384;
  float* sWi = (float*)(smem + 69280);
  constexpr int CAPL_ = 64;
  unsigned* lK = (unsigned*)smem;
  u16* lI = (u16*)(smem + 32 * CAPL_ * 4);
  {
    const int row = tid >> 3, ch = tid & 7;
    const uint4* src = (const uint4*)(Qi + (tokb + q0 + row) * 256 + ch * 32);
    uint4* dst = (uint4*)(sQi + row * 528 + ch * 64);
    dst[0] = src[0]; dst[1] = src[1]; dst[2] = src[2]; dst[3] = src[3];
    sWi[(tid & 7) * 32 + (tid >> 3)] = Wi[(tokb + q0) * 8 + tid];
  }
  int pass = radix ? 0 : 4;
  bool fast = false;
#pragma unroll 1
  while (true) {
    __syncthreads();
    if (pass < 4) { for (int i = tid; i < 32 * 257; i += 256) hist[i] = 0u; }
    __syncthreads();
    const unsigned pref = meta[r];
    const unsigned krem = meta[32 + r];
    auto elems = [&](const f32x16& sc, const int kt, const int lim) __attribute__((always_inline)) {
      if (pass == 0) {
#pragma unroll
        for (int i = 0; i < 16; i++) {
          const int kp = kt * 32 + crow(i, hh);
          const unsigned key = sortkey(sc[i]);
          const unsigned bin = (kp <= lim) ? (key >> 24) : 256u;
          atomicAdd(&hist[r * 257 + bin], 1u);
        }
      } else if (pass < 4) {
        const int sh = 24 - 8 * pass;
#pragma unroll
        for (int i = 0; i < 16; i++) {
          const int kp = kt * 32 + crow(i, hh);
          const unsigned key = sortkey(sc[i]);
          if ((key >> (sh + 8)) == pref && kp <= lim) atomicAdd(&hist[r * 257 + ((key >> sh) & 255u)], 1u);
        }
      } else if (pass == 5) {
        unsigned mc = 0u, ms = 0u;
        unsigned keys[16];
#pragma unroll
        for (int i = 0; i < 16; i++) {
          const int kp = kt * 32 + crow(i, hh);
          keys[i] = sortkey(sc[i]);
          const unsigned bt = keys[i] >> 16;
          const bool valid = (kp <= lim);
          ms |= (valid && bt > pref) ? (1u << i) : 0u;
          mc |= (valid && bt == pref) ? (1u << i) : 0u;
        }
        unsigned base_c = 0u, base_s = 0u;
        if (mc) base_c = atomicAdd(&meta[128 + r], (unsigned)__popc(mc));
        if (ms) base_s = atomicAdd(&meta[64 + r], (unsigned)__popc(ms));
#pragma unroll
        for (int i = 0; i < 16; i++) {
          const int kp = kt * 32 + crow(i, hh);
          if ((mc >> i) & 1u) {
            const unsigned cp = base_c + (unsigned)__popc(mc & ((1u << i) - 1u));
            if (cp < (unsigned)CAPL_) { lK[r * CAPL_ + cp] = keys[i]; lI[r * CAPL_ + cp] = (u16)kp; }
          }
          if ((ms >> i) & 1u) {
            const unsigned pos = base_s + (unsigned)__popc(ms & ((1u << i) - 1u));
            if (pos < 256u) sidx[r * 256 + pos] = (u16)kp;
          }
        }
      } else {
#pragma unroll
        for (int i = 0; i < 16; i++) {
          const int kp = kt * 32 + crow(i, hh);
          const unsigned key = sortkey(sc[i]);
          bool sel = (kp <= lim);
          if (radix) {
            sel = sel && (key >= pref);
            if (sel && key == pref) sel = atomicAdd(&meta[96 + r], 1u) < krem;
          }
          if (sel) { const unsigned pos = atomicAdd(&meta[64 + r], 1u); if (pos < 256u) sidx[r * 256 + pos] = (u16)kp; }
        }
      }
    };
    const int klast = nk32 - 1;
    bf16x8 nA0 = {0, 0, 0, 0, 0, 0, 0, 0}, nA1 = nA0, nB0 = nA0, nB1 = nA0;
    if (wave < nk32) {
      const int ka = wave, kb2 = min(wave + 4, klast);
      nA0 = *(const bf16x8*)(Ki + (tokb + ka * 32 + r) * 32 + hh * 8);
      nA1 = *(const bf16x8*)(Ki + (tokb + ka * 32 + r) * 32 + 16 + hh * 8);
      nB0 = *(const bf16x8*)(Ki + (tokb + kb2 * 32 + r) * 32 + hh * 8);
      nB1 = *(const bf16x8*)(Ki + (tokb + kb2 * 32 + r) * 32 + 16 + hh * 8);
    }
#pragma unroll 1
    for (int kt = wave; kt < nk32; kt += 8) {
      const bf16x8 kA0 = nA0, kA1 = nA1, kB0 = nB0, kB1 = nB1;
      {
        const int ka = min(kt + 8, klast), kb2 = min(kt + 12, klast);
        nA0 = *(const bf16x8*)(Ki + (tokb + ka * 32 + r) * 32 + hh * 8);
        nA1 = *(const bf16x8*)(Ki + (tokb + ka * 32 + r) * 32 + 16 + hh * 8);
        nB0 = *(const bf16x8*)(Ki + (tokb + kb2 * 32 + r) * 32 + hh * 8);
        nB1 = *(const bf16x8*)(Ki + (tokb + kb2 * 32 + r) * 32 + 16 + hh * 8);
      }
      f32x16 scA = zero16(), scB = zero16();
#pragma unroll 2
      for (int hd = 0; hd < 8; hd++) {
        const bf16x8 q0f = *(const bf16x8*)(sQi + r * 528 + hd * 64 + hh * 16);
        const bf16x8 q1f = *(const bf16x8*)(sQi + r * 528 + hd * 64 + 32 + hh * 16);
        const float w = sWi[hd * 32 + r];
        f32x16 sa = MFMA32(kA0, q0f, zero16());
        f32x16 sb = MFMA32(kB0, q0f, zero16());
        sa = MFMA32(kA1, q1f, sa);
        sb = MFMA32(kB1, q1f, sb);
#pragma unroll
        for (int i = 0; i < 16; i++) {
          scA[i] += __int_as_float(max(__float_as_int(sa[i]), 0)) * w;
          scB[i] += __int_as_float(max(__float_as_int(sb[i]), 0)) * w;
        }
      }
      elems(scA, kt, (kt == qt) ? qp : 0x7fffffff);
      if (kt + 4 < nk32) elems(scB, kt + 4, (kt + 4 == qt) ? qp : 0x7fffffff);
    }
    __syncthreads();
    if (pass < 4) {
      for (int j = 0; j < 8; j++) {
        const int qq = wave * 8 + j;
        const unsigned k = meta[32 + qq];
        unsigned c4[4]; unsigned tot = 0;
#pragma unroll
        for (int e = 0; e < 4; e++) { c4[e] = hist[qq * 257 + 255 - 4 * lane - e]; tot += c4[e]; }
        unsigned incl = tot;
        for (int o = 1; o < 64; o <<= 1) { const unsigned t = __shfl_up(incl, o); if (lane >= o) incl += t; }
        unsigned run = incl - tot;
#pragma unroll
        for (int e = 0; e < 4; e++) {
          if (run < k && run + c4[e] >= k) {
            meta[qq] = (meta[qq] << 8) | (unsigned)(255 - 4 * lane - e); meta[32 + qq] = k - run;
            if (pass == 1 && c4[e] > (unsigned)CAPL_) meta[192] = 1u;
          }
          run += c4[e];
        }
      }
    }
    if (pass >= 4) break;
    if (pass == 1) { __syncthreads(); fast = (meta[192] == 0u); pass = fast ? 5 : 2; } else pass++;
  }
  __syncthreads();
  if (fast) {
#pragma unroll 1
    for (int j = 0; j < 8; j++) {
      const int qq = wave * 8 + j;
      const int c = min((int)meta[128 + qq], CAPL_);
      const unsigned k = meta[32 + qq];
      const bool in = lane < c;
      const unsigned mykey = in ? lK[qq * CAPL_ + lane] : 0u;
      const unsigned myidx = in ? (unsigned)lI[qq * CAPL_ + lane] : 0u;
      unsigned rank = 0u;
      for (int t = 0; t < c; t++) {
        const unsigned ok = __shfl(mykey, t);
        rank += (ok > mykey || (ok == mykey && t < lane)) ? 1u : 0u;
      }
      const bool sel = in && (rank < k);
      const unsigned long long m = __ballot(sel);
      const unsigned base = meta[64 + qq];
      if (sel) {
        const unsigned pos = base + (unsigned)__popcll(m & ((1ull << lane) - 1ull));
        if (pos < 256u) sidx[qq * 256 + pos] = (u16)myidx;
      }
      __builtin_amdgcn_wave_barrier();
      if (lane == 0) meta[64 + qq] = base + (unsigned)__popcll(m);
    }
    __syncthreads();
  }
  float* myP = sP + wave * 1024;
  (void)sQ;
  bf16x8 qn[4];
#pragma unroll
  for (int ks = 0; ks < 4; ks++) {
    bf16x8 z = {0, 0, 0, 0, 0, 0, 0, 0};
    if (r < 4) z = *(const bf16x8*)(Qs + (tokb + q0 + wave * 8) * 256 + r * 64 + ks * 16 + hh * 8);
    qn[ks] = z;
  }
#pragma unroll 1
  for (int j = 0; j < 8; j++) {
    const int qq = wave * 8 + j;
    const int qpos = q0 + qq;
    const size_t tok = tokb + qpos;
    const int n = min((int)meta[64 + qq], 256);
    __syncthreads();
    bf16x8 qf[4];
#pragma unroll
    for (int ks = 0; ks < 4; ks++) qf[ks] = qn[ks];
    {
      const size_t tokn = tokb + q0 + wave * 8 + min(j + 1, 7);
#pragma unroll
      for (int ks = 0; ks < 4; ks++) {
        bf16x8 z = {0, 0, 0, 0, 0, 0, 0, 0};
        if (r < 4) z = *(const bf16x8*)(Qs + tokn * 256 + r * 64 + ks * 16 + hh * 8);
        qn[ks] = z;
      }
    }
#pragma unroll 4
    for (int kb = 0; kb < 8; kb++) {
      const int jj = kb * 32 + r;
      const int kidx = (jj < n) ? (int)sidx[qq * 256 + jj] : 0;
      const u16* kp = Ks + (tokb + kidx) * 64 + hh * 8;
      bf16x8 kf[4];
#pragma unroll
      for (int ks = 0; ks < 4; ks++) kf[ks] = *(const bf16x8*)(kp + ks * 16);
      f32x16 sacc = zero16();
#pragma unroll
      for (int ks = 0; ks < 4; ks++) sacc = MFMA32(kf[ks], qf[ks], sacc);
      if (r < 4) {
#pragma unroll
        for (int i = 0; i < 16; i++) myP[(kb * 32 + crow(i, hh)) * 4 + r] = sacc[i];
      }
    }
    __syncthreads();
    float sc[4][4];
#pragma unroll
    for (int rd = 0; rd < 4; rd++) {
      const int jj = rd * 64 + lane;
      const bool valid = jj < n;
      const int kidx = valid ? (int)sidx[qq * 256 + jj] : 0;
      const int dist = min(max(qpos - kidx, 0), 128);
      const float4 d = *(const float4*)(myP + jj * 4);
      sc[rd][0] = valid ? d.x * 0.125f + sbias[0 * 129 + dist] : -INFINITY;
      sc[rd][1] = valid ? d.y * 0.125f + sbias[1 * 129 + dist] : -INFINITY;
      sc[rd][2] = valid ? d.z * 0.125f + sbias[2 * 129 + dist] : -INFINITY;
      sc[rd][3] = valid ? d.w * 0.125f + sbias[3 * 129 + dist] : -INFINITY;
    }
#pragma unroll
    for (int hd = 0; hd < 4; hd++) {
      float mx = fmaxf(fmaxf(sc[0][hd], sc[1][hd]), fmaxf(sc[2][hd], sc[3][hd]));
      mx = wave_max(mx);
      float sm = 0.f;
#pragma unroll
      for (int rd = 0; rd < 4; rd++) { sc[rd][hd] = __expf(sc[rd][hd] - mx); sm += sc[rd][hd]; }
      sm = wave_sum(sm);
      const float inv = 1.f / sm;
#pragma unroll
      for (int rd = 0; rd < 4; rd++) sc[rd][hd] *= inv;
    }
#pragma unroll
    for (int rd = 0; rd < 4; rd++) *(float4*)(myP + (rd * 64 + lane) * 4) = make_float4(sc[rd][0], sc[rd][1], sc[rd][2], sc[rd][3]);
    __syncthreads();
    const int g = lane >> 3, c8 = lane & 7;
    float acc[32];
#pragma unroll
    for (int i = 0; i < 32; i++) acc[i] = 0.f;
#pragma unroll 16
    for (int it = 0; it < 32; it++) {
      const int jj = it * 8 + g;
      const int kidx = (jj < n) ? (int)sidx[qq * 256 + jj] : 0;
      const float4 pj = *(const float4*)(myP + jj * 4);
      const u32x4 vv = *(const u32x4*)(Vs + (tokb + kidx) * 64 + c8 * 8);
      const float vf[8] = {bf2f((u16)(vv.x & 0xffff)), bf2f((u16)(vv.x >> 16)), bf2f((u16)(vv.y & 0xffff)), bf2f((u16)(vv.y >> 16)),
                           bf2f((u16)(vv.z & 0xffff)), bf2f((u16)(vv.z >> 16)), bf2f((u16)(vv.w & 0xffff)), bf2f((u16)(vv.w >> 16))};
#pragma unroll
      for (int e = 0; e < 8; e++) {
        acc[0 * 8 + e] += pj.x * vf[e]; acc[1 * 8 + e] += pj.y * vf[e];
        acc[2 * 8 + e] += pj.z * vf[e]; acc[3 * 8 + e] += pj.w * vf[e];
      }
    }
    const bool b5 = lane & 32, b4 = lane & 16, b3 = lane & 8;
    float w16[16], w8[8], w4[4];
#pragma unroll
    for (int i = 0; i < 16; i++) { const float snd = b5 ? acc[i] : acc[i + 16]; const float rcv = __shfl_xor(snd, 32); w16[i] = (b5 ? acc[i + 16] : acc[i]) + rcv; }
#pragma unroll
    for (int i = 0; i < 8; i++) { const float snd = b4 ? w16[i] : w16[i + 8]; const float rcv = __shfl_xor(snd, 16); w8[i] = (b4 ? w16[i + 8] : w16[i]) + rcv; }
#pragma unroll
    for (int i = 0; i < 4; i++) { const float snd = b3 ? w8[i] : w8[i + 4]; const float rcv = __shfl_xor(snd, 8); w4[i] = (b3 ? w8[i + 4] : w8[i]) + rcv; }
    const int hd = (b5 ? 2 : 0) + (b4 ? 1 : 0);
    *(uint2*)(CC + tok * 1024 + 768 + hd * 64 + c8 * 8 + (b3 ? 4 : 0)) = make_uint2(pack2(w4[0], w4[1]), pack2(w4[2], w4[3]));
  }
}

DI void phase_mix1(const Params& P, int layer, int bid, int nb, char* smem) {
  char* mb = WS(P) + OFF_H;
  for (int w = bid * 4 + (tidx() >> 6); w < 2048; w += nb * 4) ssm_scan<false>(P, layer, w, mb, smem);
  for (int j = 0;; j++) {
    const int idx = (j & 1) ? (j * nb + (nb - 1 - bid)) : (j * nb + bid);
    if (j * nb >= 2048) break;
    if (idx >= 2048) continue;
    const int qt = 255 - (idx >> 3), b = idx & 7;
    dsa_item(P, layer, b, qt, mb, smem);
  }
  for (int j = 0;; j++) {
    const int idx = (j & 1) ? (j * nb + (nb - 1 - bid)) : (j * nb + bid);
    if (j * nb >= 2048) break;
    if (idx >= 2048) continue;
    const int qt = 63 - (idx >> 5), bh = idx & 31;
    da_item(P, layer, bh >> 2, bh & 3, qt, mb, smem);
  }
}

DI void phase_mix2(const Params& P, int layer, int bid, int nb, char* smem) {
  char* mb = WS(P) + OFF_H;
  for (int w = bid * 4 + (tidx() >> 6); w < 2048; w += nb * 4) ssm_scan<true>(P, layer, w, mb, smem);
}

DI void run_phase(const Params& P, int ph, int bid, int nb, char* smem) {
  char* ws = WS(P);
  u16* sm = (u16*)smem;
  if (ph == 0) { phase_prep(P, bid, nb, smem); return; }
  const int l = (ph - 1) / 12, s = (ph - 1) % 12;
  u16* Xb = (u16*)(ws + OFF_XB);
  u16* H = (u16*)(ws + OFF_H);
  u16* CC = (u16*)(ws + OFF_CC);
  float* X = OUTP(P);
  switch (s) {
    case 0: phase_ffn_up(Xb, (const u16*)(ws + OFF_WGU1 + l * SZ_WGU), H, bid, nb, sm); break;
    case 1: phase_ffn_down(H, (const u16*)(ws + OFF_WD1 + l * SZ_WD), (l == 0) ? INP(P, 0) : (const float*)nullptr, Xb, X, nullptr, bid, nb, sm); break;
    case 2: phase_ln(X, Xb, INP(P, 6) + l * 1024, INP(P, 7) + l * 1024, false, bid, nb); break;
    case 3: phase_w_in(Xb, (const u16*)(ws + OFF_WIN + l * SZ_WIN), ws + OFF_H, bid, nb, sm); break;
    case 4: phase_mix1(P, l, bid, nb, smem); break;
    case 5: phase_mix2(P, l, bid, nb, smem); break;
    case 6: phase_glu((const u16*)(ws + OFF_H + M_YG), (const u16*)(ws + OFF_WGLU + l * SZ_WGLU), CC, bid, nb, sm); break;
    case 7: phase_w_o(CC, (const u16*)(ws + OFF_WO + l * SZ_WO), X, Xb, bid, nb, sm); break;
    case 8: phase_ln(X, Xb, INP(P, 24) + l * 1024, INP(P, 25) + l * 1024, false, bid, nb); break;
    case 9:
      phase_ffn_up(Xb, (const u16*)(ws + OFF_WGU2 + l * SZ_WGU), H, bid, nb, sm);
      phase_ple(Xb, (const u16*)(ws + OFF_WPG + l * SZ_WPG), (const u16*)(ws + OFF_PB) + (size_t)l * T_ * 256, (const u16*)(ws + OFF_WPP + l * SZ_WPP), CC, bid, nb, sm);
      break;
    case 10: phase_ffn_down(H, (const u16*)(ws + OFF_WD2 + l * SZ_WD), (const float*)nullptr, Xb, X, CC, bid, nb, sm); break;
    case 11: phase_ln(X, Xb, INP(P, 31) + l * 1024, INP(P, 32) + l * 1024, l == 1, bid, nb); break;
  }
}

#define XB_TMO      128
#define XB_XCNT(j)  (256  + 64 * (j))
#define XB_XSUB(j)  (1280 + 64 * (j))
#define XB_XGEN(j)  (2304 + 64 * (j))
#define XB_TOP      3328
#define XB_TOPGEN   3392
#define XCD_BAR_WORDS 3456
#define XB_SPIN_CAP (1u << 22)
#define LAS __attribute__((address_space(3)))

__device__ __forceinline__ unsigned xb_ld(unsigned* p)              { return __hip_atomic_load(p, __ATOMIC_RELAXED, __HIP_MEMORY_SCOPE_AGENT); }
__device__ __forceinline__ unsigned xb_add(unsigned* p, unsigned v) { return __hip_atomic_fetch_add(p, v, __ATOMIC_RELAXED, __HIP_MEMORY_SCOPE_AGENT); }
__device__ __forceinline__ unsigned xb_xcc_id() { return (unsigned)__builtin_amdgcn_s_getreg((3 << 11) | 20) & 0xFu; }
#define XB_SPIN(cond, bar) do { unsigned _sp = 0; while (cond) { __builtin_amdgcn_s_sleep(1); \
    if ((++_sp & 255u) == 0u) { if (xb_ld(&(bar)[XB_TMO])) break; if (_sp > XB_SPIN_CAP) { atomicAdd(&(bar)[XB_TMO], 1u); break; } } } } while (0)

struct XcdBarrier {
    unsigned* bar; unsigned x;
    volatile LAS unsigned* st;
};

__device__ __forceinline__ XcdBarrier xcd_barrier_post(unsigned* bar, volatile LAS unsigned* st) {
    XcdBarrier b; b.bar = bar; b.x = xb_xcc_id(); b.st = st;
    if (threadIdx.x == 0) (void)xb_add(&bar[XB_XCNT(b.x)], 1u);
    return b;
}
__device__ __forceinline__ void xcd_barrier_complete(unsigned* bar, unsigned x, unsigned& nloc, unsigned& nx) {
    const unsigned G = gridDim.x * gridDim.y * gridDim.z;
    unsigned sum, cnt, mine, sp = 0u;
    for (;;) {
        sum = 0u; cnt = 0u; mine = 0u;
#pragma unroll
        for (unsigned j = 0; j < 16; ++j) { const unsigned c = xb_ld(&bar[XB_XCNT(j)]); sum += c; cnt += (c > 0u) ? 1u : 0u; mine = (j == x) ? c : mine; }
        if (sum == G) break;
        __builtin_amdgcn_s_sleep(1);
        if ((++sp & 255u) == 0u) { if (xb_ld(&bar[XB_TMO])) break; if (sp > XB_SPIN_CAP) { atomicAdd(&bar[XB_TMO], 1u); break; } }
    }
    nloc = mine > 0u ? mine : 1u; nx = cnt > 0u ? cnt : 1u;
}

__device__ __forceinline__ void xcd_barrier(const XcdBarrier& b) {
    asm volatile("s_waitcnt vmcnt(0)" ::: "memory");
    __syncthreads();
    if (threadIdx.x == 0) {
        unsigned* bar = b.bar;
        __builtin_amdgcn_s_waitcnt(0);
        unsigned nloc = b.st[0], nx = b.st[1];
        if (nloc == 0u) { xcd_barrier_complete(bar, b.x, nloc, nx); b.st[0] = nloc; b.st[1] = nx; }
        const unsigned old = xb_add(&bar[XB_XSUB(b.x)], 1u);
        const unsigned gen = old / nloc;
        if (old + 1u == (gen + 1u) * nloc) {
            __builtin_amdgcn_fence(__ATOMIC_RELEASE, "agent");
            asm volatile("s_waitcnt vmcnt(0)" ::: "memory");
            const unsigned og = xb_add(&bar[XB_TOP], 1u);
            const unsigned tg = og / nx;
            if (og + 1u == (tg + 1u) * nx) xb_add(&bar[XB_TOPGEN], 1u);
            else XB_SPIN(xb_ld(&bar[XB_TOPGEN]) == tg, bar);
            __builtin_amdgcn_fence(__ATOMIC_ACQUIRE, "agent");
            xb_add(&bar[XB_XGEN(b.x)], 1u);
            asm volatile("s_waitcnt vmcnt(0)" ::: "memory");
        } else {
            XB_SPIN(xb_ld(&bar[XB_XGEN(b.x)]) == gen, bar);
            __builtin_amdgcn_fence(__ATOMIC_ACQUIRE, "agent");
            asm volatile("s_waitcnt vmcnt(0)" ::: "memory");
        }
    }
    __syncthreads();
}


constexpr int NPHASES = 25;

__global__ void __launch_bounds__(256, 2) mega(Params P, int ph0, int ph1) {
  extern __shared__ __attribute__((aligned(16))) char smem[];
  cg::grid_group grid = cg::this_grid();
  const int bid = blockIdx.x, nb = gridDim.x;
  volatile LAS unsigned* xst = (volatile LAS unsigned*)(smem + 73712);
  if (threadIdx.x == 0) { xst[0] = 0u; xst[1] = 0u; xst[2] = 0u; xst[3] = 0u; }
  __syncthreads();
  const XcdBarrier xbar = xcd_barrier_post((unsigned*)(P.ws + OFF_XBAR), xst);
#ifndef DUP_MASK
#define DUP_MASK 0
#endif
#define PHASE(k) if (ph0 <= (k) && (k) < ph1) { \
    if ((k) > 0 && ((DUP_MASK >> (((k) - 1) % 12)) & 1)) { run_phase(P, (k), bid, nb, smem); grid.sync(); } \
    run_phase(P, (k), bid, nb, smem); if ((k) + 1 < ph1) { if (ph0 < 0) grid.sync(); else xcd_barrier(xbar); } }
  PHASE(0) PHASE(1) PHASE(2) PHASE(3) PHASE(4) PHASE(5) PHASE(6) PHASE(7) PHASE(8) PHASE(9) PHASE(10) PHASE(11) PHASE(12)
  PHASE(13) PHASE(14) PHASE(15) PHASE(16) PHASE(17) PHASE(18) PHASE(19) PHASE(20) PHASE(21) PHASE(22) PHASE(23) PHASE(24)
#undef PHASE
}

extern "C" void kernel_launch(void* const* d_in, const int* in_sizes, int n_in, void* d_out, int out_size, void* d_ws, size_t ws_size, hipStream_t stream) {
  static int grid_blocks = 0;
  if (grid_blocks == 0) {
    if (n_in != 33 || ws_size < WS_END) { fprintf(stderr, "kernel_launch: need 33 inputs and %zu bytes of ws (got %d, %zu)\n", (size_t)WS_END, n_in, ws_size); grid_blocks = -1; return; }
    int dev = 0, cus = 0, per_cu = 0;
    (void)hipGetDevice(&dev);
    (void)hipDeviceGetAttribute(&cus, hipDeviceAttributeMultiprocessorCount, dev);
    (void)hipFuncSetAttribute((const void*)mega, hipFuncAttributeMaxDynamicSharedMemorySize, LDS_BYTES);
    (void)hipOccupancyMaxActiveBlocksPerMultiprocessor(&per_cu, (const void*)mega, 256, LDS_BYTES);
    if (per_cu < 1) per_cu = 1;
    if (per_cu > 2) per_cu = 2;
    grid_blocks = cus * per_cu;
    fprintf(stderr, "kernel_launch: cus %d per_cu %d grid %d\n", cus, per_cu, grid_blocks);
  }
  if (grid_blocks < 0) return;
  Params p;
  memset(&p, 0, sizeof(p));
  for (int i = 0; i < 33; i++) p.in[i] = (const float*)d_in[i];
  p.out = (float*)d_out;
  p.ws = (char*)d_ws;
#if MULTI_LAUNCH
  for (int ph = 0; ph < NPHASES; ph++) {
    hipLaunchKernelGGL(mega, dim3(grid_blocks), dim3(256), LDS_BYTES, stream, p, ph, ph + 1);
  }
#else
  int ph0 = 0, ph1 = NPHASES;
  (void)hipMemsetAsync((char*)d_ws + OFF_XBAR, 0, XCD_BAR_WORDS * 4, stream);
  void* args[] = {&p, &ph0, &ph1};
  hipError_t e = hipLaunchCooperativeKernel((const void*)mega, dim3(grid_blocks), dim3(256), args, LDS_BYTES, stream);
  if (e != hipSuccess) fprintf(stderr, "cooperative launch failed: %s (grid %d)\n", hipGetErrorString(e), grid_blocks);
#endif
}
```

```cpp
#include <hip/hip_runtime.h>
#include <hip/hip_cooperative_groups.h>
#include <stdint.h>
#include <math.h>
#include <stdio.h>
#include <string.h>
namespace cg = cooperative_groups;

#ifndef MULTI_LAUNCH
#define MULTI_LAUNCH 0
#endif

typedef unsigned short u16;
typedef __attribute__((ext_vector_type(8))) short bf16x8;
typedef __attribute__((ext_vector_type(4))) short s16x4;
typedef __attribute__((ext_vector_type(16))) float f32x16;
typedef __attribute__((ext_vector_type(4))) unsigned u32x4;
typedef __attribute__((ext_vector_type(2))) unsigned u32x2;

#define DI __device__ __forceinline__
#define MFMA32(a, b, c) __builtin_amdgcn_mfma_f32_32x32x16_bf16((a), (b), (c), 0, 0, 0)

constexpr int T_ = 65536;
constexpr int L_ = 8192;
constexpr int D_ = 1024;
constexpr int FF_ = 2816;
constexpr float ALPHA_ = 1.41421356237309515f;
constexpr float LN_EPS_ = 1e-5f;
constexpr float LOG2E_ = 1.44269504088896341f;
constexpr int LDS_BYTES = 73728;

constexpr size_t SZ_WGU = (size_t)5632 * 1024 * 2;
constexpr size_t SZ_WD = (size_t)1024 * 2816 * 2;
constexpr size_t SZ_WIN = (size_t)2560 * 1024 * 2;
constexpr size_t SZ_WO = (size_t)1024 * 1024 * 2;
constexpr size_t SZ_WGLU = (size_t)256 * 256 * 2;
constexpr size_t SZ_WPG = (size_t)1024 * 1024 * 2;
constexpr size_t SZ_WPP = (size_t)1024 * 256 * 2;
constexpr size_t OFF_WGU1 = 0;
constexpr size_t OFF_WD1 = OFF_WGU1 + 2 * SZ_WGU;
constexpr size_t OFF_WGU2 = OFF_WD1 + 2 * SZ_WD;
constexpr size_t OFF_WD2 = OFF_WGU2 + 2 * SZ_WGU;
constexpr size_t OFF_WIN = OFF_WD2 + 2 * SZ_WD;
constexpr size_t OFF_WO = OFF_WIN + 2 * SZ_WIN;
constexpr size_t OFF_WGLU = OFF_WO + 2 * SZ_WO;
constexpr size_t OFF_WPG = OFF_WGLU + 2 * SZ_WGLU;
constexpr size_t OFF_WPP = OFF_WPG + 2 * SZ_WPG;
constexpr size_t OFF_COEFA = OFF_WPP + 2 * SZ_WPP;
constexpr size_t OFF_COEFB = OFF_COEFA + 2 * 16 * 64 * 16;
constexpr size_t OFF_LAM = OFF_COEFB + 2 * 16 * 64 * 16 * 8;
constexpr size_t OFF_BIAS = OFF_LAM + 256;
constexpr size_t OFF_XBAR = OFF_BIAS + 8 * 129 * 4 + 32;
constexpr size_t OFF_XB = OFF_XBAR + 16384;
constexpr size_t OFF_PB = OFF_XB + (size_t)T_ * 1024 * 2;
constexpr size_t OFF_H = OFF_PB + (size_t)2 * T_ * 256 * 2;
constexpr size_t SZ_H = (size_t)384 << 20;
constexpr size_t OFF_CC = OFF_H + SZ_H;
constexpr size_t OFF_CANDK = OFF_CC + (size_t)T_ * 1024 * 2;
constexpr int CAP_ = 2048;
constexpr size_t OFF_CANDI = OFF_CANDK + (size_t)512 * 32 * CAP_ * 4;
constexpr size_t WS_END = OFF_CANDI + (size_t)512 * 32 * CAP_ * 2;
constexpr size_t MB_ = (size_t)1 << 20;
constexpr size_t M_QD = 0, M_KD = 64 * MB_, M_VT = 128 * MB_, M_U = 192 * MB_, M_QS = 256 * MB_, M_QI = 288 * MB_, M_YG = 320 * MB_,
                 M_KS = 352 * MB_, M_VS = 360 * MB_, M_KI = 368 * MB_, M_WI = 372 * MB_, M_SEND = 374 * MB_;

struct Params {
  const float* in[33];
  float* out;
  char* ws;
};

DI int tidx() { int t = threadIdx.x; asm volatile("" : "+v"(t)); return t; }
#define GAS __attribute__((address_space(1)))
DI size_t opaque0() { size_t z = 0; asm volatile("" : "+s"(z)); return z; }
DI char* WS(const Params& P) { return P.ws + opaque0(); }
DI float* OUTP(const Params& P) { return P.out + opaque0(); }
DI const float* INP(const Params& P, int i) { return P.in[i]; }
typedef __bf16 bf16v2_ __attribute__((ext_vector_type(2)));
typedef float f32v2_ __attribute__((ext_vector_type(2)));
DI u16 f2bf(float x) { const __bf16 h = (__bf16)x; return __builtin_bit_cast(u16, h); }
DI float bf2f(u16 v) { return __uint_as_float(((unsigned)v) << 16); }
DI unsigned pack2(float a, float b) { f32v2_ v; v.x = a; v.y = b; const bf16v2_ h = __builtin_convertvector(v, bf16v2_); return __builtin_bit_cast(unsigned, h); }
DI int crow(int i, int hh) { return (i & 3) + 8 * (i >> 2) + 4 * hh; }
DI float sigmoidf_(float x) { return __builtin_amdgcn_rcpf(1.f + __expf(-x)); }
DI float wave_sum(float v) { for (int o = 32; o > 0; o >>= 1) v += __shfl_xor(v, o); return v; }
DI float wave_max(float v) { for (int o = 32; o > 0; o >>= 1) v = fmaxf(v, __shfl_xor(v, o)); return v; }
DI f32x16 zero16() { f32x16 z; for (int i = 0; i < 16; i++) z[i] = 0.f; return z; }
DI bf16x8 pack8(const f32x16& x, int s) {
  union { unsigned u[4]; bf16x8 v; } t;
  t.u[0] = pack2(x[8 * s + 0], x[8 * s + 1]); t.u[1] = pack2(x[8 * s + 2], x[8 * s + 3]);
  t.u[2] = pack2(x[8 * s + 4], x[8 * s + 5]); t.u[3] = pack2(x[8 * s + 6], x[8 * s + 7]);
  return t.v;
}

constexpr int GS_ = 72;
constexpr int GT_ = 128 * GS_;

constexpr int GST_ = 32768;
DI void gemm_stage(const u16* __restrict__ A, int lda, const u16* __restrict__ B, int ldb, int kt, char* sbuf) {
  const int tid = tidx(), lane = tid & 63, wave = __builtin_amdgcn_readfirstlane(tid >> 6);
  const int pp = lane >> 4, pos = lane & 15;
#pragma unroll
  for (int i = 0; i < 4; i++) {
    const int blk = i * 4 + wave;
    const int p = blk * 4 + pp;
    const int row = 2 * p + (pos >> 3), c8 = (pos & 7) ^ (p & 7);
    const u16* ga = A + (size_t)row * lda + kt * 64 + c8 * 8;
    const u16* gb = B + (size_t)row * ldb + kt * 64 + c8 * 8;
    __builtin_amdgcn_global_load_lds((const GAS void*)ga, (__attribute__((address_space(3))) void*)(sbuf + blk * 1024), 16, 0, 0);
    __builtin_amdgcn_global_load_lds((const GAS void*)gb, (__attribute__((address_space(3))) void*)(sbuf + 16384 + blk * 1024), 16, 0, 0);
  }
}
DI void gemm_main(f32x16 (&acc)[2][2], const u16* __restrict__ A, int lda, const u16* __restrict__ B, int ldb, int K, u16* sm) {
  const int tid = tidx(), lane = tid & 63, wave = tid >> 6;
  const int wm = wave >> 1, wn = wave & 1, r = lane & 31, hh = lane >> 5;
  char* sb = (char*)sm;
  const int rowa = wm * 64 + r, rowb = wn * 64 + r;
  const int baseA = (rowa >> 1) * 256 + ((rowa & 1) << 7), xa = (rowa >> 1) & 7;
  const int baseB = 16384 + (rowb >> 1) * 256 + ((rowb & 1) << 7), xb = (rowb >> 1) & 7;
  const int nk = K >> 6;
  asm volatile("s_waitcnt vmcnt(0)" ::: "memory");
  __syncthreads();
#pragma unroll 1
  for (int kt = 0; kt < nk; kt++) {
    if (kt + 1 < nk) gemm_stage(A, lda, B, ldb, kt + 1, sb + ((kt + 1) & 1) * GST_);
    const char* st = sb + (kt & 1) * GST_;
#pragma unroll
    for (int ks = 0; ks < 4; ks++) {
      const int ca = ((ks * 2 + hh) ^ xa) << 4, cb = ((ks * 2 + hh) ^ xb) << 4;
      const bf16x8 fa0 = *(const bf16x8*)(st + baseA + ca);
      const bf16x8 fa1 = *(const bf16x8*)(st + baseA + 4096 + ca);
      const bf16x8 fb0 = *(const bf16x8*)(st + baseB + cb);
      const bf16x8 fb1 = *(const bf16x8*)(st + baseB + 4096 + cb);
      acc[0][0] = MFMA32(fa0, fb0, acc[0][0]); acc[0][1] = MFMA32(fa0, fb1, acc[0][1]);
      acc[1][0] = MFMA32(fa1, fb0, acc[1][0]); acc[1][1] = MFMA32(fa1, fb1, acc[1][1]);
    }
    asm volatile("s_waitcnt vmcnt(0)" ::: "memory");
    __syncthreads();
  }
}

DI bool tile_at(int it, int bid, int nb, int TM, int TN, int& tm, int& tn) {
  if ((nb & 7) == 0 && (TM & 63) == 0) {
    const int xcd = bid & 7, lw = bid >> 3, nlw = nb >> 3;
    const int lt = lw + it * nlw, per = (TM >> 3) * TN;
    if (lt >= per) return false;
    const int g = lt / (4 * TN), rem = lt - g * 4 * TN;
    tn = rem >> 2; tm = xcd * (TM >> 3) + g * 4 + (rem & 3);
    return true;
  } else {
    const int t = bid + it * nb;
    if (t >= TM * TN) return false;
    tn = t / TM; tm = t - tn * TM;
    return true;
  }
}

template <class AF, class BF, class INI, class EPI>
DI void gemm_phase_init(int TM, int TN, int K, int lda, int ldb, AF a_of, BF b_of, INI ini, EPI epi, int bid, int nb, u16* sm) {
  int tm, tn;
  bool have = tile_at(0, bid, nb, TM, TN, tm, tn);
  __syncthreads();
  if (have) gemm_stage(a_of(tm), lda, b_of(tn), ldb, 0, (char*)sm);
  for (int it = 0; have; it++) {
    f32x16 acc[2][2];
    ini(acc, tm, tn);
    gemm_main(acc, a_of(tm), lda, b_of(tn), ldb, K, sm);
    int tm2 = 0, tn2 = 0;
    const bool have2 = tile_at(it + 1, bid, nb, TM, TN, tm2, tn2);
    if (have2) gemm_stage(a_of(tm2), lda, b_of(tn2), ldb, 0, (char*)sm);
    epi(acc, tm, tn);
    have = have2; tm = tm2; tn = tn2;
  }
  asm volatile("s_waitcnt vmcnt(0)" ::: "memory");
}
template <class AF, class BF, class EPI>
DI void gemm_phase(int TM, int TN, int K, int lda, int ldb, AF a_of, BF b_of, EPI epi, int bid, int nb, u16* sm) {
  gemm_phase_init(TM, TN, K, lda, ldb, a_of, b_of,
    [&](f32x16 (&acc)[2][2], int, int) { acc[0][0] = zero16(); acc[0][1] = zero16(); acc[1][0] = zero16(); acc[1][1] = zero16(); },
    epi, bid, nb, sm);
}

DI void transpose_job(const float* __restrict__ src, int K, int N, u16* __restrict__ dst, int mode, int bid, int nb, float* tile) {
  const int tid = tidx();
  const int tk = K >> 6, tn = (N + 63) >> 6;
  for (int t = bid; t < tk * tn; t += nb) {
    const int k0 = (t % tk) * 64, n0 = (t / tk) * 64;
    __syncthreads();
    float tv[16];
#pragma unroll
    for (int i = 0; i < 16; i++) {
      const int k = i * 4 + (tid >> 6), n = tid & 63;
      tv[i] = (n0 + n < N) ? src[(size_t)(k0 + k) * N + n0 + n] : 0.f;
    }
#pragma unroll
    for (int i = 0; i < 16; i++) tile[(i * 4 + (tid >> 6)) * 65 + (tid & 63)] = tv[i];
    __syncthreads();
#pragma unroll 4
    for (int i = 0; i < 16; i++) {
      const int n = i * 4 + (tid >> 6), k = tid & 63;
      const int ng = n0 + n;
      if (ng < N) {
        int row = ng;
        if (mode == 1) row = (ng >> 5) * 64 + (ng & 31);
        else if (mode == 2) row = (ng >> 5) * 64 + 32 + (ng & 31);
        dst[(size_t)row * K + k0 + k] = f2bf(tile[k * 65 + n]);
      }
    }
  }
}

DI void phase_prep(const Params& P, int bid, int nb, char* smem) {
  float* tile = (float*)smem;
  char* ws = WS(P);
  for (int l = 0; l < 2; l++) {
    transpose_job(INP(P, 3) + (size_t)l * 1024 * FF_, 1024, FF_, (u16*)(ws + OFF_WGU1 + l * SZ_WGU), 1, bid, nb, tile);
    transpose_job(INP(P, 4) + (size_t)l * 1024 * FF_, 1024, FF_, (u16*)(ws + OFF_WGU1 + l * SZ_WGU), 2, bid, nb, tile);
    transpose_job(INP(P, 5) + (size_t)l * FF_ * 1024, FF_, 1024, (u16*)(ws + OFF_WD1 + l * SZ_WD), 0, bid, nb, tile);
    transpose_job(INP(P, 26) + (size_t)l * 1024 * FF_, 1024, FF_, (u16*)(ws + OFF_WGU2 + l * SZ_WGU), 1, bid, nb, tile);
    transpose_job(INP(P, 27) + (size_t)l * 1024 * FF_, 1024, FF_, (u16*)(ws + OFF_WGU2 + l * SZ_WGU), 2, bid, nb, tile);
    transpose_job(INP(P, 28) + (size_t)l * FF_ * 1024, FF_, 1024, (u16*)(ws + OFF_WD2 + l * SZ_WD), 0, bid, nb, tile);
    transpose_job(INP(P, 8) + (size_t)l * 1024 * 2472, 1024, 2472, (u16*)(ws + OFF_WIN + l * SZ_WIN), 0, bid, nb, tile);
    transpose_job(INP(P, 9) + (size_t)l * 1024 * 1024, 1024, 1024, (u16*)(ws + OFF_WO + l * SZ_WO), 0, bid, nb, tile);
    transpose_job(INP(P, 23) + (size_t)l * 256 * 256, 256, 256, (u16*)(ws + OFF_WGLU + l * SZ_WGLU), 0, bid, nb, tile);
    transpose_job(INP(P, 30) + (size_t)l * 1024 * 1024, 1024, 1024, (u16*)(ws + OFF_WPG + l * SZ_WPG), 0, bid, nb, tile);
    transpose_job(INP(P, 29) + (size_t)l * 256 * 1024, 256, 1024, (u16*)(ws + OFF_WPP + l * SZ_WPP), 0, bid, nb, tile);
    u16* win = (u16*)(ws + OFF_WIN + l * SZ_WIN);
    for (int i = bid * 256 + tidx(); i < 88 * 1024; i += nb * 256) win[(size_t)2472 * 1024 + i] = 0;
  }
  const size_t gt = (size_t)bid * 256 + tidx(), gs = (size_t)nb * 256;
  {
    const float4* x4 = (const float4*)INP(P, 0);
    uint2* xb = (uint2*)(ws + OFF_XB);
    for (size_t i = gt; i < (size_t)T_ * 1024 / 4; i += gs * 8) {
      float4 v[8];
#pragma unroll
      for (int u = 0; u < 8; u++) v[u] = (i + u * gs < (size_t)T_ * 1024 / 4) ? x4[i + u * gs] : make_float4(0.f, 0.f, 0.f, 0.f);
#pragma unroll
      for (int u = 0; u < 8; u++) if (i + u * gs < (size_t)T_ * 1024 / 4) xb[i + u * gs] = make_uint2(pack2(v[u].x, v[u].y), pack2(v[u].z, v[u].w));
    }
    const float4* p4 = (const float4*)INP(P, 1);
    uint2* pb = (uint2*)(ws + OFF_PB);
    for (size_t i = gt; i < (size_t)2 * T_ * 256 / 4; i += gs * 8) {
      float4 v[8];
#pragma unroll
      for (int u = 0; u < 8; u++) v[u] = (i + u * gs < (size_t)2 * T_ * 256 / 4) ? p4[i + u * gs] : make_float4(0.f, 0.f, 0.f, 0.f);
#pragma unroll
      for (int u = 0; u < 8; u++) if (i + u * gs < (size_t)2 * T_ * 256 / 4) pb[i + u * gs] = make_uint2(pack2(v[u].x, v[u].y), pack2(v[u].z, v[u].w));
    }
  }
  if (gt < 2 * 16 * 64) {
    const int l = (int)gt >> 10, g = ((int)gt >> 6) & 15, p = (int)gt & 63;
    const int gi = (l * 16 + g) * 64 + p;
    const double lr = INP(P, 15)[gi], li = INP(P, 16)[gi];
    const double dt = exp((double)INP(P, 17)[l * 16 + g]);
    const double mag = exp(lr * dt);
    const double ar = mag * cos(li * dt), ai = mag * sin(li * dt);
    const double mag5 = exp(512.0 * lr * dt);
    const double a5r = mag5 * cos(512.0 * li * dt), a5i = mag5 * sin(512.0 * li * dt);
    ((float4*)(ws + OFF_COEFA))[gi] = make_float4((float)ar, (float)ai, (float)a5r, (float)a5i);
    const double den = lr * lr + li * li, nr = ar - 1.0, ni = ai;
    const double fr = (nr * lr + ni * li) / den, fi = (ni * lr - nr * li) / den;
    float2* cb = (float2*)(ws + OFF_COEFB) + (size_t)gi * 16;
    for (int c = 0; c < 16; c++) {
      const double br = INP(P, 18)[(size_t)gi * 16 + c], bi = INP(P, 19)[(size_t)gi * 16 + c];
      cb[c] = make_float2((float)(fr * br - fi * bi), (float)(fr * bi + fi * br));
    }
  }
  if (gt < 8 * 129) {
    const int hd = (int)gt / 129, n = (int)gt - hd * 129;
    int bk = n;
    if (n >= 16) { bk = 16 + (int)(log((double)n / 16.0) / log(8.0) * 16.0); bk = bk < 31 ? bk : 31; }
    ((float*)(ws + OFF_BIAS))[gt] = INP(P, 2)[bk * 8 + hd];
  }
  if (gt < 2) {
    const int l = (int)gt;
    float s1 = 0.f, s2 = 0.f;
    for (int i = 0; i < 64; i++) { s1 += INP(P, 10)[l * 64 + i] * INP(P, 11)[l * 64 + i]; s2 += INP(P, 12)[l * 64 + i] * INP(P, 13)[l * 64 + i]; }
    const float lam_init = 0.8f - 0.6f * expf(-0.3f * (float)l);
    ((float*)(ws + OFF_LAM))[l] = expf(s1) - expf(s2) + lam_init;
  }
}

DI void phase_ffn_up(const u16* __restrict__ Xb, const u16* __restrict__ Wgu, u16* __restrict__ H, int bid, int nb, u16* sm) {
  const int lane = tidx() & 63, wave = tidx() >> 6, wm = wave >> 1, wn = wave & 1, r = lane & 31, hh = lane >> 5;
  gemm_phase(512, 44, 1024, 1024, 1024,
    [&](int tm) { return Xb + (size_t)tm * 128 * 1024; }, [&](int tn) { return Wgu + (size_t)tn * 128 * 1024; },
    [&](f32x16 (&acc)[2][2], int tm, int tn) {
      const int j = tn * 64 + wn * 32 + r;
#pragma unroll
      for (int mi = 0; mi < 2; mi++)
#pragma unroll
        for (int i = 0; i < 16; i++) {
          const int row = tm * 128 + wm * 64 + mi * 32 + crow(i, hh);
          const float g = acc[mi][0][i], u = acc[mi][1][i];
          H[(size_t)row * FF_ + j] = f2bf(g * sigmoidf_(g) * u);
        }
    }, bid, nb, sm);
}

DI void phase_ffn_down(const u16* __restrict__ H, const u16* __restrict__ Wd, const float* xin, const u16* __restrict__ xinb, float* xout, const u16* __restrict__ ple, int bid, int nb, u16* sm) {
  const int lane = tidx() & 63, wave = tidx() >> 6, wm = wave >> 1, wn = wave & 1, r = lane & 31, hh = lane >> 5;
  gemm_phase_init(512, 8, FF_, FF_, FF_,
    [&](int tm) { return H + (size_t)tm * 128 * FF_; }, [&](int tn) { return Wd + (size_t)tn * 128 * FF_; },
    [&](f32x16 (&acc)[2][2], int tm, int tn) {
#pragma unroll
      for (int mi = 0; mi < 2; mi++)
#pragma unroll
        for (int ni = 0; ni < 2; ni++)
#pragma unroll
          for (int i = 0; i < 16; i++) {
            const size_t o = (size_t)(tm * 128 + wm * 64 + mi * 32 + crow(i, hh)) * 1024 + tn * 128 + wn * 64 + ni * 32 + r;
            float v = 2.f * ALPHA_ * (xin ? xin[o] : bf2f(xinb[o]));
            if (ple) v += 2.f * bf2f(ple[o]);
            acc[mi][ni][i] = v;
          }
    },
    [&](f32x16 (&acc)[2][2], int tm, int tn) {
#pragma unroll
      for (int mi = 0; mi < 2; mi++)
#pragma unroll
        for (int ni = 0; ni < 2; ni++)
#pragma unroll
          for (int i = 0; i < 16; i++) {
            const size_t o = (size_t)(tm * 128 + wm * 64 + mi * 32 + crow(i, hh)) * 1024 + tn * 128 + wn * 64 + ni * 32 + r;
            xout[o] = 0.5f * acc[mi][ni][i];
          }
    }, bid, nb, sm);
}

DI void phase_w_o(const u16* __restrict__ CC, const u16* __restrict__ Wo, float* x, const u16* __restrict__ xb, int bid, int nb, u16* sm) {
  const int lane = tidx() & 63, wave = tidx() >> 6, wm = wave >> 1, wn = wave & 1, r = lane & 31, hh = lane >> 5;
  gemm_phase_init(512, 8, 1024, 1024, 1024,
    [&](int tm) { return CC + (size_t)tm * 128 * 1024; }, [&](int tn) { return Wo + (size_t)tn * 128 * 1024; },
    [&](f32x16 (&acc)[2][2], int tm, int tn) {
#pragma unroll
      for (int mi = 0; mi < 2; mi++)
#pragma unroll
        for (int ni = 0; ni < 2; ni++)
#pragma unroll
          for (int i = 0; i < 16; i++) {
            const size_t o = (size_t)(tm * 128 + wm * 64 + mi * 32 + crow(i, hh)) * 1024 + tn * 128 + wn * 64 + ni * 32 + r;
            acc[mi][ni][i] = ALPHA_ * bf2f(xb[o]);
          }
    },
    [&](f32x16 (&acc)[2][2], int tm, int tn) {
#pragma unroll
      for (int mi = 0; mi < 2; mi++)
#pragma unroll
        for (int ni = 0; ni < 2; ni++)
#pragma unroll
          for (int i = 0; i < 16; i++) {
            const size_t o = (size_t)(tm * 128 + wm * 64 + mi * 32 + crow(i, hh)) * 1024 + tn * 128 + wn * 64 + ni * 32 + r;
            x[o] = acc[mi][ni][i];
          }
    }, bid, nb, sm);
}

DI void phase_glu(const u16* __restrict__ Yg, const u16* __restrict__ Wglu, u16* __restrict__ CC, int bid, int nb, u16* sm) {
  const int lane = tidx() & 63, wave = tidx() >> 6, wm = wave >> 1, wn = wave & 1, r = lane & 31, hh = lane >> 5;
  gemm_phase(512, 2, 256, 256, 256,
    [&](int tm) { return Yg + (size_t)tm * 128 * 256; }, [&](int tn) { return Wglu + (size_t)tn * 128 * 256; },
    [&](f32x16 (&acc)[2][2], int tm, int tn) {
#pragma unroll
      for (int mi = 0; mi < 2; mi++)
#pragma unroll
        for (int ni = 0; ni < 2; ni++)
#pragma unroll
          for (int i = 0; i < 16; i++) {
            const int row = tm * 128 + wm * 64 + mi * 32 + crow(i, hh), col = tn * 128 + wn * 64 + ni * 32 + r;
            const float y = bf2f(Yg[(size_t)row * 256 + col]);
            CC[(size_t)row * 1024 + 512 + col] = f2bf(y * sigmoidf_(acc[mi][ni][i]));
          }
    }, bid, nb, sm);
}

DI void phase_ple(const u16* __restrict__ Xb, const u16* __restrict__ Wpg, const u16* __restrict__ Pb, const u16* __restrict__ Wpp, u16* ple, int bid, int nb, u16* sm) {
  const int lane = tidx() & 63, wave = tidx() >> 6, wm = wave >> 1, wn = wave & 1, r = lane & 31, hh = lane >> 5;
  gemm_phase(512, 8, 1024, 1024, 1024,
    [&](int tm) { return Xb + (size_t)tm * 128 * 1024; }, [&](int tn) { return Wpg + (size_t)tn * 128 * 1024; },
    [&](f32x16 (&acc)[2][2], int tm, int tn) {
#pragma unroll
      for (int mi = 0; mi < 2; mi++)
#pragma unroll
        for (int ni = 0; ni < 2; ni++)
#pragma unroll
          for (int i = 0; i < 16; i++) {
            const size_t o = (size_t)(tm * 128 + wm * 64 + mi * 32 + crow(i, hh)) * 1024 + tn * 128 + wn * 64 + ni * 32 + r;
            ple[o] = f2bf(sigmoidf_(acc[mi][ni][i]));
          }
    }, bid, nb, sm);
  gemm_phase(512, 8, 256, 256, 256,
    [&](int tm) { return Pb + (size_t)tm * 128 * 256; }, [&](int tn) { return Wpp + (size_t)tn * 128 * 256; },
    [&](f32x16 (&acc)[2][2], int tm, int tn) {
#pragma unroll
      for (int mi = 0; mi < 2; mi++)
#pragma unroll
        for (int ni = 0; ni < 2; ni++)
#pragma unroll
          for (int i = 0; i < 16; i++) {
            const size_t o = (size_t)(tm * 128 + wm * 64 + mi * 32 + crow(i, hh)) * 1024 + tn * 128 + wn * 64 + ni * 32 + r;
            ple[o] = f2bf(acc[mi][ni][i] * bf2f(ple[o]));
          }
    }, bid, nb, sm);
}

DI void phase_w_in(const u16* __restrict__ Xb, const u16* __restrict__ Win, char* mb, int bid, int nb, u16* sm) {
  const int lane = tidx() & 63, wave = tidx() >> 6, wm = wave >> 1, wn = wave & 1, r = lane & 31, hh = lane >> 5;
  u16* Qd = (u16*)(mb + M_QD); u16* Kd = (u16*)(mb + M_KD); u16* Vt = (u16*)(mb + M_VT); float* U = (float*)(mb + M_U);
  u16* Qs = (u16*)(mb + M_QS); u16* Qi = (u16*)(mb + M_QI); u16* Ks = (u16*)(mb + M_KS); u16* Vs = (u16*)(mb + M_VS);
  u16* Ki = (u16*)(mb + M_KI); float* Wi = (float*)(mb + M_WI);
  gemm_phase(512, 20, 1024, 1024, 1024,
    [&](int tm) { return Xb + (size_t)tm * 128 * 1024; }, [&](int tn) { return Win + (size_t)tn * 128 * 1024; },
    [&](f32x16 (&acc)[2][2], int tm, int tn) {
#pragma unroll
    for (int ni = 0; ni < 2; ni++) {
      const int c0 = tn * 128 + wn * 64 + ni * 32;
      const int c = c0 + r;
#pragma unroll
      for (int mi = 0; mi < 2; mi++) {
        const int rowb = tm * 128 + wm * 64 + mi * 32;
        if (c0 >= 1024 && c0 < 1536) {
          const int cc = c - 1024, head = cc >> 7, dv = cc & 127;
          const int b = rowb >> 13, t0 = rowb & 8191;
#pragma unroll
          for (int g4 = 0; g4 < 4; g4++) {
            uint2 v = make_uint2(pack2(acc[mi][ni][4 * g4], acc[mi][ni][4 * g4 + 1]), pack2(acc[mi][ni][4 * g4 + 2], acc[mi][ni][4 * g4 + 3]));
            const int tt = t0 + 8 * g4 + 4 * hh;
            *(uint2*)(Vt + ((size_t)(((b * 4 + head) * 128 + (tt >> 6)) * 128 + dv)) * 64 + (tt & 63)) = v;
          }
        } else {
#pragma unroll
          for (int i = 0; i < 16; i++) {
            const size_t row = rowb + crow(i, hh);
            const float v = acc[mi][ni][i];
            if (c0 < 512) Qd[row * 512 + c] = f2bf(v);
            else if (c0 < 1024) {
              const int cc = c - 512;
              Kd[((size_t)((((int)(row >> 13) * 4 + (cc >> 7)) * 2 + ((cc >> 6) & 1))) * L_ + (row & 8191)) * 64 + (cc & 63)] = f2bf(v);
            }
            else if (c0 < 1792) U[row * 256 + (c - 1536)] = v;
            else if (c0 < 2048) Qs[row * 256 + (c - 1792)] = f2bf(v);
            else if (c0 < 2112) Ks[row * 64 + (c - 2048)] = f2bf(v);
            else if (c0 < 2176) Vs[row * 64 + (c - 2112)] = f2bf(v);
            else if (c0 < 2432) Qi[row * 256 + (c - 2176)] = f2bf(v);
            else if (c0 < 2464) Ki[row * 32 + (c - 2432)] = f2bf(v);
            else if (c0 == 2464) { if (r < 8) Wi[row * 8 + r] = v * 0.0625f; }
          }
        }
      }
    }
  }, bid, nb, sm);
}

DI void phase_ln(float* x, u16* __restrict__ xb, const float* __restrict__ g, const float* __restrict__ bta, bool write_f32, int bid, int nb) {
  const int lane = tidx() & 63, wave = tidx() >> 6;
  float4 gg[4], bb[4];
#pragma unroll
  for (int i = 0; i < 4; i++) { gg[i] = *(const float4*)(g + i * 256 + lane * 4); bb[i] = *(const float4*)(bta + i * 256 + lane * 4); }
  constexpr int RB = 4;
  for (int row0 = (bid * 4 + wave) * RB; row0 < T_; row0 += nb * 4 * RB) {
    float4 v[RB][4];
#pragma unroll
    for (int rr = 0; rr < RB; rr++)
#pragma unroll
      for (int i = 0; i < 4; i++) v[rr][i] = *(const float4*)(x + (size_t)(row0 + rr) * 1024 + i * 256 + lane * 4);
    float s[RB], q[RB];
#pragma unroll
    for (int rr = 0; rr < RB; rr++) {
      s[rr] = 0.f;
#pragma unroll
      for (int i = 0; i < 4; i++) s[rr] += v[rr][i].x + v[rr][i].y + v[rr][i].z + v[rr][i].w;
    }
#pragma unroll
    for (int o = 32; o > 0; o >>= 1)
#pragma unroll
      for (int rr = 0; rr < RB; rr++) s[rr] += __shfl_xor(s[rr], o);
#pragma unroll
    for (int rr = 0; rr < RB; rr++) {
      const float mu = s[rr] * (1.f / 1024.f);
      q[rr] = 0.f;
#pragma unroll
      for (int i = 0; i < 4; i++) {
        v[rr][i].x -= mu; v[rr][i].y -= mu; v[rr][i].z -= mu; v[rr][i].w -= mu;
        q[rr] += v[rr][i].x * v[rr][i].x + v[rr][i].y * v[rr][i].y + v[rr][i].z * v[rr][i].z + v[rr][i].w * v[rr][i].w;
      }
    }
#pragma unroll
    for (int o = 32; o > 0; o >>= 1)
#pragma unroll
      for (int rr = 0; rr < RB; rr++) q[rr] += __shfl_xor(q[rr], o);
#pragma unroll
    for (int rr = 0; rr < RB; rr++) {
      const float rs = rsqrtf(q[rr] * (1.f / 1024.f) + LN_EPS_);
#pragma unroll
      for (int i = 0; i < 4; i++) {
        float4 o;
        o.x = v[rr][i].x * rs * gg[i].x + bb[i].x; o.y = v[rr][i].y * rs * gg[i].y + bb[i].y;
        o.z = v[rr][i].z * rs * gg[i].z + bb[i].z; o.w = v[rr][i].w * rs * gg[i].w + bb[i].w;
        if (write_f32) *(float4*)(x + (size_t)(row0 + rr) * 1024 + i * 256 + lane * 4) = o;
        *(uint2*)(xb + (size_t)(row0 + rr) * 1024 + i * 256 + lane * 4) = make_uint2(pack2(o.x, o.y), pack2(o.z, o.w));
      }
    }
  }
}

DI float gelu_tanh(float x) { const float u = 0.7978845608028654f * (x + 0.044715f * x * x * x); return 0.5f * x * (1.f + tanhf(u)); }

typedef __attribute__((ext_vector_type(4))) float f32x4;
template <bool OUT>
DI void ssm_scan(const Params& P, int layer, int widx, char* mb, char* smem) {
  const int lane = tidx() & 63, wave = tidx() >> 6;
  const int b = widx >> 8, g = (widx >> 4) & 15, ch = widx & 15;
  const int gi = (layer * 16 + g) * 64 + lane;
  const float4 ca = ((const float4*)(WS(P) + OFF_COEFA))[gi];
  const float2* cbp = (const float2*)(WS(P) + OFF_COEFB) + (size_t)gi * 16;
  float bre[16], bim[16];
#pragma unroll
  for (int c = 0; c < 16; c++) { float2 t = cbp[c]; bre[c] = t.x; bim[c] = t.y; }
  const float* U = (const float*)(mb + M_U);
  float2* Send = (float2*)(mb + M_SEND);
  const size_t sbase = (size_t)((b * 16 + g) * 16) * 64 + lane;
  float xr = 0.f, xi = 0.f;
  float am[32];
  float4 dsk4 = make_float4(0.f, 0.f, 0.f, 0.f);
  float* Xs = (float*)smem + wave * (128 * 17);
  const int lm = lane & 15, lq = lane >> 4;
  if (OUT) {
    for (int j = 0; j < ch; j++) {
      const float2 e = Send[sbase + (size_t)j * 64];
      const float nr = ca.z * xr - ca.w * xi + e.x, ni = ca.z * xi + ca.w * xr + e.y;
      xr = nr; xi = ni;
    }
    const float* cre = INP(P, 20) + ((size_t)(layer * 16 + g) * 16 + lm) * 64;
    const float* cim = INP(P, 21) + ((size_t)(layer * 16 + g) * 16 + lm) * 64;
#pragma unroll
    for (int kb = 0; kb < 32; kb++) {
      const int kk = 4 * kb + lq;
      am[kb] = (kb < 16) ? cre[kk] : -cim[kk - 64];
    }
    dsk4 = *(const float4*)(INP(P, 22) + layer * 256 + g * 16 + 4 * lq);
  }
  u16* Yg = (u16*)(mb + M_YG);
  const size_t tok0 = (size_t)b * L_ + ch * 512;
  const float* ub = U + (tok0 + (lane >> 2)) * 256 + g * 16 + (lane & 3) * 4;
  float4 cur = *(const float4*)ub;
#pragma unroll 1
  for (int blk = 0; blk < 32; blk++) {
    const float4 nxt = *(const float4*)(ub + (size_t)min(blk + 1, 31) * 16 * 256);
#pragma unroll
    for (int s16 = 0; s16 < 16; s16++) {
      float uu[16];
#pragma unroll
      for (int c = 0; c < 16; c++) {
        const float comp = ((c & 3) == 0) ? cur.x : ((c & 3) == 1) ? cur.y : ((c & 3) == 2) ? cur.z : cur.w;
        uu[c] = __int_as_float(__builtin_amdgcn_readlane(__float_as_int(comp), 4 * s16 + (c >> 2)));
      }
      float br4[4] = {0.f, 0.f, 0.f, 0.f}, bi4[4] = {0.f, 0.f, 0.f, 0.f};
#pragma unroll
      for (int c = 0; c < 16; c++) { br4[c & 3] += bre[c] * uu[c]; bi4[c & 3] += bim[c] * uu[c]; }
      const float br = (br4[0] + br4[1]) + (br4[2] + br4[3]), bi = (bi4[0] + bi4[1]) + (bi4[2] + bi4[3]);
      const float nr = ca.x * xr - ca.y * xi + br, ni = ca.x * xi + ca.y * xr + bi;
      xr = nr; xi = ni;
      if (OUT) { Xs[lane * 17 + s16] = xr; Xs[(64 + lane) * 17 + s16] = xi; }
    }
    if (OUT) {
      __builtin_amdgcn_wave_barrier();
      f32x4 acc = {0.f, 0.f, 0.f, 0.f}, acc2 = {0.f, 0.f, 0.f, 0.f};
#pragma unroll
      for (int kb = 0; kb < 32; kb += 2) {
        const float bv0 = Xs[(4 * kb + lq) * 17 + lm], bv1 = Xs[(4 * kb + 4 + lq) * 17 + lm];
        acc = __builtin_amdgcn_mfma_f32_16x16x4f32(am[kb], bv0, acc, 0, 0, 0);
        acc2 = __builtin_amdgcn_mfma_f32_16x16x4f32(am[kb + 1], bv1, acc2, 0, 0, 0);
      }
      acc += acc2;
      __builtin_amdgcn_wave_barrier();
      const size_t tok = tok0 + blk * 16 + lm;
      const float4 u4 = *(const float4*)(U + tok * 256 + g * 16 + 4 * lq);
      const float y0 = gelu_tanh(acc[0] + dsk4.x * u4.x), y1 = gelu_tanh(acc[1] + dsk4.y * u4.y);
      const float y2 = gelu_tanh(acc[2] + dsk4.z * u4.z), y3 = gelu_tanh(acc[3] + dsk4.w * u4.w);
      *(uint2*)(Yg + tok * 256 + g * 16 + 4 * lq) = make_uint2(pack2(y0, y1), pack2(y2, y3));
    }
    cur = nxt;
  }
  if (!OUT) Send[sbase + (size_t)ch * 64] = make_float2(xr, xi);
}

constexpr int KS_ = 72, VS_ = 68;
DI void da_item(const Params& P, int layer, int b, int h, int qt, char* mb, char* smem) {
  const int tid = tidx(), lane = tid & 63, wave = tid >> 6, r = lane & 31, hh = lane >> 5;
  u16* sK0 = (u16*)smem;
  u16* sV0 = sK0 + 2 * 64 * KS_;
  float* sbias = (float*)(sV0 + 2 * 128 * VS_);
  u16* sQw = (u16*)(smem + 54272) + (tidx() >> 6) * 32 * KS_;
  const u16* Qd = (const u16*)(mb + M_QD); const u16* Kd = (const u16*)(mb + M_KD); const u16* Vt = (const u16*)(mb + M_VT);
  u16* CC = (u16*)(WS(P) + OFF_CC);
  const int q0 = qt * 128, qw = q0 + wave * 32, qp = qw + r;
  const size_t tokq = (size_t)b * L_ + qp;
  __syncthreads();
  if (tid < 129) sbias[tid] = ((const float*)(WS(P) + OFF_BIAS))[h * 129 + tid] * LOG2E_;
  __syncthreads();
  const float bfar = sbias[128];
  const float SC = 0.125f * LOG2E_;
  const int nkt = (q0 + 128) >> 6;
  const float lam = ((const float*)(WS(P) + OFF_LAM))[layer];
  const int krow_l = tid >> 3, kch = (tid & 7) * 8;
#pragma unroll 1
  for (int c = 0; c < 2; c++) {
#pragma unroll
    for (int ks = 0; ks < 4; ks++) *(bf16x8*)(sQw + r * KS_ + ks * 16 + hh * 8) = *(const bf16x8*)(Qd + tokq * 512 + h * 128 + c * 64 + ks * 16 + hh * 8);
    f32x16 o[4] = {zero16(), zero16(), zero16(), zero16()};
    float m = -INFINITY, l = 0.f;
    const u16* Kbase = Kd + ((size_t)(((b * 4 + h) * 2 + c)) * L_ + krow_l) * 64 + kch;
    const u16* Vbase = Vt + ((size_t)((b * 4 + h) * 128) * 128 + krow_l) * 64 + kch;
    u32x4 rk[2], rv[4];
#pragma unroll
    for (int i = 0; i < 2; i++) rk[i] = *(const u32x4*)(Kbase + (size_t)(i * 32) * 64);
#pragma unroll
    for (int i = 0; i < 4; i++) rv[i] = *(const u32x4*)(Vbase + (size_t)(i * 32) * 64);
#define DA_STAGE(BUF) { u16* sKw = sK0 + (BUF) * 64 * KS_; u16* sVw = sV0 + (BUF) * 128 * VS_; \
      _Pragma("unroll") for (int i = 0; i < 2; i++) *(u32x4*)(sKw + (krow_l + i * 32) * KS_ + kch) = rk[i]; \
      _Pragma("unroll") for (int i = 0; i < 4; i++) { u32x2* d = (u32x2*)(sVw + (krow_l + i * 32) * VS_ + kch); \
        u32x2 lo2, hi2; lo2.x = rv[i].x; lo2.y = rv[i].y; hi2.x = rv[i].z; hi2.y = rv[i].w; d[0] = lo2; d[1] = hi2; } }
#define DA_FETCH(T) { const int ktn_ = min((T), nkt - 1); \
      _Pragma("unroll") for (int i = 0; i < 2; i++) rk[i] = *(const u32x4*)(Kbase + (size_t)(ktn_ * 64 + i * 32) * 64); \
      _Pragma("unroll") for (int i = 0; i < 4; i++) rv[i] = *(const u32x4*)(Vbase + (size_t)ktn_ * 8192 + (size_t)(i * 32) * 64); }
    __syncthreads();
    DA_STAGE(0)
    DA_FETCH(1)
    __syncthreads();
#pragma unroll 1
    for (int kt = 0; kt < nkt; kt++) {
      const u16* sK = sK0 + (kt & 1) * 64 * KS_;
      const u16* sV = sV0 + (kt & 1) * 128 * VS_;
      if (kt + 1 < nkt) { DA_STAGE((kt + 1) & 1) }
      DA_FETCH(kt + 2)
      if (kt * 64 <= qw + 31) {
        f32x16 s[2];
#pragma unroll
        for (int kb = 0; kb < 2; kb++) {
          s[kb] = zero16();
#pragma unroll
          for (int ks = 0; ks < 4; ks++) {
            const bf16x8 kf = *(const bf16x8*)(sK + (kb * 32 + r) * KS_ + ks * 16 + hh * 8);
            const bf16x8 qf = *(const bf16x8*)(sQw + r * KS_ + ks * 16 + hh * 8);
            s[kb] = MFMA32(kf, qf, s[kb]);
          }
        }
        const bool nearb = (kt * 64 + 63 + 128 > qw);
        float mx = -INFINITY;
        if (nearb) {
#pragma unroll
          for (int kb = 0; kb < 2; kb++)
#pragma unroll
            for (int i = 0; i < 16; i++) {
              const int dist = qp - (kt * 64 + kb * 32 + crow(i, hh));
              const float bv = sbias[min(max(dist, 0), 128)];
              float t = s[kb][i] * SC + bv;
              t = (dist >= 0) ? t : -INFINITY;
              s[kb][i] = t; mx = fmaxf(mx, t);
              if ((i & 7) == 7) __builtin_amdgcn_sched_barrier(0);
            }
        } else {
#pragma unroll
          for (int kb = 0; kb < 2; kb++)
#pragma unroll
            for (int i = 0; i < 16; i++) { const float t = s[kb][i] * SC + bfar; s[kb][i] = t; mx = fmaxf(mx, t); }
        }
        mx = fmaxf(mx, __shfl_xor(mx, 32));
        const float mn = fmaxf(m, mx);
        const float corr = __builtin_amdgcn_exp2f(m - mn);
        m = mn;
        float ls = 0.f;
#pragma unroll
        for (int kb = 0; kb < 2; kb++)
#pragma unroll
          for (int i = 0; i < 16; i++) { const float p = __builtin_amdgcn_exp2f(s[kb][i] - mn); s[kb][i] = p; ls += p; }
        l = l * corr + ls;
        if (__ballot(corr != 1.f) != 0ull) {
#pragma unroll
          for (int dt = 0; dt < 4; dt++)
#pragma unroll
            for (int i = 0; i < 16; i++) o[dt][i] *= corr;
        }
#pragma unroll
        for (int kb = 0; kb < 2; kb++)
#pragma unroll
          for (int s2 = 0; s2 < 2; s2++) {
            const bf16x8 pf = pack8(s[kb], s2);
#pragma unroll
            for (int dt = 0; dt < 4; dt++) {
              const u16* vp = sV + (dt * 32 + r) * VS_ + kb * 32 + s2 * 16 + 4 * hh;
              const s16x4 lo = *(const s16x4*)vp, hi = *(const s16x4*)(vp + 8);
              const bf16x8 vf = __builtin_shufflevector(lo, hi, 0, 1, 2, 3, 4, 5, 6, 7);
              o[dt] = MFMA32(vf, pf, o[dt]);
            }
            __builtin_amdgcn_sched_barrier(0);
          }
      }
      __syncthreads();
    }
#undef DA_STAGE
#undef DA_FETCH
    const float lt = l + __shfl_xor(l, 32);
    const float inv = 1.f / lt;
    size_t tq = tokq;
    asm volatile("" : "+v"(tq));
    u16* obase = CC + tq * 1024 + h * 128 + 4 * hh;
    if (c == 0) {
#pragma unroll
      for (int dt = 0; dt < 4; dt++)
#pragma unroll
        for (int g4 = 0; g4 < 4; g4++) {
          *(uint2*)(obase + dt * 32 + 8 * g4) = make_uint2(pack2(o[dt][4 * g4] * inv, o[dt][4 * g4 + 1] * inv), pack2(o[dt][4 * g4 + 2] * inv, o[dt][4 * g4 + 3] * inv));
        }
    } else {
      float ss = 0.f;
#pragma unroll
      for (int dt = 0; dt < 4; dt++)
#pragma unroll
        for (int g4 = 0; g4 < 4; g4++) {
          const uint2 pv = *(const uint2*)(obase + dt * 32 + 8 * g4);
          const float a4[4] = {bf2f((u16)(pv.x & 0xffff)), bf2f((u16)(pv.x >> 16)), bf2f((u16)(pv.y & 0xffff)), bf2f((u16)(pv.y >> 16))};
#pragma unroll
          for (int e = 0; e < 4; e++) { const float v = a4[e] - lam * o[dt][4 * g4 + e] * inv; o[dt][4 * g4 + e] = v; ss = __builtin_fmaf(v, v, ss); }
        }
      ss += __shfl_xor(ss, 32);
      const float lam_init = 0.8f - 0.6f * __expf(-0.3f * (float)layer);
      const float rn = rsqrtf(ss * (1.f / 128.f) + LN_EPS_) * (1.f - lam_init);
      int hh2 = hh;
      asm volatile("" : "+v"(hh2));
      const float* sg = INP(P, 14) + layer * 128 + 4 * hh2;
#pragma unroll
      for (int dt = 0; dt < 4; dt++)
#pragma unroll
        for (int g4 = 0; g4 < 4; g4++) {
          const int dv = dt * 32 + 8 * g4 + 4 * hh;
          const float4 gv = *(const float4*)(sg + dt * 32 + 8 * g4);
          uint2 w = make_uint2(pack2(o[dt][4 * g4] * rn * gv.x, o[dt][4 * g4 + 1] * rn * gv.y),
                               pack2(o[dt][4 * g4 + 2] * rn * gv.z, o[dt][4 * g4 + 3] * rn * gv.w));
          *(uint2*)(obase + dv - 4 * hh) = w;
        }
    }
  }
}

DI unsigned sortkey(float f) { const unsigned u = __float_as_uint(f + 0.f); return u ^ (((unsigned)((int)u >> 31)) | 0x80000000u); }

DI void dsa_item(const Params& P, int layer, int b, int qt, char* mb, char* smem) {
  const int tid = tidx(), lane = tid & 63, wave = tid >> 6, r = lane & 31, hh = lane >> 5;
  unsigned* hist = (unsigned*)smem;
  float* sP = (float*)smem;
  float* sQ = (float*)(smem + 16384);
  u16* sidx = (u16*)(smem + 32896);
  unsigned* meta = (unsigned*)(smem + 49280);
  float* sbias = (float*)(smem + 50304);
  const u16* Qi = (const u16*)(mb + M_QI); const u16* Ki = (const u16*)(mb + M_KI); const float* Wi = (const float*)(mb + M_WI);
  const u16* Qs = (const u16*)(mb + M_QS); const u16* Ks = (const u16*)(mb + M_KS); const u16* Vs = (const u16*)(mb + M_VS);
  u16* CC = (u16*)(WS(P) + OFF_CC);
  const int q0 = qt * 32;
  const int qp = q0 + r;
  const size_t tokb = (size_t)b * L_;
  const int nk32 = qt + 1;
  const bool radix = (q0 >= 256);
  __syncthreads();
  for (int i = tid; i < 4 * 129; i += 256) sbias[i] = ((const float*)(WS(P) + OFF_BIAS))[4 * 129 + i];
  meta[tid] = (tid >= 32 && tid < 64) ? 256u : 0u;
  char* sQi = smem + 52384;
  float* sWi = (float*)(smem + 69280);
  constexpr int CAPL_ = 64;
  unsigned* lK = (unsigned*)smem;
  u16* lI = (u16*)(smem + 32 * CAPL_ * 4);
  {
    const int row = tid >> 3, ch = tid & 7;
    const uint4* src = (const uint4*)(Qi + (tokb + q0 + row) * 256 + ch * 32);
    uint4* dst = (uint4*)(sQi + row * 528 + ch * 64);
    dst[0] = src[0]; dst[1] = src[1]; dst[2] = src[2]; dst[3] = src[3];
    sWi[(tid & 7) * 32 + (tid >> 3)] = Wi[(tokb + q0) * 8 + tid];
  }
  int pass = radix ? 0 : 4;
  bool fast = false;
#pragma unroll 1
  while (true) {
    __syncthreads();
    if (pass < 4) { for (int i = tid; i < 32 * 257; i += 256) hist[i] = 0u; }
    __syncthreads();
    const unsigned pref = meta[r];
    const unsigned krem = meta[32 + r];
    auto elems = [&](const f32x16& sc, const int kt, const int lim) __attribute__((always_inline)) {
      if (pass == 0) {
#pragma unroll
        for (int i = 0; i < 16; i++) {
          const int kp = kt * 32 + crow(i, hh);
          const unsigned key = sortkey(sc[i]);
          const unsigned bin = (kp <= lim) ? (key >> 24) : 256u;
          atomicAdd(&hist[r * 257 + bin], 1u);
        }
      } else if (pass < 4) {
        const int sh = 24 - 8 * pass;
#pragma unroll
        for (int i = 0; i < 16; i++) {
          const int kp = kt * 32 + crow(i, hh);
          const unsigned key = sortkey(sc[i]);
          if ((key >> (sh + 8)) == pref && kp <= lim) atomicAdd(&hist[r * 257 + ((key >> sh) & 255u)], 1u);
        }
      } else if (pass == 5) {
        unsigned mc = 0u, ms = 0u;
        unsigned keys[16];
#pragma unroll
        for (int i = 0; i < 16; i++) {
          const int kp = kt * 32 + crow(i, hh);
          keys[i] = sortkey(sc[i]);
          const unsigned bt = keys[i] >> 16;
          const bool valid = (kp <= lim);
          ms |= (valid && bt > pref) ? (1u << i) : 0u;
          mc |= (valid && bt == pref) ? (1u << i) : 0u;
        }
        unsigned base_c = 0u, base_s = 0u;
        if (mc) base_c = atomicAdd(&meta[128 + r], (unsigned)__popc(mc));
        if (ms) base_s = atomicAdd(&meta[64 + r], (unsigned)__popc(ms));
#pragma unroll
        for (int i = 0; i < 16; i++) {
          const int kp = kt * 32 + crow(i, hh);
          if ((mc >> i) & 1u) {
            const unsigned cp = base_c + (unsigned)__popc(mc & ((1u << i) - 1u));
            if (cp < (unsigned)CAPL_) { lK[r * CAPL_ + cp] = keys[i]; lI[r * CAPL_ + cp] = (u16)kp; }
          }
          if ((ms >> i) & 1u) {
            const unsigned pos = base_s + (unsigned)__popc(ms & ((1u << i) - 1u));
            if (pos < 256u) sidx[r * 256 + pos] = (u16)kp;
          }
        }
      } else {
#pragma unroll
        for (int i = 0; i < 16; i++) {
          const int kp = kt * 32 + crow(i, hh);
          const unsigned key = sortkey(sc[i]);
          bool sel = (kp <= lim);
          if (radix) {
            sel = sel && (key >= pref);
            if (sel && key == pref) sel = atomicAdd(&meta[96 + r], 1u) < krem;
          }
          if (sel) { const unsigned pos = atomicAdd(&meta[64 + r], 1u); if (pos < 256u) sidx[r * 256 + pos] = (u16)kp; }
        }
      }
    };
    const int klast = nk32 - 1;
    bf16x8 nA0 = {0, 0, 0, 0, 0, 0, 0, 0}, nA1 = nA0, nB0 = nA0, nB1 = nA0;
    if (wave < nk32) {
      const int ka = wave, kb2 = min(wave + 4, klast);
      nA0 = *(const bf16x8*)(Ki + (tokb + ka * 32 + r) * 32 + hh * 8);
      nA1 = *(const bf16x8*)(Ki + (tokb + ka * 32 + r) * 32 + 16 + hh * 8);
      nB0 = *(const bf16x8*)(Ki + (tokb + kb2 * 32 + r) * 32 + hh * 8);
      nB1 = *(const bf16x8*)(Ki + (tokb + kb2 * 32 + r) * 32 + 16 + hh * 8);
    }
#pragma unroll 1
    for (int kt = wave; kt < nk32; kt += 8) {
      const bf16x8 kA0 = nA0, kA1 = nA1, kB0 = nB0, kB1 = nB1;
      {
        const int ka = min(kt + 8, klast), kb2 = min(kt + 12, klast);
        nA0 = *(const bf16x8*)(Ki + (tokb + ka * 32 + r) * 32 + hh * 8);
        nA1 = *(const bf16x8*)(Ki + (tokb + ka * 32 + r) * 32 + 16 + hh * 8);
        nB0 = *(const bf16x8*)(Ki + (tokb + kb2 * 32 + r) * 32 + hh * 8);
        nB1 = *(const bf16x8*)(Ki + (tokb + kb2 * 32 + r) * 32 + 16 + hh * 8);
      }
      f32x16 scA = zero16(), scB = zero16();
#pragma unroll 2
      for (int hd = 0; hd < 8; hd++) {
        const bf16x8 q0f = *(const bf16x8*)(sQi + r * 528 + hd * 64 + hh * 16);
        const bf16x8 q1f = *(const bf16x8*)(sQi + r * 528 + hd * 64 + 32 + hh * 16);
        const float w = sWi[hd * 32 + r];
        f32x16 sa = MFMA32(kA0, q0f, zero16());
        f32x16 sb = MFMA32(kB0, q0f, zero16());
        sa = MFMA32(kA1, q1f, sa);
        sb = MFMA32(kB1, q1f, sb);
#pragma unroll
        for (int i = 0; i < 16; i++) {
          scA[i] += __int_as_float(max(__float_as_int(sa[i]), 0)) * w;
          scB[i] += __int_as_float(max(__float_as_int(sb[i]), 0)) * w;
        }
      }
      elems(scA, kt, (kt == qt) ? qp : 0x7fffffff);
      if (kt + 4 < nk32) elems(scB, kt + 4, (kt + 4 == qt) ? qp : 0x7fffffff);
    }
    __syncthreads();
    if (pass < 4) {
      for (int j = 0; j < 8; j++) {
        const int qq = wave * 8 + j;
        const unsigned k = meta[32 + qq];
        unsigned c4[4]; unsigned tot = 0;
#pragma unroll
        for (int e = 0; e < 4; e++) { c4[e] = hist[qq * 257 + 255 - 4 * lane - e]; tot += c4[e]; }
        unsigned incl = tot;
        for (int o = 1; o < 64; o <<= 1) { const unsigned t = __shfl_up(incl, o); if (lane >= o) incl += t; }
        unsigned run = incl - tot;
#pragma unroll
        for (int e = 0; e < 4; e++) {
          if (run < k && run + c4[e] >= k) {
            meta[qq] = (meta[qq] << 8) | (unsigned)(255 - 4 * lane - e); meta[32 + qq] = k - run;
            if (pass == 1 && c4[e] > (unsigned)CAPL_) meta[192] = 1u;
          }
          run += c4[e];
        }
      }
    }
    if (pass >= 4) break;
    if (pass == 1) { __syncthreads(); fast = (meta[192] == 0u); pass = fast ? 5 : 2; } else pass++;
  }
  __syncthreads();
  if (fast) {
#pragma unroll 1
    for (int j = 0; j < 8; j++) {
      const int qq = wave * 8 + j;
      const int c = min((int)meta[128 + qq], CAPL_);
      const unsigned k = meta[32 + qq];
      const bool in = lane < c;
      const unsigned mykey = in ? lK[qq * CAPL_ + lane] : 0u;
      const unsigned myidx = in ? (unsigned)lI[qq * CAPL_ + lane] : 0u;
      unsigned rank = 0u;
      for (int t = 0; t < c; t++) {
        const unsigned ok = __shfl(mykey, t);
        rank += (ok > mykey || (ok == mykey && t < lane)) ? 1u : 0u;
      }
      const bool sel = in && (rank < k);
      const unsigned long long m = __ballot(sel);
      const unsigned base = meta[64 + qq];
      if (sel) {
        const unsigned pos = base + (unsigned)__popcll(m & ((1ull << lane) - 1ull));
        if (pos < 256u) sidx[qq * 256 + pos] = (u16)myidx;
      }
      __builtin_amdgcn_wave_barrier();
      if (lane == 0) meta[64 + qq] = base + (unsigned)__popcll(m);
    }
    __syncthreads();
  }
  float* myP = sP + wave * 1024;
  (void)sQ;
  bf16x8 qn[4];
#pragma unroll
  for (int ks = 0; ks < 4; ks++) {
    bf16x8 z = {0, 0, 0, 0, 0, 0, 0, 0};
    if (r < 4) z = *(const bf16x8*)(Qs + (tokb + q0 + wave * 8) * 256 + r * 64 + ks * 16 + hh * 8);
    qn[ks] = z;
  }
#pragma unroll 1
  for (int j = 0; j < 8; j++) {
    const int qq = wave * 8 + j;
    const int qpos = q0 + qq;
    const size_t tok = tokb + qpos;
    const int n = min((int)meta[64 + qq], 256);
    __syncthreads();
    bf16x8 qf[4];
#pragma unroll
    for (int ks = 0; ks < 4; ks++) qf[ks] = qn[ks];
    {
      const size_t tokn = tokb + q0 + wave * 8 + min(j + 1, 7);
#pragma unroll
      for (int ks = 0; ks < 4; ks++) {
        bf16x8 z = {0, 0, 0, 0, 0, 0, 0, 0};
        if (r < 4) z = *(const bf16x8*)(Qs + tokn * 256 + r * 64 + ks * 16 + hh * 8);
        qn[ks] = z;
      }
    }
#pragma unroll 4
    for (int kb = 0; kb < 8; kb++) {
      const int jj = kb * 32 + r;
      const int kidx = (jj < n) ? (int)sidx[qq * 256 + jj] : 0;
      const u16* kp = Ks + (tokb + kidx) * 64 + hh * 8;
      bf16x8 kf[4];
#pragma unroll
      for (int ks = 0; ks < 4; ks++) kf[ks] = *(const bf16x8*)(kp + ks * 16);
      f32x16 sacc = zero16();
#pragma unroll
      for (int ks = 0; ks < 4; ks++) sacc = MFMA32(kf[ks], qf[ks], sacc);
      if (r < 4) {
#pragma unroll
        for (int i = 0; i < 16; i++) myP[(kb * 32 + crow(i, hh)) * 4 + r] = sacc[i];
      }
    }
    __syncthreads();
    float sc[4][4];
#pragma unroll
    for (int rd = 0; rd < 4; rd++) {
      const int jj = rd * 64 + lane;
      const bool valid = jj < n;
      const int kidx = valid ? (int)sidx[qq * 256 + jj] : 0;
      const int dist = min(max(qpos - kidx, 0), 128);
      const float4 d = *(const float4*)(myP + jj * 4);
      sc[rd][0] = valid ? d.x * 0.125f + sbias[0 * 129 + dist] : -INFINITY;
      sc[rd][1] = valid ? d.y * 0.125f + sbias[1 * 129 + dist] : -INFINITY;
      sc[rd][2] = valid ? d.z * 0.125f + sbias[2 * 129 + dist] : -INFINITY;
      sc[rd][3] = valid ? d.w * 0.125f + sbias[3 * 129 + dist] : -INFINITY;
    }
#pragma unroll
    for (int hd = 0; hd < 4; hd++) {
      float mx = fmaxf(fmaxf(sc[0][hd], sc[1][hd]), fmaxf(sc[2][hd], sc[3][hd]));
      mx = wave_max(mx);
      float sm = 0.f;
#pragma unroll
      for (int rd = 0; rd < 4; rd++) { sc[rd][hd] = __expf(sc[rd][hd] - mx); sm += sc[rd][hd]; }
      sm = wave_sum(sm);
      const float inv = 1.f / sm;
#pragma unroll
      for (int rd = 0; rd < 4; rd++) sc[rd][hd] *= inv;
    }
#pragma unroll
    for (int rd = 0; rd < 4; rd++) *(float4*)(myP + (rd * 64 + lane) * 4) = make_float4(sc[rd][0], sc[rd][1], sc[rd][2], sc[rd][3]);
    __syncthreads();
    const int g = lane >> 3, c8 = lane & 7;
    float acc[32];
#pragma unroll
    for (int i = 0; i < 32; i++) acc[i] = 0.f;
#pragma unroll 16
    for (int it = 0; it < 32; it++) {
      const int jj = it * 8 + g;
      const int kidx = (jj < n) ? (int)sidx[qq * 256 + jj] : 0;
      const float4 pj = *(const float4*)(myP + jj * 4);
      const u32x4 vv = *(const u32x4*)(Vs + (tokb + kidx) * 64 + c8 * 8);
      const float vf[8] = {bf2f((u16)(vv.x & 0xffff)), bf2f((u16)(vv.x >> 16)), bf2f((u16)(vv.y & 0xffff)), bf2f((u16)(vv.y >> 16)),
                           bf2f((u16)(vv.z & 0xffff)), bf2f((u16)(vv.z >> 16)), bf2f((u16)(vv.w & 0xffff)), bf2f((u16)(vv.w >> 16))};
#pragma unroll
      for (int e = 0; e < 8; e++) {
        acc[0 * 8 + e] += pj.x * vf[e]; acc[1 * 8 + e] += pj.y * vf[e];
        acc[2 * 8 + e] += pj.z * vf[e]; acc[3 * 8 + e] += pj.w * vf[e];
      }
    }
    const bool b5 = lane & 32, b4 = lane & 16, b3 = lane & 8;
    float w16[16], w8[8], w4[4];
#pragma unroll
    for (int i = 0; i < 16; i++) { const float snd = b5 ? acc[i] : acc[i + 16]; const float rcv = __shfl_xor(snd, 32); w16[i] = (b5 ? acc[i + 16] : acc[i]) + rcv; }
#pragma unroll
    for (int i = 0; i < 8; i++) { const float snd = b4 ? w16[i] : w16[i + 8]; const float rcv = __shfl_xor(snd, 16); w8[i] = (b4 ? w16[i + 8] : w16[i]) + rcv; }
#pragma unroll
    for (int i = 0; i < 4; i++) { const float snd = b3 ? w8[i] : w8[i + 4]; const float rcv = __shfl_xor(snd, 8); w4[i] = (b3 ? w8[i + 4] : w8[i]) + rcv; }
    const int hd = (b5 ? 2 : 0) + (b4 ? 1 : 0);
    *(uint2*)(CC + tok * 1024 + 768 + hd * 64 + c8 * 8 + (b3 ? 4 : 0)) = make_uint2(pack2(w4[0], w4[1]), pack2(w4[2], w4[3]));
  }
}

DI void phase_mix1(const Params& P, int layer, int bid, int nb, char* smem) {
  char* mb = WS(P) + OFF_H;
  for (int w = bid * 4 + (tidx() >> 6); w < 2048; w += nb * 4) ssm_scan<false>(P, layer, w, mb, smem);
  for (int j = 0;; j++) {
    const int idx = (j & 1) ? (j * nb + (nb - 1 - bid)) : (j * nb + bid);
    if (j * nb >= 2048) break;
    if (idx >= 2048) continue;
    const int qt = 255 - (idx >> 3), b = idx & 7;
    dsa_item(P, layer, b, qt, mb, smem);
  }
  for (int j = 0;; j++) {
    const int idx = (j & 1) ? (j * nb + (nb - 1 - bid)) : (j * nb + bid);
    if (j * nb >= 2048) break;
    if (idx >= 2048) continue;
    const int qt = 63 - (idx >> 5), bh = idx & 31;
    da_item(P, layer, bh >> 2, bh & 3, qt, mb, smem);
  }
}

DI void phase_mix2(const Params& P, int layer, int bid, int nb, char* smem) {
  char* mb = WS(P) + OFF_H;
  for (int w = bid * 4 + (tidx() >> 6); w < 2048; w += nb * 4) ssm_scan<true>(P, layer, w, mb, smem);
}

DI void run_phase(const Params& P, int ph, int bid, int nb, char* smem) {
  char* ws = WS(P);
  u16* sm = (u16*)smem;
  if (ph == 0) { phase_prep(P, bid, nb, smem); return; }
  const int l = (ph - 1) / 12, s = (ph - 1) % 12;
  u16* Xb = (u16*)(ws + OFF_XB);
  u16* H = (u16*)(ws + OFF_H);
  u16* CC = (u16*)(ws + OFF_CC);
  float* X = OUTP(P);
  switch (s) {
    case 0: phase_ffn_up(Xb, (const u16*)(ws + OFF_WGU1 + l * SZ_WGU), H, bid, nb, sm); break;
    case 1: phase_ffn_down(H, (const u16*)(ws + OFF_WD1 + l * SZ_WD), (l == 0) ? INP(P, 0) : (const float*)nullptr, Xb, X, nullptr, bid, nb, sm); break;
    case 2: phase_ln(X, Xb, INP(P, 6) + l * 1024, INP(P, 7) + l * 1024, false, bid, nb); break;
    case 3: phase_w_in(Xb, (const u16*)(ws + OFF_WIN + l * SZ_WIN), ws + OFF_H, bid, nb, sm); break;
    case 4: phase_mix1(P, l, bid, nb, smem); break;
    case 5: phase_mix2(P, l, bid, nb, smem); break;
    case 6: phase_glu((const u16*)(ws + OFF_H + M_YG), (const u16*)(ws + OFF_WGLU + l * SZ_WGLU), CC, bid, nb, sm); break;
    case 7: phase_w_o(CC, (const u16*)(ws + OFF_WO + l * SZ_WO), X, Xb, bid, nb, sm); break;
    case 8: phase_ln(X, Xb, INP(P, 24) + l * 1024, INP(P, 25) + l * 1024, false, bid, nb); break;
    case 9:
      phase_ffn_up(Xb, (const u16*)(ws + OFF_WGU2 + l * SZ_WGU), H, bid, nb, sm);
      phase_ple(Xb, (const u16*)(ws + OFF_WPG + l * SZ_WPG), (const u16*)(ws + OFF_PB) + (size_t)l * T_ * 256, (const u16*)(ws + OFF_WPP + l * SZ_WPP), CC, bid, nb, sm);
      break;
    case 10: phase_ffn_down(H, (const u16*)(ws + OFF_WD2 + l * SZ_WD), (const float*)nullptr, Xb, X, CC, bid, nb, sm); break;
    case 11: phase_ln(X, Xb, INP(P, 31) + l * 1024, INP(P, 32) + l * 1024, l == 1, bid, nb); break;
  }
}

#define XB_TMO      128
#define XB_XCNT(j)  (256  + 64 * (j))
#define XB_XSUB(j)  (1280 + 64 * (j))
#define XB_XGEN(j)  (2304 + 64 * (j))
#define XB_TOP      3328
#define XB_TOPGEN   3392
#define XCD_BAR_WORDS 3456
#define XB_SPIN_CAP (1u << 22)
#define LAS __attribute__((address_space(3)))

__device__ __forceinline__ unsigned xb_ld(unsigned* p)              { return __hip_atomic_load(p, __ATOMIC_RELAXED, __HIP_MEMORY_SCOPE_AGENT); }
__device__ __forceinline__ unsigned xb_add(unsigned* p, unsigned v) { return __hip_atomic_fetch_add(p, v, __ATOMIC_RELAXED, __HIP_MEMORY_SCOPE_AGENT); }
__device__ __forceinline__ unsigned xb_xcc_id() { return (unsigned)__builtin_amdgcn_s_getreg((3 << 11) | 20) & 0xFu; }
#define XB_SPIN(cond, bar) do { unsigned _sp = 0; while (cond) { __builtin_amdgcn_s_sleep(1); \
    if ((++_sp & 255u) == 0u) { if (xb_ld(&(bar)[XB_TMO])) break; if (_sp > XB_SPIN_CAP) { atomicAdd(&(bar)[XB_TMO], 1u); break; } } } } while (0)

struct XcdBarrier {
    unsigned* bar; unsigned x;
    volatile LAS unsigned* st;
};

__device__ __forceinline__ XcdBarrier xcd_barrier_post(unsigned* bar, volatile LAS unsigned* st) {
    XcdBarrier b; b.bar = bar; b.x = xb_xcc_id(); b.st = st;
    if (threadIdx.x == 0) (void)xb_add(&bar[XB_XCNT(b.x)], 1u);
    return b;
}
__device__ __forceinline__ void xcd_barrier_complete(unsigned* bar, unsigned x, unsigned& nloc, unsigned& nx) {
    const unsigned G = gridDim.x * gridDim.y * gridDim.z;
    unsigned sum, cnt, mine, sp = 0u;
    for (;;) {
        sum = 0u; cnt = 0u; mine = 0u;
#pragma unroll
        for (unsigned j = 0; j < 16; ++j) { const unsigned c = xb_ld(&bar[XB_XCNT(j)]); sum += c; cnt += (c > 0u) ? 1u : 0u; mine = (j == x) ? c : mine; }
        if (sum == G) break;
        __builtin_amdgcn_s_sleep(1);
        if ((++sp & 255u) == 0u) { if (xb_ld(&bar[XB_TMO])) break; if (sp > XB_SPIN_CAP) { atomicAdd(&bar[XB_TMO], 1u); break; } }
    }
    nloc = mine > 0u ? mine : 1u; nx = cnt > 0u ? cnt : 1u;
}

__device__ __forceinline__ void xcd_barrier(const XcdBarrier& b) {
    asm volatile("s_waitcnt vmcnt(0)" ::: "memory");
    __syncthreads();
    if (threadIdx.x == 0) {
        unsigned* bar = b.bar;
        __builtin_amdgcn_s_waitcnt(0);
        unsigned nloc = b.st[0], nx = b.st[1];
        if (nloc == 0u) { xcd_barrier_complete(bar, b.x, nloc, nx); b.st[0] = nloc; b.st[1] = nx; }
        const unsigned old = xb_add(&bar[XB_XSUB(b.x)], 1u);
        const unsigned gen = old / nloc;
        if (old + 1u == (gen + 1u) * nloc) {
            __builtin_amdgcn_fence(__ATOMIC_RELEASE, "agent");
            asm volatile("s_waitcnt vmcnt(0)" ::: "memory");
            const unsigned og = xb_add(&bar[XB_TOP], 1u);
            const unsigned tg = og / nx;
            if (og + 1u == (tg + 1u) * nx) xb_add(&bar[XB_TOPGEN], 1u);
            else XB_SPIN(xb_ld(&bar[XB_TOPGEN]) == tg, bar);
            __builtin_amdgcn_fence(__ATOMIC_ACQUIRE, "agent");
            xb_add(&bar[XB_XGEN(b.x)], 1u);
            asm volatile("s_waitcnt vmcnt(0)" ::: "memory");
        } else {
            XB_SPIN(xb_ld(&bar[XB_XGEN(b.x)]) == gen, bar);
            __builtin_amdgcn_fence(__ATOMIC_ACQUIRE, "agent");
            asm volatile("s_waitcnt vmcnt(0)" ::: "memory");
        }
    }
    __syncthreads();
}


constexpr int NPHASES = 25;

__global__ void __launch_bounds__(256, 2) mega(Params P, int ph0, int ph1) {
  extern __shared__ __attribute__((aligned(16))) char smem[];
  cg::grid_group grid = cg::this_grid();
  const int bid = blockIdx.x, nb = gridDim.x;
  volatile LAS unsigned* xst = (volatile LAS unsigned*)(smem + 73712);
  if (threadIdx.x == 0) { xst[0] = 0u; xst[1] = 0u; xst[2] = 0u; xst[3] = 0u; }
  __syncthreads();
  const XcdBarrier xbar = xcd_barrier_post((unsigned*)(P.ws + OFF_XBAR), xst);
#ifndef DUP_MASK
#define DUP_MASK 0
#endif
#define PHASE(k) if (ph0 <= (k) && (k) < ph1) { \
    if ((k) > 0 && ((DUP_MASK >> (((k) - 1) % 12)) & 1)) { run_phase(P, (k), bid, nb, smem); grid.sync(); } \
    run_phase(P, (k), bid, nb, smem); if ((k) + 1 < ph1) { if (ph0 < 0) grid.sync(); else xcd_barrier(xbar); } }
  PHASE(0) PHASE(1) PHASE(2) PHASE(3) PHASE(4) PHASE(5) PHASE(6) PHASE(7) PHASE(8) PHASE(9) PHASE(10) PHASE(11) PHASE(12)
  PHASE(13) PHASE(14) PHASE(15) PHASE(16) PHASE(17) PHASE(18) PHASE(19) PHASE(20) PHASE(21) PHASE(22) PHASE(23) PHASE(24)
#undef PHASE
}

extern "C" void kernel_launch(void* const* d_in, const int* in_sizes, int n_in, void* d_out, int out_size, void* d_ws, size_t ws_size, hipStream_t stream) {
  static int grid_blocks = 0;
  if (grid_blocks == 0) {
    if (n_in != 33 || ws_size < WS_END) { fprintf(stderr, "kernel_launch: need 33 inputs and %zu bytes of ws (got %d, %zu)\n", (size_t)WS_END, n_in, ws_size); grid_blocks = -1; return; }
    int dev = 0, cus = 0, per_cu = 0;
    (void)hipGetDevice(&dev);
    (void)hipDeviceGetAttribute(&cus, hipDeviceAttributeMultiprocessorCount, dev);
    (void)hipFuncSetAttribute((const void*)mega, hipFuncAttributeMaxDynamicSharedMemorySize, LDS_BYTES);
    (void)hipOccupancyMaxActiveBlocksPerMultiprocessor(&per_cu, (const void*)mega, 256, LDS_BYTES);
    if (per_cu < 1) per_cu = 1;
    if (per_cu > 2) per_cu = 2;
    grid_blocks = cus * per_cu;
    fprintf(stderr, "kernel_launch: cus %d per_cu %d grid %d\n", cus, per_cu, grid_blocks);
  }
  if (grid_blocks < 0) return;
  Params p;
  memset(&p, 0, sizeof(p));
  for (int i = 0; i < 33; i++) p.in[i] = (const float*)d_in[i];
  p.out = (float*)d_out;
  p.ws = (char*)d_ws;
#if MULTI_LAUNCH
  for (int ph = 0; ph < NPHASES; ph++) {
    hipLaunchKernelGGL(mega, dim3(grid_blocks), dim3(256), LDS_BYTES, stream, p, ph, ph + 1);
  }
#else
  int ph0 = 0, ph1 = NPHASES;
  (void)hipMemsetAsync((char*)d_ws + OFF_XBAR, 0, XCD_BAR_WORDS * 4, stream);
  void* args[] = {&p, &ph0, &ph1};
  hipError_t e = hipLaunchCooperativeKernel((const void*)mega, dim3(grid_blocks), dim3(256), args, LDS_BYTES, stream);
  if (e != hipSuccess) fprintf(stderr, "cooperative launch failed: %s (grid %d)\n", hipGetErrorString(e), grid_blocks);
#endif
}
```

```cpp
#include <hip/hip_runtime.h>
#include <hip/hip_cooperative_groups.h>
#include <stdint.h>
#include <math.h>
#include <stdio.h>
#include <string.h>
namespace cg = cooperative_groups;

#ifndef MULTI_LAUNCH
#define MULTI_LAUNCH 0
#endif

typedef unsigned short u16;
typedef __attribute__((ext_vector_type(8))) short bf16x8;
typedef __attribute__((ext_vector_type(4))) short s16x4;
typedef __attribute__((ext_vector_type(16))) float f32x16;
typedef __attribute__((ext_vector_type(4))) unsigned u32x4;
typedef __attribute__((ext_vector_type(2))) unsigned u32x2;

#define DI __device__ __forceinline__
#define MFMA32(a, b, c) __builtin_amdgcn_mfma_f32_32x32x16_bf16((a), (b), (c), 0, 0, 0)

constexpr int T_ = 65536;
constexpr int L_ = 8192;
constexpr int D_ = 1024;
constexpr int FF_ = 2816;
constexpr float ALPHA_ = 1.41421356237309515f;
constexpr float LN_EPS_ = 1e-5f;
constexpr float LOG2E_ = 1.44269504088896341f;
constexpr int LDS_BYTES = 73728;

constexpr size_t SZ_WGU = (size_t)5632 * 1024 * 2;
constexpr size_t SZ_WD = (size_t)1024 * 2816 * 2;
constexpr size_t SZ_WIN = (size_t)2560 * 1024 * 2;
constexpr size_t SZ_WO = (size_t)1024 * 1024 * 2;
constexpr size_t SZ_WGLU = (size_t)256 * 256 * 2;
constexpr size_t SZ_WPG = (size_t)1024 * 1024 * 2;
constexpr size_t SZ_WPP = (size_t)1024 * 256 * 2;
constexpr size_t OFF_WGU1 = 0;
constexpr size_t OFF_WD1 = OFF_WGU1 + 2 * SZ_WGU;
constexpr size_t OFF_WGU2 = OFF_WD1 + 2 * SZ_WD;
constexpr size_t OFF_WD2 = OFF_WGU2 + 2 * SZ_WGU;
constexpr size_t OFF_WIN = OFF_WD2 + 2 * SZ_WD;
constexpr size_t OFF_WO = OFF_WIN + 2 * SZ_WIN;
constexpr size_t OFF_WGLU = OFF_WO + 2 * SZ_WO;
constexpr size_t OFF_WPG = OFF_WGLU + 2 * SZ_WGLU;
constexpr size_t OFF_WPP = OFF_WPG + 2 * SZ_WPG;
constexpr size_t OFF_COEFA = OFF_WPP + 2 * SZ_WPP;
constexpr size_t OFF_COEFB = OFF_COEFA + 2 * 16 * 64 * 16;
constexpr size_t OFF_LAM = OFF_COEFB + 2 * 16 * 64 * 16 * 8;
constexpr size_t OFF_BIAS = OFF_LAM + 256;
constexpr size_t OFF_XBAR = OFF_BIAS + 8 * 129 * 4 + 32;
constexpr size_t OFF_XB = OFF_XBAR + 16384;
constexpr size_t OFF_PB = OFF_XB + (size_t)T_ * 1024 * 2;
constexpr size_t OFF_H = OFF_PB + (size_t)2 * T_ * 256 * 2;
constexpr size_t SZ_H = (size_t)384 << 20;
constexpr size_t OFF_CC = OFF_H + SZ_H;
constexpr size_t OFF_CANDK = OFF_CC + (size_t)T_ * 1024 * 2;
constexpr int CAP_ = 2048;
constexpr size_t OFF_CANDI = OFF_CANDK + (size_t)512 * 32 * CAP_ * 4;
constexpr size_t WS_END = OFF_CANDI + (size_t)512 * 32 * CAP_ * 2;
constexpr size_t MB_ = (size_t)1 << 20;
constexpr size_t M_QD = 0, M_KD = 64 * MB_, M_VT = 128 * MB_, M_U = 192 * MB_, M_QS = 256 * MB_, M_QI = 288 * MB_, M_YG = 320 * MB_,
                 M_KS = 352 * MB_, M_VS = 360 * MB_, M_KI = 368 * MB_, M_WI = 372 * MB_, M_SEND = 374 * MB_;

struct Params {
  const float* in[33];
  float* out;
  char* ws;
};

DI int tidx() { int t = threadIdx.x; asm volatile("" : "+v"(t)); return t; }
#define GAS __attribute__((address_space(1)))
DI size_t opaque0() { size_t z = 0; asm volatile("" : "+s"(z)); return z; }
DI char* WS(const Params& P) { return P.ws + opaque0(); }
DI float* OUTP(const Params& P) { return P.out + opaque0(); }
DI const float* INP(const Params& P, int i) { return P.in[i]; }
typedef __bf16 bf16v2_ __attribute__((ext_vector_type(2)));
typedef float f32v2_ __attribute__((ext_vector_type(2)));
DI u16 f2bf(float x) { const __bf16 h = (__bf16)x; return __builtin_bit_cast(u16, h); }
DI float bf2f(u16 v) { return __uint_as_float(((unsigned)v) << 16); }
DI unsigned pack2(float a, float b) { f32v2_ v; v.x = a; v.y = b; const bf16v2_ h = __builtin_convertvector(v, bf16v2_); return __builtin_bit_cast(unsigned, h); }
DI int crow(int i, int hh) { return (i & 3) + 8 * (i >> 2) + 4 * hh; }
DI float sigmoidf_(float x) { return __builtin_amdgcn_rcpf(1.f + __expf(-x)); }
DI float wave_sum(float v) { for (int o = 32; o > 0; o >>= 1) v += __shfl_xor(v, o); return v; }
DI float wave_max(float v) { for (int o = 32; o > 0; o >>= 1) v = fmaxf(v, __shfl_xor(v, o)); return v; }
DI f32x16 zero16() { f32x16 z; for (int i = 0; i < 16; i++) z[i] = 0.f; return z; }
DI bf16x8 pack8(const f32x16& x, int s) {
  union { unsigned u[4]; bf16x8 v; } t;
  t.u[0] = pack2(x[8 * s + 0], x[8 * s + 1]); t.u[1] = pack2(x[8 * s + 2], x[8 * s + 3]);
  t.u[2] = pack2(x[8 * s + 4], x[8 * s + 5]); t.u[3] = pack2(x[8 * s + 6], x[8 * s + 7]);
  return t.v;
}

constexpr int GS_ = 72;
constexpr int GT_ = 128 * GS_;

constexpr int GST_ = 32768;
DI void gemm_stage(const u16* __restrict__ A, int lda, const u16* __restrict__ B, int ldb, int kt, char* sbuf) {
  const int tid = tidx(), lane = tid & 63, wave = __builtin_amdgcn_readfirstlane(tid >> 6);
  const int pp = lane >> 4, pos = lane & 15;
#pragma unroll
  for (int i = 0; i < 4; i++) {
    const int blk = i * 4 + wave;
    const int p = blk * 4 + pp;
    const int row = 2 * p + (pos >> 3), c8 = (pos & 7) ^ (p & 7);
    const u16* ga = A + (size_t)row * lda + kt * 64 + c8 * 8;
    const u16* gb = B + (size_t)row * ldb + kt * 64 + c8 * 8;
    __builtin_amdgcn_global_load_lds((const GAS void*)ga, (__attribute__((address_space(3))) void*)(sbuf + blk * 1024), 16, 0, 0);
    __builtin_amdgcn_global_load_lds((const GAS void*)gb, (__attribute__((address_space(3))) void*)(sbuf + 16384 + blk * 1024), 16, 0, 0);
  }
}
DI void gemm_main(f32x16 (&acc)[2][2], const u16* __restrict__ A, int lda, const u16* __restrict__ B, int ldb, int K, u16* sm) {
  const int tid = tidx(), lane = tid & 63, wave = tid >> 6;
  const int wm = wave >> 1, wn = wave & 1, r = lane & 31, hh = lane >> 5;
  char* sb = (char*)sm;
  const int rowa = wm * 64 + r, rowb = wn * 64 + r;
  const int baseA = (rowa >> 1) * 256 + ((rowa & 1) << 7), xa = (rowa >> 1) & 7;
  const int baseB = 16384 + (rowb >> 1) * 256 + ((rowb & 1) << 7), xb = (rowb >> 1) & 7;
  const int nk = K >> 6;
  asm volatile("s_waitcnt vmcnt(0)" ::: "memory");
  __syncthreads();
#pragma unroll 1
  for (int kt = 0; kt < nk; kt++) {
    if (kt + 1 < nk) gemm_stage(A, lda, B, ldb, kt + 1, sb + ((kt + 1) & 1) * GST_);
    const char* st = sb + (kt & 1) * GST_;
#pragma unroll
    for (int ks = 0; ks < 4; ks++) {
      const int ca = ((ks * 2 + hh) ^ xa) << 4, cb = ((ks * 2 + hh) ^ xb) << 4;
      const bf16x8 fa0 = *(const bf16x8*)(st + baseA + ca);
      const bf16x8 fa1 = *(const bf16x8*)(st + baseA + 4096 + ca);
      const bf16x8 fb0 = *(const bf16x8*)(st + baseB + cb);
      const bf16x8 fb1 = *(const bf16x8*)(st + baseB + 4096 + cb);
      acc[0][0] = MFMA32(fa0, fb0, acc[0][0]); acc[0][1] = MFMA32(fa0, fb1, acc[0][1]);
      acc[1][0] = MFMA32(fa1, fb0, acc[1][0]); acc[1][1] = MFMA32(fa1, fb1, acc[1][1]);
    }
    asm volatile("s_waitcnt vmcnt(0)" ::: "memory");
    __syncthreads();
  }
}

DI bool tile_at(int it, int bid, int nb, int TM, int TN, int& tm, int& tn) {
  if ((nb & 7) == 0 && (TM & 63) == 0) {
    const int xcd = bid & 7, lw = bid >> 3, nlw = nb >> 3;
    const int lt = lw + it * nlw, per = (TM >> 3) * TN;
    if (lt >= per) return false;
    const int g = lt / (4 * TN), rem = lt - g * 4 * TN;
    tn = rem >> 2; tm = xcd * (TM >> 3) + g * 4 + (rem & 3);
    return true;
  } else {
    const int t = bid + it * nb;
    if (t >= TM * TN) return false;
    tn = t / TM; tm = t - tn * TM;
    return true;
  }
}

template <class AF, class BF, class INI, class EPI>
DI void gemm_phase_init(int TM, int TN, int K, int lda, int ldb, AF a_of, BF b_of, INI ini, EPI epi, int bid, int nb, u16* sm) {
  int tm, tn;
  bool have = tile_at(0, bid, nb, TM, TN, tm, tn);
  __syncthreads();
  if (have) gemm_stage(a_of(tm), lda, b_of(tn), ldb, 0, (char*)sm);
  for (int it = 0; have; it++) {
    f32x16 acc[2][2];
    ini(acc, tm, tn);
    gemm_main(acc, a_of(tm), lda, b_of(tn), ldb, K, sm);
    int tm2 = 0, tn2 = 0;
    const bool have2 = tile_at(it + 1, bid, nb, TM, TN, tm2, tn2);
    if (have2) gemm_stage(a_of(tm2), lda, b_of(tn2), ldb, 0, (char*)sm);
    epi(acc, tm, tn);
    have = have2; tm = tm2; tn = tn2;
  }
  asm volatile("s_waitcnt vmcnt(0)" ::: "memory");
}
template <class AF, class BF, class EPI>
DI void gemm_phase(int TM, int TN, int K, int lda, int ldb, AF a_of, BF b_of, EPI epi, int bid, int nb, u16* sm) {
  gemm_phase_init(TM, TN, K, lda, ldb, a_of, b_of,
    [&](f32x16 (&acc)[2][2], int, int) { acc[0][0] = zero16(); acc[0][1] = zero16(); acc[1][0] = zero16(); acc[1][1] = zero16(); },
    epi, bid, nb, sm);
}

DI void transpose_job(const float* __restrict__ src, int K, int N, u16* __restrict__ dst, int mode, int bid, int nb, float* tile) {
  const int tid = tidx();
  const int tk = K >> 6, tn = (N + 63) >> 6;
  for (int t = bid; t < tk * tn; t += nb) {
    const int k0 = (t % tk) * 64, n0 = (t / tk) * 64;
    __syncthreads();
    float tv[16];
#pragma unroll
    for (int i = 0; i < 16; i++) {
      const int k = i * 4 + (tid >> 6), n = tid & 63;
      tv[i] = (n0 + n < N) ? src[(size_t)(k0 + k) * N + n0 + n] : 0.f;
    }
#pragma unroll
    for (int i = 0; i < 16; i++) tile[(i * 4 + (tid >> 6)) * 65 + (tid & 63)] = tv[i];
    __syncthreads();
#pragma unroll 4
    for (int i = 0; i < 16; i++) {
      const int n = i * 4 + (tid >> 6), k = tid & 63;
      const int ng = n0 + n;
      if (ng < N) {
        int row = ng;
        if (mode == 1) row = (ng >> 5) * 64 + (ng & 31);
        else if (mode == 2) row = (ng >> 5) * 64 + 32 + (ng & 31);
        dst[(size_t)row * K + k0 + k] = f2bf(tile[k * 65 + n]);
      }
    }
  }
}

DI void phase_prep(const Params& P, int bid, int nb, char* smem) {
  float* tile = (float*)smem;
  char* ws = WS(P);
  for (int l = 0; l < 2; l++) {
    transpose_job(INP(P, 3) + (size_t)l * 1024 * FF_, 1024, FF_, (u16*)(ws + OFF_WGU1 + l * SZ_WGU), 1, bid, nb, tile);
    transpose_job(INP(P, 4) + (size_t)l * 1024 * FF_, 1024, FF_, (u16*)(ws + OFF_WGU1 + l * SZ_WGU), 2, bid, nb, tile);
    transpose_job(INP(P, 5) + (size_t)l * FF_ * 1024, FF_, 1024, (u16*)(ws + OFF_WD1 + l * SZ_WD), 0, bid, nb, tile);
    transpose_job(INP(P, 26) + (size_t)l * 1024 * FF_, 1024, FF_, (u16*)(ws + OFF_WGU2 + l * SZ_WGU), 1, bid, nb, tile);
    transpose_job(INP(P, 27) + (size_t)l * 1024 * FF_, 1024, FF_, (u16*)(ws + OFF_WGU2 + l * SZ_WGU), 2, bid, nb, tile);
    transpose_job(INP(P, 28) + (size_t)l * FF_ * 1024, FF_, 1024, (u16*)(ws + OFF_WD2 + l * SZ_WD), 0, bid, nb, tile);
    transpose_job(INP(P, 8) + (size_t)l * 1024 * 2472, 1024, 2472, (u16*)(ws + OFF_WIN + l * SZ_WIN), 0, bid, nb, tile);
    transpose_job(INP(P, 9) + (size_t)l * 1024 * 1024, 1024, 1024, (u16*)(ws + OFF_WO + l * SZ_WO), 0, bid, nb, tile);
    transpose_job(INP(P, 23) + (size_t)l * 256 * 256, 256, 256, (u16*)(ws + OFF_WGLU + l * SZ_WGLU), 0, bid, nb, tile);
    transpose_job(INP(P, 30) + (size_t)l * 1024 * 1024, 1024, 1024, (u16*)(ws + OFF_WPG + l * SZ_WPG), 0, bid, nb, tile);
    transpose_job(INP(P, 29) + (size_t)l * 256 * 1024, 256, 1024, (u16*)(ws + OFF_WPP + l * SZ_WPP), 0, bid, nb, tile);
    u16* win = (u16*)(ws + OFF_WIN + l * SZ_WIN);
    for (int i = bid * 256 + tidx(); i < 88 * 1024; i += nb * 256) win[(size_t)2472 * 1024 + i] = 0;
  }
  const size_t gt = (size_t)bid * 256 + tidx(), gs = (size_t)nb * 256;
  {
    const float4* x4 = (const float4*)INP(P, 0);
    uint2* xb = (uint2*)(ws + OFF_XB);
    for (size_t i = gt; i < (size_t)T_ * 1024 / 4; i += gs * 8) {
      float4 v[8];
#pragma unroll
      for (int u = 0; u < 8; u++) v[u] = (i + u * gs < (size_t)T_ * 1024 / 4) ? x4[i + u * gs] : make_float4(0.f, 0.f, 0.f, 0.f);
#pragma unroll
      for (int u = 0; u < 8; u++) if (i + u * gs < (size_t)T_ * 1024 / 4) xb[i + u * gs] = make_uint2(pack2(v[u].x, v[u].y), pack2(v[u].z, v[u].w));
    }
    const float4* p4 = (const float4*)INP(P, 1);
    uint2* pb = (uint2*)(ws + OFF_PB);
    for (size_t i = gt; i < (size_t)2 * T_ * 256 / 4; i += gs * 8) {
      float4 v[8];
#pragma unroll
      for (int u = 0; u < 8; u++) v[u] = (i + u * gs < (size_t)2 * T_ * 256 / 4) ? p4[i + u * gs] : make_float4(0.f, 0.f, 0.f, 0.f);
#pragma unroll
      for (int u = 0; u < 8; u++) if (i + u * gs < (size_t)2 * T_ * 256 / 4) pb[i + u * gs] = make_uint2(pack2(v[u].x, v[u].y), pack2(v[u].z, v[u].w));
    }
  }
  if (gt < 2 * 16 * 64) {
    const int l = (int)gt >> 10, g = ((int)gt >> 6) & 15, p = (int)gt & 63;
    const int gi = (l * 16 + g) * 64 + p;
    const double lr = INP(P, 15)[gi], li = INP(P, 16)[gi];
    const double dt = exp((double)INP(P, 17)[l * 16 + g]);
    const double mag = exp(lr * dt);
    const double ar = mag * cos(li * dt), ai = mag * sin(li * dt);
    const double mag5 = exp(512.0 * lr * dt);
    const double a5r = mag5 * cos(512.0 * li * dt), a5i = mag5 * sin(512.0 * li * dt);
    ((float4*)(ws + OFF_COEFA))[gi] = make_float4((float)ar, (float)ai, (float)a5r, (float)a5i);
    const double den = lr * lr + li * li, nr = ar - 1.0, ni = ai;
    const double fr = (nr * lr + ni * li) / den, fi = (ni * lr - nr * li) / den;
    float2* cb = (float2*)(ws + OFF_COEFB) + (size_t)gi * 16;
    for (int c = 0; c < 16; c++) {
      const double br = INP(P, 18)[(size_t)gi * 16 + c], bi = INP(P, 19)[(size_t)gi * 16 + c];
      cb[c] = make_float2((float)(fr * br - fi * bi), (float)(fr * bi + fi * br));
    }
  }
  if (gt < 8 * 129) {
    const int hd = (int)gt / 129, n = (int)gt - hd * 129;
    int bk = n;
    if (n >= 16) { bk = 16 + (int)(log((double)n / 16.0) / log(8.0) * 16.0); bk = bk < 31 ? bk : 31; }
    ((float*)(ws + OFF_BIAS))[gt] = INP(P, 2)[bk * 8 + hd];
  }
  if (gt < 2) {
    const int l = (int)gt;
    float s1 = 0.f, s2 = 0.f;
    for (int i = 0; i < 64; i++) { s1 += INP(P, 10)[l * 64 + i] * INP(P, 11)[l * 64 + i]; s2 += INP(P, 12)[l * 64 + i] * INP(P, 13)[l * 64 + i]; }
    const float lam_init = 0.8f - 0.6f * expf(-0.3f * (float)l);
    ((float*)(ws + OFF_LAM))[l] = expf(s1) - expf(s2) + lam_init;
  }
}

DI void phase_ffn_up(const u16* __restrict__ Xb, const u16* __restrict__ Wgu, u16* __restrict__ H, int bid, int nb, u16* sm) {
  const int lane = tidx() & 63, wave = tidx() >> 6, wm = wave >> 1, wn = wave & 1, r = lane & 31, hh = lane >> 5;
  gemm_phase(512, 44, 1024, 1024, 1024,
    [&](int tm) { return Xb + (size_t)tm * 128 * 1024; }, [&](int tn) { return Wgu + (size_t)tn * 128 * 1024; },
    [&](f32x16 (&acc)[2][2], int tm, int tn) {
      const int j = tn * 64 + wn * 32 + r;
#pragma unroll
      for (int mi = 0; mi < 2; mi++)
#pragma unroll
        for (int i = 0; i < 16; i++) {
          const int row = tm * 128 + wm * 64 + mi * 32 + crow(i, hh);
          const float g = acc[mi][0][i], u = acc[mi][1][i];
          H[(size_t)row * FF_ + j] = f2bf(g * sigmoidf_(g) * u);
        }
    }, bid, nb, sm);
}

DI void phase_ffn_down(const u16* __restrict__ H, const u16* __restrict__ Wd, const float* xin, const u16* __restrict__ xinb, float* xout, const u16* __restrict__ ple, int bid, int nb, u16* sm) {
  const int lane = tidx() & 63, wave = tidx() >> 6, wm = wave >> 1, wn = wave & 1, r = lane & 31, hh = lane >> 5;
  gemm_phase_init(512, 8, FF_, FF_, FF_,
    [&](int tm) { return H + (size_t)tm * 128 * FF_; }, [&](int tn) { return Wd + (size_t)tn * 128 * FF_; },
    [&](f32x16 (&acc)[2][2], int tm, int tn) {
#pragma unroll
      for (int mi = 0; mi < 2; mi++)
#pragma unroll
        for (int ni = 0; ni < 2; ni++)
#pragma unroll
          for (int i = 0; i < 16; i++) {
            const size_t o = (size_t)(tm * 128 + wm * 64 + mi * 32 + crow(i, hh)) * 1024 + tn * 128 + wn * 64 + ni * 32 + r;
            float v = 2.f * ALPHA_ * (xin ? xin[o] : bf2f(xinb[o]));
            if (ple) v += 2.f * bf2f(ple[o]);
            acc[mi][ni][i] = v;
          }
    },
    [&](f32x16 (&acc)[2][2], int tm, int tn) {
#pragma unroll
      for (int mi = 0; mi < 2; mi++)
#pragma unroll
        for (int ni = 0; ni < 2; ni++)
#pragma unroll
          for (int i = 0; i < 16; i++) {
            const size_t o = (size_t)(tm * 128 + wm * 64 + mi * 32 + crow(i, hh)) * 1024 + tn * 128 + wn * 64 + ni * 32 + r;
            xout[o] = 0.5f * acc[mi][ni][i];
          }
    }, bid, nb, sm);
}

DI void phase_w_o(const u16* __restrict__ CC, const u16* __restrict__ Wo, float* x, const u16* __restrict__ xb, int bid, int nb, u16* sm) {
  const int lane = tidx() & 63, wave = tidx() >> 6, wm = wave >> 1, wn = wave & 1, r = lane & 31, hh = lane >> 5;
  gemm_phase_init(512, 8, 1024, 1024, 1024,
    [&](int tm) { return CC + (size_t)tm * 128 * 1024; }, [&](int tn) { return Wo + (size_t)tn * 128 * 1024; },
    [&](f32x16 (&acc)[2][2], int tm, int tn) {
#pragma unroll
      for (int mi = 0; mi < 2; mi++)
#pragma unroll
        for (int ni = 0; ni < 2; ni++)
#pragma unroll
          for (int i = 0; i < 16; i++) {
            const size_t o = (size_t)(tm * 128 + wm * 64 + mi * 32 + crow(i, hh)) * 1024 + tn * 128 + wn * 64 + ni * 32 + r;
            acc[mi][ni][i] = ALPHA_ * bf2f(xb[o]);
          }
    },
    [&](f32x16 (&acc)[2][2], int tm, int tn) {
#pragma unroll
      for (int mi = 0; mi < 2; mi++)
#pragma unroll
        for (int ni = 0; ni < 2; ni++)
#pragma unroll
          for (int i = 0; i < 16; i++) {
            const size_t o = (size_t)(tm * 128 + wm * 64 + mi * 32 + crow(i, hh)) * 1024 + tn * 128 + wn * 64 + ni * 32 + r;
            x[o] = acc[mi][ni][i];
          }
    }, bid, nb, sm);
}

DI void phase_glu(const u16* __restrict__ Yg, const u16* __restrict__ Wglu, u16* __restrict__ CC, int bid, int nb, u16* sm) {
  const int lane = tidx() & 63, wave = tidx() >> 6, wm = wave >> 1, wn = wave & 1, r = lane & 31, hh = lane >> 5;
  gemm_phase(512, 2, 256, 256, 256,
    [&](int tm) { return Yg + (size_t)tm * 128 * 256; }, [&](int tn) { return Wglu + (size_t)tn * 128 * 256; },
    [&](f32x16 (&acc)[2][2], int tm, int tn) {
#pragma unroll
      for (int mi = 0; mi < 2; mi++)
#pragma unroll
        for (int ni = 0; ni < 2; ni++)
#pragma unroll
          for (int i = 0; i < 16; i++) {
            const int row = tm * 128 + wm * 64 + mi * 32 + crow(i, hh), col = tn * 128 + wn * 64 + ni * 32 + r;
            const float y = bf2f(Yg[(size_t)row * 256 + col]);
            CC[(size_t)row * 1024 + 512 + col] = f2bf(y * sigmoidf_(acc[mi][ni][i]));
          }
    }, bid, nb, sm);
}

DI void phase_ple(const u16* __restrict__ Xb, const u16* __restrict__ Wpg, const u16* __restrict__ Pb, const u16* __restrict__ Wpp, u16* ple, int bid, int nb, u16* sm) {
  const int lane = tidx() & 63, wave = tidx() >> 6, wm = wave >> 1, wn = wave & 1, r = lane & 31, hh = lane >> 5;
  gemm_phase(512, 8, 1024, 1024, 1024,
    [&](int tm) { return Xb + (size_t)tm * 128 * 1024; }, [&](int tn) { return Wpg + (size_t)tn * 128 * 1024; },
    [&](f32x16 (&acc)[2][2], int tm, int tn) {
#pragma unroll
      for (int mi = 0; mi < 2; mi++)
#pragma unroll
        for (int ni = 0; ni < 2; ni++)
#pragma unroll
          for (int i = 0; i < 16; i++) {
            const size_t o = (size_t)(tm * 128 + wm * 64 + mi * 32 + crow(i, hh)) * 1024 + tn * 128 + wn * 64 + ni * 32 + r;
            ple[o] = f2bf(sigmoidf_(acc[mi][ni][i]));
          }
    }, bid, nb, sm);
  gemm_phase(512, 8, 256, 256, 256,
    [&](int tm) { return Pb + (size_t)tm * 128 * 256; }, [&](int tn) { return Wpp + (size_t)tn * 128 * 256; },
    [&](f32x16 (&acc)[2][2], int tm, int tn) {
#pragma unroll
      for (int mi = 0; mi < 2; mi++)
#pragma unroll
        for (int ni = 0; ni < 2; ni++)
#pragma unroll
          for (int i = 0; i < 16; i++) {
            const size_t o = (size_t)(tm * 128 + wm * 64 + mi * 32 + crow(i, hh)) * 1024 + tn * 128 + wn * 64 + ni * 32 + r;
            ple[o] = f2bf(acc[mi][ni][i] * bf2f(ple[o]));
          }
    }, bid, nb, sm);
}

DI void phase_w_in(const u16* __restrict__ Xb, const u16* __restrict__ Win, char* mb, int bid, int nb, u16* sm) {
  const int lane = tidx() & 63, wave = tidx() >> 6, wm = wave >> 1, wn = wave & 1, r = lane & 31, hh = lane >> 5;
  u16* Qd = (u16*)(mb + M_QD); u16* Kd = (u16*)(mb + M_KD); u16* Vt = (u16*)(mb + M_VT); float* U = (float*)(mb + M_U);
  u16* Qs = (u16*)(mb + M_QS); u16* Qi = (u16*)(mb + M_QI); u16* Ks = (u16*)(mb + M_KS); u16* Vs = (u16*)(mb + M_VS);
  u16* Ki = (u16*)(mb + M_KI); float* Wi = (float*)(mb + M_WI);
  gemm_phase(512, 20, 1024, 1024, 1024,
    [&](int tm) { return Xb + (size_t)tm * 128 * 1024; }, [&](int tn) { return Win + (size_t)tn * 128 * 1024; },
    [&](f32x16 (&acc)[2][2], int tm, int tn) {
#pragma unroll
    for (int ni = 0; ni < 2; ni++) {
      const int c0 = tn * 128 + wn * 64 + ni * 32;
      const int c = c0 + r;
#pragma unroll
      for (int mi = 0; mi < 2; mi++) {
        const int rowb = tm * 128 + wm * 64 + mi * 32;
        if (c0 >= 1024 && c0 < 1536) {
          const int cc = c - 1024, head = cc >> 7, dv = cc & 127;
          const int b = rowb >> 13, t0 = rowb & 8191;
#pragma unroll
          for (int g4 = 0; g4 < 4; g4++) {
            uint2 v = make_uint2(pack2(acc[mi][ni][4 * g4], acc[mi][ni][4 * g4 + 1]), pack2(acc[mi][ni][4 * g4 + 2], acc[mi][ni][4 * g4 + 3]));
            const int tt = t0 + 8 * g4 + 4 * hh;
            *(uint2*)(Vt + ((size_t)(((b * 4 + head) * 128 + (tt >> 6)) * 128 + dv)) * 64 + (tt & 63)) = v;
          }
        } else {
#pragma unroll
          for (int i = 0; i < 16; i++) {
            const size_t row = rowb + crow(i, hh);
            const float v = acc[mi][ni][i];
            if (c0 < 512) Qd[row * 512 + c] = f2bf(v);
            else if (c0 < 1024) {
              const int cc = c - 512;
              Kd[((size_t)((((int)(row >> 13) * 4 + (cc >> 7)) * 2 + ((cc >> 6) & 1))) * L_ + (row & 8191)) * 64 + (cc & 63)] = f2bf(v);
            }
            else if (c0 < 1792) U[row * 256 + (c - 1536)] = v;
            else if (c0 < 2048) Qs[row * 256 + (c - 1792)] = f2bf(v);
            else if (c0 < 2112) Ks[row * 64 + (c - 2048)] = f2bf(v);
            else if (c0 < 2176) Vs[row * 64 + (c - 2112)] = f2bf(v);
            else if (c0 < 2432) Qi[row * 256 + (c - 2176)] = f2bf(v);
            else if (c0 < 2464) Ki[row * 32 + (c - 2432)] = f2bf(v);
            else if (c0 == 2464) { if (r < 8) Wi[row * 8 + r] = v * 0.0625f; }
          }
        }
      }
    }
  }, bid, nb, sm);
}

DI void phase_ln(float* x, u16* __restrict__ xb, const float* __restrict__ g, const float* __restrict__ bta, bool write_f32, int bid, int nb) {
  const int lane = tidx() & 63, wave = tidx() >> 6;
  float4 gg[4], bb[4];
#pragma unroll
  for (int i = 0; i < 4; i++) { gg[i] = *(const float4*)(g + i * 256 + lane * 4); bb[i] = *(const float4*)(bta + i * 256 + lane * 4); }
  constexpr int RB = 4;
  for (int row0 = (bid * 4 + wave) * RB; row0 < T_; row0 += nb * 4 * RB) {
    float4 v[RB][4];
#pragma unroll
    for (int rr = 0; rr < RB; rr++)
#pragma unroll
      for (int i = 0; i < 4; i++) v[rr][i] = *(const float4*)(x + (size_t)(row0 + rr) * 1024 + i * 256 + lane * 4);
    float s[RB], q[RB];
#pragma unroll
    for (int rr = 0; rr < RB; rr++) {
      s[rr] = 0.f;
#pragma unroll
      for (int i = 0; i < 4; i++) s[rr] += v[rr][i].x + v[rr][i].y + v[rr][i].z + v[rr][i].w;
    }
#pragma unroll
    for (int o = 32; o > 0; o >>= 1)
#pragma unroll
      for (int rr = 0; rr < RB; rr++) s[rr] += __shfl_xor(s[rr], o);
#pragma unroll
    for (int rr = 0; rr < RB; rr++) {
      const float mu = s[rr] * (1.f / 1024.f);
      q[rr] = 0.f;
#pragma unroll
      for (int i = 0; i < 4; i++) {
        v[rr][i].x -= mu; v[rr][i].y -= mu; v[rr][i].z -= mu; v[rr][i].w -= mu;
        q[rr] += v[rr][i].x * v[rr][i].x + v[rr][i].y * v[rr][i].y + v[rr][i].z * v[rr][i].z + v[rr][i].w * v[rr][i].w;
      }
    }
#pragma unroll
    for (int o = 32; o > 0; o >>= 1)
#pragma unroll
      for (int rr = 0; rr < RB; rr++) q[rr] += __shfl_xor(q[rr], o);
#pragma unroll
    for (int rr = 0; rr < RB; rr++) {
      const float rs = rsqrtf(q[rr] * (1.f / 1024.f) + LN_EPS_);
#pragma unroll
      for (int i = 0; i < 4; i++) {
        float4 o;
        o.x = v[rr][i].x * rs * gg[i].x + bb[i].x; o.y = v[rr][i].y * rs * gg[i].y + bb[i].y;
        o.z = v[rr][i].z * rs * gg[i].z + bb[i].z; o.w = v[rr][i].w * rs * gg[i].w + bb[i].w;
        if (write_f32) *(float4*)(x + (size_t)(row0 + rr) * 1024 + i * 256 + lane * 4) = o;
        *(uint2*)(xb + (size_t)(row0 + rr) * 1024 + i * 256 + lane * 4) = make_uint2(pack2(o.x, o.y), pack2(o.z, o.w));
      }
    }
  }
}

DI float gelu_tanh(float x) { const float u = 0.7978845608028654f * (x + 0.044715f * x * x * x); return 0.5f * x * (1.f + tanhf(u)); }

typedef __attribute__((ext_vector_type(4))) float f32x4;
template <bool OUT>
DI void ssm_scan(const Params& P, int layer, int widx, char* mb, char* smem) {
  const int lane = tidx() & 63, wave = tidx() >> 6;
  const int b = widx >> 8, g = (widx >> 4) & 15, ch = widx & 15;
  const int gi = (layer * 16 + g) * 64 + lane;
  const float4 ca = ((const float4*)(WS(P) + OFF_COEFA))[gi];
  const float2* cbp = (const float2*)(WS(P) + OFF_COEFB) + (size_t)gi * 16;
  float bre[16], bim[16];
#pragma unroll
  for (int c = 0; c < 16; c++) { float2 t = cbp[c]; bre[c] = t.x; bim[c] = t.y; }
  const float* U = (const float*)(mb + M_U);
  float2* Send = (float2*)(mb + M_SEND);
  const size_t sbase = (size_t)((b * 16 + g) * 16) * 64 + lane;
  float xr = 0.f, xi = 0.f;
  float am[32];
  float4 dsk4 = make_float4(0.f, 0.f, 0.f, 0.f);
  float* Xs = (float*)smem + wave * (128 * 17);
  const int lm = lane & 15, lq = lane >> 4;
  if (OUT) {
    for (int j = 0; j < ch; j++) {
      const float2 e = Send[sbase + (size_t)j * 64];
      const float nr = ca.z * xr - ca.w * xi + e.x, ni = ca.z * xi + ca.w * xr + e.y;
      xr = nr; xi = ni;
    }
    const float* cre = INP(P, 20) + ((size_t)(layer * 16 + g) * 16 + lm) * 64;
    const float* cim = INP(P, 21) + ((size_t)(layer * 16 + g) * 16 + lm) * 64;
#pragma unroll
    for (int kb = 0; kb < 32; kb++) {
      const int kk = 4 * kb + lq;
      am[kb] = (kb < 16) ? cre[kk] : -cim[kk - 64];
    }
    dsk4 = *(const float4*)(INP(P, 22) + layer * 256 + g * 16 + 4 * lq);
  }
  u16* Yg = (u16*)(mb + M_YG);
  const size_t tok0 = (size_t)b * L_ + ch * 512;
  const float* ub = U + (tok0 + (lane >> 2)) * 256 + g * 16 + (lane & 3) * 4;
  float4 cur = *(const float4*)ub;
#pragma unroll 1
  for (int blk = 0; blk < 32; blk++) {
    const float4 nxt = *(const float4*)(ub + (size_t)min(blk + 1, 31) * 16 * 256);
    float4 u4 = make_float4(0.f, 0.f, 0.f, 0.f);
    if (OUT) u4 = *(const float4*)(U + (tok0 + blk * 16 + lm) * 256 + g * 16 + 4 * lq);
#pragma unroll
    for (int s16 = 0; s16 < 16; s16++) {
      float uu[16];
#pragma unroll
      for (int c = 0; c < 16; c++) {
        const float comp = ((c & 3) == 0) ? cur.x : ((c & 3) == 1) ? cur.y : ((c & 3) == 2) ? cur.z : cur.w;
        uu[c] = __int_as_float(__builtin_amdgcn_readlane(__float_as_int(comp), 4 * s16 + (c >> 2)));
      }
      float br4[4] = {0.f, 0.f, 0.f, 0.f}, bi4[4] = {0.f, 0.f, 0.f, 0.f};
#pragma unroll
      for (int c = 0; c < 16; c++) { br4[c & 3] += bre[c] * uu[c]; bi4[c & 3] += bim[c] * uu[c]; }
      const float br = (br4[0] + br4[1]) + (br4[2] + br4[3]), bi = (bi4[0] + bi4[1]) + (bi4[2] + bi4[3]);
      const float nr = ca.x * xr - ca.y * xi + br, ni = ca.x * xi + ca.y * xr + bi;
      xr = nr; xi = ni;
      if (OUT) { Xs[lane * 17 + s16] = xr; Xs[(64 + lane) * 17 + s16] = xi; }
    }
    if (OUT) {
      __builtin_amdgcn_wave_barrier();
      f32x4 acc = {0.f, 0.f, 0.f, 0.f}, acc2 = {0.f, 0.f, 0.f, 0.f};
#pragma unroll
      for (int kb = 0; kb < 32; kb += 2) {
        const float bv0 = Xs[(4 * kb + lq) * 17 + lm], bv1 = Xs[(4 * kb + 4 + lq) * 17 + lm];
        acc = __builtin_amdgcn_mfma_f32_16x16x4f32(am[kb], bv0, acc, 0, 0, 0);
        acc2 = __builtin_amdgcn_mfma_f32_16x16x4f32(am[kb + 1], bv1, acc2, 0, 0, 0);
      }
      acc += acc2;
      __builtin_amdgcn_wave_barrier();
      const size_t tok = tok0 + blk * 16 + lm;
      const float y0 = gelu_tanh(acc[0] + dsk4.x * u4.x), y1 = gelu_tanh(acc[1] + dsk4.y * u4.y);
      const float y2 = gelu_tanh(acc[2] + dsk4.z * u4.z), y3 = gelu_tanh(acc[3] + dsk4.w * u4.w);
      *(uint2*)(Yg + tok * 256 + g * 16 + 4 * lq) = make_uint2(pack2(y0, y1), pack2(y2, y3));
    }
    cur = nxt;
  }
  if (!OUT) Send[sbase + (size_t)ch * 64] = make_float2(xr, xi);
}

constexpr int KS_ = 72, VS_ = 68;
DI void da_item(const Params& P, int layer, int b, int h, int qt, char* mb, char* smem) {
  const int tid = tidx(), lane = tid & 63, wave = tid >> 6, r = lane & 31, hh = lane >> 5;
  u16* sK0 = (u16*)smem;
  u16* sV0 = sK0 + 2 * 64 * KS_;
  float* sbias = (float*)(sV0 + 2 * 128 * VS_);
  u16* sQw = (u16*)(smem + 54272) + (tidx() >> 6) * 32 * KS_;
  const u16* Qd = (const u16*)(mb + M_QD); const u16* Kd = (const u16*)(mb + M_KD); const u16* Vt = (const u16*)(mb + M_VT);
  u16* CC = (u16*)(WS(P) + OFF_CC);
  const int q0 = qt * 128, qw = q0 + wave * 32, qp = qw + r;
  const size_t tokq = (size_t)b * L_ + qp;
  __syncthreads();
  if (tid < 129) sbias[tid] = ((const float*)(WS(P) + OFF_BIAS))[h * 129 + tid] * LOG2E_;
  __syncthreads();
  const float bfar = sbias[128];
  const float SC = 0.125f * LOG2E_;
  const int nkt = (q0 + 128) >> 6;
  const float lam = ((const float*)(WS(P) + OFF_LAM))[layer];
  const int krow_l = tid >> 3, kch = (tid & 7) * 8;
#pragma unroll 1
  for (int c = 0; c < 2; c++) {
#pragma unroll
    for (int ks = 0; ks < 4; ks++) *(bf16x8*)(sQw + r * KS_ + ks * 16 + hh * 8) = *(const bf16x8*)(Qd + tokq * 512 + h * 128 + c * 64 + ks * 16 + hh * 8);
    f32x16 o[4] = {zero16(), zero16(), zero16(), zero16()};
    float m = -INFINITY, l = 0.f;
    const u16* Kbase = Kd + ((size_t)(((b * 4 + h) * 2 + c)) * L_ + krow_l) * 64 + kch;
    const u16* Vbase = Vt + ((size_t)((b * 4 + h) * 128) * 128 + krow_l) * 64 + kch;
    u32x4 rk[2], rv[4];
#pragma unroll
    for (int i = 0; i < 2; i++) rk[i] = *(const u32x4*)(Kbase + (size_t)(i * 32) * 64);
#pragma unroll
    for (int i = 0; i < 4; i++) rv[i] = *(const u32x4*)(Vbase + (size_t)(i * 32) * 64);
#define DA_STAGE(BUF) { u16* sKw = sK0 + (BUF) * 64 * KS_; u16* sVw = sV0 + (BUF) * 128 * VS_; \
      _Pragma("unroll") for (int i = 0; i < 2; i++) *(u32x4*)(sKw + (krow_l + i * 32) * KS_ + kch) = rk[i]; \
      _Pragma("unroll") for (int i = 0; i < 4; i++) { u32x2* d = (u32x2*)(sVw + (krow_l + i * 32) * VS_ + kch); \
        u32x2 lo2, hi2; lo2.x = rv[i].x; lo2.y = rv[i].y; hi2.x = rv[i].z; hi2.y = rv[i].w; d[0] = lo2; d[1] = hi2; } }
#define DA_FETCH(T) { const int ktn_ = min((T), nkt - 1); \
      _Pragma("unroll") for (int i = 0; i < 2; i++) rk[i] = *(const u32x4*)(Kbase + (size_t)(ktn_ * 64 + i * 32) * 64); \
      _Pragma("unroll") for (int i = 0; i < 4; i++) rv[i] = *(const u32x4*)(Vbase + (size_t)ktn_ * 8192 + (size_t)(i * 32) * 64); }
    __syncthreads();
    DA_STAGE(0)
    DA_FETCH(1)
    __syncthreads();
#pragma unroll 1
    for (int kt = 0; kt < nkt; kt++) {
      const u16* sK = sK0 + (kt & 1) * 64 * KS_;
      const u16* sV = sV0 + (kt & 1) * 128 * VS_;
      if (kt + 1 < nkt) { DA_STAGE((kt + 1) & 1) }
      DA_FETCH(kt + 2)
      if (kt * 64 <= qw + 31) {
        f32x16 s[2];
#pragma unroll
        for (int kb = 0; kb < 2; kb++) {
          s[kb] = zero16();
#pragma unroll
          for (int ks = 0; ks < 4; ks++) {
            const bf16x8 kf = *(const bf16x8*)(sK + (kb * 32 + r) * KS_ + ks * 16 + hh * 8);
            const bf16x8 qf = *(const bf16x8*)(sQw + r * KS_ + ks * 16 + hh * 8);
            s[kb] = MFMA32(kf, qf, s[kb]);
          }
        }
        const bool nearb = (kt * 64 + 63 + 128 > qw);
        float mx = -INFINITY;
        if (nearb) {
#pragma unroll
          for (int kb = 0; kb < 2; kb++)
#pragma unroll
            for (int i = 0; i < 16; i++) {
              const int dist = qp - (kt * 64 + kb * 32 + crow(i, hh));
              const float bv = sbias[min(max(dist, 0), 128)];
              float t = s[kb][i] * SC + bv;
              t = (dist >= 0) ? t : -INFINITY;
              s[kb][i] = t; mx = fmaxf(mx, t);
              if ((i & 7) == 7) __builtin_amdgcn_sched_barrier(0);
            }
        } else {
#pragma unroll
          for (int kb = 0; kb < 2; kb++)
#pragma unroll
            for (int i = 0; i < 16; i++) { const float t = s[kb][i] * SC + bfar; s[kb][i] = t; mx = fmaxf(mx, t); }
        }
        mx = fmaxf(mx, __shfl_xor(mx, 32));
        const float mn = fmaxf(m, mx);
        const float corr = __builtin_amdgcn_exp2f(m - mn);
        m = mn;
        float ls = 0.f;
#pragma unroll
        for (int kb = 0; kb < 2; kb++)
#pragma unroll
          for (int i = 0; i < 16; i++) { const float p = __builtin_amdgcn_exp2f(s[kb][i] - mn); s[kb][i] = p; ls += p; }
        l = l * corr + ls;
        if (__ballot(corr != 1.f) != 0ull) {
#pragma unroll
          for (int dt = 0; dt < 4; dt++)
#pragma unroll
            for (int i = 0; i < 16; i++) o[dt][i] *= corr;
        }
#pragma unroll
        for (int kb = 0; kb < 2; kb++)
#pragma unroll
          for (int s2 = 0; s2 < 2; s2++) {
            const bf16x8 pf = pack8(s[kb], s2);
#pragma unroll
            for (int dt = 0; dt < 4; dt++) {
              const u16* vp = sV + (dt * 32 + r) * VS_ + kb * 32 + s2 * 16 + 4 * hh;
              const s16x4 lo = *(const s16x4*)vp, hi = *(const s16x4*)(vp + 8);
              const bf16x8 vf = __builtin_shufflevector(lo, hi, 0, 1, 2, 3, 4, 5, 6, 7);
              o[dt] = MFMA32(vf, pf, o[dt]);
            }
            __builtin_amdgcn_sched_barrier(0);
          }
      }
      __syncthreads();
    }
#undef DA_STAGE
#undef DA_FETCH
    const float lt = l + __shfl_xor(l, 32);
    const float inv = 1.f / lt;
    size_t tq = tokq;
    asm volatile("" : "+v"(tq));
    u16* obase = CC + tq * 1024 + h * 128 + 4 * hh;
    if (c == 0) {
#pragma unroll
      for (int dt = 0; dt < 4; dt++)
#pragma unroll
        for (int g4 = 0; g4 < 4; g4++) {
          *(uint2*)(obase + dt * 32 + 8 * g4) = make_uint2(pack2(o[dt][4 * g4] * inv, o[dt][4 * g4 + 1] * inv), pack2(o[dt][4 * g4 + 2] * inv, o[dt][4 * g4 + 3] * inv));
        }
    } else {
      float ss = 0.f;
#pragma unroll
      for (int dt = 0; dt < 4; dt++)
#pragma unroll
        for (int g4 = 0; g4 < 4; g4++) {
          const uint2 pv = *(const uint2*)(obase + dt * 32 + 8 * g4);
          const float a4[4] = {bf2f((u16)(pv.x & 0xffff)), bf2f((u16)(pv.x >> 16)), bf2f((u16)(pv.y & 0xffff)), bf2f((u16)(pv.y >> 16))};
#pragma unroll
          for (int e = 0; e < 4; e++) { const float v = a4[e] - lam * o[dt][4 * g4 + e] * inv; o[dt][4 * g4 + e] = v; ss = __builtin_fmaf(v, v, ss); }
        }
      ss += __shfl_xor(ss, 32);
      const float lam_init = 0.8f - 0.6f * __expf(-0.3f * (float)layer);
      const float rn = rsqrtf(ss * (1.f / 128.f) + LN_EPS_) * (1.f - lam_init);
      int hh2 = hh;
      asm volatile("" : "+v"(hh2));
      const float* sg = INP(P, 14) + layer * 128 + 4 * hh2;
#pragma unroll
      for (int dt = 0; dt < 4; dt++)
#pragma unroll
        for (int g4 = 0; g4 < 4; g4++) {
          const int dv = dt * 32 + 8 * g4 + 4 * hh;
          const float4 gv = *(const float4*)(sg + dt * 32 + 8 * g4);
          uint2 w = make_uint2(pack2(o[dt][4 * g4] * rn * gv.x, o[dt][4 * g4 + 1] * rn * gv.y),
                               pack2(o[dt][4 * g4 + 2] * rn * gv.z, o[dt][4 * g4 + 3] * rn * gv.w));
          *(uint2*)(obase + dv - 4 * hh) = w;
        }
    }
  }
}

DI unsigned sortkey(float f) { const unsigned u = __float_as_uint(f + 0.f); return u ^ (((unsigned)((int)u >> 31)) | 0x80000000u); }

DI void dsa_item(const Params& P, int layer, int b, int qt, char* mb, char* smem) {
  const int tid = tidx(), lane = tid & 63, wave = tid >> 6, r = lane & 31, hh = lane >> 5;
  unsigned* hist = (unsigned*)smem;
  float* sP = (float*)smem;
  float* sQ = (float*)(smem + 16384);
  u16* sidx = (u16*)(smem + 32896);
  unsigned* meta = (unsigned*)(smem + 49280);
  float* sbias = (float*)(smem + 50304);
  const u16* Qi = (const u16*)(mb + M_QI); const u16* Ki = (const u16*)(mb + M_KI); const float* Wi = (const float*)(mb + M_WI);
  const u16* Qs = (const u16*)(mb + M_QS); const u16* Ks = (const u16*)(mb + M_KS); const u16* Vs = (const u16*)(mb + M_VS);
  u16* CC = (u16*)(WS(P) + OFF_CC);
  const int q0 = qt * 32;
  const int qp = q0 + r;
  const size_t tokb = (size_t)b * L_;
  const int nk32 = qt + 1;
  const bool radix = (q0 >= 256);
  __syncthreads();
  for (int i = tid; i < 4 * 129; i += 256) sbias[i] = ((const float*)(WS(P) + OFF_BIAS))[4 * 129 + i];
  meta[tid] = (tid >= 32 && tid < 64) ? 256u : 0u;
  char* sQi = smem + 52384;
  float* sWi = (float*)(smem + 69280);
  constexpr int CAPL_ = 64;
  unsigned* lK = (unsigned*)smem;
  u16* lI = (u16*)(smem + 32 * CAPL_ * 4);
  {
    const int row = tid >> 3, ch = tid & 7;
    const uint4* src = (const uint4*)(Qi + (tokb + q0 + row) * 256 + ch * 32);
    uint4* dst = (uint4*)(sQi + row * 528 + ch * 64);
    dst[0] = src[0]; dst[1] = src[1]; dst[2] = src[2]; dst[3] = src[3];
    sWi[(tid & 7) * 32 + (tid >> 3)] = Wi[(tokb + q0) * 8 + tid];
  }
  int pass = radix ? 0 : 4;
  bool fast = false;
#pragma unroll 1
  while (true) {
    __syncthreads();
    if (pass < 4) { for (int i = tid; i < 32 * 257; i += 256) hist[i] = 0u; }
    __syncthreads();
    const unsigned pref = meta[r];
    const unsigned krem = meta[32 + r];
    auto elems = [&](const f32x16& sc, const int kt, const int lim) __attribute__((always_inline)) {
      if (pass == 0) {
#pragma unroll
        for (int i = 0; i < 16; i++) {
          const int kp = kt * 32 + crow(i, hh);
          const unsigned key = sortkey(sc[i]);
          const unsigned bin = (kp <= lim) ? (key >> 24) : 256u;
          atomicAdd(&hist[r * 257 + bin], 1u);
        }
      } else if (pass < 4) {
        const int sh = 24 - 8 * pass;
#pragma unroll
        for (int i = 0; i < 16; i++) {
          const int kp = kt * 32 + crow(i, hh);
          const unsigned key = sortkey(sc[i]);
          if ((key >> (sh + 8)) == pref && kp <= lim) atomicAdd(&hist[r * 257 + ((key >> sh) & 255u)], 1u);
        }
      } else if (pass == 5) {
        unsigned mc = 0u, ms = 0u;
        unsigned keys[16];
#pragma unroll
        for (int i = 0; i < 16; i++) {
          const int kp = kt * 32 + crow(i, hh);
          keys[i] = sortkey(sc[i]);
          const unsigned bt = keys[i] >> 16;
          const bool valid = (kp <= lim);
          ms |= (valid && bt > pref) ? (1u << i) : 0u;
          mc |= (valid && bt == pref) ? (1u << i) : 0u;
        }
        unsigned base_c = 0u, base_s = 0u;
        if (mc) base_c = atomicAdd(&meta[128 + r], (unsigned)__popc(mc));
        if (ms) base_s = atomicAdd(&meta[64 + r], (unsigned)__popc(ms));
#pragma unroll
        for (int i = 0; i < 16; i++) {
          const int kp = kt * 32 + crow(i, hh);
          if ((mc >> i) & 1u) {
            const unsigned cp = base_c + (unsigned)__popc(mc & ((1u << i) - 1u));
            if (cp < (unsigned)CAPL_) { lK[r * CAPL_ + cp] = keys[i]; lI[r * CAPL_ + cp] = (u16)kp; }
          }
          if ((ms >> i) & 1u) {
            const unsigned pos = base_s + (unsigned)__popc(ms & ((1u << i) - 1u));
            if (pos < 256u) sidx[r * 256 + pos] = (u16)kp;
          }
        }
      } else {
#pragma unroll
        for (int i = 0; i < 16; i++) {
          const int kp = kt * 32 + crow(i, hh);
          const unsigned key = sortkey(sc[i]);
          bool sel = (kp <= lim);
          if (radix) {
            sel = sel && (key >= pref);
            if (sel && key == pref) sel = atomicAdd(&meta[96 + r], 1u) < krem;
          }
          if (sel) { const unsigned pos = atomicAdd(&meta[64 + r], 1u); if (pos < 256u) sidx[r * 256 + pos] = (u16)kp; }
        }
      }
    };
    const int klast = nk32 - 1;
    bf16x8 nA0 = {0, 0, 0, 0, 0, 0, 0, 0}, nA1 = nA0, nB0 = nA0, nB1 = nA0;
    if (wave < nk32) {
      const int ka = wave, kb2 = min(wave + 4, klast);
      nA0 = *(const bf16x8*)(Ki + (tokb + ka * 32 + r) * 32 + hh * 8);
      nA1 = *(const bf16x8*)(Ki + (tokb + ka * 32 + r) * 32 + 16 + hh * 8);
      nB0 = *(const bf16x8*)(Ki + (tokb + kb2 * 32 + r) * 32 + hh * 8);
      nB1 = *(const bf16x8*)(Ki + (tokb + kb2 * 32 + r) * 32 + 16 + hh * 8);
    }
#pragma unroll 1
    for (int kt = wave; kt < nk32; kt += 8) {
      const bf16x8 kA0 = nA0, kA1 = nA1, kB0 = nB0, kB1 = nB1;
      {
        const int ka = min(kt + 8, klast), kb2 = min(kt + 12, klast);
        nA0 = *(const bf16x8*)(Ki + (tokb + ka * 32 + r) * 32 + hh * 8);
        nA1 = *(const bf16x8*)(Ki + (tokb + ka * 32 + r) * 32 + 16 + hh * 8);
        nB0 = *(const bf16x8*)(Ki + (tokb + kb2 * 32 + r) * 32 + hh * 8);
        nB1 = *(const bf16x8*)(Ki + (tokb + kb2 * 32 + r) * 32 + 16 + hh * 8);
      }
      f32x16 scA = zero16(), scB = zero16();
#pragma unroll 2
      for (int hd = 0; hd < 8; hd++) {
        const bf16x8 q0f = *(const bf16x8*)(sQi + r * 528 + hd * 64 + hh * 16);
        const bf16x8 q1f = *(const bf16x8*)(sQi + r * 528 + hd * 64 + 32 + hh * 16);
        const float w = sWi[hd * 32 + r];
        f32x16 sa = MFMA32(kA0, q0f, zero16());
        f32x16 sb = MFMA32(kB0, q0f, zero16());
        sa = MFMA32(kA1, q1f, sa);
        sb = MFMA32(kB1, q1f, sb);
#pragma unroll
        for (int i = 0; i < 16; i++) {
          scA[i] += __int_as_float(max(__float_as_int(sa[i]), 0)) * w;
          scB[i] += __int_as_float(max(__float_as_int(sb[i]), 0)) * w;
        }
      }
      elems(scA, kt, (kt == qt) ? qp : 0x7fffffff);
      if (kt + 4 < nk32) elems(scB, kt + 4, (kt + 4 == qt) ? qp : 0x7fffffff);
    }
    __syncthreads();
    if (pass < 4) {
      for (int j = 0; j < 8; j++) {
        const int qq = wave * 8 + j;
        const unsigned k = meta[32 + qq];
        unsigned c4[4]; unsigned tot = 0;
#pragma unroll
        for (int e = 0; e < 4; e++) { c4[e] = hist[qq * 257 + 255 - 4 * lane - e]; tot += c4[e]; }
        unsigned incl = tot;
        for (int o = 1; o < 64; o <<= 1) { const unsigned t = __shfl_up(incl, o); if (lane >= o) incl += t; }
        unsigned run = incl - tot;
#pragma unroll
        for (int e = 0; e < 4; e++) {
          if (run < k && run + c4[e] >= k) {
            meta[qq] = (meta[qq] << 8) | (unsigned)(255 - 4 * lane - e); meta[32 + qq] = k - run;
            if (pass == 1 && c4[e] > (unsigned)CAPL_) meta[192] = 1u;
          }
          run += c4[e];
        }
      }
    }
    if (pass >= 4) break;
    if (pass == 1) { __syncthreads(); fast = (meta[192] == 0u); pass = fast ? 5 : 2; } else pass++;
  }
  __syncthreads();
  if (fast) {
#pragma unroll 1
    for (int j = 0; j < 8; j++) {
      const int qq = wave * 8 + j;
      const int c = min((int)meta[128 + qq], CAPL_);
      const unsigned k = meta[32 + qq];
      const bool in = lane < c;
      const unsigned mykey = in ? lK[qq * CAPL_ + lane] : 0u;
      const unsigned myidx = in ? (unsigned)lI[qq * CAPL_ + lane] : 0u;
      unsigned rank = 0u;
      for (int t = 0; t < c; t++) {
        const unsigned ok = __shfl(mykey, t);
        rank += (ok > mykey || (ok == mykey && t < lane)) ? 1u : 0u;
      }
      const bool sel = in && (rank < k);
      const unsigned long long m = __ballot(sel);
      const unsigned base = meta[64 + qq];
      if (sel) {
        const unsigned pos = base + (unsigned)__popcll(m & ((1ull << lane) - 1ull));
        if (pos < 256u) sidx[qq * 256 + pos] = (u16)myidx;
      }
      __builtin_amdgcn_wave_barrier();
      if (lane == 0) meta[64 + qq] = base + (unsigned)__popcll(m);
    }
    __syncthreads();
  }
  float* myP = sP + wave * 1024;
  (void)sQ;
  bf16x8 qn[4];
#pragma unroll
  for (int ks = 0; ks < 4; ks++) {
    bf16x8 z = {0, 0, 0, 0, 0, 0, 0, 0};
    if (r < 4) z = *(const bf16x8*)(Qs + (tokb + q0 + wave * 8) * 256 + r * 64 + ks * 16 + hh * 8);
    qn[ks] = z;
  }
#pragma unroll 1
  for (int j = 0; j < 8; j++) {
    const int qq = wave * 8 + j;
    const int qpos = q0 + qq;
    const size_t tok = tokb + qpos;
    const int n = min((int)meta[64 + qq], 256);
    __syncthreads();
    bf16x8 qf[4];
#pragma unroll
    for (int ks = 0; ks < 4; ks++) qf[ks] = qn[ks];
    {
      const size_t tokn = tokb + q0 + wave * 8 + min(j + 1, 7);
#pragma unroll
      for (int ks = 0; ks < 4; ks++) {
        bf16x8 z = {0, 0, 0, 0, 0, 0, 0, 0};
        if (r < 4) z = *(const bf16x8*)(Qs + tokn * 256 + r * 64 + ks * 16 + hh * 8);
        qn[ks] = z;
      }
    }
#pragma unroll 4
    for (int kb = 0; kb < 8; kb++) {
      const int jj = kb * 32 + r;
      const int kidx = (jj < n) ? (int)sidx[qq * 256 + jj] : 0;
      const u16* kp = Ks + (tokb + kidx) * 64 + hh * 8;
      bf16x8 kf[4];
#pragma unroll
      for (int ks = 0; ks < 4; ks++) kf[ks] = *(const bf16x8*)(kp + ks * 16);
      f32x16 sacc = zero16();
#pragma unroll
      for (int ks = 0; ks < 4; ks++) sacc = MFMA32(kf[ks], qf[ks], sacc);
      if (r < 4) {
#pragma unroll
        for (int i = 0; i < 16; i++) myP[(kb * 32 + crow(i, hh)) * 4 + r] = sacc[i];
      }
    }
    __syncthreads();
    float sc[4][4];
#pragma unroll
    for (int rd = 0; rd < 4; rd++) {
      const int jj = rd * 64 + lane;
      const bool valid = jj < n;
      const int kidx = valid ? (int)sidx[qq * 256 + jj] : 0;
      const int dist = min(max(qpos - kidx, 0), 128);
      const float4 d = *(const float4*)(myP + jj * 4);
      sc[rd][0] = valid ? d.x * 0.125f + sbias[0 * 129 + dist] : -INFINITY;
      sc[rd][1] = valid ? d.y * 0.125f + sbias[1 * 129 + dist] : -INFINITY;
      sc[rd][2] = valid ? d.z * 0.125f + sbias[2 * 129 + dist] : -INFINITY;
      sc[rd][3] = valid ? d.w * 0.125f + sbias[3 * 129 + dist] : -INFINITY;
    }
#pragma unroll
    for (int hd = 0; hd < 4; hd++) {
      float mx = fmaxf(fmaxf(sc[0][hd], sc[1][hd]), fmaxf(sc[2][hd], sc[3][hd]));
      mx = wave_max(mx);
      float sm = 0.f;
#pragma unroll
      for (int rd = 0; rd < 4; rd++) { sc[rd][hd] = __expf(sc[rd][hd] - mx); sm += sc[rd][hd]; }
      sm = wave_sum(sm);
      const float inv = 1.f / sm;
#pragma unroll
      for (int rd = 0; rd < 4; rd++) sc[rd][hd] *= inv;
    }
#pragma unroll
    for (int rd = 0; rd < 4; rd++) *(float4*)(myP + (rd * 64 + lane) * 4) = make_float4(sc[rd][0], sc[rd][1], sc[rd][2], sc[rd][3]);
    __syncthreads();
    const int g = lane >> 3, c8 = lane & 7;
    float acc[32];
#pragma unroll
    for (int i = 0; i < 32; i++) acc[i] = 0.f;
#pragma unroll 16
    for (int it = 0; it < 32; it++) {
      const int jj = it * 8 + g;
      const int kidx = (jj < n) ? (int)sidx[qq * 256 + jj] : 0;
      const float4 pj = *(const float4*)(myP + jj * 4);
      const u32x4 vv = *(const u32x4*)(Vs + (tokb + kidx) * 64 + c8 * 8);
      const float vf[8] = {bf2f((u16)(vv.x & 0xffff)), bf2f((u16)(vv.x >> 16)), bf2f((u16)(vv.y & 0xffff)), bf2f((u16)(vv.y >> 16)),
                           bf2f((u16)(vv.z & 0xffff)), bf2f((u16)(vv.z >> 16)), bf2f((u16)(vv.w & 0xffff)), bf2f((u16)(vv.w >> 16))};
#pragma unroll
      for (int e = 0; e < 8; e++) {
        acc[0 * 8 + e] += pj.x * vf[e]; acc[1 * 8 + e] += pj.y * vf[e];
        acc[2 * 8 + e] += pj.z * vf[e]; acc[3 * 8 + e] += pj.w * vf[e];
      }
    }
    const bool b5 = lane & 32, b4 = lane & 16, b3 = lane & 8;
    float w16[16], w8[8], w4[4];
#pragma unroll
    for (int i = 0; i < 16; i++) { const float snd = b5 ? acc[i] : acc[i + 16]; const float rcv = __shfl_xor(snd, 32); w16[i] = (b5 ? acc[i + 16] : acc[i]) + rcv; }
#pragma unroll
    for (int i = 0; i < 8; i++) { const float snd = b4 ? w16[i] : w16[i + 8]; const float rcv = __shfl_xor(snd, 16); w8[i] = (b4 ? w16[i + 8] : w16[i]) + rcv; }
#pragma unroll
    for (int i = 0; i < 4; i++) { const float snd = b3 ? w8[i] : w8[i + 4]; const float rcv = __shfl_xor(snd, 8); w4[i] = (b3 ? w8[i + 4] : w8[i]) + rcv; }
    const int hd = (b5 ? 2 : 0) + (b4 ? 1 : 0);
    *(uint2*)(CC + tok * 1024 + 768 + hd * 64 + c8 * 8 + (b3 ? 4 : 0)) = make_uint2(pack2(w4[0], w4[1]), pack2(w4[2], w4[3]));
  }
}

DI void phase_mix1(const Params& P, int layer, int bid, int nb, char* smem) {
  char* mb = WS(P) + OFF_H;
  for (int w = bid * 4 + (tidx() >> 6); w < 2048; w += nb * 4) ssm_scan<false>(P, layer, w, mb, smem);
  for (int j = 0;; j++) {
    const int idx = (j & 1) ? (j * nb + (nb - 1 - bid)) : (j * nb + bid);
    if (j * nb >= 2048) break;
    if (idx >= 2048) continue;
    const int qt = 255 - (idx >> 3), b = idx & 7;
    dsa_item(P, layer, b, qt, mb, smem);
  }
  for (int j = 0;; j++) {
    const int idx = (j & 1) ? (j * nb + (nb - 1 - bid)) : (j * nb + bid);
    if (j * nb >= 2048) break;
    if (idx >= 2048) continue;
    const int qt = 63 - (idx >> 5), bh = idx & 31;
    da_item(P, layer, bh >> 2, bh & 3, qt, mb, smem);
  }
}

DI void phase_mix2(const Params& P, int layer, int bid, int nb, char* smem) {
  char* mb = WS(P) + OFF_H;
  for (int w = bid * 4 + (tidx() >> 6); w < 2048; w += nb * 4) ssm_scan<true>(P, layer, w, mb, smem);
}

DI void run_phase(const Params& P, int ph, int bid, int nb, char* smem) {
  char* ws = WS(P);
  u16* sm = (u16*)smem;
  if (ph == 0) { phase_prep(P, bid, nb, smem); return; }
  const int l = (ph - 1) / 12, s = (ph - 1) % 12;
  u16* Xb = (u16*)(ws + OFF_XB);
  u16* H = (u16*)(ws + OFF_H);
  u16* CC = (u16*)(ws + OFF_CC);
  float* X = OUTP(P);
  switch (s) {
    case 0: phase_ffn_up(Xb, (const u16*)(ws + OFF_WGU1 + l * SZ_WGU), H, bid, nb, sm); break;
    case 1: phase_ffn_down(H, (const u16*)(ws + OFF_WD1 + l * SZ_WD), (l == 0) ? INP(P, 0) : (const float*)nullptr, Xb, X, nullptr, bid, nb, sm); break;
    case 2: phase_ln(X, Xb, INP(P, 6) + l * 1024, INP(P, 7) + l * 1024, false, bid, nb); break;
    case 3: phase_w_in(Xb, (const u16*)(ws + OFF_WIN + l * SZ_WIN), ws + OFF_H, bid, nb, sm); break;
    case 4: phase_mix1(P, l, bid, nb, smem); break;
    case 5: phase_mix2(P, l, bid, nb, smem); break;
    case 6: phase_glu((const u16*)(ws + OFF_H + M_YG), (const u16*)(ws + OFF_WGLU + l * SZ_WGLU), CC, bid, nb, sm); break;
    case 7: phase_w_o(CC, (const u16*)(ws + OFF_WO + l * SZ_WO), X, Xb, bid, nb, sm); break;
    case 8: phase_ln(X, Xb, INP(P, 24) + l * 1024, INP(P, 25) + l * 1024, false, bid, nb); break;
    case 9:
      phase_ffn_up(Xb, (const u16*)(ws + OFF_WGU2 + l * SZ_WGU), H, bid, nb, sm);
      phase_ple(Xb, (const u16*)(ws + OFF_WPG + l * SZ_WPG), (const u16*)(ws + OFF_PB) + (size_t)l * T_ * 256, (const u16*)(ws + OFF_WPP + l * SZ_WPP), CC, bid, nb, sm);
      break;
    case 10: phase_ffn_down(H, (const u16*)(ws + OFF_WD2 + l * SZ_WD), (const float*)nullptr, Xb, X, CC, bid, nb, sm); break;
    case 11: phase_ln(X, Xb, INP(P, 31) + l * 1024, INP(P, 32) + l * 1024, l == 1, bid, nb); break;
  }
}

#define XB_TMO      128
#define XB_XCNT(j)  (256  + 64 * (j))
#define XB_XSUB(j)  (1280 + 64 * (j))
#define XB_XGEN(j)  (2304 + 64 * (j))
#define XB_TOP      3328
#define XB_TOPGEN   3392
#define XCD_BAR_WORDS 3456
#define XB_SPIN_CAP (1u << 22)
#define LAS __attribute__((address_space(3)))

__device__ __forceinline__ unsigned xb_ld(unsigned* p)              { return __hip_atomic_load(p, __ATOMIC_RELAXED, __HIP_MEMORY_SCOPE_AGENT); }
__device__ __forceinline__ unsigned xb_add(unsigned* p, unsigned v) { return __hip_atomic_fetch_add(p, v, __ATOMIC_RELAXED, __HIP_MEMORY_SCOPE_AGENT); }
__device__ __forceinline__ unsigned xb_xcc_id() { return (unsigned)__builtin_amdgcn_s_getreg((3 << 11) | 20) & 0xFu; }
#define XB_SPIN(cond, bar) do { unsigned _sp = 0; while (cond) { __builtin_amdgcn_s_sleep(1); \
    if ((++_sp & 255u) == 0u) { if (xb_ld(&(bar)[XB_TMO])) break; if (_sp > XB_SPIN_CAP) { atomicAdd(&(bar)[XB_TMO], 1u); break; } } } } while (0)

struct XcdBarrier {
    unsigned* bar; unsigned x;
    volatile LAS unsigned* st;
};

__device__ __forceinline__ XcdBarrier xcd_barrier_post(unsigned* bar, volatile LAS unsigned* st) {
    XcdBarrier b; b.bar = bar; b.x = xb_xcc_id(); b.st = st;
    if (threadIdx.x == 0) (void)xb_add(&bar[XB_XCNT(b.x)], 1u);
    return b;
}
__device__ __forceinline__ void xcd_barrier_complete(unsigned* bar, unsigned x, unsigned& nloc, unsigned& nx) {
    const unsigned G = gridDim.x * gridDim.y * gridDim.z;
    unsigned sum, cnt, mine, sp = 0u;
    for (;;) {
        sum = 0u; cnt = 0u; mine = 0u;
#pragma unroll
        for (unsigned j = 0; j < 16; ++j) { const unsigned c = xb_ld(&bar[XB_XCNT(j)]); sum += c; cnt += (c > 0u) ? 1u : 0u; mine = (j == x) ? c : mine; }
        if (sum == G) break;
        __builtin_amdgcn_s_sleep(1);
        if ((++sp & 255u) == 0u) { if (xb_ld(&bar[XB_TMO])) break; if (sp > XB_SPIN_CAP) { atomicAdd(&bar[XB_TMO], 1u); break; } }
    }
    nloc = mine > 0u ? mine : 1u; nx = cnt > 0u ? cnt : 1u;
}

__device__ __forceinline__ void xcd_barrier(const XcdBarrier& b) {
    asm volatile("s_waitcnt vmcnt(0)" ::: "memory");
    __syncthreads();
    if (threadIdx.x == 0) {
        unsigned* bar = b.bar;
        __builtin_amdgcn_s_waitcnt(0);
        unsigned nloc = b.st[0], nx = b.st[1];
        if (nloc == 0u) { xcd_barrier_complete(bar, b.x, nloc, nx); b.st[0] = nloc; b.st[1] = nx; }
        const unsigned old = xb_add(&bar[XB_XSUB(b.x)], 1u);
        const unsigned gen = old / nloc;
        if (old + 1u == (gen + 1u) * nloc) {
            __builtin_amdgcn_fence(__ATOMIC_RELEASE, "agent");
            asm volatile("s_waitcnt vmcnt(0)" ::: "memory");
            const unsigned og = xb_add(&bar[XB_TOP], 1u);
            const unsigned tg = og / nx;
            if (og + 1u == (tg + 1u) * nx) xb_add(&bar[XB_TOPGEN], 1u);
            else XB_SPIN(xb_ld(&bar[XB_TOPGEN]) == tg, bar);
            __builtin_amdgcn_fence(__ATOMIC_ACQUIRE, "agent");
            xb_add(&bar[XB_XGEN(b.x)], 1u);
            asm volatile("s_waitcnt vmcnt(0)" ::: "memory");
        } else {
            XB_SPIN(xb_ld(&bar[XB_XGEN(b.x)]) == gen, bar);
            __builtin_amdgcn_fence(__ATOMIC_ACQUIRE, "agent");
            asm volatile("s_waitcnt vmcnt(0)" ::: "memory");
        }
    }
    __syncthreads();
}


constexpr int NPHASES = 25;

__global__ void __launch_bounds__(256, 2) mega(Params P, int ph0, int ph1) {
  extern __shared__ __attribute__((aligned(16))) char smem[];
  cg::grid_group grid = cg::this_grid();
  const int bid = blockIdx.x, nb = gridDim.x;
  volatile LAS unsigned* xst = (volatile LAS unsigned*)(smem + 73712);
  if (threadIdx.x == 0) { xst[0] = 0u; xst[1] = 0u; xst[2] = 0u; xst[3] = 0u; }
  __syncthreads();
  const XcdBarrier xbar = xcd_barrier_post((unsigned*)(P.ws + OFF_XBAR), xst);
#ifndef DUP_MASK
#define DUP_MASK 0
#endif
#define PHASE(k) if (ph0 <= (k) && (k) < ph1) { \
    if ((k) > 0 && ((DUP_MASK >> (((k) - 1) % 12)) & 1)) { run_phase(P, (k), bid, nb, smem); grid.sync(); } \
    run_phase(P, (k), bid, nb, smem); if ((k) + 1 < ph1) { if (ph0 < 0) grid.sync(); else xcd_barrier(xbar); } }
  PHASE(0) PHASE(1) PHASE(2) PHASE(3) PHASE(4) PHASE(5) PHASE(6) PHASE(7) PHASE(8) PHASE(9) PHASE(10) PHASE(11) PHASE(12)
  PHASE(13) PHASE(14) PHASE(15) PHASE(16) PHASE(17) PHASE(18) PHASE(19) PHASE(20) PHASE(21) PHASE(22) PHASE(23) PHASE(24)
#undef PHASE
}

extern "C" void kernel_launch(void* const* d_in, const int* in_sizes, int n_in, void* d_out, int out_size, void* d_ws, size_t ws_size, hipStream_t stream) {
  static int grid_blocks = 0;
  if (grid_blocks == 0) {
    if (n_in != 33 || ws_size < WS_END) { fprintf(stderr, "kernel_launch: need 33 inputs and %zu bytes of ws (got %d, %zu)\n", (size_t)WS_END, n_in, ws_size); grid_blocks = -1; return; }
    int dev = 0, cus = 0, per_cu = 0;
    (void)hipGetDevice(&dev);
    (void)hipDeviceGetAttribute(&cus, hipDeviceAttributeMultiprocessorCount, dev);
    (void)hipFuncSetAttribute((const void*)mega, hipFuncAttributeMaxDynamicSharedMemorySize, LDS_BYTES);
    (void)hipOccupancyMaxActiveBlocksPerMultiprocessor(&per_cu, (const void*)mega, 256, LDS_BYTES);
    if (per_cu < 1) per_cu = 1;
    if (per_cu > 2) per_cu = 2;
    grid_blocks = cus * per_cu;
    fprintf(stderr, "kernel_launch: cus %d per_cu %d grid %d\n", cus, per_cu, grid_blocks);
  }
  if (grid_blocks < 0) return;
  Params p;
  memset(&p, 0, sizeof(p));
  for (int i = 0; i < 33; i++) p.in[i] = (const float*)d_in[i];
  p.out = (float*)d_out;
  p.ws = (char*)d_ws;
#if MULTI_LAUNCH
  for (int ph = 0; ph < NPHASES; ph++) {
    hipLaunchKernelGGL(mega, dim3(grid_blocks), dim3(256), LDS_BYTES, stream, p, ph, ph + 1);
  }
#else
  int ph0 = 0, ph1 = NPHASES;
  (void)hipMemsetAsync((char*)d_ws + OFF_XBAR, 0, XCD_BAR_WORDS * 4, stream);
  void* args[] = {&p, &ph0, &ph1};
  hipError_t e = hipLaunchCooperativeKernel((const void*)mega, dim3(grid_blocks), dim3(256), args, LDS_BYTES, stream);
  if (e != hipSuccess) fprintf(stderr, "cooperative launch failed: %s (grid %d)\n", hipGetErrorString(e), grid_blocks);
#endif
}
```
